# Optimizing an MI355X kernel written in HIP

```python
import math
import jax, jax.numpy as jnp
from jax import lax
import numpy as np

D_MODEL = 1024
BATCH = 8
SEQ = 2048
DEPTH = 1

HEAD_DIM = 64
SCALE = HEAD_DIM ** -0.5
Q_BLOCK = 128
NSA_HEADS = 8
NSA_KV_GROUPS = 2
NSA_HPG = NSA_HEADS // NSA_KV_GROUPS
CMP_BLOCK = 32
CMP_STRIDE = 16
CMP_HIDDEN = 256
SLC_BLOCK = 64
SLC_TOP_N = 16
SLC_Q_CHUNK = 32
WINDOW = 512
FORCE_SCORE = 1e4
DIFF_HEADS = 4
DIFF_V_DIM = 2 * HEAD_DIM
REL_BUCKETS = 32
REL_MAX_DIST = 128
N_ATTN_HEADS = NSA_HEADS + DIFF_HEADS
N_GROUPS = 4
EXPERTS_PER_GROUP = 4
N_EXPERTS = N_GROUPS * EXPERTS_PER_GROUP
TOP_K_IN_GROUP = 2
EXPERT_HIDDEN = 512
COL_NSA_Q = NSA_HEADS * HEAD_DIM
COL_NSA_KV = 3 * 2 * NSA_KV_GROUPS * HEAD_DIM
COL_NSA_GATE = 3 * NSA_HEADS
COL_DIFF_Q = DIFF_HEADS * 2 * HEAD_DIM
COL_DIFF_K = DIFF_HEADS * 2 * HEAD_DIM
COL_DIFF_V = DIFF_HEADS * DIFF_V_DIM
COL_MERGE = 2 * D_MODEL
IN_COLS = COL_NSA_Q + COL_NSA_KV + COL_NSA_GATE + COL_DIFF_Q + COL_DIFF_K + COL_DIFF_V + COL_MERGE
RMS_EPS = 1e-6
NEG = -1e30

kernel_name = "hybrid_nsa_diffattn_hmoe_block"


def rms_norm(x, g):
    xf = x.astype(jnp.float32)
    y = xf * lax.rsqrt(jnp.mean(xf * xf, axis=-1, keepdims=True) + RMS_EPS)
    return (y * g.astype(jnp.float32)).astype(x.dtype)


def masked_softmax(logits, mask):
    logits = jnp.where(mask, logits.astype(jnp.float32), NEG)
    p = jax.nn.softmax(logits, axis=-1)
    return p * jnp.any(mask, axis=-1, keepdims=True)


def t5_bucket(dist):
    n = jnp.maximum(dist, 0)
    max_exact = REL_BUCKETS // 2
    nf = jnp.maximum(n, 1).astype(jnp.float32)
    large = max_exact + (jnp.log(nf / max_exact) / math.log(REL_MAX_DIST / max_exact)
                         * (REL_BUCKETS - max_exact)).astype(jnp.int32)
    large = jnp.minimum(large, REL_BUCKETS - 1)
    return jnp.where(n < max_exact, n, large)


def nsa_compress(tok, pos_emb, w1, w2):
    B, S, G, dh = tok.shape
    n_cmp = (S - CMP_BLOCK) // CMP_STRIDE + 1
    idx = np.arange(n_cmp)[:, None] * CMP_STRIDE + np.arange(CMP_BLOCK)[None, :]
    blocks = tok[:, idx] + pos_emb[:, None, :]
    blocks = blocks.transpose(0, 1, 3, 2, 4).reshape(B, n_cmp, G, CMP_BLOCK * dh)
    return jax.nn.gelu(blocks @ w1) @ w2


def nsa_compressed_attention(q, k_cmp, v_cmp, tbl):
    S = q.shape[1]
    n_cmp = k_cmp.shape[1]
    block_end = jnp.arange(n_cmp) * CMP_STRIDE + CMP_BLOCK - 1
    dist = jnp.arange(S)[:, None] - block_end[None, :]
    mask = dist >= 0
    bias = tbl[:, :, t5_bucket(dist)]
    logits = jnp.einsum('bsghd,bngd->bghsn', q, k_cmp) * SCALE + bias
    p = masked_softmax(logits, mask)
    o = jnp.einsum('bghsn,bngd->bsghd', p.astype(v_cmp.dtype), v_cmp)
    return o, p


def nsa_select_blocks(p_cmp):
    S, n_cmp = p_cmp.shape[3], p_cmp.shape[4]
    n_slc = S // SLC_BLOCK
    c_start = np.arange(n_cmp) * CMP_STRIDE
    s_start = np.arange(n_slc) * SLC_BLOCK
    lo = np.maximum(s_start[:, None], c_start[None, :])
    hi = np.minimum(s_start[:, None] + SLC_BLOCK, c_start[None, :] + CMP_BLOCK)
    overlap = (np.maximum(hi - lo, 0) / CMP_BLOCK).astype(np.float32)
    imp = jnp.einsum('bghsn,jn->bgsj', p_cmp, jnp.asarray(overlap))
    blk = jnp.arange(n_slc)[None, :]
    cur = (jnp.arange(S) // SLC_BLOCK)[:, None]
    valid = blk <= cur
    forced = (blk == 0) | (blk == cur) | (blk == cur - 1)
    score = jnp.where(valid, imp + jnp.where(forced, FORCE_SCORE, 0.0), NEG)
    _, idx = lax.top_k(score, min(SLC_TOP_N, n_slc))
    return idx


def nsa_selected_attention(q, k_slc, v_slc, sel_idx, tbl):
    B, S, G, Hg, dh = q.shape
    n_slc = S // SLC_BLOCK
    k_blocks = k_slc.reshape(B, n_slc, SLC_BLOCK, G, dh).transpose(0, 3, 1, 2, 4)
    v_blocks = v_slc.reshape(B, n_slc, SLC_BLOCK, G, dh).transpose(0, 3, 1, 2, 4)
    q_g = q.transpose(0, 2, 3, 1, 4)
    b_ix = jnp.arange(B)[:, None, None, None]
    g_ix = jnp.arange(G)[None, :, None, None]
    tg = jnp.arange(G)[None, :, None, None, None, None]
    th = jnp.arange(Hg)[None, None, :, None, None, None]
    in_block = jnp.arange(SLC_BLOCK)
    n_keys = sel_idx.shape[-1] * SLC_BLOCK

    def chunk(c):
        s0 = c * SLC_Q_CHUNK
        qc = lax.dynamic_slice_in_dim(q_g, s0, SLC_Q_CHUNK, axis=3)
        ic = lax.dynamic_slice_in_dim(sel_idx, s0, SLC_Q_CHUNK, axis=2)
        kc = k_blocks[b_ix, g_ix, ic]
        vc = v_blocks[b_ix, g_ix, ic]
        tq = s0 + jnp.arange(SLC_Q_CHUNK)
        dist = tq[None, None, :, None, None] - (ic[..., None] * SLC_BLOCK + in_block)
        bias = tbl[tg, th, t5_bucket(dist)[:, :, None]]
        logits = jnp.einsum('bghqd,bgqnld->bghqnl', qc, kc) * SCALE + bias
        p = masked_softmax(logits.reshape(B, G, Hg, SLC_Q_CHUNK, n_keys),
                           (dist >= 0).reshape(B, G, 1, SLC_Q_CHUNK, n_keys))
        return jnp.einsum('bghqm,bgqmd->bghqd', p.astype(vc.dtype),
                          vc.reshape(B, G, SLC_Q_CHUNK, n_keys, dh))

    out = lax.map(chunk, jnp.arange(S // SLC_Q_CHUNK))
    return out.transpose(1, 0, 4, 2, 3, 5).reshape(B, S, G, Hg, dh)


def nsa_window_attention(q, k_win, v_win, tbl):
    B, S, G, Hg, dh = q.shape
    q_g = q.transpose(0, 2, 3, 1, 4)
    pad = ((0, 0), (WINDOW, 0), (0, 0), (0, 0))
    kp = jnp.pad(k_win, pad)
    vp = jnp.pad(v_win, pad)
    span = WINDOW + Q_BLOCK
    r = jnp.arange(span)
    dist = jnp.arange(Q_BLOCK)[:, None] - (r[None, :] - WINDOW)
    in_band = (dist >= 0) & (dist < WINDOW)
    bias = tbl[:, :, t5_bucket(dist)]

    def block(i):
        s0 = i * Q_BLOCK
        qb = lax.dynamic_slice_in_dim(q_g, s0, Q_BLOCK, axis=3)
        kb = lax.dynamic_slice_in_dim(kp, s0, span, axis=1)
        vb = lax.dynamic_slice_in_dim(vp, s0, span, axis=1)
        mask = in_band & (s0 - WINDOW + r >= 0)[None, :]
        logits = jnp.einsum('bghqd,bkgd->bghqk', qb, kb) * SCALE + bias
        p = masked_softmax(logits, mask)
        return jnp.einsum('bghqk,bkgd->bghqd', p.astype(vb.dtype), vb)

    out = lax.map(block, jnp.arange(S // Q_BLOCK))
    return out.transpose(1, 0, 4, 2, 3, 5).reshape(B, S, G, Hg, dh)


def diff_attention(q1, q2, k1, k2, v, lam, tbl):
    B, S, H, _ = q1.shape
    kpos = jnp.arange(S)

    def block(i):
        s0 = i * Q_BLOCK
        dist = (s0 + jnp.arange(Q_BLOCK))[:, None] - kpos[None, :]
        mask = dist >= 0
        bias = tbl[:, t5_bucket(dist)]
        q1b = lax.dynamic_slice_in_dim(q1, s0, Q_BLOCK, axis=1)
        q2b = lax.dynamic_slice_in_dim(q2, s0, Q_BLOCK, axis=1)
        a1 = masked_softmax(jnp.einsum('bqhd,bkhd->bhqk', q1b, k1) * SCALE + bias, mask)
        a2 = masked_softmax(jnp.einsum('bqhd,bkhd->bhqk', q2b, k2) * SCALE + bias, mask)
        attn = a1 - lam * a2
        return jnp.einsum('bhqk,bkhe->bqhe', attn.astype(v.dtype), v)

    out = lax.map(block, jnp.arange(S // Q_BLOCK))
    return out.transpose(1, 0, 2, 3, 4).reshape(B, S, H, v.shape[-1])


def mixer_layer(h, w_in, nsa_q_norm, nsa_k_norm, cmp_pos, cmp_w1, cmp_w2,
                diff_q_norm, diff_k_norm, diff_lambda, diff_out_norm, rel_bias,
                w_branch_nsa, w_branch_diff, w_out, lambda_init):
    B, S, _ = h.shape
    G, Hg, dh = NSA_KV_GROUPS, NSA_HPG, HEAD_DIM
    proj = h @ w_in
    sizes = (COL_NSA_Q, COL_NSA_KV, COL_NSA_GATE, COL_DIFF_Q, COL_DIFF_K, COL_DIFF_V)
    points, acc = [], 0
    for s in sizes:
        acc += s
        points.append(acc)
    q_nsa, kv_nsa, g_nsa, q_diff, k_diff, v_diff, g_merge = jnp.split(proj, points, axis=-1)

    tbl_nsa = rel_bias[:, :NSA_HEADS].T.reshape(G, Hg, REL_BUCKETS)
    tbl_diff = rel_bias[:, NSA_HEADS:].T

    q = rms_norm(q_nsa.reshape(B, S, G, Hg, dh), nsa_q_norm)
    kv = kv_nsa.reshape(B, S, 3, 2, G, dh)
    k_cmp = rms_norm(nsa_compress(kv[:, :, 0, 0], cmp_pos[0], cmp_w1[0], cmp_w2[0]), nsa_k_norm[0])
    v_cmp = nsa_compress(kv[:, :, 0, 1], cmp_pos[1], cmp_w1[1], cmp_w2[1])
    k_slc = rms_norm(kv[:, :, 1, 0], nsa_k_norm[1])
    v_slc = kv[:, :, 1, 1]
    k_win = rms_norm(kv[:, :, 2, 0], nsa_k_norm[2])
    v_win = kv[:, :, 2, 1]
    o_cmp, p_cmp = nsa_compressed_attention(q, k_cmp, v_cmp, tbl_nsa)
    sel_idx = nsa_select_blocks(p_cmp)
    o_slc = nsa_selected_attention(q, k_slc, v_slc, sel_idx, tbl_nsa)
    o_win = nsa_window_attention(q, k_win, v_win, tbl_nsa)
    gates = jax.nn.sigmoid(g_nsa.reshape(B, S, 3, G, Hg, 1))
    o_nsa = gates[:, :, 0] * o_cmp + gates[:, :, 1] * o_slc + gates[:, :, 2] * o_win
    o_nsa = o_nsa.reshape(B, S, NSA_HEADS * dh)

    qd = rms_norm(q_diff.reshape(B, S, DIFF_HEADS, 2, dh), diff_q_norm)
    kd = rms_norm(k_diff.reshape(B, S, DIFF_HEADS, 2, dh), diff_k_norm)
    vd = v_diff.reshape(B, S, DIFF_HEADS, DIFF_V_DIM)
    lam_f = diff_lambda.astype(jnp.float32)
    lam = (jnp.exp(jnp.sum(lam_f[0] * lam_f[1])) - jnp.exp(jnp.sum(lam_f[2] * lam_f[3]))
           + lambda_init)
    o_diff = diff_attention(qd[..., 0, :], qd[..., 1, :], kd[..., 0, :], kd[..., 1, :], vd, lam, tbl_diff)
    o_diff = rms_norm(o_diff, diff_out_norm) * (1.0 - lambda_init)
    o_diff = o_diff.reshape(B, S, DIFF_HEADS * DIFF_V_DIM)

    gm = jax.nn.sigmoid(g_merge.reshape(B, S, 2, D_MODEL))
    y = gm[:, :, 0] * (o_nsa @ w_branch_nsa) + gm[:, :, 1] * (o_diff @ w_branch_diff)
    return y @ w_out


def hier_moe(h, rg_w, rg_b, re_w, re_b, w_gate, w_up, w_down):
    B, S, D = h.shape
    hf = h.reshape(B * S, D)
    n_tok = hf.shape[0]
    g_prob = jax.nn.softmax((hf @ rg_w + rg_b).astype(jnp.float32), axis=-1)
    g_top_p, g_top = lax.top_k(g_prob, 1)
    e_logits = (hf @ re_w + re_b).astype(jnp.float32).reshape(n_tok, N_GROUPS, EXPERTS_PER_GROUP)
    e_in = jnp.take_along_axis(e_logits, g_top[:, :, None], axis=1)[:, 0]
    e_prob = jax.nn.softmax(e_in, axis=-1)
    e_top_p, e_top = lax.top_k(e_prob, TOP_K_IN_GROUP)
    e_top_p = e_top_p / jnp.sum(e_top_p, axis=-1, keepdims=True)
    weights = g_top_p * e_top_p
    expert_id = g_top * EXPERTS_PER_GROUP + e_top
    combine = jnp.sum(jax.nn.one_hot(expert_id, N_EXPERTS, dtype=jnp.float32) * weights[..., None], axis=1)
    combine = combine.astype(hf.dtype)
    hid = jax.nn.silu(jnp.einsum('nd,edf->nef', hf, w_gate)) * jnp.einsum('nd,edf->nef', hf, w_up)
    out = jnp.einsum('nef,efd->nd', hid * combine[:, :, None], w_down)
    return out.reshape(B, S, D)


def setup_inputs(seed: int = 0) -> dict:
    key = jax.random.key(seed)
    ks = jax.random.split(key, 24)
    L, dh = DEPTH, HEAD_DIM

    def nrm(k, shape, scale):
        return jax.random.normal(k, shape, jnp.float32) * scale

    def gain(k, shape):
        return 1.0 + 0.1 * jax.random.normal(k, shape, jnp.float32)

    return {
        "x": nrm(ks[0], (BATCH, SEQ, D_MODEL), 1.0),
        "norm1_g": gain(ks[1], (L, D_MODEL)),
        "w_in": nrm(ks[2], (L, D_MODEL, IN_COLS), D_MODEL ** -0.5),
        "nsa_q_norm": gain(ks[3], (L, dh)),
        "nsa_k_norm": gain(ks[4], (L, 3, dh)),
        "cmp_pos": nrm(ks[5], (L, 2, CMP_BLOCK, dh), 0.1),
        "cmp_w1": nrm(ks[6], (L, 2, CMP_BLOCK * dh, CMP_HIDDEN), (CMP_BLOCK * dh) ** -0.5),
        "cmp_w2": nrm(ks[7], (L, 2, CMP_HIDDEN, dh), CMP_HIDDEN ** -0.5),
        "diff_q_norm": gain(ks[8], (L, 2, dh)),
        "diff_k_norm": gain(ks[9], (L, 2, dh)),
        "diff_lambda": nrm(ks[10], (L, 4, dh), 0.1),
        "diff_out_norm": gain(ks[11], (L, DIFF_V_DIM)),
        "rel_bias": nrm(ks[12], (REL_BUCKETS, N_ATTN_HEADS), 0.2),
        "w_branch_nsa": nrm(ks[13], (L, NSA_HEADS * dh, D_MODEL), (NSA_HEADS * dh) ** -0.5),
        "w_branch_diff": nrm(ks[14], (L, DIFF_HEADS * DIFF_V_DIM, D_MODEL), (DIFF_HEADS * DIFF_V_DIM) ** -0.5),
        "w_out": nrm(ks[15], (L, D_MODEL, D_MODEL), D_MODEL ** -0.5),
        "norm2_g": gain(ks[16], (L, D_MODEL)),
        "router_group_w": nrm(ks[17], (L, D_MODEL, N_GROUPS), D_MODEL ** -0.5),
        "router_group_b": nrm(ks[18], (L, N_GROUPS), 0.01),
        "router_expert_w": nrm(ks[19], (L, D_MODEL, N_EXPERTS), D_MODEL ** -0.5),
        "router_expert_b": nrm(ks[20], (L, N_EXPERTS), 0.01),
        "expert_w_gate": nrm(ks[21], (L, N_EXPERTS, D_MODEL, EXPERT_HIDDEN), D_MODEL ** -0.5),
        "expert_w_up": nrm(ks[22], (L, N_EXPERTS, D_MODEL, EXPERT_HIDDEN), D_MODEL ** -0.5),
        "expert_w_down": nrm(ks[23], (L, N_EXPERTS, EXPERT_HIDDEN, D_MODEL), EXPERT_HIDDEN ** -0.5),
    }


def reference(x, norm1_g, w_in, nsa_q_norm, nsa_k_norm, cmp_pos, cmp_w1, cmp_w2,
              diff_q_norm, diff_k_norm, diff_lambda, diff_out_norm, rel_bias,
              w_branch_nsa, w_branch_diff, w_out, norm2_g, router_group_w,
              router_group_b, router_expert_w, router_expert_b, expert_w_gate,
              expert_w_up, expert_w_down):
    for layer in range(DEPTH):
        lambda_init = 0.8 - 0.6 * math.exp(-0.3 * layer)
        h = rms_norm(x, norm1_g[layer])
        x = x + mixer_layer(h, w_in[layer], nsa_q_norm[layer], nsa_k_norm[layer],
                            cmp_pos[layer], cmp_w1[layer], cmp_w2[layer],
                            diff_q_norm[layer], diff_k_norm[layer], diff_lambda[layer],
                            diff_out_norm[layer], rel_bias, w_branch_nsa[layer],
                            w_branch_diff[layer], w_out[layer], lambda_init)
        h = rms_norm(x, norm2_g[layer])
        x = x + hier_moe(h, router_group_w[layer], router_group_b[layer],
                         router_expert_w[layer], router_expert_b[layer],
                         expert_w_gate[layer], expert_w_up[layer], expert_w_down[layer])
    return x
```

```cpp
#include <hip/hip_runtime.h>
#include <cstdint>
#include <cstdio>

constexpr int NB = 8, S = 2048, D = 1024, T = NB * S;
constexpr int INC = 4888;
constexpr int C_QN = 0, C_KV = 512, C_GN = 1280, C_QD = 1304, C_KD = 1816, C_VD = 2328, C_GM = 2840;
constexpr int NCMP = 127;
constexpr float LAMBDA_INIT = 0.2f;
constexpr float RMS_EPS = 1e-6f;

typedef unsigned short bf16;
#define LAS __attribute__((address_space(3)))

constexpr size_t MiB = 1u << 20;
constexpr size_t WS_CTL = 0, CTL_ZERO_BYTES = 1 * MiB;
constexpr size_t WS_WIN = 1 * MiB;
constexpr size_t WS_WOUT = 11 * MiB;
constexpr size_t WS_WBN = 13 * MiB, WS_WBD = 14 * MiB;
constexpr size_t WS_WC1 = 15 * MiB;
constexpr size_t WS_WGU = 17 * MiB;
constexpr size_t WS_WDN = 49 * MiB;
constexpr size_t WS_H1 = 65 * MiB;
constexpr size_t WS_QN = 97 * MiB;
constexpr size_t WS_CT = 113 * MiB;
constexpr size_t WS_KS = 121 * MiB, WS_VS = 125 * MiB, WS_KW = 129 * MiB, WS_VW = 133 * MiB;
constexpr size_t WS_QD = 137 * MiB, WS_KD = 153 * MiB, WS_VD = 169 * MiB;
constexpr size_t WS_GM = 185 * MiB;
constexpr size_t WS_GN = 249 * MiB;
constexpr size_t WS_KCMP = 251 * MiB;
constexpr size_t WS_VCMP = 251 * MiB + 256 * 1024;
constexpr size_t WS_ROUTE = 252 * MiB + 512 * 1024;
constexpr size_t WS_LAM = 252 * MiB + 768 * 1024;
constexpr size_t WS_POSB = 252 * MiB + 800 * 1024;
constexpr size_t WS_BIAS = 252 * MiB + 832 * 1024;
constexpr size_t WS_BIASV = 252 * MiB + 848 * 1024;
constexpr size_t WS_END = 256 * MiB;
constexpr size_t WS_U = WS_H1;
constexpr size_t WS_ONSAB = WS_H1 + 16 * MiB;
constexpr size_t WS_X2B = WS_H1;
constexpr size_t WS_Y = WS_QN;
constexpr size_t WS_HID = WS_GM;

constexpr int CW_BAR = 4096;

#define XB_TMO      128
#define XB_XCNT(j)  (256  + 64 * (j))
#define XB_XSUB(j)  (1280 + 64 * (j))
#define XB_XGEN(j)  (2304 + 64 * (j))
#define XB_TOP      3328
#define XB_TOPGEN   3392
#define XCD_BAR_WORDS 3456
#define XB_SPIN_CAP (1u << 22)

__device__ __forceinline__ unsigned xb_ld(unsigned* p)              { return __hip_atomic_load(p, __ATOMIC_RELAXED, __HIP_MEMORY_SCOPE_AGENT); }
__device__ __forceinline__ unsigned xb_add(unsigned* p, unsigned v) { return __hip_atomic_fetch_add(p, v, __ATOMIC_RELAXED, __HIP_MEMORY_SCOPE_AGENT); }
__device__ __forceinline__ unsigned xb_xcc_id() { return (unsigned)__builtin_amdgcn_s_getreg((3 << 11) | 20) & 0xFu; }
#define XB_SPIN(cond, bar) do { unsigned _sp = 0; while (cond) { __builtin_amdgcn_s_sleep(1); \
    if ((++_sp & 255u) == 0u) { if (xb_ld(&(bar)[XB_TMO])) break; if (_sp > XB_SPIN_CAP) { atomicAdd(&(bar)[XB_TMO], 1u); break; } } } } while (0)

struct XcdBarrier { unsigned* bar; unsigned x; volatile LAS unsigned* st; };

__device__ __forceinline__ XcdBarrier xcd_barrier_post(unsigned* bar, volatile LAS unsigned* st) {
    XcdBarrier b; b.bar = bar; b.x = xb_xcc_id(); b.st = st;
    if (threadIdx.x == 0) (void)xb_add(&bar[XB_XCNT(b.x)], 1u);
    return b;
}
__device__ __forceinline__ void xcd_barrier_complete(unsigned* bar, unsigned x, unsigned& nloc, unsigned& nx) {
    const unsigned G = gridDim.x * gridDim.y * gridDim.z;
    unsigned sum, cnt, mine, sp = 0u;
    for (;;) {
        sum = 0u; cnt = 0u; mine = 0u;
#pragma unroll
        for (unsigned j = 0; j < 16; ++j) { const unsigned c = xb_ld(&bar[XB_XCNT(j)]); sum += c; cnt += (c > 0u) ? 1u : 0u; mine = (j == x) ? c : mine; }
        if (sum == G) break;
        __builtin_amdgcn_s_sleep(1);
        if ((++sp & 255u) == 0u) { if (xb_ld(&bar[XB_TMO])) break; if (sp > XB_SPIN_CAP) { atomicAdd(&bar[XB_TMO], 1u); break; } }
    }
    nloc = mine > 0u ? mine : 1u; nx = cnt > 0u ? cnt : 1u;
}
__device__ __forceinline__ void xcd_barrier(const XcdBarrier& b) {
    asm volatile("s_waitcnt vmcnt(0)" ::: "memory");
    __syncthreads();
    if (threadIdx.x == 0) {
        unsigned* bar = b.bar;
        __builtin_amdgcn_s_waitcnt(0);
        unsigned nloc = b.st[0], nx = b.st[1];
        if (nloc == 0u) { xcd_barrier_complete(bar, b.x, nloc, nx); b.st[0] = nloc; b.st[1] = nx; }
        const unsigned old = xb_add(&bar[XB_XSUB(b.x)], 1u);
        const unsigned gen = old / nloc;
        if (old + 1u == (gen + 1u) * nloc) {
            __builtin_amdgcn_fence(__ATOMIC_RELEASE, "agent");
            asm volatile("s_waitcnt vmcnt(0)" ::: "memory");
            const unsigned og = xb_add(&bar[XB_TOP], 1u);
            const unsigned tg = og / nx;
            if (og + 1u == (tg + 1u) * nx) xb_add(&bar[XB_TOPGEN], 1u);
            else XB_SPIN(xb_ld(&bar[XB_TOPGEN]) == tg, bar);
            __builtin_amdgcn_fence(__ATOMIC_ACQUIRE, "agent");
            xb_add(&bar[XB_XGEN(b.x)], 1u);
            asm volatile("s_waitcnt vmcnt(0)" ::: "memory");
        } else {
            XB_SPIN(xb_ld(&bar[XB_XGEN(b.x)]) == gen, bar);
            __builtin_amdgcn_fence(__ATOMIC_ACQUIRE, "agent");
            asm volatile("s_waitcnt vmcnt(0)" ::: "memory");
        }
    }
    __syncthreads();
}

__device__ __forceinline__ bf16 f2bf(float f) { unsigned u = __float_as_uint(f); return (bf16)((u + 0x7fffu + ((u >> 16) & 1u)) >> 16); }
typedef float g_f32x2 __attribute__((ext_vector_type(2))); typedef __bf16 g_bf16x2 __attribute__((ext_vector_type(2)));
__device__ __forceinline__ unsigned pk2bf(float lo, float hi) { const g_f32x2 v = {lo, hi}; const g_bf16x2 b = __builtin_convertvector(v, g_bf16x2); return __builtin_bit_cast(unsigned, b); }
__device__ __forceinline__ float wave_sum(float v) {
#pragma unroll
    for (int o = 1; o < 64; o <<= 1) v += __shfl_xor(v, o);
    return v;
}
typedef float nt_f32x4 __attribute__((ext_vector_type(4)));
__device__ __forceinline__ float sigmoidf_(float x) { return __builtin_amdgcn_rcpf(1.f + __builtin_amdgcn_exp2f(-1.4426950408889634f * x)); }

__device__ const unsigned char T5B[128] = {0, 1, 2, 3, 4, 5, 6, 7, 8, 9, 10, 11, 12, 13, 14, 15, 16, 16, 16, 17, 17, 18, 18, 18, 19, 19, 19, 20, 20, 20, 20, 21, 21, 21, 21, 22, 22, 22, 22, 22, 23, 23, 23, 23, 23, 23, 24, 24, 24, 24, 24, 24, 25, 25, 25, 25, 25, 25, 25, 26, 26, 26, 26, 26, 26, 26, 26, 27, 27, 27, 27, 27, 27, 27, 27, 27, 27, 28, 28, 28, 28, 28, 28, 28, 28, 28, 28, 29, 29, 29, 29, 29, 29, 29, 29, 29, 29, 29, 29, 30, 30, 30, 30, 30, 30, 30, 30, 30, 30, 30, 30, 30, 30, 31, 31, 31, 31, 31, 31, 31, 31, 31, 31, 31, 31, 31, 31, 31};
__device__ __forceinline__ int t5_bucket(int dist) { return (int)T5B[dist > 127 ? 127 : (dist < 0 ? 0 : dist)]; }

#define LO16(u) __uint_as_float((u) << 16)
#define HI16(u) __uint_as_float((u) & 0xffff0000u)

struct Args { const float* in[24]; float* out; unsigned char* ws; int ph_lo, ph_hi; };

struct Ctx {
    Args a;
#define CF(name, idx) __device__ __forceinline__ const float* name() const { return a.in[idx]; }
    CF(x, 0) CF(norm1_g, 1) CF(w_in, 2) CF(nsa_q_norm, 3) CF(nsa_k_norm, 4) CF(cmp_pos, 5) CF(cmp_w1, 6) CF(cmp_w2, 7) CF(diff_q_norm, 8) CF(diff_k_norm, 9)
    CF(diff_lambda, 10) CF(diff_out_norm, 11) CF(rel_bias, 12) CF(w_bn, 13) CF(w_bd, 14) CF(w_out, 15) CF(norm2_g, 16) CF(rg_w, 17) CF(rg_b, 18) CF(re_w, 19) CF(re_b, 20)
    CF(w_gate, 21) CF(w_up, 22) CF(w_down, 23)
#undef CF
#define CW(type, name, off) __device__ __forceinline__ type* name() const { return (type*)(a.ws + (off)); }
    CW(bf16, H1, WS_H1) CW(bf16, QN, WS_QN) CW(bf16, CT, WS_CT) CW(bf16, KS, WS_KS) CW(bf16, VS, WS_VS) CW(bf16, KW, WS_KW) CW(bf16, VW, WS_VW)
    CW(bf16, QD, WS_QD) CW(bf16, KD, WS_KD) CW(bf16, VD, WS_VD) CW(bf16, GM, WS_GM) CW(float, GN, WS_GN) CW(bf16, KCMP, WS_KCMP) CW(bf16, VCMP, WS_VCMP)
    CW(bf16, ONSAB, WS_ONSAB) CW(float, ROUTE, WS_ROUTE)
    CW(float, LAM, WS_LAM) CW(bf16, Y, WS_Y) CW(bf16, HID, WS_HID)
    CW(float, U, WS_U) CW(bf16, X2B, WS_X2B) CW(float, POSB, WS_POSB) CW(float, BIAS, WS_BIAS) CW(float, BIASV, WS_BIASV) CW(bf16, WIN, WS_WIN) CW(bf16, WOUT, WS_WOUT) CW(bf16, WBN, WS_WBN) CW(bf16, WBD, WS_WBD) CW(bf16, WC1, WS_WC1) CW(bf16, WGU, WS_WGU) CW(bf16, WDN, WS_WDN)
    __device__ __forceinline__ bf16* ODIFF() const { return (bf16*)a.out; }
#undef CW
    __device__ __forceinline__ float* out() const { return a.out; }
};

struct ChunkDesc { int src; int ncols; int mode; const float* gain; bf16* dst; float* dstf; int pitch; int dcol; float qscale;
    int img; int c0; int tile_bytes; int bstride; };
__device__ __forceinline__ ChunkDesc chunk_desc(const Ctx& c, int ch) {
    ChunkDesc d; d.src = 0; d.ncols = 64; d.mode = 0; d.gain = nullptr; d.dst = nullptr; d.dstf = nullptr; d.pitch = 0; d.dcol = 0; d.qscale = 1.f; d.img = 0; d.c0 = 0; d.tile_bytes = 0; d.bstride = 0;
    if (ch < 8) { d.src = C_QN + 64 * ch; d.mode = 1; d.gain = c.nsa_q_norm(); d.dst = c.QN(); d.pitch = 512; d.dcol = 64 * ch; d.qscale = 0.125f * 1.4426950408889634f; }
    else if (ch < 20) { const int j = ch - 8; d.src = C_KV + 64 * j; const int t = j >> 2, kv = (j >> 1) & 1, g = j & 1;
        if (t == 0) { d.dst = c.CT() + (size_t)(kv * 2 + g) * T * 64; d.pitch = 64; d.dcol = 0; }
        else { d.dst = ((t == 1) ? (kv ? c.VS() : c.KS()) : (kv ? c.VW() : c.KW())) + (size_t)g * 32 * 4096; d.img = kv ? 2 : 1; d.c0 = 0; d.tile_bytes = 8192; d.bstride = 2 * 32 * 8192;
               if (kv == 0) { d.mode = 1; d.gain = c.nsa_k_norm() + 64 * t; } } }
    else if (ch < 24) { if (ch == 20) { d.src = C_GN; d.ncols = 24; d.mode = 2; d.dstf = c.GN(); d.pitch = 24; d.dcol = 0; } else d.ncols = 0; }
    else if (ch < 32) { const int j = ch - 24; d.src = C_QD + 64 * j; d.mode = 1; d.gain = c.diff_q_norm() + 64 * (j & 1); d.dst = c.QD(); d.pitch = 512; d.dcol = 64 * j; d.qscale = 0.125f * 1.4426950408889634f; }
    else if (ch < 40) { const int j = ch - 32; d.src = C_KD + 64 * j; d.mode = 1; d.gain = c.diff_k_norm() + 64 * (j & 1); d.dst = c.KD() + (size_t)(j >> 1) * 32 * 8192; d.img = 1; d.c0 = (j & 1) * 8; d.tile_bytes = 16384; d.bstride = 4 * 32 * 16384; }
    else if (ch < 48) { const int j = ch - 40; d.src = C_VD + 64 * j; d.dst = c.VD() + (size_t)(j >> 1) * 32 * 8192; d.img = 2; d.c0 = (j & 1) * 2; d.tile_bytes = 16384; d.bstride = 4 * 32 * 16384; }
    else { const int j = ch - 48; d.src = C_GM + 64 * j; d.mode = 2; d.dst = c.GM(); d.pitch = 2048; d.dcol = 64 * j; }
    return d;
}


namespace pg8 {
typedef short bf16x8 __attribute__((ext_vector_type(8)));
typedef float f32x4 __attribute__((ext_vector_type(4)));
typedef unsigned u32x4 __attribute__((ext_vector_type(4)));
constexpr int BM = 256, BK = 64, HALF = 128, HTB = HALF * BK * 2, NXCD = 8, WGM = 8;
__device__ __forceinline__ int lds_byte(int r, int c) { const int st = (r >> 4) * 2 + (c >> 5), rr = r & 15, cc = c & 31, ob = rr * 64 + cc * 2; return st * 1024 + (ob ^ (((ob >> 9) & 1) << 5)); }
__device__ __forceinline__ void stage_rc(int b, int& R, int& C) { const int st = b / 1024, sb = b % 1024, swz = sb ^ (((sb >> 9) & 1) << 5); R = (st >> 1) * 16 + swz / 64; C = (st & 1) * 32 + (swz % 64) / 2; }
__device__ __forceinline__ int perm32(int rho) { const int n = rho >> 4, i = rho & 15; return 8 * (i >> 2) + 4 * n + (i & 3); }
__device__ __forceinline__ unsigned cvt_pk_bf16(float lo, float hi) { return pk2bf(lo, hi); }

struct Unit { int pm, pn, z; };
struct Ops { const bf16 *A0, *A1, *B0, *B1; int K;
    __device__ __forceinline__ const char* a(const Unit& u) const { return (const char*)((u.z ? A1 : A0) + (size_t)u.pm * BM * K); }
    __device__ __forceinline__ const char* b(const Unit& u) const { return (const char*)((u.z ? B1 : B0) + (size_t)u.pn * BM * K); } };

template <int NZ> struct StaticOrder {
    int nM, nN, nwg, G, c;
    __device__ __forceinline__ void init(int M, int N, int G_, int c_) { nM = M / BM; nN = N / BM; nwg = nM * nN; G = G_; c = c_; }
    __device__ __forceinline__ bool next(int i, Unit& u) const {
        const int it = i / NZ; u.z = i % NZ;
        const long L = (long)it * G + c; if (L >= nwg) return false;
        int wgid = (int)L; { const int q = nwg / NXCD, r = nwg % NXCD, xcd = wgid % NXCD, off = wgid / NXCD; wgid = (xcd < r ? xcd * (q + 1) : r * (q + 1) + (xcd - r) * q) + off; }
        const int nig = WGM * nN, gid = wgid / nig, fm = gid * WGM, gsz = (nM - fm) < WGM ? (nM - fm) : WGM;
        u.pm = fm + ((wgid % nig) % gsz); u.pn = (wgid % nig) / gsz; return true;
    }
};

template <class Epi, class Sched>
__device__ __forceinline__ void gemm_phase(LAS unsigned char* lds, const Ops g, const Sched& S, const Epi& E) {
    const int tid = threadIdx.x, wid = __builtin_amdgcn_readfirstlane(tid >> 6), lane = tid & 63, wr = wid >> 2, wc = wid & 3, fr = lane & 15, fq = lane >> 4;
    const int K = g.K, nt = K / BK;
    unsigned voffA[2], voffB[2];
#pragma unroll
    for (int i = 0; i < 2; ++i) { int R, C; stage_rc(tid * 16 + i * 8192, R, C); const int Rb = (R & ~31) + perm32(R & 31);
        voffA[i] = (unsigned)(R * K + C) * 2u; voffB[i] = (unsigned)(Rb * K + C) * 2u; }
    const size_t kstep = (size_t)(BK * 2);
    const size_t hstep = (size_t)HALF * K * 2;
    const unsigned ldsw = (unsigned)wid * 1024u;
    const int aoff = lds_byte(wr * 64 + fr, fq * 8), boff = lds_byte(wc * 32 + fr, fq * 8);
#define PG8_SA(b, h) (((b) * 2 + (h)) * HTB)
#define PG8_SB(b, h) ((4 + (b) * 2 + (h)) * HTB)
#define PG8_STAGE(bufoff, gbase, voff) do { _Pragma("unroll") for (int _i = 0; _i < 2; ++_i) \
        __builtin_amdgcn_global_load_lds((const unsigned*)((const char*)(gbase) + (voff)[_i]), (LAS unsigned*)(lds + (bufoff) + ldsw + _i * 8192), 16, 0, 0); } while (0)
#define PG8_LDA(dst, b, h) do { _Pragma("unroll") for (int m = 0; m < 4; ++m) _Pragma("unroll") for (int k = 0; k < 2; ++k) dst[m][k] = *(const LAS bf16x8*)(lds + PG8_SA(b, h) + aoff + m * 2048 + k * 1024); } while (0)
#define PG8_LDB(dst, b, h) do { _Pragma("unroll") for (int n = 0; n < 2; ++n) _Pragma("unroll") for (int k = 0; k < 2; ++k) dst[n][k] = *(const LAS bf16x8*)(lds + PG8_SB(b, h) + boff + n * 2048 + k * 1024); } while (0)
#define PG8_MMA(ai, bj, At, Bt) do { __builtin_amdgcn_s_setprio(1); _Pragma("unroll") for (int m = 0; m < 4; ++m) _Pragma("unroll") for (int n = 0; n < 2; ++n) _Pragma("unroll") for (int k = 0; k < 2; ++k) \
        acc[ai][bj][m][n] = __builtin_amdgcn_mfma_f32_16x16x32_bf16(Bt[n][k], At[m][k], acc[ai][bj][m][n], 0, 0, 0); __builtin_amdgcn_s_setprio(0); } while (0)
#define PG8_WAIT_V(n) asm volatile("s_waitcnt vmcnt(" #n ")" ::: "memory")
#define PG8_WAIT_L(n) asm volatile("s_waitcnt lgkmcnt(" #n ")" ::: "memory")
#define PG8_BAR __builtin_amdgcn_s_barrier()
#define PG8_SCHED __builtin_amdgcn_sched_barrier(0)
    Unit cur, nxt; int ui = 0;
    if (!S.next(0, cur)) return;
    f32x4 acc[2][2][4][2];
#pragma unroll
    for (int a = 0; a < 2; ++a)
#pragma unroll
        for (int b = 0; b < 2; ++b)
#pragma unroll
            for (int m = 0; m < 4; ++m)
#pragma unroll
                for (int n = 0; n < 2; ++n) acc[a][b][m][n] = (f32x4){0.f, 0.f, 0.f, 0.f};
    bf16x8 At[4][2], B0[2][2], B1[2][2];
    const char* cA = g.a(cur); const char* cB = g.b(cur);
    PG8_STAGE(PG8_SB(0, 0), cB, voffB); PG8_STAGE(PG8_SB(0, 1), cB + hstep, voffB); PG8_STAGE(PG8_SA(0, 0), cA, voffA); PG8_STAGE(PG8_SA(0, 1), cA + hstep, voffA);
    if (wr == 1) PG8_BAR;
    PG8_WAIT_V(2); PG8_BAR;
    PG8_STAGE(PG8_SB(1, 0), cB + kstep, voffB); PG8_STAGE(PG8_SA(1, 0), cA + kstep, voffA); PG8_STAGE(PG8_SB(1, 1), cB + hstep + kstep, voffB);
    PG8_WAIT_V(6); PG8_BAR;
    for (;;) {
        const bool has_next = S.next(ui + 1, nxt);
        const char* nA = has_next ? g.a(nxt) : cA; const char* nB = has_next ? g.b(nxt) : cB;
        for (int t = 0; t < nt; t += 2) {
            const bool last = (t == nt - 2);
            const char* a1 = cA + (size_t)(t + 1) * kstep;
            const char* a2 = last ? nA : cA + (size_t)(t + 2) * kstep; const char* b2 = last ? nB : cB + (size_t)(t + 2) * kstep;
            const char* a3 = a2 + kstep; const char* b3 = b2 + kstep;
            PG8_LDB(B0, 0, 0); PG8_LDB(B1, 0, 1); PG8_SCHED; PG8_LDA(At, 0, 0); PG8_STAGE(PG8_SA(1, 1), a1 + hstep, voffA);
            PG8_WAIT_V(8); PG8_WAIT_L(0); PG8_BAR; PG8_MMA(0, 0, At, B0); PG8_MMA(0, 1, At, B1); PG8_BAR; PG8_SCHED;
            PG8_LDA(At, 0, 1); PG8_STAGE(PG8_SB(0, 0), b2, voffB); PG8_STAGE(PG8_SB(0, 1), b2 + hstep, voffB); PG8_STAGE(PG8_SA(0, 0), a2, voffA);
            PG8_WAIT_V(8); PG8_WAIT_L(0); PG8_BAR; PG8_MMA(1, 0, At, B0); PG8_MMA(1, 1, At, B1); PG8_BAR; PG8_SCHED;
            PG8_LDB(B0, 1, 0); PG8_LDB(B1, 1, 1); PG8_SCHED; PG8_LDA(At, 1, 0); PG8_STAGE(PG8_SA(0, 1), a2 + hstep, voffA);
            PG8_WAIT_V(8); PG8_WAIT_L(0); PG8_BAR; PG8_MMA(0, 0, At, B0); PG8_MMA(0, 1, At, B1); PG8_BAR; PG8_SCHED;
            PG8_LDA(At, 1, 1); PG8_STAGE(PG8_SB(1, 0), b3, voffB); PG8_STAGE(PG8_SB(1, 1), b3 + hstep, voffB); PG8_STAGE(PG8_SA(1, 0), a3, voffA);
            PG8_WAIT_V(8); PG8_WAIT_L(0); PG8_BAR; PG8_MMA(1, 0, At, B0); PG8_MMA(1, 1, At, B1); PG8_BAR; PG8_SCHED;
        }
        if (wr == 0) PG8_BAR;
        const bool keep = E(acc, cur, wr, wc, fr, fq);
        if (!has_next) break;
        if (!keep) {
#pragma unroll
        for (int a = 0; a < 2; ++a)
#pragma unroll
            for (int b = 0; b < 2; ++b)
#pragma unroll
                for (int m = 0; m < 4; ++m)
#pragma unroll
                    for (int n = 0; n < 2; ++n) acc[a][b][m][n] = (f32x4){0.f, 0.f, 0.f, 0.f};
        }
        cur = nxt; cA = nA; cB = nB; ++ui;
        if (wr == 1) PG8_BAR;
    }
    PG8_WAIT_V(0);
    PG8_BAR;
#undef PG8_SA
#undef PG8_SB
#undef PG8_STAGE
#undef PG8_LDA
#undef PG8_LDB
#undef PG8_MMA
#undef PG8_WAIT_V
#undef PG8_WAIT_L
#undef PG8_BAR
#undef PG8_SCHED
}

template <class G, class Epi, class Sched>
__device__ __forceinline__ void gemm_phase_g(LAS unsigned char* lds, const G& g, const Sched& S, const Epi& E) {
    const int tid = threadIdx.x, wid = __builtin_amdgcn_readfirstlane(tid >> 6), lane = tid & 63, wr = wid >> 2, wc = wid & 3, fr = lane & 15, fq = lane >> 4;
    constexpr int nt = G::NT;
    unsigned voffB[2];
#pragma unroll
    for (int i = 0; i < 2; ++i) { int R, C; stage_rc(tid * 16 + i * 8192, R, C); const int Rb = (R & ~31) + perm32(R & 31); voffB[i] = (unsigned)(Rb * G::LDB + C) * 2u; }
#define PG8_RC int sR[2], sC[2]; stage_rc(tid * 16, sR[0], sC[0]); stage_rc(tid * 16 + 8192, sR[1], sC[1])
    const size_t kstep = (size_t)(BK * 2);
    const size_t hstepB = (size_t)HALF * G::LDB * 2;
    const unsigned ldsw = (unsigned)wid * 1024u;
    const int aoff = lds_byte(wr * 64 + fr, fq * 8), boff = lds_byte(wc * 32 + fr, fq * 8);
#define PG8_SA(b, h) (((b) * 2 + (h)) * HTB)
#define PG8_SB(b, h) ((4 + (b) * 2 + (h)) * HTB)
#define PG8_STAGE(bufoff, gbase, voff) do { _Pragma("unroll") for (int _i = 0; _i < 2; ++_i) \
        __builtin_amdgcn_global_load_lds((const unsigned*)((const char*)(gbase) + (voff)[_i]), (LAS unsigned*)(lds + (bufoff) + ldsw + _i * 8192), 16, 0, 0); } while (0)
#define PG8_LDA(dst, b, h) do { _Pragma("unroll") for (int m = 0; m < 4; ++m) _Pragma("unroll") for (int k = 0; k < 2; ++k) dst[m][k] = *(const LAS bf16x8*)(lds + PG8_SA(b, h) + aoff + m * 2048 + k * 1024); } while (0)
#define PG8_LDB(dst, b, h) do { _Pragma("unroll") for (int n = 0; n < 2; ++n) _Pragma("unroll") for (int k = 0; k < 2; ++k) dst[n][k] = *(const LAS bf16x8*)(lds + PG8_SB(b, h) + boff + n * 2048 + k * 1024); } while (0)
#define PG8_MMA(ai, bj, At, Bt) do { __builtin_amdgcn_s_setprio(1); _Pragma("unroll") for (int m = 0; m < 4; ++m) _Pragma("unroll") for (int n = 0; n < 2; ++n) _Pragma("unroll") for (int k = 0; k < 2; ++k) \
        acc[ai][bj][m][n] = __builtin_amdgcn_mfma_f32_16x16x32_bf16(Bt[n][k], At[m][k], acc[ai][bj][m][n], 0, 0, 0); __builtin_amdgcn_s_setprio(0); } while (0)
#define PG8_WAIT_V(n) asm volatile("s_waitcnt vmcnt(" #n ")" ::: "memory")
#define PG8_WAIT_L(n) asm volatile("s_waitcnt lgkmcnt(" #n ")" ::: "memory")
#define PG8_BAR __builtin_amdgcn_s_barrier()
#define PG8_SCHED __builtin_amdgcn_sched_barrier(0)
    Unit cur, nxt; int ui = 0;
    if (!S.next(0, cur)) return;
    unsigned vc[2][2], vn[2][2];
    bool has_next = S.next(1, nxt);
    {   PG8_RC; g.a_voff(cur, sR, sC, vc);
        if (has_next) g.a_voff(nxt, sR, sC, vn); }
    if (has_next) {} else { vn[0][0] = vc[0][0]; vn[0][1] = vc[0][1]; vn[1][0] = vc[1][0]; vn[1][1] = vc[1][1]; }
    f32x4 acc[2][2][4][2];
#pragma unroll
    for (int a = 0; a < 2; ++a)
#pragma unroll
        for (int b = 0; b < 2; ++b)
#pragma unroll
            for (int m = 0; m < 4; ++m)
#pragma unroll
                for (int n = 0; n < 2; ++n) acc[a][b][m][n] = (f32x4){0.f, 0.f, 0.f, 0.f};
    bf16x8 At[4][2], B0[2][2], B1[2][2];
    const char* cA = g.a_base(cur);
    const char *cb0, *cb1, *nb0, *nb1;
    g.bprep(cur, cb0, cb1);
    if (has_next) g.bprep(nxt, nb0, nb1); else { nb0 = cb0; nb1 = cb1; }
    {   const char* cB0 = G::bat(cb0, cb1, 0); const char* cB1 = G::bat(cb0, cb1, 1);
        PG8_STAGE(PG8_SB(0, 0), cB0, voffB); PG8_STAGE(PG8_SB(0, 1), cB0 + hstepB, voffB); PG8_STAGE(PG8_SA(0, 0), cA, vc[0]); PG8_STAGE(PG8_SA(0, 1), cA, vc[1]);
        if (wr == 1) PG8_BAR;
        PG8_WAIT_V(2); PG8_BAR;
        PG8_STAGE(PG8_SB(1, 0), cB1, voffB); PG8_STAGE(PG8_SA(1, 0), cA + kstep, vc[0]); PG8_STAGE(PG8_SB(1, 1), cB1 + hstepB, voffB);
        PG8_WAIT_V(6); PG8_BAR; }
    for (;;) {
        const char* nA = has_next ? g.a_base(nxt) : cA;
        for (int t = 0; t < nt; t += 2) {
            const bool last = (t == nt - 2);
            const char* a1 = cA + (size_t)(t + 1) * kstep;
            const char* a2 = last ? nA : cA + (size_t)(t + 2) * kstep; const char* a3 = a2 + kstep;
            const char* b2 = last ? G::bat(nb0, nb1, 0) : G::bat(cb0, cb1, t + 2); const char* b3 = last ? G::bat(nb0, nb1, 1) : G::bat(cb0, cb1, t + 3);
            PG8_LDB(B0, 0, 0); PG8_LDB(B1, 0, 1); PG8_SCHED; PG8_LDA(At, 0, 0); PG8_STAGE(PG8_SA(1, 1), a1, vc[1]);
            if (last) { vc[0][0] = vn[0][0]; vc[0][1] = vn[0][1]; vc[1][0] = vn[1][0]; vc[1][1] = vn[1][1]; }
            PG8_WAIT_V(8); PG8_WAIT_L(0); PG8_BAR; PG8_MMA(0, 0, At, B0); PG8_MMA(0, 1, At, B1); PG8_BAR; PG8_SCHED;
            PG8_LDA(At, 0, 1); PG8_STAGE(PG8_SB(0, 0), b2, voffB); PG8_STAGE(PG8_SB(0, 1), b2 + hstepB, voffB); PG8_STAGE(PG8_SA(0, 0), a2, vc[0]);
            PG8_WAIT_V(8); PG8_WAIT_L(0); PG8_BAR; PG8_MMA(1, 0, At, B0); PG8_MMA(1, 1, At, B1); PG8_BAR; PG8_SCHED;
            PG8_LDB(B0, 1, 0); PG8_LDB(B1, 1, 1); PG8_SCHED; PG8_LDA(At, 1, 0); PG8_STAGE(PG8_SA(0, 1), a2, vc[1]);
            PG8_WAIT_V(8); PG8_WAIT_L(0); PG8_BAR; PG8_MMA(0, 0, At, B0); PG8_MMA(0, 1, At, B1); PG8_BAR; PG8_SCHED;
            PG8_LDA(At, 1, 1); PG8_STAGE(PG8_SB(1, 0), b3, voffB); PG8_STAGE(PG8_SB(1, 1), b3 + hstepB, voffB); PG8_STAGE(PG8_SA(1, 0), a3, vc[0]);
            PG8_WAIT_V(8); PG8_WAIT_L(0); PG8_BAR; PG8_MMA(1, 0, At, B0); PG8_MMA(1, 1, At, B1); PG8_BAR; PG8_SCHED;
        }
        if (wr == 0) PG8_BAR;
        E(acc, cur, wr, wc, fr, fq);
        if (!has_next) break;
#pragma unroll
        for (int a = 0; a < 2; ++a)
#pragma unroll
            for (int b = 0; b < 2; ++b)
#pragma unroll
                for (int m = 0; m < 4; ++m)
#pragma unroll
                    for (int n = 0; n < 2; ++n) acc[a][b][m][n] = (f32x4){0.f, 0.f, 0.f, 0.f};
        cur = nxt; cA = nA; cb0 = nb0; cb1 = nb1; ++ui;
        has_next = S.next(ui + 1, nxt);
        if (has_next) { PG8_RC; g.a_voff(nxt, sR, sC, vn); g.bprep(nxt, nb0, nb1); }
        if (wr == 1) PG8_BAR;
    }
    PG8_WAIT_V(0);
    PG8_BAR;
#undef PG8_RC
#undef PG8_SA
#undef PG8_SB
#undef PG8_STAGE
#undef PG8_LDA
#undef PG8_LDB
#undef PG8_MMA
#undef PG8_WAIT_V
#undef PG8_WAIT_L
#undef PG8_BAR
#undef PG8_SCHED
}
}

struct EpiInProj {
    Ctx c;
    __device__ __forceinline__ bool operator()(pg8::f32x4 (&acc)[2][2][4][2], const pg8::Unit& u, int wr, int wc, int fr_, int fq_) const {
        int fr = fr_, fq = fq_; asm volatile("" : "+v"(fr), "+v"(fq));
        const ChunkDesc d = chunk_desc(c, u.pn * 4 + wc);
        if (d.ncols == 0) return false;
        const int row0 = u.pm * 256 + wr * 64 + fr;
        float gn[2][8];
        const float* gp = (d.mode == 1) ? d.gain : c.nsa_q_norm();
#pragma unroll
        for (int bj = 0; bj < 2; ++bj)
#pragma unroll
            for (int i = 0; i < 8; ++i) { gn[bj][i] = gp[32 * bj + 8 * fq + i] * d.qscale; asm volatile("" : "+v"(gn[bj][i])); }
#pragma unroll
        for (int ai = 0; ai < 2; ++ai)
#pragma unroll
            for (int m = 0; m < 4; ++m) {
                const size_t row = (size_t)(row0 + ai * 128 + m * 16);
                float v[2][8];
#pragma unroll
                for (int bj = 0; bj < 2; ++bj)
#pragma unroll
                    for (int n = 0; n < 2; ++n)
#pragma unroll
                        for (int i = 0; i < 4; ++i) v[bj][4 * n + i] = acc[ai][bj][m][n][i];
                if (d.mode == 1) {
                    float ss = 0.f;
#pragma unroll
                    for (int bj = 0; bj < 2; ++bj)
#pragma unroll
                        for (int i = 0; i < 8; ++i) ss += v[bj][i] * v[bj][i];
                    ss += __shfl_xor(ss, 16); ss += __shfl_xor(ss, 32);
                    const float r = rsqrtf(ss * (1.f / 64.f) + RMS_EPS);
#pragma unroll
                    for (int bj = 0; bj < 2; ++bj)
#pragma unroll
                        for (int i = 0; i < 8; ++i) v[bj][i] = v[bj][i] * r * gn[bj][i];
                } else if (d.mode == 2) {
#pragma unroll
                    for (int bj = 0; bj < 2; ++bj)
#pragma unroll
                        for (int i = 0; i < 8; ++i) v[bj][i] = sigmoidf_(v[bj][i]);
                }
                if (d.dstf) {
                    if (fq < 3) { float4* p = (float4*)(d.dstf + row * 24 + 8 * fq); p[0] = make_float4(v[0][0], v[0][1], v[0][2], v[0][3]); p[1] = make_float4(v[0][4], v[0][5], v[0][6], v[0][7]); }
                } else {
#pragma unroll
                    for (int bj = 0; bj < 2; ++bj) { pg8::u32x4 w; w.x = pg8::cvt_pk_bf16(v[bj][0], v[bj][1]); w.y = pg8::cvt_pk_bf16(v[bj][2], v[bj][3]); w.z = pg8::cvt_pk_bf16(v[bj][4], v[bj][5]); w.w = pg8::cvt_pk_bf16(v[bj][6], v[bj][7]);
                        if (d.img == 0) *(pg8::u32x4*)(d.dst + row * d.pitch + d.dcol + 32 * bj + 8 * fq) = w;
                        else { const int bb = (int)(row >> 11), sq = (int)(row & 2047), key = sq & 63;
                            const size_t tb = (size_t)bb * d.bstride + (size_t)(sq >> 6) * d.tile_bytes;
                            const size_t off = (d.img == 1) ? tb + (size_t)(d.c0 + 4 * bj + fq) * 1024 + key * 16 : tb + (size_t)(d.c0 + bj) * 4096 + (key >> 4) * 1024 + (key & 15) * 64 + fq * 16;
                            *(pg8::u32x4*)((unsigned char*)d.dst + off) = w; } }
                }
            }
        return false;
    }
};
struct EpiMerge {
    bf16* Y; const bf16* GM;
    __device__ __forceinline__ bool operator()(pg8::f32x4 (&acc)[2][2][4][2], const pg8::Unit& u, int wr, int wc, int fr_, int fq_) const {
        int fr = fr_, fq = fq_; asm volatile("" : "+v"(fr), "+v"(fq));
        const int row0 = u.pm * 256 + wr * 64 + fr, col0 = u.pn * 256 + wc * 32 + 8 * fq;
#pragma unroll
        for (int ai = 0; ai < 2; ++ai)
#pragma unroll
            for (int m = 0; m < 4; ++m) {
                const size_t row = (size_t)(row0 + ai * 128 + m * 16);
#pragma unroll
                for (int bj = 0; bj < 2; ++bj) {
                    const int col = col0 + bj * 128;
                    const uint4 g1 = *(const uint4*)(GM + row * 2048 + 1024 + col);
                    float q1[8] = {LO16(g1.x), HI16(g1.x), LO16(g1.y), HI16(g1.y), LO16(g1.z), HI16(g1.z), LO16(g1.w), HI16(g1.w)};
                    if (u.z == 0) {
                        const uint4 g0 = *(const uint4*)(GM + row * 2048 + col);
                        const float q0[8] = {LO16(g0.x), HI16(g0.x), LO16(g0.y), HI16(g0.y), LO16(g0.z), HI16(g0.z), LO16(g0.w), HI16(g0.w)};
#pragma unroll
                        for (int n = 0; n < 2; ++n)
#pragma unroll
                            for (int i = 0; i < 4; ++i) acc[ai][bj][m][n][i] *= q0[4 * n + i] * __builtin_amdgcn_rcpf(fmaxf(q1[4 * n + i], 1e-30f));
                    } else {
                        float v[8];
#pragma unroll
                        for (int n = 0; n < 2; ++n)
#pragma unroll
                            for (int i = 0; i < 4; ++i) v[4 * n + i] = acc[ai][bj][m][n][i] * fmaxf(q1[4 * n + i], 1e-30f);
                        uint4 w; w.x = pg8::cvt_pk_bf16(v[0], v[1]); w.y = pg8::cvt_pk_bf16(v[2], v[3]); w.z = pg8::cvt_pk_bf16(v[4], v[5]); w.w = pg8::cvt_pk_bf16(v[6], v[7]);
                        *(uint4*)(Y + row * 1024 + col) = w;
                    }
                }
            }
        return u.z == 0;
    }
};
struct EpiResid {
    const float* X; bf16* O;
    __device__ __forceinline__ bool operator()(pg8::f32x4 (&acc)[2][2][4][2], const pg8::Unit& u, int wr, int wc, int fr_, int fq_) const {
        int fr = fr_, fq = fq_; asm volatile("" : "+v"(fr), "+v"(fq));
        const int row0 = u.pm * 256 + wr * 64 + fr, col0 = u.pn * 256 + wc * 32 + 8 * fq;
#pragma unroll
        for (int ai = 0; ai < 2; ++ai)
#pragma unroll
            for (int m = 0; m < 4; ++m) {
                const size_t row = (size_t)(row0 + ai * 128 + m * 16);
#pragma unroll
                for (int bj = 0; bj < 2; ++bj) { const size_t off = row * 1024 + col0 + bj * 128;
                    const float4 x0 = *(const float4*)(X + off), x1 = *(const float4*)(X + off + 4); const pg8::f32x4 a0 = acc[ai][bj][m][0], a1 = acc[ai][bj][m][1];
                    uint4 w; w.x = pk2bf(x0.x + a0[0], x0.y + a0[1]); w.y = pk2bf(x0.z + a0[2], x0.w + a0[3]); w.z = pk2bf(x1.x + a1[0], x1.y + a1[1]); w.w = pk2bf(x1.z + a1[2], x1.w + a1[3]);
                    *(uint4*)(O + off) = w; }
            }
        return false;
    }
};

struct EpiF32 {
    float* O; int ldc;
    __device__ __forceinline__ bool operator()(pg8::f32x4 (&acc)[2][2][4][2], const pg8::Unit& u, int wr, int wc, int fr_, int fq_) const {
        int fr = fr_, fq = fq_; asm volatile("" : "+v"(fr), "+v"(fq));
        const int row0 = u.pm * 256 + wr * 64 + fr, col0 = u.pn * 256 + wc * 32 + 8 * fq;
#pragma unroll
        for (int ai = 0; ai < 2; ++ai)
#pragma unroll
            for (int m = 0; m < 4; ++m)
#pragma unroll
                for (int bj = 0; bj < 2; ++bj)
#pragma unroll
                    for (int n = 0; n < 2; ++n) { const pg8::f32x4 a = acc[ai][bj][m][n];
                        *(float4*)(O + (size_t)(row0 + ai * 128 + m * 16) * ldc + col0 + bj * 128 + 4 * n) = make_float4(a[0], a[1], a[2], a[3]); }
        return false;
    }
};
struct SchedCmp { int c;
    __device__ __forceinline__ bool next(int i, pg8::Unit& u) const { if (i > 0 || c >= 32) return false; u.pm = c >> 1; u.pn = c & 1; u.z = c >> 4; return true; } };

__device__ __forceinline__ float4 posb_sum(const float* p) { float4 a = *(const float4*)p;
#pragma unroll
    for (int sl = 1; sl < 8; ++sl) { const float4 b = *(const float4*)(p + sl * 512); a.x += b.x; a.y += b.y; a.z += b.z; a.w += b.w; }
    return a; }

__device__ __forceinline__ void tr_item(const float* src, int ldn, int k0, int n0, int nvalid, bf16* dst, int ldk, int r0, LAS float* scr, int lane, const float* kgain = nullptr) {
    const int nn = lane & 31;
    float tv[32];
#pragma unroll
    for (int i = 0; i < 32; ++i) { const int kk = 2 * i + (lane >> 5); tv[i] = (nn < nvalid) ? __builtin_nontemporal_load(src + (size_t)(k0 + kk) * ldn + n0 + nn) : 0.f; }
#pragma unroll
    for (int i = 0; i < 32; ++i) { const int kk = 2 * i + (lane >> 5); scr[kk * 33 + nn] = kgain ? tv[i] * kgain[k0 + kk] : tv[i]; }
    asm volatile("s_waitcnt lgkmcnt(0)" ::: "memory");
    const int cch = lane & 7;
#pragma unroll
    for (int j = 0; j < 4; ++j) { const int n = (lane >> 3) + 8 * j; const LAS float* sp = scr + (8 * cch) * 33 + n;
        uint4 o; o.x = pg8::cvt_pk_bf16(sp[0 * 33], sp[1 * 33]); o.y = pg8::cvt_pk_bf16(sp[2 * 33], sp[3 * 33]); o.z = pg8::cvt_pk_bf16(sp[4 * 33], sp[5 * 33]); o.w = pg8::cvt_pk_bf16(sp[6 * 33], sp[7 * 33]);
        *(uint4*)(dst + (size_t)(r0 + n) * ldk + k0 + 8 * cch) = o; }
    asm volatile("s_waitcnt lgkmcnt(0)" ::: "memory");
}


namespace att {
typedef short bf16x8 __attribute__((ext_vector_type(8)));
typedef short s16x4 __attribute__((ext_vector_type(4)));
typedef short v4i16_t __attribute__((ext_vector_type(4)));
typedef float f32x16 __attribute__((ext_vector_type(16)));
typedef unsigned u32x4 __attribute__((ext_vector_type(4)));
typedef float f32x4v __attribute__((ext_vector_type(4)));
constexpr float C2 = 0.125f * 1.4426950408889634f;
constexpr float LOG2E = 1.4426950408889634f;
constexpr float NEGB = -1e30f, MFLOOR = -1e4f;
__device__ __forceinline__ int crow(int r, int hi) { return (r & 3) + 8 * (r >> 2) + 4 * hi; }
__device__ __forceinline__ s16x4 vtr(const LAS char* p) { return __builtin_bit_cast(s16x4, __builtin_amdgcn_ds_read_tr16_b64_v4i16((LAS v4i16_t*)p)); }
typedef float f32x2_t __attribute__((ext_vector_type(2))); typedef __bf16 bf16x2_t __attribute__((ext_vector_type(2)));
__device__ __forceinline__ unsigned cvtpk(float lo, float hi) { const f32x2_t v = {lo, hi}; const bf16x2_t b = __builtin_convertvector(v, bf16x2_t); return __builtin_bit_cast(unsigned, b); }
#define ATT_WAIT_BAR() asm volatile("s_waitcnt vmcnt(0) lgkmcnt(0)\n\ts_barrier" ::: "memory")

template <int NKB> __device__ __forceinline__ void stage_img(LAS unsigned char* dst, const unsigned char* src, int wid, int lane) {
#pragma unroll
    for (int c = 0; c < (NKB + 7) / 8; ++c) { const int pc = wid + 8 * c;
        if (NKB % 8 == 0 || pc < NKB) __builtin_amdgcn_global_load_lds((const unsigned*)(src + pc * 1024 + lane * 16), (LAS unsigned*)(dst + pc * 1024), 16, 0, 0); }
}
__device__ __forceinline__ void qk_tile(f32x16& p0, f32x16& p1, const LAS unsigned char* kt, int ch0, const bf16x8 (&qf)[4], int r32, int hi) {
    const LAS unsigned char* kb = kt + (ch0 + hi) * 1024 + r32 * 16;
    p0 = (f32x16){0.f, 0.f, 0.f, 0.f, 0.f, 0.f, 0.f, 0.f, 0.f, 0.f, 0.f, 0.f, 0.f, 0.f, 0.f, 0.f}; p1 = p0;
#pragma unroll
    for (int d0 = 0; d0 < 4; ++d0) {
        const bf16x8 a0 = *(const LAS bf16x8*)(kb + d0 * 2048), a1 = *(const LAS bf16x8*)(kb + d0 * 2048 + 512);
        p0 = __builtin_amdgcn_mfma_f32_32x32x16_bf16(a0, qf[d0], p0, 0, 0, 0);
        p1 = __builtin_amdgcn_mfma_f32_32x32x16_bf16(a1, qf[d0], p1, 0, 0, 0);
    }
}
template <int EB> __device__ __forceinline__ void pv_tile(f32x16 (&o)[EB], const LAS unsigned char* vt, const f32x16& p0, const f32x16& p1, int lane) {
    const int hi = lane >> 5;
    const LAS char* vb = (const LAS char*)vt + ((lane >> 4) & 1) * 32 + (lane & 3) * 8 + (4 * hi + ((lane & 15) >> 2)) * 64;
#pragma unroll
    for (int ks = 0; ks < 4; ++ks) {
        s16x4 lo[EB], hh[EB];
#pragma unroll
        for (int eb = 0; eb < EB; ++eb) { lo[eb] = vtr(vb + eb * 4096 + ks * 1024); hh[eb] = vtr(vb + eb * 4096 + ks * 1024 + 512); }
        const f32x16& p = (ks < 2) ? p0 : p1; const int rb = (ks & 1) * 8;
        const u32x4 w = (u32x4){cvtpk(p[rb + 0], p[rb + 1]), cvtpk(p[rb + 2], p[rb + 3]), cvtpk(p[rb + 4], p[rb + 5]), cvtpk(p[rb + 6], p[rb + 7])};
        const bf16x8 pa = __builtin_bit_cast(bf16x8, w);
#pragma unroll
        for (int eb = 0; eb < EB; ++eb) {
            const bf16x8 vf = (bf16x8){lo[eb][0], lo[eb][1], lo[eb][2], lo[eb][3], hh[eb][0], hh[eb][1], hh[eb][2], hh[eb][3]};
            o[eb] = __builtin_amdgcn_mfma_f32_32x32x16_bf16(pa, vf, o[eb], 0, 0, 0);
        }
    }
}
template <bool BIAS, bool CAUSAL, bool BAND> __device__ __forceinline__ void bias_mask(f32x16& p0, f32x16& p1, const LAS float* bl, int qabs, int kt0, int hi) {
#pragma unroll
    for (int r = 0; r < 16; ++r) {
        const int d0 = qabs - (kt0 + crow(r, hi)), d1 = d0 - 32;
        if (BIAS) { p0[r] += bl[d0 < 0 ? 0 : (d0 > 255 ? 255 : d0)]; p1[r] += bl[d1 < 0 ? 0 : (d1 > 255 ? 255 : d1)]; }
        if (CAUSAL) { if (d0 < 0) p0[r] = NEGB; if (d1 < 0) p1[r] = NEGB; }
        if (BAND) { if (d0 >= 512) p0[r] = NEGB; if (d1 >= 512) p1[r] = NEGB; }
    }
}
__device__ __forceinline__ void bias_vec(f32x16& p0, f32x16& p1, const LAS float* rt, int e0, int hi) {
    const int a = (-e0) & 3;
    const LAS float* bp = rt + a * 320 + (208 - e0 - a) + 4 * hi;
#pragma unroll
    for (int g4 = 0; g4 < 4; ++g4) { const f32x4v v0 = *(const LAS f32x4v*)(bp + 8 * g4), v1 = *(const LAS f32x4v*)(bp + 8 * g4 + 32);
        p0[4 * g4] += v0[0]; p0[4 * g4 + 1] += v0[1]; p0[4 * g4 + 2] += v0[2]; p0[4 * g4 + 3] += v0[3];
        p1[4 * g4] += v1[0]; p1[4 * g4 + 1] += v1[1]; p1[4 * g4 + 2] += v1[2]; p1[4 * g4 + 3] += v1[3]; }
}
constexpr float THR = 8.f;
__device__ __forceinline__ float max3f(float a, float b, float c) { return fmaxf(fmaxf(a, b), c); }
template <int EB> __device__ __forceinline__ void softmax_step(f32x16& p0, f32x16& p1, float& m, float& l, f32x16 (&o)[EB], LAS float* wsf, int r32, int hi) {
    if (__any(m != 0.f)) {
#pragma unroll
        for (int r = 0; r < 16; ++r) { p0[r] -= m; p1[r] -= m; }
    }
    float ra = max3f(p0[0], p0[1], p1[0]), rb2 = max3f(p0[2], p0[3], p1[1]); ra = max3f(ra, p1[2], p1[3]);
#pragma unroll
    for (int r = 4; r < 16; r += 4) { ra = max3f(ra, p0[r], p0[r + 1]); rb2 = max3f(rb2, p0[r + 2], p0[r + 3]); ra = max3f(ra, p1[r], p1[r + 1]); rb2 = max3f(rb2, p1[r + 2], p1[r + 3]); }
    float rm = fmaxf(ra, rb2);
    if (__any(rm > THR)) {
        rm = fmaxf(rm, __shfl_xor(rm, 32));
        const float dl = rm > THR ? rm : 0.f;
        const float al = __builtin_amdgcn_exp2f(-dl);
        m += dl; l *= al;
#pragma unroll
        for (int r = 0; r < 16; ++r) { p0[r] -= dl; p1[r] -= dl; }
        if (hi == 0) wsf[r32] = al;
#pragma unroll
        for (int g = 0; g < 4; ++g) { const f32x4v a4 = *(const LAS f32x4v*)(wsf + 8 * g + 4 * hi);
#pragma unroll
            for (int eb = 0; eb < EB; ++eb) { o[eb][4 * g + 0] *= a4.x; o[eb][4 * g + 1] *= a4.y; o[eb][4 * g + 2] *= a4.z; o[eb][4 * g + 3] *= a4.w; } }
    }
    float s0 = 0.f, s1 = 0.f;
#pragma unroll
    for (int r = 0; r < 16; ++r) { p0[r] = __builtin_amdgcn_exp2f(p0[r]); p1[r] = __builtin_amdgcn_exp2f(p1[r]); s0 += p0[r]; s1 += p1[r]; }
    l += s0 + s1;
}
template <int EB> __device__ __forceinline__ void scale_rows(f32x16 (&o)[EB], float f, LAS float* wsf, int r32, int hi) {
    if (hi == 0) wsf[r32] = f;
#pragma unroll
    for (int g = 0; g < 4; ++g) { const f32x4v a4 = *(const LAS f32x4v*)(wsf + 8 * g + 4 * hi);
#pragma unroll
        for (int eb = 0; eb < EB; ++eb) { o[eb][4 * g + 0] *= a4.x; o[eb][4 * g + 1] *= a4.y; o[eb][4 * g + 2] *= a4.z; o[eb][4 * g + 3] *= a4.w; } }
}

struct DiffArgs { const bf16 *Q, *K, *V; bf16* O; const float* biasv; const float* out_gain; float lam; };
__device__ __forceinline__ void diff_unit(LAS unsigned char* lds, const DiffArgs& A, int b, int h, int qt) {
    int tid_ = threadIdx.x; asm volatile("" : "+v"(tid_));
    const int tid = tid_, lane = tid & 63, r32 = lane & 31, hi = lane >> 5, wid = __builtin_amdgcn_readfirstlane(tid >> 6);
    const int cs = wid >> 2, wq = wid & 3, q0 = qt * 128, qw0 = q0 + wq * 32, qabs = qw0 + r32;
    LAS float* bl = (LAS float*)(lds + 81920);
    LAS float* wsf = (LAS float*)(lds + 83968) + wid * 64;
    const size_t rowb = (size_t)b * S;
    LAS float* rt = (LAS float*)(lds + 86016);
    for (int i = tid; i < 1280; i += 512) rt[i] = A.biasv[(8 + h) * 1280 + i];
    const unsigned char* Kh = (const unsigned char*)A.K + (size_t)(b * 4 + h) * 32 * 16384; const unsigned char* Vh = (const unsigned char*)A.V + (size_t)(b * 4 + h) * 32 * 16384;
    const int NT = (q0 + 128) / 64;
    stage_img<16>(lds, Kh, wid, lane); stage_img<16>(lds + 49152, Vh, wid, lane);
    stage_img<16>(lds + 16384, Kh + 16384, wid, lane);
    bf16x8 qf[4];
    { const bf16* qp = A.Q + (rowb + qabs) * 512 + h * 128 + cs * 64 + hi * 8;
#pragma unroll
      for (int d0 = 0; d0 < 4; ++d0) qf[d0] = *(const bf16x8*)(qp + d0 * 16); }
    f32x16 o[4];
#pragma unroll
    for (int eb = 0; eb < 4; ++eb) o[eb] = (f32x16){0.f, 0.f, 0.f, 0.f, 0.f, 0.f, 0.f, 0.f, 0.f, 0.f, 0.f, 0.f, 0.f, 0.f, 0.f, 0.f};
    float m = 0.f, l = 0.f;
    ATT_WAIT_BAR();
    if (wid >= 4) __builtin_amdgcn_s_setprio(1);
    f32x16 n0, n1;
    qk_tile(n0, n1, lds, cs * 8, qf, r32, hi);
    int kb_cur = 0, kb_nxt = 16384, kb_fre = 32768;
    for (int t = 0; t < NT; ++t) {
        if (t + 2 < NT) stage_img<16>(lds + kb_fre, Kh + (size_t)(t + 2) * 16384, wid, lane);
        if (t + 1 < NT) stage_img<16>(lds + 49152 + ((t + 1) & 1) * 16384, Vh + (size_t)(t + 1) * 16384, wid, lane);
        const int kt0 = t * 64;
        if (kt0 <= qw0 + 31) {
            f32x16 p0 = n0, p1 = n1;
            if (t + 1 < NT && kt0 + 64 <= qw0 + 31) qk_tile(n0, n1, lds + kb_nxt, cs * 8, qf, r32, hi);
            const bool causal = (kt0 + 63 > qw0), near_ = (qw0 - (kt0 + 63) < 113);
            if (causal || near_) bias_vec(p0, p1, rt, qabs - kt0, hi);
            softmax_step<4>(p0, p1, m, l, o, wsf, r32, hi);
            pv_tile<4>(o, lds + 49152 + (t & 1) * 16384, p0, p1, lane);
        }
        ATT_WAIT_BAR();
        { const int tmp = kb_cur; kb_cur = kb_nxt; kb_nxt = kb_fre; kb_fre = tmp; }
    }
    __builtin_amdgcn_s_setprio(0);
    l += __shfl_xor(l, 32);
    scale_rows<4>(o, (cs ? A.lam : 1.f) / l, wsf, r32, hi);
    LAS float* xch = (LAS float*)lds + (size_t)wq * 4096;
    if (cs == 1) {
#pragma unroll
        for (int eb = 0; eb < 4; ++eb)
#pragma unroll
            for (int r = 0; r < 16; ++r) xch[crow(r, hi) * 128 + eb * 32 + r32] = o[eb][r];
    }
    ATT_WAIT_BAR();
    if (cs == 0) {
        float ss[16];
#pragma unroll
        for (int r = 0; r < 16; ++r) ss[r] = 0.f;
#pragma unroll
        for (int eb = 0; eb < 4; ++eb)
#pragma unroll
            for (int r = 0; r < 16; ++r) { o[eb][r] -= xch[crow(r, hi) * 128 + eb * 32 + r32]; ss[r] += o[eb][r] * o[eb][r]; }
#pragma unroll
        for (int r = 0; r < 16; ++r) {
#pragma unroll
            for (int sft = 1; sft < 32; sft <<= 1) ss[r] += __shfl_xor(ss[r], sft);
            ss[r] = rsqrtf(ss[r] * (1.f / 128.f) + RMS_EPS) * (1.f - LAMBDA_INIT);
        }
        int hi_ = hi, r32_ = r32; asm volatile("" : "+v"(hi_), "+v"(r32_));
        bf16* op = A.O + (rowb + qw0 + 4 * hi_) * 512 + h * 128 + r32_;
#pragma unroll
        for (int eb = 0; eb < 4; ++eb) { const float gn = A.out_gain[eb * 32 + r32_];
#pragma unroll
            for (int r = 0; r < 16; ++r) op[(size_t)((r & 3) + 8 * (r >> 2)) * 512 + eb * 32] = f2bf(o[eb][r] * ss[r] * gn); }
    }
    ATT_WAIT_BAR();
}

struct NsaArgs { const bf16 *Q, *KS, *VS, *KW, *VW, *KC, *VC; const float* GN; bf16* O; const float* rel_bias; const float* biasv; };
__device__ __forceinline__ void imp_tile(const f32x16& p, int gbase, LAS float* ip, float inv, int hi, float& prevR) {
    float Av[4], Rv[4];
#pragma unroll
    for (int gq = 0; gq < 4; ++gq) { const float c3 = 0.5f * p[4 * gq + 3]; Av[gq] = p[4 * gq] + p[4 * gq + 1] + p[4 * gq + 2] + c3; Rv[gq] = __shfl_xor(c3, 32); }
#pragma unroll
    for (int gq = 0; gq < 4; ++gq) { const float add = hi ? Rv[gq] : (gq > 0 ? Rv[gq > 0 ? gq - 1 : 0] : prevR); ip[2 * (gbase + gq)] = (Av[gq] + add) * inv; }
    prevR = Rv[3];
}

__device__ __forceinline__ int cmp_class(int qw0, int n0) { return (16 * n0 > qw0) ? 2 : ((qw0 - 16 * (n0 + 31) - 31 >= 113) ? 0 : 1); }
__device__ __forceinline__ void cmp_bm1(f32x16& p, const LAS float* bl, int qabs, int n0, int hi) {
#pragma unroll
    for (int r = 0; r < 16; ++r) { const int d = qabs - 16 * (n0 + crow(r, hi)) - 31; p[r] += bl[d < 0 ? 0 : (d > 255 ? 255 : d)]; if (d < 0) p[r] = NEGB; }
}
__device__ __forceinline__ void cmp_pass(LAS unsigned char* lds, const bf16x8 (&qf)[4], const LAS float* bl, LAS float* ip, bool need_sel, float mref, int qw0, int qabs,
                                         int lane, int r32, int hi, f32x16 (&o)[2], float& l, float& rmax) {
    l = 0.f; rmax = NEGB; float prevR = 0.f;
    o[0] = (f32x16){0.f, 0.f, 0.f, 0.f, 0.f, 0.f, 0.f, 0.f, 0.f, 0.f, 0.f, 0.f, 0.f, 0.f, 0.f, 0.f}; o[1] = o[0];
#pragma unroll
    for (int tl = 0; tl < 2; ++tl) {
        const int c0 = cmp_class(qw0, 64 * tl), c1 = cmp_class(qw0, 64 * tl + 32);
        if (c0 == 2) {
            if (need_sel) {
#pragma unroll
                for (int gq = 0; gq < 8; ++gq) ip[2 * (8 * tl + gq)] = (gq == 0 && hi == 0) ? prevR : 0.f; }
            prevR = 0.f;
        } else {
            f32x16 p0, p1;
            qk_tile(p0, p1, lds + tl * 16384, 0, qf, r32, hi);
            if (c0 == 1) cmp_bm1(p0, bl, qabs, 64 * tl, hi);
            if (c1 == 1) cmp_bm1(p1, bl, qabs, 64 * tl + 32, hi);
            else if (c1 == 2) { p1 = (f32x16){NEGB, NEGB, NEGB, NEGB, NEGB, NEGB, NEGB, NEGB, NEGB, NEGB, NEGB, NEGB, NEGB, NEGB, NEGB, NEGB}; }
            float ra = max3f(p0[0], p0[1], p1[0]), rb2 = max3f(p0[2], p0[3], p1[1]); ra = max3f(ra, p1[2], p1[3]);
#pragma unroll
            for (int r = 4; r < 16; r += 4) { ra = max3f(ra, p0[r], p0[r + 1]); rb2 = max3f(rb2, p0[r + 2], p0[r + 3]); ra = max3f(ra, p1[r], p1[r + 1]); rb2 = max3f(rb2, p1[r + 2], p1[r + 3]); }
            rmax = max3f(rmax, ra, rb2);
            float s0 = 0.f, s1 = 0.f;
#pragma unroll
            for (int r = 0; r < 16; ++r) { p0[r] = __builtin_amdgcn_exp2f(p0[r] - mref); p1[r] = __builtin_amdgcn_exp2f(p1[r] - mref); s0 += p0[r]; s1 += p1[r]; }
            l += s0 + s1;
            if (need_sel) { imp_tile(p0, 8 * tl, ip, 1.f, hi, prevR); imp_tile(p1, 8 * tl + 4, ip, 1.f, hi, prevR); }
            pv_tile<2>(o, lds + tl * 16384 + 8192, p0, p1, lane);
        }
    }
}
__device__ __forceinline__ void nsa_unit(LAS unsigned char* lds, const NsaArgs& A, int b, int g, int qt) {
    int tid_ = threadIdx.x; asm volatile("" : "+v"(tid_));
    const int tid = tid_, wid = __builtin_amdgcn_readfirstlane(tid >> 6);
    int lane = tid & 63, r32 = lane & 31, hi = lane >> 5;
#define NSA_RELANE() do { asm volatile("" : "+v"(lane)); r32 = lane & 31; hi = lane >> 5; qabs = qw0 + r32; } while (0)
    const int hh = wid >> 1, head = g * 4 + hh, q0 = qt * 64, qw0 = q0 + (wid & 1) * 32; int qabs = qw0 + r32;
    LAS float* bl = (LAS float*)(lds + 32768) + hh * 256;
    LAS float* wsf = (LAS float*)(lds + 36864) + wid * 64;
    LAS float* ipart = (LAS float*)(lds + 40960);
    LAS float* itot = (LAS float*)(lds + 73728);
    LAS unsigned* sell = (LAS unsigned*)(lds + 81920);
    LAS float* invs = (LAS float*)(lds + 82176);
    LAS f32x16* otl = (LAS f32x16*)(lds + 86016) + (size_t)wid * 128 + lane;
    const size_t rowb = (size_t)b * S;
    for (int i = tid; i < 1024; i += 512) ((LAS float*)(lds + 32768))[i] = A.rel_bias[g * 1024 + i];
    { const unsigned char* Kc = (const unsigned char*)A.KC + (size_t)(b * 2 + g) * 16384; const unsigned char* Vc = (const unsigned char*)A.VC + (size_t)(b * 2 + g) * 16384;
      stage_img<8>(lds, Kc, wid, lane); stage_img<8>(lds + 8192, Vc, wid, lane);
      stage_img<8>(lds + 16384, Kc + 8192, wid, lane); stage_img<8>(lds + 24576, Vc + 8192, wid, lane); }
    bf16x8 qf[4];
    { const bf16* qp = A.Q + (rowb + qabs) * 512 + head * 64 + hi * 8;
#pragma unroll
      for (int d0 = 0; d0 < 4; ++d0) qf[d0] = *(const bf16x8*)(qp + d0 * 16); }
    ATT_WAIT_BAR();
    const bool need_sel = (qt >= 16);
    {
        NSA_RELANE();
        LAS float* ip = ipart + ((size_t)hh * 64 + (wid & 1) * 32 + r32) * 32 + hi;
        f32x16 o[2]; float l, rmax;
        cmp_pass(lds, qf, bl, ip, need_sel, 0.f, qw0, qabs, lane, r32, hi, o, l, rmax);
        if (__any(rmax > 64.f)) {
            rmax = fmaxf(rmax, __shfl_xor(rmax, 32));
            float dummy;
            cmp_pass(lds, qf, bl, ip, need_sel, fmaxf(rmax, 0.f), qw0, qabs, lane, r32, hi, o, l, dummy);
        }
        l += __shfl_xor(l, 32);
        const float inv = l > 0.f ? 1.f / l : 0.f;
        if (hi == 0) invs[hh * 64 + (wid & 1) * 32 + r32] = inv;
        { int qa = qabs; asm volatile("" : "+v"(qa)); scale_rows<2>(o, A.GN[(rowb + qa) * 24 + head] * inv, wsf, r32, hi); }
        otl[0] = o[0]; otl[64] = o[1];
    }
    ATT_WAIT_BAR();
    unsigned selq, un;
    if (need_sel) {
        {
            const int q = tid >> 3, j4 = (tid & 7) * 4;
#pragma unroll
            for (int jj = 0; jj < 4; ++jj) { const int j = j4 + jj; itot[q * 32 + j] = ((ipart[(0 * 64 + q) * 32 + j] * invs[q] + ipart[(1 * 64 + q) * 32 + j] * invs[64 + q]) + ipart[(2 * 64 + q) * 32 + j] * invs[128 + q]) + ipart[(3 * 64 + q) * 32 + j] * invs[192 + q]; }
        }
        ATT_WAIT_BAR();
        {
            const int j = lane & 31;
#pragma unroll 1
            for (int rd = 0; rd < 4; ++rd) {
                const int q = wid * 8 + rd * 2 + hi;
                const bool vj = j <= qt, fj = (j == 0) || (j == qt) || (j == qt - 1);
                const float sj = vj ? itot[q * 32 + j] + (fj ? 1e4f : 0.f) : -1e30f;
                int cnt = 0;
#pragma unroll 4
                for (int k = 0; k < 32; ++k) {
                    const bool vk = k <= qt, fk = (k == 0) || (k == qt) || (k == qt - 1);
                    const float sk = vk ? itot[q * 32 + k] + (fk ? 1e4f : 0.f) : -1e30f;
                    cnt += (sk > sj || (sk == sj && k < j)) ? 1 : 0;
                }
                const unsigned long long bal = __ballot(cnt < 16);
                if (lane == 0) sell[q] = (unsigned)bal;
                if (lane == 32) sell[q] = (unsigned)(bal >> 32);
            }
        }
        ATT_WAIT_BAR();
        NSA_RELANE();
        selq = sell[(wid & 1) * 32 + r32];
        un = sell[lane];
#pragma unroll
        for (int sft = 1; sft < 64; sft <<= 1) un |= __shfl_xor(un, sft);
        un = __builtin_amdgcn_readfirstlane(un) & (qt >= 31 ? 0xffffffffu : ((2u << qt) - 1u));
    } else {
        selq = (2u << qt) - 1u; un = selq;
    }
    for (int i = tid; i < 5120; i += 512) ipart[i] = A.biasv[(size_t)g * 5120 + i];
    const LAS float* rt = ipart + hh * 1280;
    {
        NSA_RELANE();
        const unsigned char* Kg = (const unsigned char*)A.KS + (size_t)(b * 2 + g) * 32 * 8192; const unsigned char* Vg = (const unsigned char*)A.VS + (size_t)(b * 2 + g) * 32 * 8192;
        f32x16 o[2]; o[0] = (f32x16){0.f, 0.f, 0.f, 0.f, 0.f, 0.f, 0.f, 0.f, 0.f, 0.f, 0.f, 0.f, 0.f, 0.f, 0.f, 0.f}; o[1] = o[0];
        float m = 0.f, l = 0.f;
        unsigned rem = un; int j = __builtin_ctz(rem); rem &= rem - 1u; int it = 0;
        stage_img<8>(lds, Kg + (size_t)j * 8192, wid, lane); stage_img<8>(lds + 8192, Vg + (size_t)j * 8192, wid, lane);
        ATT_WAIT_BAR();
        for (;;) {
            LAS unsigned char* cur = lds + (it & 1) * 16384; LAS unsigned char* nxt = lds + ((it + 1) & 1) * 16384;
            const int jn = rem ? __builtin_ctz(rem) : -1;
            if (jn >= 0) { rem &= rem - 1u; stage_img<8>(nxt, Kg + (size_t)jn * 8192, wid, lane); stage_img<8>(nxt + 8192, Vg + (size_t)jn * 8192, wid, lane); }
            const int kt0 = j * 64;
            if (kt0 <= qw0 + 31 && __any((selq >> j) & 1u)) {
                f32x16 p0, p1;
                qk_tile(p0, p1, cur, 0, qf, r32, hi);
                const bool causal = (kt0 + 63 > qw0), near_ = (qw0 - (kt0 + 63) < 113);
                if (causal || near_) bias_vec(p0, p1, rt, qabs - kt0, hi);
                if (!__all((selq >> j) & 1u)) {
                    const float off = ((selq >> j) & 1u) ? 0.f : NEGB;
#pragma unroll
                    for (int r = 0; r < 16; ++r) { p0[r] += off; p1[r] += off; } }
                softmax_step<2>(p0, p1, m, l, o, wsf, r32, hi);
                pv_tile<2>(o, cur + 8192, p0, p1, lane);
            }
            ATT_WAIT_BAR();
            if (jn < 0) break;
            j = jn; ++it;
        }
        l += __shfl_xor(l, 32);
        { int qa = qabs; asm volatile("" : "+v"(qa)); scale_rows<2>(o, A.GN[(rowb + qa) * 24 + 8 + head] / l, wsf, r32, hi); }
        otl[0] = otl[0] + o[0]; otl[64] = otl[64] + o[1];
    }
    f32x16 ot[2];
    {
        NSA_RELANE();
        const unsigned char* Kg = (const unsigned char*)A.KW + (size_t)(b * 2 + g) * 32 * 8192; const unsigned char* Vg = (const unsigned char*)A.VW + (size_t)(b * 2 + g) * 32 * 8192;
        f32x16 o[2]; o[0] = (f32x16){0.f, 0.f, 0.f, 0.f, 0.f, 0.f, 0.f, 0.f, 0.f, 0.f, 0.f, 0.f, 0.f, 0.f, 0.f, 0.f}; o[1] = o[0];
        float m = 0.f, l = 0.f;
        const int j0 = qt >= 8 ? qt - 8 : 0;
        stage_img<8>(lds, Kg + (size_t)j0 * 8192, wid, lane); stage_img<8>(lds + 8192, Vg + (size_t)j0 * 8192, wid, lane);
        ATT_WAIT_BAR();
        for (int j = j0; j <= qt; ++j) {
            const int it = j - j0;
            LAS unsigned char* cur = lds + (it & 1) * 16384; LAS unsigned char* nxt = lds + ((it + 1) & 1) * 16384;
            if (j < qt) { stage_img<8>(nxt, Kg + (size_t)(j + 1) * 8192, wid, lane); stage_img<8>(nxt + 8192, Vg + (size_t)(j + 1) * 8192, wid, lane); }
            const int kt0 = j * 64;
            if (kt0 <= qw0 + 31) {
                f32x16 p0, p1;
                qk_tile(p0, p1, cur, 0, qf, r32, hi);
                const bool causal = (kt0 + 63 > qw0), near_ = (qw0 - (kt0 + 63) < 113), band = (qw0 + 31 - kt0 >= 512);
                if (causal || near_) bias_vec(p0, p1, rt, qabs - kt0, hi);
                else if (band) bias_mask<false, false, true>(p0, p1, bl, qabs, kt0, hi);
                softmax_step<2>(p0, p1, m, l, o, wsf, r32, hi);
                pv_tile<2>(o, cur + 8192, p0, p1, lane);
            }
            ATT_WAIT_BAR();
        }
        l += __shfl_xor(l, 32);
        { int qa = qabs; asm volatile("" : "+v"(qa)); scale_rows<2>(o, A.GN[(rowb + qa) * 24 + 16 + head] / l, wsf, r32, hi); }
        ot[0] = otl[0] + o[0]; ot[1] = otl[64] + o[1];
    }
    {   int hi_ = hi, r32_ = r32; asm volatile("" : "+v"(hi_), "+v"(r32_));
        bf16* op = A.O + (rowb + qw0 + 4 * hi_) * 512 + head * 64 + r32_;
#pragma unroll
        for (int eb = 0; eb < 2; ++eb)
#pragma unroll
            for (int r = 0; r < 16; ++r) op[(size_t)((r & 3) + 8 * (r >> 2)) * 512 + eb * 32] = f2bf(ot[eb][r]); }
#undef NSA_RELANE
}
}

constexpr int NCLS = 24;
constexpr int CW_CMPD = 10752, CW_FIN = 11008;
constexpr int CW_WQ = 10240;
constexpr int CW_CNT = 8192;
constexpr size_t WS_LIST = 254 * MiB;
constexpr int MISC_OFF = 161792;
constexpr int TAB_OFF = MISC_OFF + 256;
__device__ __forceinline__ void class_experts(int c, int& ea, int& eb) {
    const int g = c / 6, p = c % 6; const int a = p < 3 ? 0 : (p < 5 ? 1 : 2); const int b = p < 3 ? p + 1 : (p < 5 ? p - 1 : 3); ea = g * 4 + a; eb = g * 4 + b; }
__device__ __forceinline__ void moe_build_tab(const unsigned* ctl, LAS int* tab) {
    if (threadIdx.x == 0) { int tiles = 0;
        for (int c = 0; c < NCLS; ++c) { const int n = (int)__hip_atomic_load(ctl + CW_CNT + 64 * c, __ATOMIC_RELAXED, __HIP_MEMORY_SCOPE_AGENT); const int nt_ = (n + 255) >> 8;
            tab[c] = tiles; tab[32 + c] = n; for (int j = 0; j < nt_; ++j) tab[64 + tiles + j] = c; tiles += nt_; }
        tab[NCLS] = tiles; }
    __syncthreads();
}
struct OpsGU { const bf16* H2; const bf16* WGU; const unsigned* LIST; const LAS int* tab; static constexpr int NT = 16, LDB = 1024;
    __device__ __forceinline__ const char* a_base(const pg8::Unit&) const { return (const char*)H2; }
    __device__ __forceinline__ void a_voff(const pg8::Unit& u, const int (&R)[2], const int (&C)[2], unsigned (&out)[2][2]) const {
        const int c = tab[64 + u.pm], n = tab[32 + c], r0 = (u.pm - tab[c]) * 256;
#pragma unroll
        for (int h = 0; h < 2; ++h)
#pragma unroll
            for (int i = 0; i < 2; ++i) { const int r = r0 + h * 128 + R[i]; const unsigned tok = (r < n) ? LIST[(size_t)c * T + r] : 0u; out[h][i] = (tok * 1024u + (unsigned)C[i]) * 2u; } }
    __device__ __forceinline__ void bprep(const pg8::Unit& u, const char*& p0, const char*& p1) const {
        int ea, eb; class_experts(tab[64 + u.pm], ea, eb); const int e = u.z ? eb : ea; p0 = (const char*)(WGU + ((size_t)e * 1024 + u.pn * 256) * 1024); p1 = p0; }
    __device__ static __forceinline__ const char* bat(const char* p0, const char*, int kt) { return p0 + (size_t)kt * 128; } };
constexpr int CW_MQ = 10496;
constexpr int CW_DONE = 12288;
struct SchedGU { const LAS int* tab; int G, vcu;
    __device__ __forceinline__ bool next(int i, pg8::Unit& u) const { const int L = i * G + vcu; if (L >= tab[NCLS] * 8) return false; u.pm = L >> 3; u.z = (L >> 2) & 1; u.pn = L & 3; return true; } };
struct EpiGU { bf16* HID; const unsigned* LIST; const float* ROUTE; const LAS int* tab; unsigned* ctl;
    __device__ __forceinline__ void operator()(const pg8::f32x4 (&acc)[2][2][4][2], const pg8::Unit& u, int wr, int wc, int fr_, int fq_) const {
        int fr = fr_, fq = fq_; asm volatile("" : "+v"(fr), "+v"(fq));
        const int c = tab[64 + u.pm], n = tab[32 + c], r0 = (u.pm - tab[c]) * 256;
        const __amdgpu_buffer_rsrc_t rsrc = __builtin_amdgcn_make_buffer_rsrc((void*)HID, 0, 0x7fffffff, 0x00020000);
#pragma unroll
        for (int ai = 0; ai < 2; ++ai)
#pragma unroll
            for (int m = 0; m < 4; ++m) {
                const int rl = ai * 128 + wr * 64 + m * 16 + fr, r = r0 + rl;
                if (r < n) {
                    const unsigned tok = LIST[(size_t)c * T + r]; const float w = ROUTE[(size_t)tok * 4 + u.z], rs = ROUTE[(size_t)tok * 4 + 3];
                    float v[8];
#pragma unroll
                    for (int nn = 0; nn < 2; ++nn)
#pragma unroll
                        for (int i = 0; i < 4; ++i) { const float gt = acc[ai][0][m][nn][i] * rs, up = acc[ai][1][m][nn][i] * rs; v[4 * nn + i] = gt * __builtin_amdgcn_rcpf(1.f + __builtin_amdgcn_exp2f(-1.4426950408889634f * gt)) * up * w; }
                    uint4 o; o.x = pg8::cvt_pk_bf16(v[0], v[1]); o.y = pg8::cvt_pk_bf16(v[2], v[3]); o.z = pg8::cvt_pk_bf16(v[4], v[5]); o.w = pg8::cvt_pk_bf16(v[6], v[7]);
                    __builtin_amdgcn_raw_buffer_store_b128(__builtin_bit_cast(pg8::u32x4, o), rsrc, (int)(((unsigned)(u.pm * 256 + rl) * 1024u + (unsigned)(u.z * 512 + u.pn * 128 + wc * 32 + 8 * fq)) * 2u), 0, 16);
                }
                asm volatile("" ::: "memory");
            }
        asm volatile("s_waitcnt vmcnt(0)" ::: "memory");
        if (fr == 0 && fq == 0) __hip_atomic_fetch_add(ctl + CW_DONE + 64 * u.pm, 1u, __ATOMIC_RELAXED, __HIP_MEMORY_SCOPE_AGENT);
    }
};
struct OpsDN { const bf16* HID; const bf16* WDN; const LAS int* tab; static constexpr int NT = 16, LDB = 512;
    __device__ __forceinline__ const char* a_base(const pg8::Unit& u) const { return (const char*)(HID + (size_t)u.pm * 256 * 1024); }
    __device__ __forceinline__ void a_voff(const pg8::Unit&, const int (&R)[2], const int (&C)[2], unsigned (&out)[2][2]) const {
#pragma unroll
        for (int h = 0; h < 2; ++h)
#pragma unroll
            for (int i = 0; i < 2; ++i) out[h][i] = (unsigned)((h * 128 + R[i]) * 1024 + C[i]) * 2u; }
    __device__ __forceinline__ void bprep(const pg8::Unit& u, const char*& p0, const char*& p1) const {
        int ea, eb; class_experts(tab[64 + u.pm], ea, eb);
        p0 = (const char*)(WDN + ((size_t)ea * 1024 + u.pn * 256) * 512); p1 = (const char*)(WDN + ((size_t)eb * 1024 + u.pn * 256) * 512); }
    __device__ static __forceinline__ const char* bat(const char* p0, const char* p1, int kt) { return (kt < 8 ? p0 : p1) + (size_t)(kt & 7) * 128; } };
struct SchedDN { const LAS int* tab; unsigned* ctl; int G, vcu;
    __device__ __forceinline__ bool next(int i, pg8::Unit& u) const {
        const int total = tab[NCLS] * 4;
        int L = -1;
        if (i == 0) L = vcu; else if (i == 1) { const int e = G - 1 - vcu; if (G + e < total) L = G + e; }
        if (L < 0 || L >= total) L = -1;
        __builtin_amdgcn_s_barrier();
        if (threadIdx.x == 0 && L >= 0) {
            unsigned* dn = ctl + CW_DONE + 64 * (L >> 2); unsigned sp = 0;
            while (__hip_atomic_load(dn, __ATOMIC_RELAXED, __HIP_MEMORY_SCOPE_AGENT) < 64u) { __builtin_amdgcn_s_sleep(2); if (++sp > (1u << 22)) { atomicAdd(ctl + XB_TMO + CW_BAR, 1u); break; } }
            __builtin_amdgcn_fence(__ATOMIC_ACQUIRE, "agent");
            asm volatile("s_waitcnt vmcnt(0)" ::: "memory");
        }
        __builtin_amdgcn_s_barrier();
        if (L < 0) return false; u.pm = L >> 2; u.pn = L & 3; u.z = 0; return true; } };
struct EpiDN { float* O; const bf16* X2; const unsigned* LIST; const LAS int* tab;
    __device__ __forceinline__ void operator()(const pg8::f32x4 (&acc)[2][2][4][2], const pg8::Unit& u, int wr, int wc, int fr_, int fq_) const {
        int fr = fr_, fq = fq_; asm volatile("" : "+v"(fr), "+v"(fq));
        const int c = tab[64 + u.pm], n = tab[32 + c], r0 = (u.pm - tab[c]) * 256;
#pragma unroll
        for (int ai = 0; ai < 2; ++ai)
#pragma unroll
            for (int m = 0; m < 4; ++m) {
                const int r = r0 + ai * 128 + wr * 64 + m * 16 + fr;
                if (r < n) {
                    const unsigned tok = LIST[(size_t)c * T + r];
#pragma unroll
                    for (int bj = 0; bj < 2; ++bj) { const size_t off = (size_t)tok * 1024 + u.pn * 256 + bj * 128 + wc * 32 + 8 * fq;
                        const uint4 xw = *(const uint4*)(X2 + off); const pg8::f32x4 a0 = acc[ai][bj][m][0], a1 = acc[ai][bj][m][1];
                        const nt_f32x4 y0 = {LO16(xw.x) + a0[0], HI16(xw.x) + a0[1], LO16(xw.y) + a0[2], HI16(xw.y) + a0[3]}, y1 = {LO16(xw.z) + a1[0], HI16(xw.z) + a1[1], LO16(xw.w) + a1[2], HI16(xw.w) + a1[3]};
                        __builtin_nontemporal_store(y0, (nt_f32x4*)(O + off)); __builtin_nontemporal_store(y1, (nt_f32x4*)(O + off + 4)); }
                }
            }
    }
};

constexpr int NTHR = 512;
constexpr int LDS_BYTES = 163840;

__global__ void __launch_bounds__(NTHR, 2) fwd_kernel(Args args) {
    extern __shared__ __attribute__((aligned(16))) unsigned char lds[];
    const int tid = threadIdx.x, lane = tid & 63;
    const int gtid = blockIdx.x * NTHR + tid, nthreads = gridDim.x * NTHR;
    const int gwave = gtid >> 6, nwaves = nthreads >> 6;
    Ctx c; c.a = args; unsigned char* ws = args.ws;

    volatile LAS unsigned* MISC = (volatile LAS unsigned*)((LAS unsigned char*)lds + MISC_OFF);
    if (tid < 32) MISC[tid] = 0u;
    __syncthreads();
    XcdBarrier bar = xcd_barrier_post((unsigned*)(ws + WS_CTL) + CW_BAR, MISC + 8);
    const int lo = args.ph_lo, hi = args.ph_hi;
#ifdef ONLY_PHASE
#define IN(k) ((k) == ONLY_PHASE)
#else
#define IN(k) (lo <= (k) && (k) < hi)
#endif
#define SEAM(k) do { if (IN(k) && IN((k) + 1)) xcd_barrier(bar); } while (0)


    if (IN(0)) {
        for (int t = gwave * 2; t < T; t += nwaves * 2) {
            const float4* xr = (const float4*)(c.x() + (size_t)t * D) + lane;
            float4 v[8]; float s0 = 0.f, s1 = 0.f;
#pragma unroll
            for (int j = 0; j < 8; ++j) v[j] = xr[64 * j];
#pragma unroll
            for (int j = 0; j < 4; ++j) { s0 += v[j].x * v[j].x + v[j].y * v[j].y + v[j].z * v[j].z + v[j].w * v[j].w; s1 += v[4 + j].x * v[4 + j].x + v[4 + j].y * v[4 + j].y + v[4 + j].z * v[4 + j].z + v[4 + j].w * v[4 + j].w; }
            const float r0 = rsqrtf(wave_sum(s0) * (1.f / D) + RMS_EPS), r1 = rsqrtf(wave_sum(s1) * (1.f / D) + RMS_EPS);
#pragma unroll
            for (int j = 0; j < 8; ++j) { const float4 g = ((const float4*)c.norm1_g())[lane + 64 * (j & 3)]; const float r = j < 4 ? r0 : r1;
                uint2 o; o.x = pk2bf(v[j].x * r * g.x, v[j].y * r * g.y); o.y = pk2bf(v[j].z * r * g.z, v[j].w * r * g.w);
                ((uint2*)(c.H1() + (size_t)t * D))[lane + 64 * j] = o; }
        }
        {
            LAS float* scr = (LAS float*)((LAS unsigned char*)lds + (tid >> 6) * 16384);
            constexpr int I_IN = 16 * 160, I_OUT = 16 * 32, I_BR = 8 * 32, I_GU = 16 * 4 * 2 * 4 * 16, I_DN = 16 * 8 * 32, I_C1 = 512;
            for (int it = gwave; it < I_IN + I_OUT + 2 * I_BR + I_GU + I_DN + I_C1; it += nwaves) {
                int r = it;
                if (r < I_IN) { const int kb = r / 160, vb = r % 160, pn = vb >> 3, bj = (vb >> 2) & 1, wc = vb & 3;
                    const ChunkDesc d = chunk_desc(c, pn * 4 + wc); int nv = d.ncols - 32 * bj; nv = nv < 0 ? 0 : (nv > 32 ? 32 : nv);
                    tr_item(c.w_in(), INC, 64 * kb, d.src + 32 * bj, nv, c.WIN(), 1024, 256 * pn + 128 * bj + 32 * wc, scr, lane); continue; }
                r -= I_IN;
                if (r < I_OUT) { tr_item(c.w_out(), 1024, 64 * (r / 32), 32 * (r % 32), 32, c.WOUT(), 1024, 32 * (r % 32), scr, lane); continue; }
                r -= I_OUT;
                if (r < I_BR) { tr_item(c.w_bn(), 1024, 64 * (r / 32), 32 * (r % 32), 32, c.WBN(), 512, 32 * (r % 32), scr, lane); continue; }
                r -= I_BR;
                if (r < I_BR) { tr_item(c.w_bd(), 1024, 64 * (r / 32), 32 * (r % 32), 32, c.WBD(), 512, 32 * (r % 32), scr, lane); continue; }
                r -= I_BR;
                if (r < I_GU) { const int kb = r & 15, blk = (r >> 4) & 3, bj = (r >> 6) & 1, ntile = (r >> 7) & 3, e = r >> 9;
                    tr_item((bj ? c.w_up() : c.w_gate()) + (size_t)e * 1024 * 512, 512, 64 * kb, ntile * 128 + 32 * blk, 32, c.WGU() + (size_t)e * 1024 * 1024, 1024, 256 * ntile + 128 * bj + 32 * blk, scr, lane, c.norm2_g()); continue; }
                r -= I_GU;
                if (r < I_DN) { const int nb = r & 31, kb = (r >> 5) & 7, e = r >> 8;
                    tr_item(c.w_down() + (size_t)e * 512 * 1024, 1024, 64 * kb, 32 * nb, 32, c.WDN() + (size_t)e * 1024 * 512, 512, 32 * nb, scr, lane); continue; }
                r -= I_DN;
                { const int nb = r & 7, kb = (r >> 3) & 15, bot = (r >> 7) & 1, kv = r >> 8;
                    tr_item(c.cmp_w1() + (size_t)kv * 2048 * 256 + (size_t)bot * 1024 * 256, 256, 64 * kb, 32 * nb, 32, c.WC1() + (size_t)kv * 512 * 1024, 1024, bot * 256 + 32 * nb, scr, lane); }
            }
            if (gwave >= nwaves - 64) { const int w = gwave - (nwaves - 64), sl = w & 7, jb = (w >> 3) & 3, kv = w >> 5, j = jb * 64 + lane;
                const float* w1 = c.cmp_w1() + (size_t)kv * 2048 * 256 + (size_t)sl * 256 * 256 + j; const float* pos = c.cmp_pos() + kv * 2048 + sl * 256;
                float a0 = 0.f, a1 = 0.f, a2 = 0.f, a3 = 0.f;
                for (int k = 0; k < 256; k += 4) { a0 += pos[k] * w1[(size_t)k * 256]; a1 += pos[k + 1] * w1[(size_t)(k + 1) * 256]; a2 += pos[k + 2] * w1[(size_t)(k + 2) * 256]; a3 += pos[k + 3] * w1[(size_t)(k + 3) * 256]; }
                c.POSB()[(sl * 2 + kv) * 256 + j] = (a0 + a1) + (a2 + a3); }
            if (gtid >= 8192 && gtid < 8192 + 12 * 1280) { const int i = gtid - 8192, hd = i / 1280, a = (i % 1280) / 320, j = (i % 320) + a, d = 208 - j;
                c.BIASV()[i] = (d < 0) ? -1e30f : (d >= 113 ? 0.f : (c.rel_bias()[t5_bucket(d) * 12 + hd] - c.rel_bias()[31 * 12 + hd]) * 1.4426950408889634f); }
            if (gtid >= 4096 && gtid < 4096 + 3072) { const int i = gtid - 4096, hd = i >> 8, d = i & 255; c.BIAS()[i] = (c.rel_bias()[t5_bucket(d) * 12 + hd] - c.rel_bias()[31 * 12 + hd]) * 1.4426950408889634f; }
            if (gtid >= 512 && gtid < 512 + 2048) { const int i = gtid - 512, kv = i >> 10, bg = (i >> 6) & 15, e = i & 63; const size_t tb = ((size_t)bg * 2 + 1) * 4096; if (kv) c.VCMP()[tb + (e >> 5) * 2048 + 3 * 512 + 15 * 32 + (e & 31)] = 0; else c.KCMP()[tb + (e >> 3) * 512 + 63 * 8 + (e & 7)] = 0; }
        }
        if (gwave == 0) {
            const float a = wave_sum(c.diff_lambda()[lane] * c.diff_lambda()[64 + lane]);
            const float b = wave_sum(c.diff_lambda()[128 + lane] * c.diff_lambda()[192 + lane]);
            if (lane == 0) c.LAM()[0] = expf(a) - expf(b) + LAMBDA_INIT;
        }
    }
    xcd_barrier(bar);

    if (IN(1)) {
        pg8::Ops g; g.A0 = c.H1(); g.A1 = c.H1(); g.B0 = c.WIN(); g.B1 = c.WIN(); g.K = 1024;
        pg8::StaticOrder<1> So; So.init(T, 5120, (int)gridDim.x, (int)blockIdx.x);
        EpiInProj E; E.c = c;
        pg8::gemm_phase(( LAS unsigned char*)lds, g, So, E);
    }
    xcd_barrier(bar);

    if (IN(2)) {
        pg8::Ops g; g.A0 = c.CT(); g.A1 = c.CT(); g.B0 = c.WC1(); g.B1 = c.WC1() + 512 * 1024; g.K = 1024;
        SchedCmp So; So.c = (int)blockIdx.x;
        EpiF32 E; E.O = c.U(); E.ldc = 512;
        pg8::gemm_phase((LAS unsigned char*)lds, g, So, E);
        unsigned* ctl = (unsigned*)(ws + WS_CTL);
        volatile LAS int* wq = (volatile LAS int*)((LAS unsigned char*)lds + MISC_OFF + 64);
        if (blockIdx.x < 32 && tid == 0) { __builtin_amdgcn_fence(__ATOMIC_RELEASE, "agent"); asm volatile("s_waitcnt vmcnt(0)" ::: "memory");
            __hip_atomic_fetch_add(ctl + CW_CMPD, 1u, __ATOMIC_RELAXED, __HIP_MEMORY_SCOPE_AGENT); }
        {   att::DiffArgs A; A.Q = c.QD(); A.K = c.KD(); A.V = c.VD(); A.O = c.ODIFF(); A.biasv = c.BIASV(); A.out_gain = c.diff_out_norm(); A.lam = c.LAM()[0];
            for (;;) {
                __syncthreads();
                if (tid == 0) *wq = (int)atomicAdd(ctl + CW_WQ, 1u);
                __syncthreads();
                const int u = *wq;
                if (u >= 512) break;
                att::diff_unit((LAS unsigned char*)lds, A, (u & 31) >> 2, u & 3, 15 - (u >> 5));
            } }
        {   __syncthreads();
            if (tid == 0) { unsigned sp = 0;
                while (__hip_atomic_load(ctl + CW_CMPD, __ATOMIC_RELAXED, __HIP_MEMORY_SCOPE_AGENT) < 32u) { __builtin_amdgcn_s_sleep(2); if (++sp > (1u << 22)) { atomicAdd(ctl + XB_TMO + CW_BAR, 1u); break; } }
                __builtin_amdgcn_fence(__ATOMIC_ACQUIRE, "agent"); asm volatile("s_waitcnt vmcnt(0)" ::: "memory"); }
            __syncthreads();
            LAS float* hid = (LAS float*)((LAS unsigned char*)lds) + (tid >> 6) * 256;
            for (;;) {
                __syncthreads();
                if (tid == 0) *wq = (int)atomicAdd(ctl + CW_WQ + 128, 1u);
                __syncthreads();
                const int q = *wq;
                if (q >= 128) break;
                const int quarter = q & 3, b = (q >> 2) & 7, g = (q >> 5) & 1, kv = q >> 6;
                for (int jj = 0; jj < 4; ++jj) {
                    const int n = quarter * 32 + (tid >> 6) * 4 + jj;
                    if (n >= NCMP) continue;
                    const float* u1 = c.U() + ((size_t)(kv * 2 + g) * 1024 + b * 128 + n) * 512;
                    const float4 t4 = *(const float4*)(u1 + 4 * lane), b4 = *(const float4*)(u1 + 512 + 256 + 4 * lane), p4 = posb_sum(c.POSB() + kv * 256 + 4 * lane);
                    const float hv[4] = {t4.x + b4.x + p4.x, t4.y + b4.y + p4.y, t4.z + b4.z + p4.z, t4.w + b4.w + p4.w};
#pragma unroll
                    for (int i = 0; i < 4; ++i) { const float a = hv[i]; const float uu = 0.7978845608028654f * (a + 0.044715f * a * a * a); hid[4 * lane + i] = 0.5f * a * (1.f + tanhf(uu)); }
                    const float* w2 = c.cmp_w2() + (size_t)kv * 256 * 64 + lane;
                    float o = 0.f;
                    for (int j = 0; j < 256; ++j) o += hid[j] * w2[j * 64];
                    if (kv == 0) { const float ss = wave_sum(o * o); o = o * rsqrtf(ss * (1.f / 64.f) + RMS_EPS) * c.nsa_k_norm()[lane]; }
                    { const int key = n & 63, e = lane; const size_t tb = ((size_t)(b * 2 + g) * 2 + (n >> 6)) * 4096;
                      if (kv) c.VCMP()[tb + (e >> 5) * 2048 + (key >> 4) * 512 + (key & 15) * 32 + (e & 31)] = f2bf(o);
                      else c.KCMP()[tb + (e >> 3) * 512 + key * 8 + (e & 7)] = f2bf(o); }
                }
                asm volatile("s_waitcnt vmcnt(0)" ::: "memory");
                __syncthreads();
                if (tid == 0) { __builtin_amdgcn_fence(__ATOMIC_RELEASE, "agent"); asm volatile("s_waitcnt vmcnt(0)" ::: "memory");
                    __hip_atomic_fetch_add(ctl + CW_FIN + 64 * (b * 2 + g), 1u, __ATOMIC_RELAXED, __HIP_MEMORY_SCOPE_AGENT); }
            } }
        {   att::NsaArgs A; A.Q = c.QN(); A.KS = c.KS(); A.VS = c.VS(); A.KW = c.KW(); A.VW = c.VW(); A.KC = c.KCMP(); A.VC = c.VCMP(); A.GN = c.GN(); A.O = c.ONSAB(); A.rel_bias = c.BIAS(); A.biasv = c.BIASV();
            bool all_seen = false;
            for (;;) {
                __syncthreads();
                if (tid == 0) {
                    const int u = (int)atomicAdd(ctl + CW_WQ + 64, 1u);
                    if (u < 512 && !all_seen) {
                        unsigned* fc = ctl + CW_FIN + 64 * (u & 15); unsigned sp = 0;
                        while (__hip_atomic_load(fc, __ATOMIC_RELAXED, __HIP_MEMORY_SCOPE_AGENT) < 8u) { __builtin_amdgcn_s_sleep(2); if (++sp > (1u << 22)) { atomicAdd(ctl + XB_TMO + CW_BAR, 1u); break; } }
                        bool all = true;
                        for (int k = 0; k < 16; ++k) all = all && (__hip_atomic_load(ctl + CW_FIN + 64 * k, __ATOMIC_RELAXED, __HIP_MEMORY_SCOPE_AGENT) >= 8u);
                        __builtin_amdgcn_fence(__ATOMIC_ACQUIRE, "agent"); asm volatile("s_waitcnt vmcnt(0)" ::: "memory");
                        all_seen = all;
                    }
                    *wq = u;
                }
                __syncthreads();
                const int u = *wq;
                if (u >= 512) break;
                att::nsa_unit((LAS unsigned char*)lds, A, (u & 15) >> 1, u & 1, 31 - (u >> 4));
            } }
    }
    xcd_barrier(bar);
    if (IN(7)) {
        pg8::Ops g; g.A0 = c.ONSAB(); g.A1 = c.ODIFF(); g.B0 = c.WBN(); g.B1 = c.WBD(); g.K = 512;
        pg8::StaticOrder<2> So; So.init(T, 1024, (int)gridDim.x, (int)blockIdx.x);
        EpiMerge E; E.Y = c.Y(); E.GM = c.GM();
        pg8::gemm_phase((LAS unsigned char*)lds, g, So, E);
    }
    xcd_barrier(bar);
    if (IN(8)) {
        pg8::Ops g; g.A0 = c.Y(); g.A1 = c.Y(); g.B0 = c.WOUT(); g.B1 = c.WOUT(); g.K = 1024;
        pg8::StaticOrder<1> So; So.init(T, 1024, (int)gridDim.x, (int)blockIdx.x);
        EpiResid E; E.X = c.x(); E.O = c.X2B();
        pg8::gemm_phase((LAS unsigned char*)lds, g, So, E);
    }
    xcd_barrier(bar);
    if (IN(9)) {
        LAS int* smc = (LAS int*)((LAS unsigned char*)lds + 81920);
        LAS float* Wl = (LAS float*)lds;
        unsigned* ctl = (unsigned*)(ws + WS_CTL); unsigned* LIST = (unsigned*)(ws + WS_LIST);
        for (int k = tid; k < D; k += NTHR) {
            const float4 gw = *(const float4*)(c.rg_w() + (size_t)k * 4);
            Wl[0 * D + k] = gw.x; Wl[1 * D + k] = gw.y; Wl[2 * D + k] = gw.z; Wl[3 * D + k] = gw.w;
#pragma unroll
            for (int i4 = 0; i4 < 4; ++i4) { const float4 ew = *(const float4*)(c.re_w() + (size_t)k * 16 + 4 * i4);
                Wl[(4 + 4 * i4) * D + k] = ew.x; Wl[(5 + 4 * i4) * D + k] = ew.y; Wl[(6 + 4 * i4) * D + k] = ew.z; Wl[(7 + 4 * i4) * D + k] = ew.w; }
        }
        __syncthreads();
        for (int tb = blockIdx.x; tb < T / 64; tb += gridDim.x) {
#pragma unroll 1
            for (int j = 0; j < 8; j += 2) {
                const int tl0 = (tid >> 6) * 8 + j, t0 = tb * 64 + tl0;
                const uint2* xr = (const uint2*)(c.X2B() + (size_t)t0 * D) + lane;
                float4 v[8]; float ssa = 0.f, ssb = 0.f;
#pragma unroll
                for (int q = 0; q < 8; ++q) { const uint2 w = xr[64 * q]; v[q] = make_float4(LO16(w.x), HI16(w.x), LO16(w.y), HI16(w.y)); }
#pragma unroll
                for (int q = 0; q < 4; ++q) { ssa += v[q].x * v[q].x + v[q].y * v[q].y + v[q].z * v[q].z + v[q].w * v[q].w; ssb += v[4 + q].x * v[4 + q].x + v[4 + q].y * v[4 + q].y + v[4 + q].z * v[4 + q].z + v[4 + q].w * v[4 + q].w; }
                const float ra = rsqrtf(wave_sum(ssa) * (1.f / D) + RMS_EPS), rb = rsqrtf(wave_sum(ssb) * (1.f / D) + RMS_EPS);
                float ha[16], hb[16];
#pragma unroll
                for (int q = 0; q < 4; ++q) { const float4 g = ((const float4*)c.norm2_g())[lane + 64 * q];
                    ha[4 * q + 0] = v[q].x * ra * g.x; ha[4 * q + 1] = v[q].y * ra * g.y; ha[4 * q + 2] = v[q].z * ra * g.z; ha[4 * q + 3] = v[q].w * ra * g.w;
                    hb[4 * q + 0] = v[4 + q].x * rb * g.x; hb[4 * q + 1] = v[4 + q].y * rb * g.y; hb[4 * q + 2] = v[4 + q].z * rb * g.z; hb[4 * q + 3] = v[4 + q].w * rb * g.w; }
                float la[20], lb[20];
                const LAS float* wl = Wl + lane * 4;
#pragma unroll
                for (int i = 0; i < 20; ++i) {
                    float sa = 0.f, sb = 0.f;
#pragma unroll
                    for (int q = 0; q < 4; ++q) { const att::f32x4v w4 = *(const LAS att::f32x4v*)(wl + i * D + 256 * q);
                        sa += (ha[4 * q] * w4[0] + ha[4 * q + 1] * w4[1]) + (ha[4 * q + 2] * w4[2] + ha[4 * q + 3] * w4[3]);
                        sb += (hb[4 * q] * w4[0] + hb[4 * q + 1] * w4[1]) + (hb[4 * q + 2] * w4[2] + hb[4 * q + 3] * w4[3]); }
                    la[i] = sa; lb[i] = sb;
                    if ((i & 3) == 3) asm volatile("" ::: "memory");
                }
                const bool up = lane >= 32;
                float lg[20];
#pragma unroll
                for (int i = 0; i < 20; ++i) { const float keep = up ? lb[i] : la[i], send = up ? la[i] : lb[i]; float x = keep + __shfl_xor(send, 32);
                    x += __shfl_xor(x, 16); x += __shfl_xor(x, 8); x += __shfl_xor(x, 4); x += __shfl_xor(x, 2); x += __shfl_xor(x, 1); lg[i] = x; }
                const int tl = tl0 + (up ? 1 : 0), t = t0 + (up ? 1 : 0);
                if ((lane & 31) == 0) {
                    float gl[4];
#pragma unroll
                    for (int i = 0; i < 4; ++i) gl[i] = lg[i] + c.rg_b()[i];
                    int gt = 0; float gbest = gl[0];
#pragma unroll
                    for (int i = 1; i < 4; ++i) if (gl[i] > gbest) { gbest = gl[i]; gt = i; }
                    float gs = 0.f;
#pragma unroll
                    for (int i = 0; i < 4; ++i) gs += expf(gl[i] - gbest);
                    const float gp = 1.f / gs;
                    float el[4];
#pragma unroll
                    for (int i = 0; i < 4; ++i) { float v0 = 0.f;
#pragma unroll
                        for (int gg = 0; gg < 4; ++gg) v0 = (gg == gt) ? lg[4 + gg * 4 + i] + c.re_b()[gg * 4 + i] : v0;
                        el[i] = v0; }
                    int e0 = 0; float b0 = el[0];
#pragma unroll
                    for (int i = 1; i < 4; ++i) if (el[i] > b0) { b0 = el[i]; e0 = i; }
                    int e1 = -1; float b1 = -3.0e38f;
#pragma unroll
                    for (int i = 0; i < 4; ++i) if (i != e0 && el[i] > b1) { b1 = el[i]; e1 = i; }
                    const float p1 = expf(b1 - b0); const float w0 = gp / (1.f + p1), w1 = gp * p1 / (1.f + p1);
                    const int ea = e0 < e1 ? e0 : e1, eb = e0 < e1 ? e1 : e0;
                    const int pr = (ea == 0) ? eb - 1 : (ea == 1 ? eb + 1 : 5);
                    const int cls = gt * 6 + pr;
                    float* rp = c.ROUTE() + (size_t)t * 4;
                    rp[0] = e0 < e1 ? w0 : w1; rp[1] = e0 < e1 ? w1 : w0; rp[2] = __int_as_float(cls); rp[3] = up ? rb : ra;
                    smc[tl] = cls;
                }
            }
            __syncthreads();
            if (tid < 64) {
                const int mycls = smc[lane];
                for (int cc = 0; cc < NCLS; ++cc) {
                    const unsigned long long mask = __ballot(mycls == cc);
                    if (mask) {
                        const int cnt = __popcll(mask), rank = __popcll(mask & ((1ull << lane) - 1ull)), leader = __ffsll((long long)mask) - 1;
                        unsigned base = 0u;
                        if (lane == leader) base = atomicAdd(ctl + CW_CNT + 64 * cc, (unsigned)cnt);
                        base = __shfl(base, leader);
                        if (mycls == cc) LIST[(size_t)cc * T + base + rank] = (unsigned)(tb * 64 + lane);
                    }
                }
            }
            __syncthreads();
        }
    }
    xcd_barrier(bar);
    if (IN(10)) {
        LAS int* tab = (LAS int*)((LAS unsigned char*)lds + TAB_OFF);
        moe_build_tab((const unsigned*)(ws + WS_CTL), tab);
        unsigned* ctl = (unsigned*)(ws + WS_CTL);
        const int G = (int)gridDim.x, bx = (int)blockIdx.x, vcu = (G % 8 == 0) ? (bx % 8) * (G / 8) + bx / 8 : bx;
        {   OpsGU g; g.H2 = c.X2B(); g.WGU = c.WGU(); g.LIST = (const unsigned*)(ws + WS_LIST); g.tab = tab;
            SchedGU So; So.tab = tab; So.G = G; So.vcu = vcu;
            EpiGU E; E.HID = c.HID(); E.LIST = (const unsigned*)(ws + WS_LIST); E.ROUTE = c.ROUTE(); E.tab = tab; E.ctl = ctl;
            pg8::gemm_phase_g((LAS unsigned char*)lds, g, So, E); }
        {   OpsDN g; g.HID = c.HID(); g.WDN = c.WDN(); g.tab = tab;
            SchedDN So; So.tab = tab; So.ctl = ctl; So.G = G; So.vcu = vcu;
            EpiDN E; E.O = c.out(); E.X2 = c.X2B(); E.LIST = (const unsigned*)(ws + WS_LIST); E.tab = tab;
            pg8::gemm_phase_g((LAS unsigned char*)lds, g, So, E); }
    }
#undef IN
#undef SEAM
}

extern "C" void kernel_launch(void* const* d_in, const int* in_sizes, int n_in, void* d_out, int out_size, void* d_ws, size_t ws_size, hipStream_t stream) {
    static int grid = 0;
    if (grid == 0) {
        if (n_in != 24 || out_size != T * D || ws_size < WS_END) { fprintf(stderr, "kernel_launch: unexpected shapes (n_in %d out %d ws %zu)\n", n_in, out_size, ws_size); grid = -1; return; }
        int dev = 0, cus = 0, per_cu = 0;
        if (hipGetDevice(&dev) != hipSuccess || hipDeviceGetAttribute(&cus, hipDeviceAttributeMultiprocessorCount, dev) != hipSuccess) { grid = -1; return; }
        if (hipFuncSetAttribute((const void*)fwd_kernel, hipFuncAttributeMaxDynamicSharedMemorySize, LDS_BYTES) != hipSuccess) { fprintf(stderr, "kernel_launch: hipFuncSetAttribute failed\n"); grid = -1; return; }
        if (hipOccupancyMaxActiveBlocksPerMultiprocessor(&per_cu, (const void*)fwd_kernel, NTHR, LDS_BYTES) != hipSuccess || per_cu < 1) { fprintf(stderr, "kernel_launch: occupancy query says %d\n", per_cu); }
        (void)hipGetLastError();
        grid = cus;
    }
    if (grid < 0) return;
    (void)hipMemsetAsync((char*)d_ws + WS_CTL, 0, CTL_ZERO_BYTES, stream);
    Args a{};
    for (int i = 0; i < 24; ++i) a.in[i] = (const float*)d_in[i];
    a.out = (float*)d_out; a.ws = (unsigned char*)d_ws; a.ph_lo = 0; a.ph_hi = 11;
    hipLaunchKernelGGL(fwd_kernel, dim3(grid), dim3(NTHR), LDS_BYTES, stream, a);
}
```

```cpp
#include <hip/hip_runtime.h>
#include <cstdint>
#include <cstdio>

constexpr int NB = 8, S = 2048, D = 1024, T = NB * S;
constexpr int INC = 4888;
constexpr int C_QN = 0, C_KV = 512, C_GN = 1280, C_QD = 1304, C_KD = 1816, C_VD = 2328, C_GM = 2840;
constexpr int NCMP = 127;
constexpr float LAMBDA_INIT = 0.2f;
constexpr float RMS_EPS = 1e-6f;

typedef unsigned short bf16;
#define LAS __attribute__((address_space(3)))

constexpr size_t MiB = 1u << 20;
constexpr size_t WS_CTL = 0, CTL_ZERO_BYTES = 1 * MiB;
constexpr size_t WS_WIN = 1 * MiB;
constexpr size_t WS_WOUT = 11 * MiB;
constexpr size_t WS_WBN = 13 * MiB, WS_WBD = 14 * MiB;
constexpr size_t WS_WC1 = 15 * MiB;
constexpr size_t WS_WGU = 17 * MiB;
constexpr size_t WS_WDN = 49 * MiB;
constexpr size_t WS_H1 = 65 * MiB;
constexpr size_t WS_QN = 97 * MiB;
constexpr size_t WS_CT = 113 * MiB;
constexpr size_t WS_KS = 121 * MiB, WS_VS = 125 * MiB, WS_KW = 129 * MiB, WS_VW = 133 * MiB;
constexpr size_t WS_QD = 137 * MiB, WS_KD = 153 * MiB, WS_VD = 169 * MiB;
constexpr size_t WS_GM = 185 * MiB;
constexpr size_t WS_GN = 249 * MiB;
constexpr size_t WS_KCMP = 251 * MiB;
constexpr size_t WS_VCMP = 251 * MiB + 256 * 1024;
constexpr size_t WS_ROUTE = 252 * MiB + 512 * 1024;
constexpr size_t WS_LAM = 252 * MiB + 768 * 1024;
constexpr size_t WS_POSB = 252 * MiB + 800 * 1024;
constexpr size_t WS_BIAS = 252 * MiB + 832 * 1024;
constexpr size_t WS_BIASV = 252 * MiB + 848 * 1024;
constexpr size_t WS_END = 256 * MiB;
constexpr size_t WS_U = WS_H1;
constexpr size_t WS_ONSAB = WS_H1 + 16 * MiB;
constexpr size_t WS_X2B = WS_H1;
constexpr size_t WS_Y = WS_QN;
constexpr size_t WS_HID = WS_GM;

constexpr int CW_BAR = 4096;

#define XB_TMO      128
#define XB_XCNT(j)  (256  + 64 * (j))
#define XB_XSUB(j)  (1280 + 64 * (j))
#define XB_XGEN(j)  (2304 + 64 * (j))
#define XB_TOP      3328
#define XB_TOPGEN   3392
#define XCD_BAR_WORDS 3456
#define XB_SPIN_CAP (1u << 22)

__device__ __forceinline__ unsigned xb_ld(unsigned* p)              { return __hip_atomic_load(p, __ATOMIC_RELAXED, __HIP_MEMORY_SCOPE_AGENT); }
__device__ __forceinline__ unsigned xb_add(unsigned* p, unsigned v) { return __hip_atomic_fetch_add(p, v, __ATOMIC_RELAXED, __HIP_MEMORY_SCOPE_AGENT); }
__device__ __forceinline__ unsigned xb_xcc_id() { return (unsigned)__builtin_amdgcn_s_getreg((3 << 11) | 20) & 0xFu; }
#define XB_SPIN(cond, bar) do { unsigned _sp = 0; while (cond) { __builtin_amdgcn_s_sleep(1); \
    if ((++_sp & 255u) == 0u) { if (xb_ld(&(bar)[XB_TMO])) break; if (_sp > XB_SPIN_CAP) { atomicAdd(&(bar)[XB_TMO], 1u); break; } } } } while (0)

struct XcdBarrier { unsigned* bar; unsigned x; volatile LAS unsigned* st; };

__device__ __forceinline__ XcdBarrier xcd_barrier_post(unsigned* bar, volatile LAS unsigned* st) {
    XcdBarrier b; b.bar = bar; b.x = xb_xcc_id(); b.st = st;
    if (threadIdx.x == 0) (void)xb_add(&bar[XB_XCNT(b.x)], 1u);
    return b;
}
__device__ __forceinline__ void xcd_barrier_complete(unsigned* bar, unsigned x, unsigned& nloc, unsigned& nx) {
    const unsigned G = gridDim.x * gridDim.y * gridDim.z;
    unsigned sum, cnt, mine, sp = 0u;
    for (;;) {
        sum = 0u; cnt = 0u; mine = 0u;
#pragma unroll
        for (unsigned j = 0; j < 16; ++j) { const unsigned c = xb_ld(&bar[XB_XCNT(j)]); sum += c; cnt += (c > 0u) ? 1u : 0u; mine = (j == x) ? c : mine; }
        if (sum == G) break;
        __builtin_amdgcn_s_sleep(1);
        if ((++sp & 255u) == 0u) { if (xb_ld(&bar[XB_TMO])) break; if (sp > XB_SPIN_CAP) { atomicAdd(&bar[XB_TMO], 1u); break; } }
    }
    nloc = mine > 0u ? mine : 1u; nx = cnt > 0u ? cnt : 1u;
}
__device__ __forceinline__ void xcd_barrier(const XcdBarrier& b) {
    asm volatile("s_waitcnt vmcnt(0)" ::: "memory");
    __syncthreads();
    if (threadIdx.x == 0) {
        unsigned* bar = b.bar;
        __builtin_amdgcn_s_waitcnt(0);
        unsigned nloc = b.st[0], nx = b.st[1];
        if (nloc == 0u) { xcd_barrier_complete(bar, b.x, nloc, nx); b.st[0] = nloc; b.st[1] = nx; }
        const unsigned old = xb_add(&bar[XB_XSUB(b.x)], 1u);
        const unsigned gen = old / nloc;
        if (old + 1u == (gen + 1u) * nloc) {
            __builtin_amdgcn_fence(__ATOMIC_RELEASE, "agent");
            asm volatile("s_waitcnt vmcnt(0)" ::: "memory");
            const unsigned og = xb_add(&bar[XB_TOP], 1u);
            const unsigned tg = og / nx;
            if (og + 1u == (tg + 1u) * nx) xb_add(&bar[XB_TOPGEN], 1u);
            else XB_SPIN(xb_ld(&bar[XB_TOPGEN]) == tg, bar);
            __builtin_amdgcn_fence(__ATOMIC_ACQUIRE, "agent");
            xb_add(&bar[XB_XGEN(b.x)], 1u);
            asm volatile("s_waitcnt vmcnt(0)" ::: "memory");
        } else {
            XB_SPIN(xb_ld(&bar[XB_XGEN(b.x)]) == gen, bar);
            __builtin_amdgcn_fence(__ATOMIC_ACQUIRE, "agent");
            asm volatile("s_waitcnt vmcnt(0)" ::: "memory");
        }
    }
    __syncthreads();
}

__device__ __forceinline__ bf16 f2bf(float f) { unsigned u = __float_as_uint(f); return (bf16)((u + 0x7fffu + ((u >> 16) & 1u)) >> 16); }
typedef float g_f32x2 __attribute__((ext_vector_type(2))); typedef __bf16 g_bf16x2 __attribute__((ext_vector_type(2)));
__device__ __forceinline__ unsigned pk2bf(float lo, float hi) { const g_f32x2 v = {lo, hi}; const g_bf16x2 b = __builtin_convertvector(v, g_bf16x2); return __builtin_bit_cast(unsigned, b); }
__device__ __forceinline__ float wave_sum(float v) {
#pragma unroll
    for (int o = 1; o < 64; o <<= 1) v += __shfl_xor(v, o);
    return v;
}
typedef float nt_f32x4 __attribute__((ext_vector_type(4)));
__device__ __forceinline__ float sigmoidf_(float x) { return __builtin_amdgcn_rcpf(1.f + __builtin_amdgcn_exp2f(-1.4426950408889634f * x)); }

__device__ const unsigned char T5B[128] = {0, 1, 2, 3, 4, 5, 6, 7, 8, 9, 10, 11, 12, 13, 14, 15, 16, 16, 16, 17, 17, 18, 18, 18, 19, 19, 19, 20, 20, 20, 20, 21, 21, 21, 21, 22, 22, 22, 22, 22, 23, 23, 23, 23, 23, 23, 24, 24, 24, 24, 24, 24, 25, 25, 25, 25, 25, 25, 25, 26, 26, 26, 26, 26, 26, 26, 26, 27, 27, 27, 27, 27, 27, 27, 27, 27, 27, 28, 28, 28, 28, 28, 28, 28, 28, 28, 28, 29, 29, 29, 29, 29, 29, 29, 29, 29, 29, 29, 29, 30, 30, 30, 30, 30, 30, 30, 30, 30, 30, 30, 30, 30, 30, 31, 31, 31, 31, 31, 31, 31, 31, 31, 31, 31, 31, 31, 31, 31};
__device__ __forceinline__ int t5_bucket(int dist) { return (int)T5B[dist > 127 ? 127 : (dist < 0 ? 0 : dist)]; }

#define LO16(u) __uint_as_float((u) << 16)
#define HI16(u) __uint_as_float((u) & 0xffff0000u)

struct Args { const float* in[24]; float* out; unsigned char* ws; int ph_lo, ph_hi; };

struct Ctx {
    Args a;
#define CF(name, idx) __device__ __forceinline__ const float* name() const { return a.in[idx]; }
    CF(x, 0) CF(norm1_g, 1) CF(w_in, 2) CF(nsa_q_norm, 3) CF(nsa_k_norm, 4) CF(cmp_pos, 5) CF(cmp_w1, 6) CF(cmp_w2, 7) CF(diff_q_norm, 8) CF(diff_k_norm, 9)
    CF(diff_lambda, 10) CF(diff_out_norm, 11) CF(rel_bias, 12) CF(w_bn, 13) CF(w_bd, 14) CF(w_out, 15) CF(norm2_g, 16) CF(rg_w, 17) CF(rg_b, 18) CF(re_w, 19) CF(re_b, 20)
    CF(w_gate, 21) CF(w_up, 22) CF(w_down, 23)
#undef CF
#define CW(type, name, off) __device__ __forceinline__ type* name() const { return (type*)(a.ws + (off)); }
    CW(bf16, H1, WS_H1) CW(bf16, QN, WS_QN) CW(bf16, CT, WS_CT) CW(bf16, KS, WS_KS) CW(bf16, VS, WS_VS) CW(bf16, KW, WS_KW) CW(bf16, VW, WS_VW)
    CW(bf16, QD, WS_QD) CW(bf16, KD, WS_KD) CW(bf16, VD, WS_VD) CW(bf16, GM, WS_GM) CW(float, GN, WS_GN) CW(bf16, KCMP, WS_KCMP) CW(bf16, VCMP, WS_VCMP)
    CW(bf16, ONSAB, WS_ONSAB) CW(float, ROUTE, WS_ROUTE)
    CW(float, LAM, WS_LAM) CW(bf16, Y, WS_Y) CW(bf16, HID, WS_HID)
    CW(float, U, WS_U) CW(bf16, X2B, WS_X2B) CW(float, POSB, WS_POSB) CW(float, BIAS, WS_BIAS) CW(float, BIASV, WS_BIASV) CW(bf16, WIN, WS_WIN) CW(bf16, WOUT, WS_WOUT) CW(bf16, WBN, WS_WBN) CW(bf16, WBD, WS_WBD) CW(bf16, WC1, WS_WC1) CW(bf16, WGU, WS_WGU) CW(bf16, WDN, WS_WDN)
    __device__ __forceinline__ bf16* ODIFF() const { return (bf16*)a.out; }
#undef CW
    __device__ __forceinline__ float* out() const { return a.out; }
};

struct ChunkDesc { int src; int ncols; int mode; const float* gain; bf16* dst; float* dstf; int pitch; int dcol; float qscale;
    int img; int c0; int tile_bytes; int bstride; };
__device__ __forceinline__ ChunkDesc chunk_desc(const Ctx& c, int ch) {
    ChunkDesc d; d.src = 0; d.ncols = 64; d.mode = 0; d.gain = nullptr; d.dst = nullptr; d.dstf = nullptr; d.pitch = 0; d.dcol = 0; d.qscale = 1.f; d.img = 0; d.c0 = 0; d.tile_bytes = 0; d.bstride = 0;
    if (ch < 8) { d.src = C_QN + 64 * ch; d.mode = 1; d.gain = c.nsa_q_norm(); d.dst = c.QN(); d.pitch = 512; d.dcol = 64 * ch; d.qscale = 0.125f * 1.4426950408889634f; }
    else if (ch < 20) { const int j = ch - 8; d.src = C_KV + 64 * j; const int t = j >> 2, kv = (j >> 1) & 1, g = j & 1;
        if (t == 0) { d.dst = c.CT() + (size_t)(kv * 2 + g) * T * 64; d.pitch = 64; d.dcol = 0; }
        else { d.dst = ((t == 1) ? (kv ? c.VS() : c.KS()) : (kv ? c.VW() : c.KW())) + (size_t)g * 32 * 4096; d.img = kv ? 2 : 1; d.c0 = 0; d.tile_bytes = 8192; d.bstride = 2 * 32 * 8192;
               if (kv == 0) { d.mode = 1; d.gain = c.nsa_k_norm() + 64 * t; } } }
    else if (ch < 24) { if (ch == 20) { d.src = C_GN; d.ncols = 24; d.mode = 2; d.dstf = c.GN(); d.pitch = 24; d.dcol = 0; } else d.ncols = 0; }
    else if (ch < 32) { const int j = ch - 24; d.src = C_QD + 64 * j; d.mode = 1; d.gain = c.diff_q_norm() + 64 * (j & 1); d.dst = c.QD(); d.pitch = 512; d.dcol = 64 * j; d.qscale = 0.125f * 1.4426950408889634f; }
    else if (ch < 40) { const int j = ch - 32; d.src = C_KD + 64 * j; d.mode = 1; d.gain = c.diff_k_norm() + 64 * (j & 1); d.dst = c.KD() + (size_t)(j >> 1) * 32 * 8192; d.img = 1; d.c0 = (j & 1) * 8; d.tile_bytes = 16384; d.bstride = 4 * 32 * 16384; }
    else if (ch < 48) { const int j = ch - 40; d.src = C_VD + 64 * j; d.dst = c.VD() + (size_t)(j >> 1) * 32 * 8192; d.img = 2; d.c0 = (j & 1) * 2; d.tile_bytes = 16384; d.bstride = 4 * 32 * 16384; }
    else { const int j = ch - 48; d.src = C_GM + 64 * j; d.mode = 2; d.dst = c.GM(); d.pitch = 2048; d.dcol = 64 * j; }
    return d;
}


namespace pg8 {
typedef short bf16x8 __attribute__((ext_vector_type(8)));
typedef float f32x4 __attribute__((ext_vector_type(4)));
typedef unsigned u32x4 __attribute__((ext_vector_type(4)));
constexpr int BM = 256, BK = 64, HALF = 128, HTB = HALF * BK * 2, NXCD = 8, WGM = 8;
__device__ __forceinline__ int lds_byte(int r, int c) { const int st = (r >> 4) * 2 + (c >> 5), rr = r & 15, cc = c & 31, ob = rr * 64 + cc * 2; return st * 1024 + (ob ^ (((ob >> 9) & 1) << 5)); }
__device__ __forceinline__ void stage_rc(int b, int& R, int& C) { const int st = b / 1024, sb = b % 1024, swz = sb ^ (((sb >> 9) & 1) << 5); R = (st >> 1) * 16 + swz / 64; C = (st & 1) * 32 + (swz % 64) / 2; }
__device__ __forceinline__ int perm32(int rho) { const int n = rho >> 4, i = rho & 15; return 8 * (i >> 2) + 4 * n + (i & 3); }
__device__ __forceinline__ unsigned cvt_pk_bf16(float lo, float hi) { return pk2bf(lo, hi); }

struct Unit { int pm, pn, z; };
struct Ops { const bf16 *A0, *A1, *B0, *B1; int K;
    __device__ __forceinline__ const char* a(const Unit& u) const { return (const char*)((u.z ? A1 : A0) + (size_t)u.pm * BM * K); }
    __device__ __forceinline__ const char* b(const Unit& u) const { return (const char*)((u.z ? B1 : B0) + (size_t)u.pn * BM * K); } };

template <int NZ> struct StaticOrder {
    int nM, nN, nwg, G, c;
    __device__ __forceinline__ void init(int M, int N, int G_, int c_) { nM = M / BM; nN = N / BM; nwg = nM * nN; G = G_; c = c_; }
    __device__ __forceinline__ bool next(int i, Unit& u) const {
        const int it = i / NZ; u.z = i % NZ;
        const long L = (long)it * G + c; if (L >= nwg) return false;
        int wgid = (int)L; { const int q = nwg / NXCD, r = nwg % NXCD, xcd = wgid % NXCD, off = wgid / NXCD; wgid = (xcd < r ? xcd * (q + 1) : r * (q + 1) + (xcd - r) * q) + off; }
        const int nig = WGM * nN, gid = wgid / nig, fm = gid * WGM, gsz = (nM - fm) < WGM ? (nM - fm) : WGM;
        u.pm = fm + ((wgid % nig) % gsz); u.pn = (wgid % nig) / gsz; return true;
    }
};

template <class Epi, class Sched>
__device__ __forceinline__ void gemm_phase(LAS unsigned char* lds, const Ops g, const Sched& S, const Epi& E) {
    const int tid = threadIdx.x, wid = __builtin_amdgcn_readfirstlane(tid >> 6), lane = tid & 63, wr = wid >> 2, wc = wid & 3, fr = lane & 15, fq = lane >> 4;
    const int K = g.K, nt = K / BK;
    unsigned voffA[2], voffB[2];
#pragma unroll
    for (int i = 0; i < 2; ++i) { int R, C; stage_rc(tid * 16 + i * 8192, R, C); const int Rb = (R & ~31) + perm32(R & 31);
        voffA[i] = (unsigned)(R * K + C) * 2u; voffB[i] = (unsigned)(Rb * K + C) * 2u; }
    const size_t kstep = (size_t)(BK * 2);
    const size_t hstep = (size_t)HALF * K * 2;
    const unsigned ldsw = (unsigned)wid * 1024u;
    const int aoff = lds_byte(wr * 64 + fr, fq * 8), boff = lds_byte(wc * 32 + fr, fq * 8);
#define PG8_SA(b, h) (((b) * 2 + (h)) * HTB)
#define PG8_SB(b, h) ((4 + (b) * 2 + (h)) * HTB)
#define PG8_STAGE(bufoff, gbase, voff) do { _Pragma("unroll") for (int _i = 0; _i < 2; ++_i) \
        __builtin_amdgcn_global_load_lds((const unsigned*)((const char*)(gbase) + (voff)[_i]), (LAS unsigned*)(lds + (bufoff) + ldsw + _i * 8192), 16, 0, 0); } while (0)
#define PG8_LDA(dst, b, h) do { _Pragma("unroll") for (int m = 0; m < 4; ++m) _Pragma("unroll") for (int k = 0; k < 2; ++k) dst[m][k] = *(const LAS bf16x8*)(lds + PG8_SA(b, h) + aoff + m * 2048 + k * 1024); } while (0)
#define PG8_LDB(dst, b, h) do { _Pragma("unroll") for (int n = 0; n < 2; ++n) _Pragma("unroll") for (int k = 0; k < 2; ++k) dst[n][k] = *(const LAS bf16x8*)(lds + PG8_SB(b, h) + boff + n * 2048 + k * 1024); } while (0)
#define PG8_MMA(ai, bj, At, Bt) do { __builtin_amdgcn_s_setprio(1); _Pragma("unroll") for (int m = 0; m < 4; ++m) _Pragma("unroll") for (int n = 0; n < 2; ++n) _Pragma("unroll") for (int k = 0; k < 2; ++k) \
        acc[ai][bj][m][n] = __builtin_amdgcn_mfma_f32_16x16x32_bf16(Bt[n][k], At[m][k], acc[ai][bj][m][n], 0, 0, 0); __builtin_amdgcn_s_setprio(0); } while (0)
#define PG8_WAIT_V(n) asm volatile("s_waitcnt vmcnt(" #n ")" ::: "memory")
#define PG8_WAIT_L(n) asm volatile("s_waitcnt lgkmcnt(" #n ")" ::: "memory")
#define PG8_BAR __builtin_amdgcn_s_barrier()
#define PG8_SCHED __builtin_amdgcn_sched_barrier(0)
    Unit cur, nxt; int ui = 0;
    if (!S.next(0, cur)) return;
    f32x4 acc[2][2][4][2];
#pragma unroll
    for (int a = 0; a < 2; ++a)
#pragma unroll
        for (int b = 0; b < 2; ++b)
#pragma unroll
            for (int m = 0; m < 4; ++m)
#pragma unroll
                for (int n = 0; n < 2; ++n) acc[a][b][m][n] = (f32x4){0.f, 0.f, 0.f, 0.f};
    bf16x8 At[4][2], B0[2][2], B1[2][2];
    const char* cA = g.a(cur); const char* cB = g.b(cur);
    PG8_STAGE(PG8_SB(0, 0), cB, voffB); PG8_STAGE(PG8_SB(0, 1), cB + hstep, voffB); PG8_STAGE(PG8_SA(0, 0), cA, voffA); PG8_STAGE(PG8_SA(0, 1), cA + hstep, voffA);
    if (wr == 1) PG8_BAR;
    PG8_WAIT_V(2); PG8_BAR;
    PG8_STAGE(PG8_SB(1, 0), cB + kstep, voffB); PG8_STAGE(PG8_SA(1, 0), cA + kstep, voffA); PG8_STAGE(PG8_SB(1, 1), cB + hstep + kstep, voffB);
    PG8_WAIT_V(6); PG8_BAR;
    for (;;) {
        const bool has_next = S.next(ui + 1, nxt);
        const char* nA = has_next ? g.a(nxt) : cA; const char* nB = has_next ? g.b(nxt) : cB;
        for (int t = 0; t < nt; t += 2) {
            const bool last = (t == nt - 2);
            const char* a1 = cA + (size_t)(t + 1) * kstep;
            const char* a2 = last ? nA : cA + (size_t)(t + 2) * kstep; const char* b2 = last ? nB : cB + (size_t)(t + 2) * kstep;
            const char* a3 = a2 + kstep; const char* b3 = b2 + kstep;
            PG8_LDB(B0, 0, 0); PG8_LDB(B1, 0, 1); PG8_SCHED; PG8_LDA(At, 0, 0); PG8_STAGE(PG8_SA(1, 1), a1 + hstep, voffA);
            PG8_WAIT_V(8); PG8_WAIT_L(0); PG8_BAR; PG8_MMA(0, 0, At, B0); PG8_MMA(0, 1, At, B1); PG8_BAR; PG8_SCHED;
            PG8_LDA(At, 0, 1); PG8_STAGE(PG8_SB(0, 0), b2, voffB); PG8_STAGE(PG8_SB(0, 1), b2 + hstep, voffB); PG8_STAGE(PG8_SA(0, 0), a2, voffA);
            PG8_WAIT_V(8); PG8_WAIT_L(0); PG8_BAR; PG8_MMA(1, 0, At, B0); PG8_MMA(1, 1, At, B1); PG8_BAR; PG8_SCHED;
            PG8_LDB(B0, 1, 0); PG8_LDB(B1, 1, 1); PG8_SCHED; PG8_LDA(At, 1, 0); PG8_STAGE(PG8_SA(0, 1), a2 + hstep, voffA);
            PG8_WAIT_V(8); PG8_WAIT_L(0); PG8_BAR; PG8_MMA(0, 0, At, B0); PG8_MMA(0, 1, At, B1); PG8_BAR; PG8_SCHED;
            PG8_LDA(At, 1, 1); PG8_STAGE(PG8_SB(1, 0), b3, voffB); PG8_STAGE(PG8_SB(1, 1), b3 + hstep, voffB); PG8_STAGE(PG8_SA(1, 0), a3, voffA);
            PG8_WAIT_V(8); PG8_WAIT_L(0); PG8_BAR; PG8_MMA(1, 0, At, B0); PG8_MMA(1, 1, At, B1); PG8_BAR; PG8_SCHED;
        }
        if (wr == 0) PG8_BAR;
        const bool keep = E(acc, cur, wr, wc, fr, fq);
        if (!has_next) break;
        if (!keep) {
#pragma unroll
        for (int a = 0; a < 2; ++a)
#pragma unroll
            for (int b = 0; b < 2; ++b)
#pragma unroll
                for (int m = 0; m < 4; ++m)
#pragma unroll
                    for (int n = 0; n < 2; ++n) acc[a][b][m][n] = (f32x4){0.f, 0.f, 0.f, 0.f};
        }
        cur = nxt; cA = nA; cB = nB; ++ui;
        if (wr == 1) PG8_BAR;
    }
    PG8_WAIT_V(0);
    PG8_BAR;
#undef PG8_SA
#undef PG8_SB
#undef PG8_STAGE
#undef PG8_LDA
#undef PG8_LDB
#undef PG8_MMA
#undef PG8_WAIT_V
#undef PG8_WAIT_L
#undef PG8_BAR
#undef PG8_SCHED
}

template <class G, class Epi, class Sched>
__device__ __forceinline__ void gemm_phase_g(LAS unsigned char* lds, const G& g, const Sched& S, const Epi& E) {
    const int tid = threadIdx.x, wid = __builtin_amdgcn_readfirstlane(tid >> 6), lane = tid & 63, wr = wid >> 2, wc = wid & 3, fr = lane & 15, fq = lane >> 4;
    constexpr int nt = G::NT;
    unsigned voffB[2];
#pragma unroll
    for (int i = 0; i < 2; ++i) { int R, C; stage_rc(tid * 16 + i * 8192, R, C); const int Rb = (R & ~31) + perm32(R & 31); voffB[i] = (unsigned)(Rb * G::LDB + C) * 2u; }
#define PG8_RC int sR[2], sC[2]; stage_rc(tid * 16, sR[0], sC[0]); stage_rc(tid * 16 + 8192, sR[1], sC[1])
    const size_t kstep = (size_t)(BK * 2);
    const size_t hstepB = (size_t)HALF * G::LDB * 2;
    const unsigned ldsw = (unsigned)wid * 1024u;
    const int aoff = lds_byte(wr * 64 + fr, fq * 8), boff = lds_byte(wc * 32 + fr, fq * 8);
#define PG8_SA(b, h) (((b) * 2 + (h)) * HTB)
#define PG8_SB(b, h) ((4 + (b) * 2 + (h)) * HTB)
#define PG8_STAGE(bufoff, gbase, voff) do { _Pragma("unroll") for (int _i = 0; _i < 2; ++_i) \
        __builtin_amdgcn_global_load_lds((const unsigned*)((const char*)(gbase) + (voff)[_i]), (LAS unsigned*)(lds + (bufoff) + ldsw + _i * 8192), 16, 0, 0); } while (0)
#define PG8_LDA(dst, b, h) do { _Pragma("unroll") for (int m = 0; m < 4; ++m) _Pragma("unroll") for (int k = 0; k < 2; ++k) dst[m][k] = *(const LAS bf16x8*)(lds + PG8_SA(b, h) + aoff + m * 2048 + k * 1024); } while (0)
#define PG8_LDB(dst, b, h) do { _Pragma("unroll") for (int n = 0; n < 2; ++n) _Pragma("unroll") for (int k = 0; k < 2; ++k) dst[n][k] = *(const LAS bf16x8*)(lds + PG8_SB(b, h) + boff + n * 2048 + k * 1024); } while (0)
#define PG8_MMA(ai, bj, At, Bt) do { __builtin_amdgcn_s_setprio(1); _Pragma("unroll") for (int m = 0; m < 4; ++m) _Pragma("unroll") for (int n = 0; n < 2; ++n) _Pragma("unroll") for (int k = 0; k < 2; ++k) \
        acc[ai][bj][m][n] = __builtin_amdgcn_mfma_f32_16x16x32_bf16(Bt[n][k], At[m][k], acc[ai][bj][m][n], 0, 0, 0); __builtin_amdgcn_s_setprio(0); } while (0)
#define PG8_WAIT_V(n) asm volatile("s_waitcnt vmcnt(" #n ")" ::: "memory")
#define PG8_WAIT_L(n) asm volatile("s_waitcnt lgkmcnt(" #n ")" ::: "memory")
#define PG8_BAR __builtin_amdgcn_s_barrier()
#define PG8_SCHED __builtin_amdgcn_sched_barrier(0)
    Unit cur, nxt; int ui = 0;
    if (!S.next(0, cur)) return;
    unsigned vc[2][2], vn[2][2];
    bool has_next = S.next(1, nxt);
    {   PG8_RC; g.a_voff(cur, sR, sC, vc);
        if (has_next) g.a_voff(nxt, sR, sC, vn); }
    if (has_next) {} else { vn[0][0] = vc[0][0]; vn[0][1] = vc[0][1]; vn[1][0] = vc[1][0]; vn[1][1] = vc[1][1]; }
    f32x4 acc[2][2][4][2];
#pragma unroll
    for (int a = 0; a < 2; ++a)
#pragma unroll
        for (int b = 0; b < 2; ++b)
#pragma unroll
            for (int m = 0; m < 4; ++m)
#pragma unroll
                for (int n = 0; n < 2; ++n) acc[a][b][m][n] = (f32x4){0.f, 0.f, 0.f, 0.f};
    bf16x8 At[4][2], B0[2][2], B1[2][2];
    const char* cA = g.a_base(cur);
    const char *cb0, *cb1, *nb0, *nb1;
    g.bprep(cur, cb0, cb1);
    if (has_next) g.bprep(nxt, nb0, nb1); else { nb0 = cb0; nb1 = cb1; }
    {   const char* cB0 = G::bat(cb0, cb1, 0); const char* cB1 = G::bat(cb0, cb1, 1);
        PG8_STAGE(PG8_SB(0, 0), cB0, voffB); PG8_STAGE(PG8_SB(0, 1), cB0 + hstepB, voffB); PG8_STAGE(PG8_SA(0, 0), cA, vc[0]); PG8_STAGE(PG8_SA(0, 1), cA, vc[1]);
        if (wr == 1) PG8_BAR;
        PG8_WAIT_V(2); PG8_BAR;
        PG8_STAGE(PG8_SB(1, 0), cB1, voffB); PG8_STAGE(PG8_SA(1, 0), cA + kstep, vc[0]); PG8_STAGE(PG8_SB(1, 1), cB1 + hstepB, voffB);
        PG8_WAIT_V(6); PG8_BAR; }
    for (;;) {
        const char* nA = has_next ? g.a_base(nxt) : cA;
        for (int t = 0; t < nt; t += 2) {
            const bool last = (t == nt - 2);
            const char* a1 = cA + (size_t)(t + 1) * kstep;
            const char* a2 = last ? nA : cA + (size_t)(t + 2) * kstep; const char* a3 = a2 + kstep;
            const char* b2 = last ? G::bat(nb0, nb1, 0) : G::bat(cb0, cb1, t + 2); const char* b3 = last ? G::bat(nb0, nb1, 1) : G::bat(cb0, cb1, t + 3);
            PG8_LDB(B0, 0, 0); PG8_LDB(B1, 0, 1); PG8_SCHED; PG8_LDA(At, 0, 0); PG8_STAGE(PG8_SA(1, 1), a1, vc[1]);
            if (last) { vc[0][0] = vn[0][0]; vc[0][1] = vn[0][1]; vc[1][0] = vn[1][0]; vc[1][1] = vn[1][1]; }
            PG8_WAIT_V(8); PG8_WAIT_L(0); PG8_BAR; PG8_MMA(0, 0, At, B0); PG8_MMA(0, 1, At, B1); PG8_BAR; PG8_SCHED;
            PG8_LDA(At, 0, 1); PG8_STAGE(PG8_SB(0, 0), b2, voffB); PG8_STAGE(PG8_SB(0, 1), b2 + hstepB, voffB); PG8_STAGE(PG8_SA(0, 0), a2, vc[0]);
            PG8_WAIT_V(8); PG8_WAIT_L(0); PG8_BAR; PG8_MMA(1, 0, At, B0); PG8_MMA(1, 1, At, B1); PG8_BAR; PG8_SCHED;
            PG8_LDB(B0, 1, 0); PG8_LDB(B1, 1, 1); PG8_SCHED; PG8_LDA(At, 1, 0); PG8_STAGE(PG8_SA(0, 1), a2, vc[1]);
            PG8_WAIT_V(8); PG8_WAIT_L(0); PG8_BAR; PG8_MMA(0, 0, At, B0); PG8_MMA(0, 1, At, B1); PG8_BAR; PG8_SCHED;
            PG8_LDA(At, 1, 1); PG8_STAGE(PG8_SB(1, 0), b3, voffB); PG8_STAGE(PG8_SB(1, 1), b3 + hstepB, voffB); PG8_STAGE(PG8_SA(1, 0), a3, vc[0]);
            PG8_WAIT_V(8); PG8_WAIT_L(0); PG8_BAR; PG8_MMA(1, 0, At, B0); PG8_MMA(1, 1, At, B1); PG8_BAR; PG8_SCHED;
        }
        if (wr == 0) PG8_BAR;
        E(acc, cur, wr, wc, fr, fq);
        if (!has_next) break;
#pragma unroll
        for (int a = 0; a < 2; ++a)
#pragma unroll
            for (int b = 0; b < 2; ++b)
#pragma unroll
                for (int m = 0; m < 4; ++m)
#pragma unroll
                    for (int n = 0; n < 2; ++n) acc[a][b][m][n] = (f32x4){0.f, 0.f, 0.f, 0.f};
        cur = nxt; cA = nA; cb0 = nb0; cb1 = nb1; ++ui;
        has_next = S.next(ui + 1, nxt);
        if (has_next) { PG8_RC; g.a_voff(nxt, sR, sC, vn); g.bprep(nxt, nb0, nb1); }
        if (wr == 1) PG8_BAR;
    }
    PG8_WAIT_V(0);
    PG8_BAR;
#undef PG8_RC
#undef PG8_SA
#undef PG8_SB
#undef PG8_STAGE
#undef PG8_LDA
#undef PG8_LDB
#undef PG8_MMA
#undef PG8_WAIT_V
#undef PG8_WAIT_L
#undef PG8_BAR
#undef PG8_SCHED
}
}

struct EpiInProj {
    Ctx c;
    __device__ __forceinline__ bool operator()(pg8::f32x4 (&acc)[2][2][4][2], const pg8::Unit& u, int wr, int wc, int fr_, int fq_) const {
        int fr = fr_, fq = fq_; asm volatile("" : "+v"(fr), "+v"(fq));
        const ChunkDesc d = chunk_desc(c, u.pn * 4 + wc);
        if (d.ncols == 0) return false;
        const int row0 = u.pm * 256 + wr * 64 + fr;
        float gn[2][8];
        const float* gp = (d.mode == 1) ? d.gain : c.nsa_q_norm();
#pragma unroll
        for (int bj = 0; bj < 2; ++bj)
#pragma unroll
            for (int i = 0; i < 8; ++i) { gn[bj][i] = gp[32 * bj + 8 * fq + i] * d.qscale; asm volatile("" : "+v"(gn[bj][i])); }
#pragma unroll
        for (int ai = 0; ai < 2; ++ai)
#pragma unroll
            for (int m = 0; m < 4; ++m) {
                const size_t row = (size_t)(row0 + ai * 128 + m * 16);
                float v[2][8];
#pragma unroll
                for (int bj = 0; bj < 2; ++bj)
#pragma unroll
                    for (int n = 0; n < 2; ++n)
#pragma unroll
                        for (int i = 0; i < 4; ++i) v[bj][4 * n + i] = acc[ai][bj][m][n][i];
                if (d.mode == 1) {
                    float ss = 0.f;
#pragma unroll
                    for (int bj = 0; bj < 2; ++bj)
#pragma unroll
                        for (int i = 0; i < 8; ++i) ss += v[bj][i] * v[bj][i];
                    ss += __shfl_xor(ss, 16); ss += __shfl_xor(ss, 32);
                    const float r = rsqrtf(ss * (1.f / 64.f) + RMS_EPS);
#pragma unroll
                    for (int bj = 0; bj < 2; ++bj)
#pragma unroll
                        for (int i = 0; i < 8; ++i) v[bj][i] = v[bj][i] * r * gn[bj][i];
                } else if (d.mode == 2) {
#pragma unroll
                    for (int bj = 0; bj < 2; ++bj)
#pragma unroll
                        for (int i = 0; i < 8; ++i) v[bj][i] = sigmoidf_(v[bj][i]);
                }
                if (d.dstf) {
                    if (fq < 3) { float4* p = (float4*)(d.dstf + row * 24 + 8 * fq); p[0] = make_float4(v[0][0], v[0][1], v[0][2], v[0][3]); p[1] = make_float4(v[0][4], v[0][5], v[0][6], v[0][7]); }
                } else {
#pragma unroll
                    for (int bj = 0; bj < 2; ++bj) { pg8::u32x4 w; w.x = pg8::cvt_pk_bf16(v[bj][0], v[bj][1]); w.y = pg8::cvt_pk_bf16(v[bj][2], v[bj][3]); w.z = pg8::cvt_pk_bf16(v[bj][4], v[bj][5]); w.w = pg8::cvt_pk_bf16(v[bj][6], v[bj][7]);
                        if (d.img == 0) *(pg8::u32x4*)(d.dst + row * d.pitch + d.dcol + 32 * bj + 8 * fq) = w;
                        else { const int bb = (int)(row >> 11), sq = (int)(row & 2047), key = sq & 63;
                            const size_t tb = (size_t)bb * d.bstride + (size_t)(sq >> 6) * d.tile_bytes;
                            const size_t off = (d.img == 1) ? tb + (size_t)(d.c0 + 4 * bj + fq) * 1024 + key * 16 : tb + (size_t)(d.c0 + bj) * 4096 + (key >> 4) * 1024 + (key & 15) * 64 + fq * 16;
                            *(pg8::u32x4*)((unsigned char*)d.dst + off) = w; } }
                }
            }
        return false;
    }
};
struct EpiMerge {
    bf16* Y; const bf16* GM;
    __device__ __forceinline__ bool operator()(pg8::f32x4 (&acc)[2][2][4][2], const pg8::Unit& u, int wr, int wc, int fr_, int fq_) const {
        int fr = fr_, fq = fq_; asm volatile("" : "+v"(fr), "+v"(fq));
        const int row0 = u.pm * 256 + wr * 64 + fr, col0 = u.pn * 256 + wc * 32 + 8 * fq;
#pragma unroll
        for (int ai = 0; ai < 2; ++ai)
#pragma unroll
            for (int m = 0; m < 4; ++m) {
                const size_t row = (size_t)(row0 + ai * 128 + m * 16);
#pragma unroll
                for (int bj = 0; bj < 2; ++bj) {
                    const int col = col0 + bj * 128;
                    const uint4 g1 = *(const uint4*)(GM + row * 2048 + 1024 + col);
                    float q1[8] = {LO16(g1.x), HI16(g1.x), LO16(g1.y), HI16(g1.y), LO16(g1.z), HI16(g1.z), LO16(g1.w), HI16(g1.w)};
                    if (u.z == 0) {
                        const uint4 g0 = *(const uint4*)(GM + row * 2048 + col);
                        const float q0[8] = {LO16(g0.x), HI16(g0.x), LO16(g0.y), HI16(g0.y), LO16(g0.z), HI16(g0.z), LO16(g0.w), HI16(g0.w)};
#pragma unroll
                        for (int n = 0; n < 2; ++n)
#pragma unroll
                            for (int i = 0; i < 4; ++i) acc[ai][bj][m][n][i] *= q0[4 * n + i] * __builtin_amdgcn_rcpf(fmaxf(q1[4 * n + i], 1e-30f));
                    } else {
                        float v[8];
#pragma unroll
                        for (int n = 0; n < 2; ++n)
#pragma unroll
                            for (int i = 0; i < 4; ++i) v[4 * n + i] = acc[ai][bj][m][n][i] * fmaxf(q1[4 * n + i], 1e-30f);
                        uint4 w; w.x = pg8::cvt_pk_bf16(v[0], v[1]); w.y = pg8::cvt_pk_bf16(v[2], v[3]); w.z = pg8::cvt_pk_bf16(v[4], v[5]); w.w = pg8::cvt_pk_bf16(v[6], v[7]);
                        *(uint4*)(Y + row * 1024 + col) = w;
                    }
                }
            }
        return u.z == 0;
    }
};
struct EpiResid {
    const float* X; bf16* O;
    __device__ __forceinline__ bool operator()(pg8::f32x4 (&acc)[2][2][4][2], const pg8::Unit& u, int wr, int wc, int fr_, int fq_) const {
        int fr = fr_, fq = fq_; asm volatile("" : "+v"(fr), "+v"(fq));
        const int row0 = u.pm * 256 + wr * 64 + fr, col0 = u.pn * 256 + wc * 32 + 8 * fq;
#pragma unroll
        for (int ai = 0; ai < 2; ++ai)
#pragma unroll
            for (int m = 0; m < 4; ++m) {
                const size_t row = (size_t)(row0 + ai * 128 + m * 16);
#pragma unroll
                for (int bj = 0; bj < 2; ++bj) { const size_t off = row * 1024 + col0 + bj * 128;
                    const float4 x0 = *(const float4*)(X + off), x1 = *(const float4*)(X + off + 4); const pg8::f32x4 a0 = acc[ai][bj][m][0], a1 = acc[ai][bj][m][1];
                    uint4 w; w.x = pk2bf(x0.x + a0[0], x0.y + a0[1]); w.y = pk2bf(x0.z + a0[2], x0.w + a0[3]); w.z = pk2bf(x1.x + a1[0], x1.y + a1[1]); w.w = pk2bf(x1.z + a1[2], x1.w + a1[3]);
                    *(uint4*)(O + off) = w; }
            }
        return false;
    }
};

struct EpiF32 {
    float* O; int ldc;
    __device__ __forceinline__ bool operator()(pg8::f32x4 (&acc)[2][2][4][2], const pg8::Unit& u, int wr, int wc, int fr_, int fq_) const {
        int fr = fr_, fq = fq_; asm volatile("" : "+v"(fr), "+v"(fq));
        const int row0 = u.pm * 256 + wr * 64 + fr, col0 = u.pn * 256 + wc * 32 + 8 * fq;
#pragma unroll
        for (int ai = 0; ai < 2; ++ai)
#pragma unroll
            for (int m = 0; m < 4; ++m)
#pragma unroll
                for (int bj = 0; bj < 2; ++bj)
#pragma unroll
                    for (int n = 0; n < 2; ++n) { const pg8::f32x4 a = acc[ai][bj][m][n];
                        *(float4*)(O + (size_t)(row0 + ai * 128 + m * 16) * ldc + col0 + bj * 128 + 4 * n) = make_float4(a[0], a[1], a[2], a[3]); }
        return false;
    }
};
struct SchedCmp { int c;
    __device__ __forceinline__ bool next(int i, pg8::Unit& u) const { if (i > 0 || c >= 32) return false; u.pm = c >> 1; u.pn = c & 1; u.z = c >> 4; return true; } };

__device__ __forceinline__ float4 posb_sum(const float* p) { float4 a = *(const float4*)p;
#pragma unroll
    for (int sl = 1; sl < 8; ++sl) { const float4 b = *(const float4*)(p + sl * 512); a.x += b.x; a.y += b.y; a.z += b.z; a.w += b.w; }
    return a; }

__device__ __forceinline__ void tr_item(const float* src, int ldn, int k0, int n0, int nvalid, bf16* dst, int ldk, int r0, LAS float* scr, int lane, const float* kgain = nullptr) {
    const int nn = lane & 31;
    float tv[32];
#pragma unroll
    for (int i = 0; i < 32; ++i) { const int kk = 2 * i + (lane >> 5); tv[i] = (nn < nvalid) ? __builtin_nontemporal_load(src + (size_t)(k0 + kk) * ldn + n0 + nn) : 0.f; }
#pragma unroll
    for (int i = 0; i < 32; ++i) { const int kk = 2 * i + (lane >> 5); scr[kk * 33 + nn] = kgain ? tv[i] * kgain[k0 + kk] : tv[i]; }
    asm volatile("s_waitcnt lgkmcnt(0)" ::: "memory");
    const int cch = lane & 7;
#pragma unroll
    for (int j = 0; j < 4; ++j) { const int n = (lane >> 3) + 8 * j; const LAS float* sp = scr + (8 * cch) * 33 + n;
        uint4 o; o.x = pg8::cvt_pk_bf16(sp[0 * 33], sp[1 * 33]); o.y = pg8::cvt_pk_bf16(sp[2 * 33], sp[3 * 33]); o.z = pg8::cvt_pk_bf16(sp[4 * 33], sp[5 * 33]); o.w = pg8::cvt_pk_bf16(sp[6 * 33], sp[7 * 33]);
        *(uint4*)(dst + (size_t)(r0 + n) * ldk + k0 + 8 * cch) = o; }
    asm volatile("s_waitcnt lgkmcnt(0)" ::: "memory");
}


namespace att {
typedef short bf16x8 __attribute__((ext_vector_type(8)));
typedef short s16x4 __attribute__((ext_vector_type(4)));
typedef short v4i16_t __attribute__((ext_vector_type(4)));
typedef float f32x16 __attribute__((ext_vector_type(16)));
typedef unsigned u32x4 __attribute__((ext_vector_type(4)));
typedef float f32x4v __attribute__((ext_vector_type(4)));
constexpr float C2 = 0.125f * 1.4426950408889634f;
constexpr float LOG2E = 1.4426950408889634f;
constexpr float NEGB = -1e30f, MFLOOR = -1e4f;
__device__ __forceinline__ int crow(int r, int hi) { return (r & 3) + 8 * (r >> 2) + 4 * hi; }
__device__ __forceinline__ s16x4 vtr(const LAS char* p) { return __builtin_bit_cast(s16x4, __builtin_amdgcn_ds_read_tr16_b64_v4i16((LAS v4i16_t*)p)); }
typedef float f32x2_t __attribute__((ext_vector_type(2))); typedef __bf16 bf16x2_t __attribute__((ext_vector_type(2)));
__device__ __forceinline__ unsigned cvtpk(float lo, float hi) { const f32x2_t v = {lo, hi}; const bf16x2_t b = __builtin_convertvector(v, bf16x2_t); return __builtin_bit_cast(unsigned, b); }
#define ATT_WAIT_BAR() asm volatile("s_waitcnt vmcnt(0) lgkmcnt(0)\n\ts_barrier" ::: "memory")

template <int NKB> __device__ __forceinline__ void stage_img(LAS unsigned char* dst, const unsigned char* src, int wid, int lane) {
#pragma unroll
    for (int c = 0; c < (NKB + 7) / 8; ++c) { const int pc = wid + 8 * c;
        if (NKB % 8 == 0 || pc < NKB) __builtin_amdgcn_global_load_lds((const unsigned*)(src + pc * 1024 + lane * 16), (LAS unsigned*)(dst + pc * 1024), 16, 0, 0); }
}
__device__ __forceinline__ void qk_tile(f32x16& p0, f32x16& p1, const LAS unsigned char* kt, int ch0, const bf16x8 (&qf)[4], int r32, int hi) {
    const LAS unsigned char* kb = kt + (ch0 + hi) * 1024 + r32 * 16;
    p0 = (f32x16){0.f, 0.f, 0.f, 0.f, 0.f, 0.f, 0.f, 0.f, 0.f, 0.f, 0.f, 0.f, 0.f, 0.f, 0.f, 0.f}; p1 = p0;
#pragma unroll
    for (int d0 = 0; d0 < 4; ++d0) {
        const bf16x8 a0 = *(const LAS bf16x8*)(kb + d0 * 2048), a1 = *(const LAS bf16x8*)(kb + d0 * 2048 + 512);
        p0 = __builtin_amdgcn_mfma_f32_32x32x16_bf16(a0, qf[d0], p0, 0, 0, 0);
        p1 = __builtin_amdgcn_mfma_f32_32x32x16_bf16(a1, qf[d0], p1, 0, 0, 0);
    }
}
template <int EB> __device__ __forceinline__ void pv_tile(f32x16 (&o)[EB], const LAS unsigned char* vt, const f32x16& p0, const f32x16& p1, int lane) {
    const int hi = lane >> 5;
    const LAS char* vb = (const LAS char*)vt + ((lane >> 4) & 1) * 32 + (lane & 3) * 8 + (4 * hi + ((lane & 15) >> 2)) * 64;
#pragma unroll
    for (int ks = 0; ks < 4; ++ks) {
        s16x4 lo[EB], hh[EB];
#pragma unroll
        for (int eb = 0; eb < EB; ++eb) { lo[eb] = vtr(vb + eb * 4096 + ks * 1024); hh[eb] = vtr(vb + eb * 4096 + ks * 1024 + 512); }
        const f32x16& p = (ks < 2) ? p0 : p1; const int rb = (ks & 1) * 8;
        const u32x4 w = (u32x4){cvtpk(p[rb + 0], p[rb + 1]), cvtpk(p[rb + 2], p[rb + 3]), cvtpk(p[rb + 4], p[rb + 5]), cvtpk(p[rb + 6], p[rb + 7])};
        const bf16x8 pa = __builtin_bit_cast(bf16x8, w);
#pragma unroll
        for (int eb = 0; eb < EB; ++eb) {
            const bf16x8 vf = (bf16x8){lo[eb][0], lo[eb][1], lo[eb][2], lo[eb][3], hh[eb][0], hh[eb][1], hh[eb][2], hh[eb][3]};
            o[eb] = __builtin_amdgcn_mfma_f32_32x32x16_bf16(pa, vf, o[eb], 0, 0, 0);
        }
    }
}
template <bool BIAS, bool CAUSAL, bool BAND> __device__ __forceinline__ void bias_mask(f32x16& p0, f32x16& p1, const LAS float* bl, int qabs, int kt0, int hi) {
#pragma unroll
    for (int r = 0; r < 16; ++r) {
        const int d0 = qabs - (kt0 + crow(r, hi)), d1 = d0 - 32;
        if (BIAS) { p0[r] += bl[d0 < 0 ? 0 : (d0 > 255 ? 255 : d0)]; p1[r] += bl[d1 < 0 ? 0 : (d1 > 255 ? 255 : d1)]; }
        if (CAUSAL) { if (d0 < 0) p0[r] = NEGB; if (d1 < 0) p1[r] = NEGB; }
        if (BAND) { if (d0 >= 512) p0[r] = NEGB; if (d1 >= 512) p1[r] = NEGB; }
    }
}
__device__ __forceinline__ void bias_vec(f32x16& p0, f32x16& p1, const LAS float* rt, int e0, int hi) {
    const int a = (-e0) & 3;
    const LAS float* bp = rt + a * 320 + (208 - e0 - a) + 4 * hi;
#pragma unroll
    for (int g4 = 0; g4 < 4; ++g4) { const f32x4v v0 = *(const LAS f32x4v*)(bp + 8 * g4), v1 = *(const LAS f32x4v*)(bp + 8 * g4 + 32);
        p0[4 * g4] += v0[0]; p0[4 * g4 + 1] += v0[1]; p0[4 * g4 + 2] += v0[2]; p0[4 * g4 + 3] += v0[3];
        p1[4 * g4] += v1[0]; p1[4 * g4 + 1] += v1[1]; p1[4 * g4 + 2] += v1[2]; p1[4 * g4 + 3] += v1[3]; }
}
constexpr float THR = 8.f;
__device__ __forceinline__ float max3f(float a, float b, float c) { return fmaxf(fmaxf(a, b), c); }
template <int EB> __device__ __forceinline__ void softmax_step(f32x16& p0, f32x16& p1, float& m, float& l, f32x16 (&o)[EB], LAS float* wsf, int r32, int hi) {
    if (__any(m != 0.f)) {
#pragma unroll
        for (int r = 0; r < 16; ++r) { p0[r] -= m; p1[r] -= m; }
    }
    float ra = max3f(p0[0], p0[1], p1[0]), rb2 = max3f(p0[2], p0[3], p1[1]); ra = max3f(ra, p1[2], p1[3]);
#pragma unroll
    for (int r = 4; r < 16; r += 4) { ra = max3f(ra, p0[r], p0[r + 1]); rb2 = max3f(rb2, p0[r + 2], p0[r + 3]); ra = max3f(ra, p1[r], p1[r + 1]); rb2 = max3f(rb2, p1[r + 2], p1[r + 3]); }
    float rm = fmaxf(ra, rb2);
    if (__any(rm > THR)) {
        rm = fmaxf(rm, __shfl_xor(rm, 32));
        const float dl = rm > THR ? rm : 0.f;
        const float al = __builtin_amdgcn_exp2f(-dl);
        m += dl; l *= al;
#pragma unroll
        for (int r = 0; r < 16; ++r) { p0[r] -= dl; p1[r] -= dl; }
        if (hi == 0) wsf[r32] = al;
#pragma unroll
        for (int g = 0; g < 4; ++g) { const f32x4v a4 = *(const LAS f32x4v*)(wsf + 8 * g + 4 * hi);
#pragma unroll
            for (int eb = 0; eb < EB; ++eb) { o[eb][4 * g + 0] *= a4.x; o[eb][4 * g + 1] *= a4.y; o[eb][4 * g + 2] *= a4.z; o[eb][4 * g + 3] *= a4.w; } }
    }
    float s0 = 0.f, s1 = 0.f;
#pragma unroll
    for (int r = 0; r < 16; ++r) { p0[r] = __builtin_amdgcn_exp2f(p0[r]); p1[r] = __builtin_amdgcn_exp2f(p1[r]); s0 += p0[r]; s1 += p1[r]; }
    l += s0 + s1;
}
template <int EB> __device__ __forceinline__ void scale_rows(f32x16 (&o)[EB], float f, LAS float* wsf, int r32, int hi) {
    if (hi == 0) wsf[r32] = f;
#pragma unroll
    for (int g = 0; g < 4; ++g) { const f32x4v a4 = *(const LAS f32x4v*)(wsf + 8 * g + 4 * hi);
#pragma unroll
        for (int eb = 0; eb < EB; ++eb) { o[eb][4 * g + 0] *= a4.x; o[eb][4 * g + 1] *= a4.y; o[eb][4 * g + 2] *= a4.z; o[eb][4 * g + 3] *= a4.w; } }
}

struct DiffArgs { const bf16 *Q, *K, *V; bf16* O; const float* biasv; const float* out_gain; float lam; };
__device__ __forceinline__ void diff_unit(LAS unsigned char* lds, const DiffArgs& A, int b, int h, int qt) {
    int tid_ = threadIdx.x; asm volatile("" : "+v"(tid_));
    const int tid = tid_, lane = tid & 63, r32 = lane & 31, hi = lane >> 5, wid = __builtin_amdgcn_readfirstlane(tid >> 6);
    const int cs = wid >> 2, wq = wid & 3, q0 = qt * 128, qw0 = q0 + wq * 32, qabs = qw0 + r32;
    LAS float* bl = (LAS float*)(lds + 81920);
    LAS float* wsf = (LAS float*)(lds + 83968) + wid * 64;
    const size_t rowb = (size_t)b * S;
    LAS float* rt = (LAS float*)(lds + 86016);
    for (int i = tid; i < 1280; i += 512) rt[i] = A.biasv[(8 + h) * 1280 + i];
    const unsigned char* Kh = (const unsigned char*)A.K + (size_t)(b * 4 + h) * 32 * 16384; const unsigned char* Vh = (const unsigned char*)A.V + (size_t)(b * 4 + h) * 32 * 16384;
    const int NT = (q0 + 128) / 64;
    stage_img<16>(lds, Kh, wid, lane); stage_img<16>(lds + 49152, Vh, wid, lane);
    stage_img<16>(lds + 16384, Kh + 16384, wid, lane);
    bf16x8 qf[4];
    { const bf16* qp = A.Q + (rowb + qabs) * 512 + h * 128 + cs * 64 + hi * 8;
#pragma unroll
      for (int d0 = 0; d0 < 4; ++d0) qf[d0] = *(const bf16x8*)(qp + d0 * 16); }
    f32x16 o[4];
#pragma unroll
    for (int eb = 0; eb < 4; ++eb) o[eb] = (f32x16){0.f, 0.f, 0.f, 0.f, 0.f, 0.f, 0.f, 0.f, 0.f, 0.f, 0.f, 0.f, 0.f, 0.f, 0.f, 0.f};
    float m = 0.f, l = 0.f;
    ATT_WAIT_BAR();
    if (wid >= 4) __builtin_amdgcn_s_setprio(1);
    f32x16 n0, n1;
    qk_tile(n0, n1, lds, cs * 8, qf, r32, hi);
    int kb_cur = 0, kb_nxt = 16384, kb_fre = 32768;
    for (int t = 0; t < NT; ++t) {
        if (t + 2 < NT) stage_img<16>(lds + kb_fre, Kh + (size_t)(t + 2) * 16384, wid, lane);
        if (t + 1 < NT) stage_img<16>(lds + 49152 + ((t + 1) & 1) * 16384, Vh + (size_t)(t + 1) * 16384, wid, lane);
        const int kt0 = t * 64;
        if (kt0 <= qw0 + 31) {
            f32x16 p0 = n0, p1 = n1;
            if (t + 1 < NT && kt0 + 64 <= qw0 + 31) qk_tile(n0, n1, lds + kb_nxt, cs * 8, qf, r32, hi);
            const bool causal = (kt0 + 63 > qw0), near_ = (qw0 - (kt0 + 63) < 113);
            if (causal || near_) bias_vec(p0, p1, rt, qabs - kt0, hi);
            softmax_step<4>(p0, p1, m, l, o, wsf, r32, hi);
            pv_tile<4>(o, lds + 49152 + (t & 1) * 16384, p0, p1, lane);
        }
        ATT_WAIT_BAR();
        { const int tmp = kb_cur; kb_cur = kb_nxt; kb_nxt = kb_fre; kb_fre = tmp; }
    }
    __builtin_amdgcn_s_setprio(0);
    l += __shfl_xor(l, 32);
    scale_rows<4>(o, (cs ? A.lam : 1.f) / l, wsf, r32, hi);
    LAS float* xch = (LAS float*)lds + (size_t)wq * 4096;
    if (cs == 1) {
#pragma unroll
        for (int eb = 0; eb < 4; ++eb)
#pragma unroll
            for (int r = 0; r < 16; ++r) xch[crow(r, hi) * 128 + eb * 32 + r32] = o[eb][r];
    }
    ATT_WAIT_BAR();
    if (cs == 0) {
        float ss[16];
#pragma unroll
        for (int r = 0; r < 16; ++r) ss[r] = 0.f;
#pragma unroll
        for (int eb = 0; eb < 4; ++eb)
#pragma unroll
            for (int r = 0; r < 16; ++r) { o[eb][r] -= xch[crow(r, hi) * 128 + eb * 32 + r32]; ss[r] += o[eb][r] * o[eb][r]; }
#pragma unroll
        for (int r = 0; r < 16; ++r) {
#pragma unroll
            for (int sft = 1; sft < 32; sft <<= 1) ss[r] += __shfl_xor(ss[r], sft);
            ss[r] = rsqrtf(ss[r] * (1.f / 128.f) + RMS_EPS) * (1.f - LAMBDA_INIT);
        }
        int hi_ = hi, r32_ = r32; asm volatile("" : "+v"(hi_), "+v"(r32_));
        bf16* op = A.O + (rowb + qw0 + 4 * hi_) * 512 + h * 128 + r32_;
#pragma unroll
        for (int eb = 0; eb < 4; ++eb) { const float gn = A.out_gain[eb * 32 + r32_];
#pragma unroll
            for (int r = 0; r < 16; ++r) op[(size_t)((r & 3) + 8 * (r >> 2)) * 512 + eb * 32] = f2bf(o[eb][r] * ss[r] * gn); }
    }
    ATT_WAIT_BAR();
}

struct NsaArgs { const bf16 *Q, *KS, *VS, *KW, *VW, *KC, *VC; const float* GN; bf16* O; const float* rel_bias; const float* biasv; };
__device__ __forceinline__ void imp_tile(const f32x16& p, int gbase, LAS float* ip, float inv, int hi, float& prevR) {
    float Av[4], Rv[4];
#pragma unroll
    for (int gq = 0; gq < 4; ++gq) { const float c3 = 0.5f * p[4 * gq + 3]; Av[gq] = p[4 * gq] + p[4 * gq + 1] + p[4 * gq + 2] + c3; Rv[gq] = __shfl_xor(c3, 32); }
#pragma unroll
    for (int gq = 0; gq < 4; ++gq) { const float add = hi ? Rv[gq] : (gq > 0 ? Rv[gq > 0 ? gq - 1 : 0] : prevR); ip[2 * (gbase + gq)] = (Av[gq] + add) * inv; }
    prevR = Rv[3];
}

__device__ __forceinline__ int cmp_class(int qw0, int n0) { return (16 * n0 > qw0) ? 2 : ((qw0 - 16 * (n0 + 31) - 31 >= 113) ? 0 : 1); }
__device__ __forceinline__ void cmp_bm1(f32x16& p, const LAS float* bl, int qabs, int n0, int hi) {
#pragma unroll
    for (int r = 0; r < 16; ++r) { const int d = qabs - 16 * (n0 + crow(r, hi)) - 31; p[r] += bl[d < 0 ? 0 : (d > 255 ? 255 : d)]; if (d < 0) p[r] = NEGB; }
}
__device__ __forceinline__ void cmp_pass(LAS unsigned char* lds, const bf16x8 (&qf)[4], const LAS float* bl, LAS float* ip, bool need_sel, float mref, int qw0, int qabs,
                                         int lane, int r32, int hi, f32x16 (&o)[2], float& l, float& rmax) {
    l = 0.f; rmax = NEGB; float prevR = 0.f;
    o[0] = (f32x16){0.f, 0.f, 0.f, 0.f, 0.f, 0.f, 0.f, 0.f, 0.f, 0.f, 0.f, 0.f, 0.f, 0.f, 0.f, 0.f}; o[1] = o[0];
#pragma unroll
    for (int tl = 0; tl < 2; ++tl) {
        const int c0 = cmp_class(qw0, 64 * tl), c1 = cmp_class(qw0, 64 * tl + 32);
        if (c0 == 2) {
            if (need_sel) {
#pragma unroll
                for (int gq = 0; gq < 8; ++gq) ip[2 * (8 * tl + gq)] = (gq == 0 && hi == 0) ? prevR : 0.f; }
            prevR = 0.f;
        } else {
            f32x16 p0, p1;
            qk_tile(p0, p1, lds + tl * 16384, 0, qf, r32, hi);
            if (c0 == 1) cmp_bm1(p0, bl, qabs, 64 * tl, hi);
            if (c1 == 1) cmp_bm1(p1, bl, qabs, 64 * tl + 32, hi);
            else if (c1 == 2) { p1 = (f32x16){NEGB, NEGB, NEGB, NEGB, NEGB, NEGB, NEGB, NEGB, NEGB, NEGB, NEGB, NEGB, NEGB, NEGB, NEGB, NEGB}; }
            float ra = max3f(p0[0], p0[1], p1[0]), rb2 = max3f(p0[2], p0[3], p1[1]); ra = max3f(ra, p1[2], p1[3]);
#pragma unroll
            for (int r = 4; r < 16; r += 4) { ra = max3f(ra, p0[r], p0[r + 1]); rb2 = max3f(rb2, p0[r + 2], p0[r + 3]); ra = max3f(ra, p1[r], p1[r + 1]); rb2 = max3f(rb2, p1[r + 2], p1[r + 3]); }
            rmax = max3f(rmax, ra, rb2);
            float s0 = 0.f, s1 = 0.f;
#pragma unroll
            for (int r = 0; r < 16; ++r) { p0[r] = __builtin_amdgcn_exp2f(p0[r] - mref); p1[r] = __builtin_amdgcn_exp2f(p1[r] - mref); s0 += p0[r]; s1 += p1[r]; }
            l += s0 + s1;
            if (need_sel) { imp_tile(p0, 8 * tl, ip, 1.f, hi, prevR); imp_tile(p1, 8 * tl + 4, ip, 1.f, hi, prevR); }
            pv_tile<2>(o, lds + tl * 16384 + 8192, p0, p1, lane);
        }
    }
}
__device__ __forceinline__ void nsa_unit(LAS unsigned char* lds, const NsaArgs& A, int b, int g, int qt) {
    int tid_ = threadIdx.x; asm volatile("" : "+v"(tid_));
    const int tid = tid_, wid = __builtin_amdgcn_readfirstlane(tid >> 6);
    int lane = tid & 63, r32 = lane & 31, hi = lane >> 5;
#define NSA_RELANE() do { asm volatile("" : "+v"(lane)); r32 = lane & 31; hi = lane >> 5; qabs = qw0 + r32; } while (0)
    const int hh = wid >> 1, head = g * 4 + hh, q0 = qt * 64, qw0 = q0 + (wid & 1) * 32; int qabs = qw0 + r32;
    LAS float* bl = (LAS float*)(lds + 32768) + hh * 256;
    LAS float* wsf = (LAS float*)(lds + 36864) + wid * 64;
    LAS float* ipart = (LAS float*)(lds + 40960);
    LAS float* itot = (LAS float*)(lds + 73728);
    LAS unsigned* sell = (LAS unsigned*)(lds + 81920);
    LAS float* invs = (LAS float*)(lds + 82176);
    LAS f32x16* otl = (LAS f32x16*)(lds + 86016) + (size_t)wid * 128 + lane;
    const size_t rowb = (size_t)b * S;
    for (int i = tid; i < 1024; i += 512) ((LAS float*)(lds + 32768))[i] = A.rel_bias[g * 1024 + i];
    { const unsigned char* Kc = (const unsigned char*)A.KC + (size_t)(b * 2 + g) * 16384; const unsigned char* Vc = (const unsigned char*)A.VC + (size_t)(b * 2 + g) * 16384;
      stage_img<8>(lds, Kc, wid, lane); stage_img<8>(lds + 8192, Vc, wid, lane);
      stage_img<8>(lds + 16384, Kc + 8192, wid, lane); stage_img<8>(lds + 24576, Vc + 8192, wid, lane); }
    bf16x8 qf[4];
    { const bf16* qp = A.Q + (rowb + qabs) * 512 + head * 64 + hi * 8;
#pragma unroll
      for (int d0 = 0; d0 < 4; ++d0) qf[d0] = *(const bf16x8*)(qp + d0 * 16); }
    ATT_WAIT_BAR();
    const bool need_sel = (qt >= 16);
    {
        NSA_RELANE();
        LAS float* ip = ipart + ((size_t)hh * 64 + (wid & 1) * 32 + r32) * 32 + hi;
        f32x16 o[2]; float l, rmax;
        cmp_pass(lds, qf, bl, ip, need_sel, 0.f, qw0, qabs, lane, r32, hi, o, l, rmax);
        if (__any(rmax > 64.f)) {
            rmax = fmaxf(rmax, __shfl_xor(rmax, 32));
            float dummy;
            cmp_pass(lds, qf, bl, ip, need_sel, fmaxf(rmax, 0.f), qw0, qabs, lane, r32, hi, o, l, dummy);
        }
        l += __shfl_xor(l, 32);
        const float inv = l > 0.f ? 1.f / l : 0.f;
        if (hi == 0) invs[hh * 64 + (wid & 1) * 32 + r32] = inv;
        { int qa = qabs; asm volatile("" : "+v"(qa)); scale_rows<2>(o, A.GN[(rowb + qa) * 24 + head] * inv, wsf, r32, hi); }
        otl[0] = o[0]; otl[64] = o[1];
    }
    ATT_WAIT_BAR();
    unsigned selq, un;
    if (need_sel) {
        {
            const int q = tid >> 3, j4 = (tid & 7) * 4;
#pragma unroll
            for (int jj = 0; jj < 4; ++jj) { const int j = j4 + jj; itot[q * 32 + j] = ((ipart[(0 * 64 + q) * 32 + j] * invs[q] + ipart[(1 * 64 + q) * 32 + j] * invs[64 + q]) + ipart[(2 * 64 + q) * 32 + j] * invs[128 + q]) + ipart[(3 * 64 + q) * 32 + j] * invs[192 + q]; }
        }
        ATT_WAIT_BAR();
        {
            const int j = lane & 31;
#pragma unroll 1
            for (int rd = 0; rd < 4; ++rd) {
                const int q = wid * 8 + rd * 2 + hi;
                const bool vj = j <= qt, fj = (j == 0) || (j == qt) || (j == qt - 1);
                const float sj = vj ? itot[q * 32 + j] + (fj ? 1e4f : 0.f) : -1e30f;
                int cnt = 0;
#pragma unroll 4
                for (int k = 0; k < 32; ++k) {
                    const bool vk = k <= qt, fk = (k == 0) || (k == qt) || (k == qt - 1);
                    const float sk = vk ? itot[q * 32 + k] + (fk ? 1e4f : 0.f) : -1e30f;
                    cnt += (sk > sj || (sk == sj && k < j)) ? 1 : 0;
                }
                const unsigned long long bal = __ballot(cnt < 16);
                if (lane == 0) sell[q] = (unsigned)bal;
                if (lane == 32) sell[q] = (unsigned)(bal >> 32);
            }
        }
        ATT_WAIT_BAR();
        NSA_RELANE();
        selq = sell[(wid & 1) * 32 + r32];
        un = sell[lane];
#pragma unroll
        for (int sft = 1; sft < 64; sft <<= 1) un |= __shfl_xor(un, sft);
        un = __builtin_amdgcn_readfirstlane(un) & (qt >= 31 ? 0xffffffffu : ((2u << qt) - 1u));
    } else {
        selq = (2u << qt) - 1u; un = selq;
    }
    for (int i = tid; i < 5120; i += 512) ipart[i] = A.biasv[(size_t)g * 5120 + i];
    const LAS float* rt = ipart + hh * 1280;
    {
        NSA_RELANE();
        const unsigned char* Kg = (const unsigned char*)A.KS + (size_t)(b * 2 + g) * 32 * 8192; const unsigned char* Vg = (const unsigned char*)A.VS + (size_t)(b * 2 + g) * 32 * 8192;
        f32x16 o[2]; o[0] = (f32x16){0.f, 0.f, 0.f, 0.f, 0.f, 0.f, 0.f, 0.f, 0.f, 0.f, 0.f, 0.f, 0.f, 0.f, 0.f, 0.f}; o[1] = o[0];
        float m = 0.f, l = 0.f;
        unsigned rem = un; int j = __builtin_ctz(rem); rem &= rem - 1u; int it = 0;
        stage_img<8>(lds, Kg + (size_t)j * 8192, wid, lane); stage_img<8>(lds + 8192, Vg + (size_t)j * 8192, wid, lane);
        ATT_WAIT_BAR();
        for (;;) {
            LAS unsigned char* cur = lds + (it & 1) * 16384; LAS unsigned char* nxt = lds + ((it + 1) & 1) * 16384;
            const int jn = rem ? __builtin_ctz(rem) : -1;
            if (jn >= 0) { rem &= rem - 1u; stage_img<8>(nxt, Kg + (size_t)jn * 8192, wid, lane); stage_img<8>(nxt + 8192, Vg + (size_t)jn * 8192, wid, lane); }
            const int kt0 = j * 64;
            if (kt0 <= qw0 + 31 && __any((selq >> j) & 1u)) {
                f32x16 p0, p1;
                qk_tile(p0, p1, cur, 0, qf, r32, hi);
                const bool causal = (kt0 + 63 > qw0), near_ = (qw0 - (kt0 + 63) < 113);
                if (causal || near_) bias_vec(p0, p1, rt, qabs - kt0, hi);
                if (!__all((selq >> j) & 1u)) {
                    const float off = ((selq >> j) & 1u) ? 0.f : NEGB;
#pragma unroll
                    for (int r = 0; r < 16; ++r) { p0[r] += off; p1[r] += off; } }
                softmax_step<2>(p0, p1, m, l, o, wsf, r32, hi);
                pv_tile<2>(o, cur + 8192, p0, p1, lane);
            }
            ATT_WAIT_BAR();
            if (jn < 0) break;
            j = jn; ++it;
        }
        l += __shfl_xor(l, 32);
        { int qa = qabs; asm volatile("" : "+v"(qa)); scale_rows<2>(o, A.GN[(rowb + qa) * 24 + 8 + head] / l, wsf, r32, hi); }
        otl[0] = otl[0] + o[0]; otl[64] = otl[64] + o[1];
    }
    f32x16 ot[2];
    {
        NSA_RELANE();
        const unsigned char* Kg = (const unsigned char*)A.KW + (size_t)(b * 2 + g) * 32 * 8192; const unsigned char* Vg = (const unsigned char*)A.VW + (size_t)(b * 2 + g) * 32 * 8192;
        f32x16 o[2]; o[0] = (f32x16){0.f, 0.f, 0.f, 0.f, 0.f, 0.f, 0.f, 0.f, 0.f, 0.f, 0.f, 0.f, 0.f, 0.f, 0.f, 0.f}; o[1] = o[0];
        float m = 0.f, l = 0.f;
        const int j0 = qt >= 8 ? qt - 8 : 0;
        stage_img<8>(lds, Kg + (size_t)j0 * 8192, wid, lane); stage_img<8>(lds + 8192, Vg + (size_t)j0 * 8192, wid, lane);
        ATT_WAIT_BAR();
        for (int j = j0; j <= qt; ++j) {
            const int it = j - j0;
            LAS unsigned char* cur = lds + (it & 1) * 16384; LAS unsigned char* nxt = lds + ((it + 1) & 1) * 16384;
            if (j < qt) { stage_img<8>(nxt, Kg + (size_t)(j + 1) * 8192, wid, lane); stage_img<8>(nxt + 8192, Vg + (size_t)(j + 1) * 8192, wid, lane); }
            const int kt0 = j * 64;
            if (kt0 <= qw0 + 31) {
                f32x16 p0, p1;
                qk_tile(p0, p1, cur, 0, qf, r32, hi);
                const bool causal = (kt0 + 63 > qw0), near_ = (qw0 - (kt0 + 63) < 113), band = (qw0 + 31 - kt0 >= 512);
                if (causal || near_) bias_vec(p0, p1, rt, qabs - kt0, hi);
                else if (band) bias_mask<false, false, true>(p0, p1, bl, qabs, kt0, hi);
                softmax_step<2>(p0, p1, m, l, o, wsf, r32, hi);
                pv_tile<2>(o, cur + 8192, p0, p1, lane);
            }
            ATT_WAIT_BAR();
        }
        l += __shfl_xor(l, 32);
        { int qa = qabs; asm volatile("" : "+v"(qa)); scale_rows<2>(o, A.GN[(rowb + qa) * 24 + 16 + head] / l, wsf, r32, hi); }
        ot[0] = otl[0] + o[0]; ot[1] = otl[64] + o[1];
    }
    {   int hi_ = hi, r32_ = r32; asm volatile("" : "+v"(hi_), "+v"(r32_));
        bf16* op = A.O + (rowb + qw0 + 4 * hi_) * 512 + head * 64 + r32_;
#pragma unroll
        for (int eb = 0; eb < 2; ++eb)
#pragma unroll
            for (int r = 0; r < 16; ++r) op[(size_t)((r & 3) + 8 * (r >> 2)) * 512 + eb * 32] = f2bf(ot[eb][r]); }
#undef NSA_RELANE
}
}

constexpr int NCLS = 24;
constexpr int CW_CMPD = 10752, CW_FIN = 11008;
constexpr int CW_WQ = 10240;
constexpr int CW_CNT = 8192;
constexpr size_t WS_LIST = 254 * MiB;
constexpr int MISC_OFF = 161792;
constexpr int TAB_OFF = MISC_OFF + 256;
__device__ __forceinline__ void class_experts(int c, int& ea, int& eb) {
    const int g = c / 6, p = c % 6; const int a = p < 3 ? 0 : (p < 5 ? 1 : 2); const int b = p < 3 ? p + 1 : (p < 5 ? p - 1 : 3); ea = g * 4 + a; eb = g * 4 + b; }
__device__ __forceinline__ void moe_build_tab(const unsigned* ctl, LAS int* tab) {
    if (threadIdx.x < 64) {
        const int lane = threadIdx.x;
        const int n = (lane < NCLS) ? (int)__hip_atomic_load(ctl + CW_CNT + 64 * lane, __ATOMIC_RELAXED, __HIP_MEMORY_SCOPE_AGENT) : 0;
        const int nt_ = (n + 255) >> 8;
        int pre = nt_;
#pragma unroll
        for (int o = 1; o < 32; o <<= 1) { const int v = __shfl_up(pre, o); if (lane >= o) pre += v; }
        const int first = pre - nt_;
        if (lane < NCLS) { tab[lane] = first; tab[32 + lane] = n; for (int j = 0; j < nt_; ++j) tab[64 + first + j] = lane; }
        if (lane == NCLS - 1) tab[NCLS] = pre;
    }
    __syncthreads();
}
struct OpsGU { const bf16* H2; const bf16* WGU; const unsigned* LIST; const LAS int* tab; static constexpr int NT = 16, LDB = 1024;
    __device__ __forceinline__ const char* a_base(const pg8::Unit&) const { return (const char*)H2; }
    __device__ __forceinline__ void a_voff(const pg8::Unit& u, const int (&R)[2], const int (&C)[2], unsigned (&out)[2][2]) const {
        const int c = tab[64 + u.pm], n = tab[32 + c], r0 = (u.pm - tab[c]) * 256;
#pragma unroll
        for (int h = 0; h < 2; ++h)
#pragma unroll
            for (int i = 0; i < 2; ++i) { const int r = r0 + h * 128 + R[i]; const unsigned tok = (r < n) ? LIST[(size_t)c * T + r] : 0u; out[h][i] = (tok * 1024u + (unsigned)C[i]) * 2u; } }
    __device__ __forceinline__ void bprep(const pg8::Unit& u, const char*& p0, const char*& p1) const {
        int ea, eb; class_experts(tab[64 + u.pm], ea, eb); const int e = u.z ? eb : ea; p0 = (const char*)(WGU + ((size_t)e * 1024 + u.pn * 256) * 1024); p1 = p0; }
    __device__ static __forceinline__ const char* bat(const char* p0, const char*, int kt) { return p0 + (size_t)kt * 128; } };
constexpr int CW_MQ = 10496;
constexpr int CW_DONE = 12288;
struct SchedGU { const LAS int* tab; int G, vcu;
    __device__ __forceinline__ bool next(int i, pg8::Unit& u) const { const int L = i * G + vcu; if (L >= tab[NCLS] * 8) return false; u.pm = L >> 3; u.z = (L >> 2) & 1; u.pn = L & 3; return true; } };
struct EpiGU { bf16* HID; const unsigned* LIST; const float* ROUTE; const LAS int* tab; unsigned* ctl;
    __device__ __forceinline__ void operator()(const pg8::f32x4 (&acc)[2][2][4][2], const pg8::Unit& u, int wr, int wc, int fr_, int fq_) const {
        int fr = fr_, fq = fq_; asm volatile("" : "+v"(fr), "+v"(fq));
        const int c = tab[64 + u.pm], n = tab[32 + c], r0 = (u.pm - tab[c]) * 256;
        const __amdgpu_buffer_rsrc_t rsrc = __builtin_amdgcn_make_buffer_rsrc((void*)HID, 0, 0x7fffffff, 0x00020000);
#pragma unroll
        for (int ai = 0; ai < 2; ++ai)
#pragma unroll
            for (int m = 0; m < 4; ++m) {
                const int rl = ai * 128 + wr * 64 + m * 16 + fr, r = r0 + rl;
                if (r < n) {
                    const unsigned tok = LIST[(size_t)c * T + r]; const float w = ROUTE[(size_t)tok * 4 + u.z], rs = ROUTE[(size_t)tok * 4 + 3];
                    float v[8];
#pragma unroll
                    for (int nn = 0; nn < 2; ++nn)
#pragma unroll
                        for (int i = 0; i < 4; ++i) { const float gt = acc[ai][0][m][nn][i] * rs, up = acc[ai][1][m][nn][i] * rs; v[4 * nn + i] = gt * __builtin_amdgcn_rcpf(1.f + __builtin_amdgcn_exp2f(-1.4426950408889634f * gt)) * up * w; }
                    uint4 o; o.x = pg8::cvt_pk_bf16(v[0], v[1]); o.y = pg8::cvt_pk_bf16(v[2], v[3]); o.z = pg8::cvt_pk_bf16(v[4], v[5]); o.w = pg8::cvt_pk_bf16(v[6], v[7]);
                    __builtin_amdgcn_raw_buffer_store_b128(__builtin_bit_cast(pg8::u32x4, o), rsrc, (int)(((unsigned)(u.pm * 256 + rl) * 1024u + (unsigned)(u.z * 512 + u.pn * 128 + wc * 32 + 8 * fq)) * 2u), 0, 16);
                }
                asm volatile("" ::: "memory");
            }
        asm volatile("s_waitcnt vmcnt(0)" ::: "memory");
        if (fr == 0 && fq == 0) __hip_atomic_fetch_add(ctl + CW_DONE + 64 * u.pm, 1u, __ATOMIC_RELAXED, __HIP_MEMORY_SCOPE_AGENT);
    }
};
struct OpsDN { const bf16* HID; const bf16* WDN; const LAS int* tab; static constexpr int NT = 16, LDB = 512;
    __device__ __forceinline__ const char* a_base(const pg8::Unit& u) const { return (const char*)(HID + (size_t)u.pm * 256 * 1024); }
    __device__ __forceinline__ void a_voff(const pg8::Unit&, const int (&R)[2], const int (&C)[2], unsigned (&out)[2][2]) const {
#pragma unroll
        for (int h = 0; h < 2; ++h)
#pragma unroll
            for (int i = 0; i < 2; ++i) out[h][i] = (unsigned)((h * 128 + R[i]) * 1024 + C[i]) * 2u; }
    __device__ __forceinline__ void bprep(const pg8::Unit& u, const char*& p0, const char*& p1) const {
        int ea, eb; class_experts(tab[64 + u.pm], ea, eb);
        p0 = (const char*)(WDN + ((size_t)ea * 1024 + u.pn * 256) * 512); p1 = (const char*)(WDN + ((size_t)eb * 1024 + u.pn * 256) * 512); }
    __device__ static __forceinline__ const char* bat(const char* p0, const char* p1, int kt) { return (kt < 8 ? p0 : p1) + (size_t)(kt & 7) * 128; } };
struct SchedDN { const LAS int* tab; unsigned* ctl; int G, vcu;
    __device__ __forceinline__ bool next(int i, pg8::Unit& u) const {
        const int total = tab[NCLS] * 4;
        int L = -1;
        if (i == 0) L = vcu; else if (i == 1) { const int e = G - 1 - vcu; if (G + e < total) L = G + e; }
        if (L < 0 || L >= total) L = -1;
        __builtin_amdgcn_s_barrier();
        if (threadIdx.x == 0 && L >= 0) {
            unsigned* dn = ctl + CW_DONE + 64 * (L >> 2); unsigned sp = 0;
            while (__hip_atomic_load(dn, __ATOMIC_RELAXED, __HIP_MEMORY_SCOPE_AGENT) < 64u) { __builtin_amdgcn_s_sleep(2); if (++sp > (1u << 22)) { atomicAdd(ctl + XB_TMO + CW_BAR, 1u); break; } }
            __builtin_amdgcn_fence(__ATOMIC_ACQUIRE, "agent");
            asm volatile("s_waitcnt vmcnt(0)" ::: "memory");
        }
        __builtin_amdgcn_s_barrier();
        if (L < 0) return false; u.pm = L >> 2; u.pn = L & 3; u.z = 0; return true; } };
struct EpiDN { float* O; const bf16* X2; const unsigned* LIST; const LAS int* tab;
    __device__ __forceinline__ void operator()(const pg8::f32x4 (&acc)[2][2][4][2], const pg8::Unit& u, int wr, int wc, int fr_, int fq_) const {
        int fr = fr_, fq = fq_; asm volatile("" : "+v"(fr), "+v"(fq));
        const int c = tab[64 + u.pm], n = tab[32 + c], r0 = (u.pm - tab[c]) * 256;
#pragma unroll
        for (int ai = 0; ai < 2; ++ai)
#pragma unroll
            for (int m = 0; m < 4; ++m) {
                const int r = r0 + ai * 128 + wr * 64 + m * 16 + fr;
                if (r < n) {
                    const unsigned tok = LIST[(size_t)c * T + r];
#pragma unroll
                    for (int bj = 0; bj < 2; ++bj) { const size_t off = (size_t)tok * 1024 + u.pn * 256 + bj * 128 + wc * 32 + 8 * fq;
                        const uint4 xw = *(const uint4*)(X2 + off); const pg8::f32x4 a0 = acc[ai][bj][m][0], a1 = acc[ai][bj][m][1];
                        const nt_f32x4 y0 = {LO16(xw.x) + a0[0], HI16(xw.x) + a0[1], LO16(xw.y) + a0[2], HI16(xw.y) + a0[3]}, y1 = {LO16(xw.z) + a1[0], HI16(xw.z) + a1[1], LO16(xw.w) + a1[2], HI16(xw.w) + a1[3]};
                        __builtin_nontemporal_store(y0, (nt_f32x4*)(O + off)); __builtin_nontemporal_store(y1, (nt_f32x4*)(O + off + 4)); }
                }
            }
    }
};

constexpr int NTHR = 512;
constexpr int LDS_BYTES = 163840;

__global__ void __launch_bounds__(NTHR, 2) fwd_kernel(Args args) {
    extern __shared__ __attribute__((aligned(16))) unsigned char lds[];
    const int tid = threadIdx.x, lane = tid & 63;
    const int gtid = blockIdx.x * NTHR + tid, nthreads = gridDim.x * NTHR;
    const int gwave = gtid >> 6, nwaves = nthreads >> 6;
    Ctx c; c.a = args; unsigned char* ws = args.ws;

    volatile LAS unsigned* MISC = (volatile LAS unsigned*)((LAS unsigned char*)lds + MISC_OFF);
    if (tid < 32) MISC[tid] = 0u;
    __syncthreads();
    XcdBarrier bar = xcd_barrier_post((unsigned*)(ws + WS_CTL) + CW_BAR, MISC + 8);
    const int lo = args.ph_lo, hi = args.ph_hi;
#ifdef ONLY_PHASE
#define IN(k) ((k) == ONLY_PHASE)
#else
#define IN(k) (lo <= (k) && (k) < hi)
#endif
#define SEAM(k) do { if (IN(k) && IN((k) + 1)) xcd_barrier(bar); } while (0)


    if (IN(0)) {
        for (int t = gwave * 2; t < T; t += nwaves * 2) {
            const float4* xr = (const float4*)(c.x() + (size_t)t * D) + lane;
            float4 v[8]; float s0 = 0.f, s1 = 0.f;
#pragma unroll
            for (int j = 0; j < 8; ++j) v[j] = xr[64 * j];
#pragma unroll
            for (int j = 0; j < 4; ++j) { s0 += v[j].x * v[j].x + v[j].y * v[j].y + v[j].z * v[j].z + v[j].w * v[j].w; s1 += v[4 + j].x * v[4 + j].x + v[4 + j].y * v[4 + j].y + v[4 + j].z * v[4 + j].z + v[4 + j].w * v[4 + j].w; }
            const float r0 = rsqrtf(wave_sum(s0) * (1.f / D) + RMS_EPS), r1 = rsqrtf(wave_sum(s1) * (1.f / D) + RMS_EPS);
#pragma unroll
            for (int j = 0; j < 8; ++j) { const float4 g = ((const float4*)c.norm1_g())[lane + 64 * (j & 3)]; const float r = j < 4 ? r0 : r1;
                uint2 o; o.x = pk2bf(v[j].x * r * g.x, v[j].y * r * g.y); o.y = pk2bf(v[j].z * r * g.z, v[j].w * r * g.w);
                ((uint2*)(c.H1() + (size_t)t * D))[lane + 64 * j] = o; }
        }
        {
            LAS float* scr = (LAS float*)((LAS unsigned char*)lds + (tid >> 6) * 16384);
            constexpr int I_IN = 16 * 160, I_OUT = 16 * 32, I_BR = 8 * 32, I_GU = 16 * 4 * 2 * 4 * 16, I_DN = 16 * 8 * 32, I_C1 = 512;
            for (int it = gwave; it < I_IN + I_OUT + 2 * I_BR + I_GU + I_DN + I_C1; it += nwaves) {
                int r = it;
                if (r < I_IN) { const int kb = r / 160, vb = r % 160, pn = vb >> 3, bj = (vb >> 2) & 1, wc = vb & 3;
                    const ChunkDesc d = chunk_desc(c, pn * 4 + wc); int nv = d.ncols - 32 * bj; nv = nv < 0 ? 0 : (nv > 32 ? 32 : nv);
                    tr_item(c.w_in(), INC, 64 * kb, d.src + 32 * bj, nv, c.WIN(), 1024, 256 * pn + 128 * bj + 32 * wc, scr, lane); continue; }
                r -= I_IN;
                if (r < I_OUT) { tr_item(c.w_out(), 1024, 64 * (r / 32), 32 * (r % 32), 32, c.WOUT(), 1024, 32 * (r % 32), scr, lane); continue; }
                r -= I_OUT;
                if (r < I_BR) { tr_item(c.w_bn(), 1024, 64 * (r / 32), 32 * (r % 32), 32, c.WBN(), 512, 32 * (r % 32), scr, lane); continue; }
                r -= I_BR;
                if (r < I_BR) { tr_item(c.w_bd(), 1024, 64 * (r / 32), 32 * (r % 32), 32, c.WBD(), 512, 32 * (r % 32), scr, lane); continue; }
                r -= I_BR;
                if (r < I_GU) { const int kb = r & 15, blk = (r >> 4) & 3, bj = (r >> 6) & 1, ntile = (r >> 7) & 3, e = r >> 9;
                    tr_item((bj ? c.w_up() : c.w_gate()) + (size_t)e * 1024 * 512, 512, 64 * kb, ntile * 128 + 32 * blk, 32, c.WGU() + (size_t)e * 1024 * 1024, 1024, 256 * ntile + 128 * bj + 32 * blk, scr, lane, c.norm2_g()); continue; }
                r -= I_GU;
                if (r < I_DN) { const int nb = r & 31, kb = (r >> 5) & 7, e = r >> 8;
                    tr_item(c.w_down() + (size_t)e * 512 * 1024, 1024, 64 * kb, 32 * nb, 32, c.WDN() + (size_t)e * 1024 * 512, 512, 32 * nb, scr, lane); continue; }
                r -= I_DN;
                { const int nb = r & 7, kb = (r >> 3) & 15, bot = (r >> 7) & 1, kv = r >> 8;
                    tr_item(c.cmp_w1() + (size_t)kv * 2048 * 256 + (size_t)bot * 1024 * 256, 256, 64 * kb, 32 * nb, 32, c.WC1() + (size_t)kv * 512 * 1024, 1024, bot * 256 + 32 * nb, scr, lane); }
            }
            if (gwave >= nwaves - 64) { const int w = gwave - (nwaves - 64), sl = w & 7, jb = (w >> 3) & 3, kv = w >> 5, j = jb * 64 + lane;
                const float* w1 = c.cmp_w1() + (size_t)kv * 2048 * 256 + (size_t)sl * 256 * 256 + j; const float* pos = c.cmp_pos() + kv * 2048 + sl * 256;
                float a0 = 0.f, a1 = 0.f, a2 = 0.f, a3 = 0.f;
                for (int k = 0; k < 256; k += 4) { a0 += pos[k] * w1[(size_t)k * 256]; a1 += pos[k + 1] * w1[(size_t)(k + 1) * 256]; a2 += pos[k + 2] * w1[(size_t)(k + 2) * 256]; a3 += pos[k + 3] * w1[(size_t)(k + 3) * 256]; }
                c.POSB()[(sl * 2 + kv) * 256 + j] = (a0 + a1) + (a2 + a3); }
            if (gtid >= 8192 && gtid < 8192 + 12 * 1280) { const int i = gtid - 8192, hd = i / 1280, a = (i % 1280) / 320, j = (i % 320) + a, d = 208 - j;
                c.BIASV()[i] = (d < 0) ? -1e30f : (d >= 113 ? 0.f : (c.rel_bias()[t5_bucket(d) * 12 + hd] - c.rel_bias()[31 * 12 + hd]) * 1.4426950408889634f); }
            if (gtid >= 4096 && gtid < 4096 + 3072) { const int i = gtid - 4096, hd = i >> 8, d = i & 255; c.BIAS()[i] = (c.rel_bias()[t5_bucket(d) * 12 + hd] - c.rel_bias()[31 * 12 + hd]) * 1.4426950408889634f; }
            if (gtid >= 512 && gtid < 512 + 2048) { const int i = gtid - 512, kv = i >> 10, bg = (i >> 6) & 15, e = i & 63; const size_t tb = ((size_t)bg * 2 + 1) * 4096; if (kv) c.VCMP()[tb + (e >> 5) * 2048 + 3 * 512 + 15 * 32 + (e & 31)] = 0; else c.KCMP()[tb + (e >> 3) * 512 + 63 * 8 + (e & 7)] = 0; }
        }
        if (gwave == 0) {
            const float a = wave_sum(c.diff_lambda()[lane] * c.diff_lambda()[64 + lane]);
            const float b = wave_sum(c.diff_lambda()[128 + lane] * c.diff_lambda()[192 + lane]);
            if (lane == 0) c.LAM()[0] = expf(a) - expf(b) + LAMBDA_INIT;
        }
    }
    xcd_barrier(bar);

    if (IN(1)) {
        pg8::Ops g; g.A0 = c.H1(); g.A1 = c.H1(); g.B0 = c.WIN(); g.B1 = c.WIN(); g.K = 1024;
        pg8::StaticOrder<1> So; So.init(T, 5120, (int)gridDim.x, (int)blockIdx.x);
        EpiInProj E; E.c = c;
        pg8::gemm_phase(( LAS unsigned char*)lds, g, So, E);
    }
    xcd_barrier(bar);

    if (IN(2)) {
        pg8::Ops g; g.A0 = c.CT(); g.A1 = c.CT(); g.B0 = c.WC1(); g.B1 = c.WC1() + 512 * 1024; g.K = 1024;
        SchedCmp So; So.c = (int)blockIdx.x;
        EpiF32 E; E.O = c.U(); E.ldc = 512;
        pg8::gemm_phase((LAS unsigned char*)lds, g, So, E);
        unsigned* ctl = (unsigned*)(ws + WS_CTL);
        volatile LAS int* wq = (volatile LAS int*)((LAS unsigned char*)lds + MISC_OFF + 64);
        if (blockIdx.x < 32 && tid == 0) { __builtin_amdgcn_fence(__ATOMIC_RELEASE, "agent"); asm volatile("s_waitcnt vmcnt(0)" ::: "memory");
            __hip_atomic_fetch_add(ctl + CW_CMPD, 1u, __ATOMIC_RELAXED, __HIP_MEMORY_SCOPE_AGENT); }
        {   att::DiffArgs A; A.Q = c.QD(); A.K = c.KD(); A.V = c.VD(); A.O = c.ODIFF(); A.biasv = c.BIASV(); A.out_gain = c.diff_out_norm(); A.lam = c.LAM()[0];
            for (;;) {
                __syncthreads();
                if (tid == 0) *wq = (int)atomicAdd(ctl + CW_WQ, 1u);
                __syncthreads();
                const int u = *wq;
                if (u >= 512) break;
                att::diff_unit((LAS unsigned char*)lds, A, (u & 31) >> 2, u & 3, 15 - (u >> 5));
            } }
        {   __syncthreads();
            if (tid == 0) { unsigned sp = 0;
                while (__hip_atomic_load(ctl + CW_CMPD, __ATOMIC_RELAXED, __HIP_MEMORY_SCOPE_AGENT) < 32u) { __builtin_amdgcn_s_sleep(2); if (++sp > (1u << 22)) { atomicAdd(ctl + XB_TMO + CW_BAR, 1u); break; } }
                __builtin_amdgcn_fence(__ATOMIC_ACQUIRE, "agent"); asm volatile("s_waitcnt vmcnt(0)" ::: "memory"); }
            __syncthreads();
            LAS float* hid = (LAS float*)((LAS unsigned char*)lds) + (tid >> 6) * 256;
            for (;;) {
                __syncthreads();
                if (tid == 0) *wq = (int)atomicAdd(ctl + CW_WQ + 128, 1u);
                __syncthreads();
                const int q = *wq;
                if (q >= 128) break;
                const int quarter = q & 3, b = (q >> 2) & 7, g = (q >> 5) & 1, kv = q >> 6;
                for (int jj = 0; jj < 4; ++jj) {
                    const int n = quarter * 32 + (tid >> 6) * 4 + jj;
                    if (n >= NCMP) continue;
                    const float* u1 = c.U() + ((size_t)(kv * 2 + g) * 1024 + b * 128 + n) * 512;
                    const float4 t4 = *(const float4*)(u1 + 4 * lane), b4 = *(const float4*)(u1 + 512 + 256 + 4 * lane), p4 = posb_sum(c.POSB() + kv * 256 + 4 * lane);
                    const float hv[4] = {t4.x + b4.x + p4.x, t4.y + b4.y + p4.y, t4.z + b4.z + p4.z, t4.w + b4.w + p4.w};
#pragma unroll
                    for (int i = 0; i < 4; ++i) { const float a = hv[i]; const float uu = 0.7978845608028654f * (a + 0.044715f * a * a * a); hid[4 * lane + i] = 0.5f * a * (1.f + tanhf(uu)); }
                    const float* w2 = c.cmp_w2() + (size_t)kv * 256 * 64 + lane;
                    float o = 0.f;
                    for (int j = 0; j < 256; ++j) o += hid[j] * w2[j * 64];
                    if (kv == 0) { const float ss = wave_sum(o * o); o = o * rsqrtf(ss * (1.f / 64.f) + RMS_EPS) * c.nsa_k_norm()[lane]; }
                    { const int key = n & 63, e = lane; const size_t tb = ((size_t)(b * 2 + g) * 2 + (n >> 6)) * 4096;
                      if (kv) c.VCMP()[tb + (e >> 5) * 2048 + (key >> 4) * 512 + (key & 15) * 32 + (e & 31)] = f2bf(o);
                      else c.KCMP()[tb + (e >> 3) * 512 + key * 8 + (e & 7)] = f2bf(o); }
                }
                asm volatile("s_waitcnt vmcnt(0)" ::: "memory");
                __syncthreads();
                if (tid == 0) { __builtin_amdgcn_fence(__ATOMIC_RELEASE, "agent"); asm volatile("s_waitcnt vmcnt(0)" ::: "memory");
                    __hip_atomic_fetch_add(ctl + CW_FIN + 64 * (b * 2 + g), 1u, __ATOMIC_RELAXED, __HIP_MEMORY_SCOPE_AGENT); }
            } }
        {   att::NsaArgs A; A.Q = c.QN(); A.KS = c.KS(); A.VS = c.VS(); A.KW = c.KW(); A.VW = c.VW(); A.KC = c.KCMP(); A.VC = c.VCMP(); A.GN = c.GN(); A.O = c.ONSAB(); A.rel_bias = c.BIAS(); A.biasv = c.BIASV();
            bool all_seen = false;
            for (;;) {
                __syncthreads();
                if (tid == 0) {
                    const int u = (int)atomicAdd(ctl + CW_WQ + 64, 1u);
                    if (u < 512 && !all_seen) {
                        unsigned* fc = ctl + CW_FIN + 64 * (u & 15); unsigned sp = 0;
                        while (__hip_atomic_load(fc, __ATOMIC_RELAXED, __HIP_MEMORY_SCOPE_AGENT) < 8u) { __builtin_amdgcn_s_sleep(2); if (++sp > (1u << 22)) { atomicAdd(ctl + XB_TMO + CW_BAR, 1u); break; } }
                        bool all = true;
                        for (int k = 0; k < 16; ++k) all = all && (__hip_atomic_load(ctl + CW_FIN + 64 * k, __ATOMIC_RELAXED, __HIP_MEMORY_SCOPE_AGENT) >= 8u);
                        __builtin_amdgcn_fence(__ATOMIC_ACQUIRE, "agent"); asm volatile("s_waitcnt vmcnt(0)" ::: "memory");
                        all_seen = all;
                    }
                    *wq = u;
                }
                __syncthreads();
                const int u = *wq;
                if (u >= 512) break;
                att::nsa_unit((LAS unsigned char*)lds, A, (u & 15) >> 1, u & 1, 31 - (u >> 4));
            } }
    }
    xcd_barrier(bar);
    if (IN(7)) {
        pg8::Ops g; g.A0 = c.ONSAB(); g.A1 = c.ODIFF(); g.B0 = c.WBN(); g.B1 = c.WBD(); g.K = 512;
        pg8::StaticOrder<2> So; So.init(T, 1024, (int)gridDim.x, (int)blockIdx.x);
        EpiMerge E; E.Y = c.Y(); E.GM = c.GM();
        pg8::gemm_phase((LAS unsigned char*)lds, g, So, E);
    }
    xcd_barrier(bar);
    if (IN(8)) {
        pg8::Ops g; g.A0 = c.Y(); g.A1 = c.Y(); g.B0 = c.WOUT(); g.B1 = c.WOUT(); g.K = 1024;
        pg8::StaticOrder<1> So; So.init(T, 1024, (int)gridDim.x, (int)blockIdx.x);
        EpiResid E; E.X = c.x(); E.O = c.X2B();
        pg8::gemm_phase((LAS unsigned char*)lds, g, So, E);
    }
    xcd_barrier(bar);
    if (IN(9)) {
        LAS int* smc = (LAS int*)((LAS unsigned char*)lds + 81920);
        LAS float* Wl = (LAS float*)lds;
        unsigned* ctl = (unsigned*)(ws + WS_CTL); unsigned* LIST = (unsigned*)(ws + WS_LIST);
        for (int k = tid; k < D; k += NTHR) {
            const float4 gw = *(const float4*)(c.rg_w() + (size_t)k * 4);
            Wl[0 * D + k] = gw.x; Wl[1 * D + k] = gw.y; Wl[2 * D + k] = gw.z; Wl[3 * D + k] = gw.w;
#pragma unroll
            for (int i4 = 0; i4 < 4; ++i4) { const float4 ew = *(const float4*)(c.re_w() + (size_t)k * 16 + 4 * i4);
                Wl[(4 + 4 * i4) * D + k] = ew.x; Wl[(5 + 4 * i4) * D + k] = ew.y; Wl[(6 + 4 * i4) * D + k] = ew.z; Wl[(7 + 4 * i4) * D + k] = ew.w; }
        }
        __syncthreads();
        for (int tb = blockIdx.x; tb < T / 64; tb += gridDim.x) {
#pragma unroll 1
            for (int j = 0; j < 8; j += 2) {
                const int tl0 = (tid >> 6) * 8 + j, t0 = tb * 64 + tl0;
                const uint2* xr = (const uint2*)(c.X2B() + (size_t)t0 * D) + lane;
                float4 v[8]; float ssa = 0.f, ssb = 0.f;
#pragma unroll
                for (int q = 0; q < 8; ++q) { const uint2 w = xr[64 * q]; v[q] = make_float4(LO16(w.x), HI16(w.x), LO16(w.y), HI16(w.y)); }
#pragma unroll
                for (int q = 0; q < 4; ++q) { ssa += v[q].x * v[q].x + v[q].y * v[q].y + v[q].z * v[q].z + v[q].w * v[q].w; ssb += v[4 + q].x * v[4 + q].x + v[4 + q].y * v[4 + q].y + v[4 + q].z * v[4 + q].z + v[4 + q].w * v[4 + q].w; }
                const float ra = rsqrtf(wave_sum(ssa) * (1.f / D) + RMS_EPS), rb = rsqrtf(wave_sum(ssb) * (1.f / D) + RMS_EPS);
                float ha[16], hb[16];
#pragma unroll
                for (int q = 0; q < 4; ++q) { const float4 g = ((const float4*)c.norm2_g())[lane + 64 * q];
                    ha[4 * q + 0] = v[q].x * ra * g.x; ha[4 * q + 1] = v[q].y * ra * g.y; ha[4 * q + 2] = v[q].z * ra * g.z; ha[4 * q + 3] = v[q].w * ra * g.w;
                    hb[4 * q + 0] = v[4 + q].x * rb * g.x; hb[4 * q + 1] = v[4 + q].y * rb * g.y; hb[4 * q + 2] = v[4 + q].z * rb * g.z; hb[4 * q + 3] = v[4 + q].w * rb * g.w; }
                float la[20], lb[20];
                const LAS float* wl = Wl + lane * 4;
#pragma unroll
                for (int i = 0; i < 20; ++i) {
                    float sa = 0.f, sb = 0.f;
#pragma unroll
                    for (int q = 0; q < 4; ++q) { const att::f32x4v w4 = *(const LAS att::f32x4v*)(wl + i * D + 256 * q);
                        sa += (ha[4 * q] * w4[0] + ha[4 * q + 1] * w4[1]) + (ha[4 * q + 2] * w4[2] + ha[4 * q + 3] * w4[3]);
                        sb += (hb[4 * q] * w4[0] + hb[4 * q + 1] * w4[1]) + (hb[4 * q + 2] * w4[2] + hb[4 * q + 3] * w4[3]); }
                    la[i] = sa; lb[i] = sb;
                    if ((i & 3) == 3) asm volatile("" ::: "memory");
                }
                const bool up = lane >= 32;
                float lg[20];
#pragma unroll
                for (int i = 0; i < 20; ++i) { const float keep = up ? lb[i] : la[i], send = up ? la[i] : lb[i]; float x = keep + __shfl_xor(send, 32);
                    x += __shfl_xor(x, 16); x += __shfl_xor(x, 8); x += __shfl_xor(x, 4); x += __shfl_xor(x, 2); x += __shfl_xor(x, 1); lg[i] = x; }
                const int tl = tl0 + (up ? 1 : 0), t = t0 + (up ? 1 : 0);
                if ((lane & 31) == 0) {
                    float gl[4];
#pragma unroll
                    for (int i = 0; i < 4; ++i) gl[i] = lg[i] + c.rg_b()[i];
                    int gt = 0; float gbest = gl[0];
#pragma unroll
                    for (int i = 1; i < 4; ++i) if (gl[i] > gbest) { gbest = gl[i]; gt = i; }
                    float gs = 0.f;
#pragma unroll
                    for (int i = 0; i < 4; ++i) gs += expf(gl[i] - gbest);
                    const float gp = 1.f / gs;
                    float el[4];
#pragma unroll
                    for (int i = 0; i < 4; ++i) { float v0 = 0.f;
#pragma unroll
                        for (int gg = 0; gg < 4; ++gg) v0 = (gg == gt) ? lg[4 + gg * 4 + i] + c.re_b()[gg * 4 + i] : v0;
                        el[i] = v0; }
                    int e0 = 0; float b0 = el[0];
#pragma unroll
                    for (int i = 1; i < 4; ++i) if (el[i] > b0) { b0 = el[i]; e0 = i; }
                    int e1 = -1; float b1 = -3.0e38f;
#pragma unroll
                    for (int i = 0; i < 4; ++i) if (i != e0 && el[i] > b1) { b1 = el[i]; e1 = i; }
                    const float p1 = expf(b1 - b0); const float w0 = gp / (1.f + p1), w1 = gp * p1 / (1.f + p1);
                    const int ea = e0 < e1 ? e0 : e1, eb = e0 < e1 ? e1 : e0;
                    const int pr = (ea == 0) ? eb - 1 : (ea == 1 ? eb + 1 : 5);
                    const int cls = gt * 6 + pr;
                    float* rp = c.ROUTE() + (size_t)t * 4;
                    rp[0] = e0 < e1 ? w0 : w1; rp[1] = e0 < e1 ? w1 : w0; rp[2] = __int_as_float(cls); rp[3] = up ? rb : ra;
                    smc[tl] = cls;
                }
            }
            __syncthreads();
            if (tid < 64) {
                const int mycls = smc[lane];
                int cnt_l = 0, rank = 0;
                for (int cc = 0; cc < NCLS; ++cc) {
                    const unsigned long long mask = __ballot(mycls == cc);
                    if (lane == cc) cnt_l = __popcll(mask);
                    if (mycls == cc) rank = __popcll(mask & ((1ull << lane) - 1ull));
                }
                unsigned base_l = 0u;
                if (lane < NCLS && cnt_l > 0) base_l = atomicAdd(ctl + CW_CNT + 64 * lane, (unsigned)cnt_l);
                const unsigned base = __shfl(base_l, mycls);
                LIST[(size_t)mycls * T + base + rank] = (unsigned)(tb * 64 + lane);
            }
            __syncthreads();
        }
    }
    xcd_barrier(bar);
    if (IN(10)) {
        LAS int* tab = (LAS int*)((LAS unsigned char*)lds + TAB_OFF);
        moe_build_tab((const unsigned*)(ws + WS_CTL), tab);
        unsigned* ctl = (unsigned*)(ws + WS_CTL);
        const int G = (int)gridDim.x, bx = (int)blockIdx.x, vcu = (G % 8 == 0) ? (bx % 8) * (G / 8) + bx / 8 : bx;
        {   OpsGU g; g.H2 = c.X2B(); g.WGU = c.WGU(); g.LIST = (const unsigned*)(ws + WS_LIST); g.tab = tab;
            SchedGU So; So.tab = tab; So.G = G; So.vcu = vcu;
            EpiGU E; E.HID = c.HID(); E.LIST = (const unsigned*)(ws + WS_LIST); E.ROUTE = c.ROUTE(); E.tab = tab; E.ctl = ctl;
            pg8::gemm_phase_g((LAS unsigned char*)lds, g, So, E); }
        {   OpsDN g; g.HID = c.HID(); g.WDN = c.WDN(); g.tab = tab;
            SchedDN So; So.tab = tab; So.ctl = ctl; So.G = G; So.vcu = vcu;
            EpiDN E; E.O = c.out(); E.X2 = c.X2B(); E.LIST = (const unsigned*)(ws + WS_LIST); E.tab = tab;
            pg8::gemm_phase_g((LAS unsigned char*)lds, g, So, E); }
    }
#undef IN
#undef SEAM
}

extern "C" void kernel_launch(void* const* d_in, const int* in_sizes, int n_in, void* d_out, int out_size, void* d_ws, size_t ws_size, hipStream_t stream) {
    static int grid = 0;
    if (grid == 0) {
        if (n_in != 24 || out_size != T * D || ws_size < WS_END) { fprintf(stderr, "kernel_launch: unexpected shapes (n_in %d out %d ws %zu)\n", n_in, out_size, ws_size); grid = -1; return; }
        int dev = 0, cus = 0, per_cu = 0;
        if (hipGetDevice(&dev) != hipSuccess || hipDeviceGetAttribute(&cus, hipDeviceAttributeMultiprocessorCount, dev) != hipSuccess) { grid = -1; return; }
        if (hipFuncSetAttribute((const void*)fwd_kernel, hipFuncAttributeMaxDynamicSharedMemorySize, LDS_BYTES) != hipSuccess) { fprintf(stderr, "kernel_launch: hipFuncSetAttribute failed\n"); grid = -1; return; }
        if (hipOccupancyMaxActiveBlocksPerMultiprocessor(&per_cu, (const void*)fwd_kernel, NTHR, LDS_BYTES) != hipSuccess || per_cu < 1) { fprintf(stderr, "kernel_launch: occupancy query says %d\n", per_cu); }
        (void)hipGetLastError();
        grid = cus;
    }
    if (grid < 0) return;
    (void)hipMemsetAsync((char*)d_ws + WS_CTL, 0, CTL_ZERO_BYTES, stream);
    Args a{};
    for (int i = 0; i < 24; ++i) a.in[i] = (const float*)d_in[i];
    a.out = (float*)d_out; a.ws = (unsigned char*)d_ws; a.ph_lo = 0; a.ph_hi = 11;
    hipLaunchKernelGGL(fwd_kernel, dim3(grid), dim3(NTHR), LDS_BYTES, stream, a);
}
```

```cpp
#include <hip/hip_runtime.h>
#include <cstdint>
#include <cstdio>

constexpr int NB = 8, S = 2048, D = 1024, T = NB * S;
constexpr int INC = 4888;
constexpr int C_QN = 0, C_KV = 512, C_GN = 1280, C_QD = 1304, C_KD = 1816, C_VD = 2328, C_GM = 2840;
constexpr int NCMP = 127;
constexpr float LAMBDA_INIT = 0.2f;
constexpr float RMS_EPS = 1e-6f;

typedef unsigned short bf16;
#define LAS __attribute__((address_space(3)))

constexpr size_t MiB = 1u << 20;
constexpr size_t WS_CTL = 0, CTL_ZERO_BYTES = 1 * MiB;
constexpr size_t WS_WIN = 1 * MiB;
constexpr size_t WS_WOUT = 11 * MiB;
constexpr size_t WS_WBN = 13 * MiB, WS_WBD = 14 * MiB;
constexpr size_t WS_WC1 = 15 * MiB;
constexpr size_t WS_WGU = 17 * MiB;
constexpr size_t WS_WDN = 49 * MiB;
constexpr size_t WS_H1 = 65 * MiB;
constexpr size_t WS_QN = 97 * MiB;
constexpr size_t WS_CT = 113 * MiB;
constexpr size_t WS_KS = 121 * MiB, WS_VS = 125 * MiB, WS_KW = 129 * MiB, WS_VW = 133 * MiB;
constexpr size_t WS_QD = 137 * MiB, WS_KD = 153 * MiB, WS_VD = 169 * MiB;
constexpr size_t WS_GM = 185 * MiB;
constexpr size_t WS_GN = 249 * MiB;
constexpr size_t WS_KCMP = 251 * MiB;
constexpr size_t WS_VCMP = 251 * MiB + 256 * 1024;
constexpr size_t WS_ROUTE = 252 * MiB + 512 * 1024;
constexpr size_t WS_LAM = 252 * MiB + 768 * 1024;
constexpr size_t WS_POSB = 252 * MiB + 800 * 1024;
constexpr size_t WS_BIAS = 252 * MiB + 832 * 1024;
constexpr size_t WS_BIASV = 252 * MiB + 848 * 1024;
constexpr size_t WS_END = 256 * MiB;
constexpr size_t WS_U = WS_H1;
constexpr size_t WS_ONSAB = WS_H1 + 16 * MiB;
constexpr size_t WS_X2B = WS_H1;
constexpr size_t WS_Y = WS_QN;
constexpr size_t WS_HID = WS_GM;

constexpr int CW_BAR = 4096;

#define XB_TMO      128
#define XB_XCNT(j)  (256  + 64 * (j))
#define XB_XSUB(j)  (1280 + 64 * (j))
#define XB_XGEN(j)  (2304 + 64 * (j))
#define XB_TOP      3328
#define XB_TOPGEN   3392
#define XCD_BAR_WORDS 3456
#define XB_SPIN_CAP (1u << 22)

__device__ __forceinline__ unsigned xb_ld(unsigned* p)              { return __hip_atomic_load(p, __ATOMIC_RELAXED, __HIP_MEMORY_SCOPE_AGENT); }
__device__ __forceinline__ unsigned xb_add(unsigned* p, unsigned v) { return __hip_atomic_fetch_add(p, v, __ATOMIC_RELAXED, __HIP_MEMORY_SCOPE_AGENT); }
__device__ __forceinline__ unsigned xb_xcc_id() { return (unsigned)__builtin_amdgcn_s_getreg((3 << 11) | 20) & 0xFu; }
#define XB_SPIN(cond, bar) do { unsigned _sp = 0; while (cond) { __builtin_amdgcn_s_sleep(1); \
    if ((++_sp & 255u) == 0u) { if (xb_ld(&(bar)[XB_TMO])) break; if (_sp > XB_SPIN_CAP) { atomicAdd(&(bar)[XB_TMO], 1u); break; } } } } while (0)

struct XcdBarrier { unsigned* bar; unsigned x; volatile LAS unsigned* st; };

__device__ __forceinline__ XcdBarrier xcd_barrier_post(unsigned* bar, volatile LAS unsigned* st) {
    XcdBarrier b; b.bar = bar; b.x = xb_xcc_id(); b.st = st;
    if (threadIdx.x == 0) (void)xb_add(&bar[XB_XCNT(b.x)], 1u);
    return b;
}
__device__ __forceinline__ void xcd_barrier_complete(unsigned* bar, unsigned x, unsigned& nloc, unsigned& nx) {
    const unsigned G = gridDim.x * gridDim.y * gridDim.z;
    unsigned sum, cnt, mine, sp = 0u;
    for (;;) {
        sum = 0u; cnt = 0u; mine = 0u;
#pragma unroll
        for (unsigned j = 0; j < 16; ++j) { const unsigned c = xb_ld(&bar[XB_XCNT(j)]); sum += c; cnt += (c > 0u) ? 1u : 0u; mine = (j == x) ? c : mine; }
        if (sum == G) break;
        __builtin_amdgcn_s_sleep(1);
        if ((++sp & 255u) == 0u) { if (xb_ld(&bar[XB_TMO])) break; if (sp > XB_SPIN_CAP) { atomicAdd(&bar[XB_TMO], 1u); break; } }
    }
    nloc = mine > 0u ? mine : 1u; nx = cnt > 0u ? cnt : 1u;
}
__device__ __forceinline__ void xcd_barrier(const XcdBarrier& b) {
    asm volatile("s_waitcnt vmcnt(0)" ::: "memory");
    __syncthreads();
    if (threadIdx.x == 0) {
        unsigned* bar = b.bar;
        __builtin_amdgcn_s_waitcnt(0);
        unsigned nloc = b.st[0], nx = b.st[1];
        if (nloc == 0u) { xcd_barrier_complete(bar, b.x, nloc, nx); b.st[0] = nloc; b.st[1] = nx; }
        const unsigned old = xb_add(&bar[XB_XSUB(b.x)], 1u);
        const unsigned gen = old / nloc;
        if (old + 1u == (gen + 1u) * nloc) {
            __builtin_amdgcn_fence(__ATOMIC_RELEASE, "agent");
            asm volatile("s_waitcnt vmcnt(0)" ::: "memory");
            const unsigned og = xb_add(&bar[XB_TOP], 1u);
            const unsigned tg = og / nx;
            if (og + 1u == (tg + 1u) * nx) xb_add(&bar[XB_TOPGEN], 1u);
            else XB_SPIN(xb_ld(&bar[XB_TOPGEN]) == tg, bar);
            __builtin_amdgcn_fence(__ATOMIC_ACQUIRE, "agent");
            xb_add(&bar[XB_XGEN(b.x)], 1u);
            asm volatile("s_waitcnt vmcnt(0)" ::: "memory");
        } else {
            XB_SPIN(xb_ld(&bar[XB_XGEN(b.x)]) == gen, bar);
            __builtin_amdgcn_fence(__ATOMIC_ACQUIRE, "agent");
            asm volatile("s_waitcnt vmcnt(0)" ::: "memory");
        }
    }
    __syncthreads();
}

__device__ __forceinline__ bf16 f2bf(float f) { unsigned u = __float_as_uint(f); return (bf16)((u + 0x7fffu + ((u >> 16) & 1u)) >> 16); }
typedef float g_f32x2 __attribute__((ext_vector_type(2))); typedef __bf16 g_bf16x2 __attribute__((ext_vector_type(2)));
__device__ __forceinline__ unsigned pk2bf(float lo, float hi) { const g_f32x2 v = {lo, hi}; const g_bf16x2 b = __builtin_convertvector(v, g_bf16x2); return __builtin_bit_cast(unsigned, b); }
__device__ __forceinline__ float wave_sum(float v) {
#pragma unroll
    for (int o = 1; o < 64; o <<= 1) v += __shfl_xor(v, o);
    return v;
}
typedef float nt_f32x4 __attribute__((ext_vector_type(4)));
__device__ __forceinline__ float sigmoidf_(float x) { return __builtin_amdgcn_rcpf(1.f + __builtin_amdgcn_exp2f(-1.4426950408889634f * x)); }

__device__ const unsigned char T5B[128] = {0, 1, 2, 3, 4, 5, 6, 7, 8, 9, 10, 11, 12, 13, 14, 15, 16, 16, 16, 17, 17, 18, 18, 18, 19, 19, 19, 20, 20, 20, 20, 21, 21, 21, 21, 22, 22, 22, 22, 22, 23, 23, 23, 23, 23, 23, 24, 24, 24, 24, 24, 24, 25, 25, 25, 25, 25, 25, 25, 26, 26, 26, 26, 26, 26, 26, 26, 27, 27, 27, 27, 27, 27, 27, 27, 27, 27, 28, 28, 28, 28, 28, 28, 28, 28, 28, 28, 29, 29, 29, 29, 29, 29, 29, 29, 29, 29, 29, 29, 30, 30, 30, 30, 30, 30, 30, 30, 30, 30, 30, 30, 30, 30, 31, 31, 31, 31, 31, 31, 31, 31, 31, 31, 31, 31, 31, 31, 31};
__device__ __forceinline__ int t5_bucket(int dist) { return (int)T5B[dist > 127 ? 127 : (dist < 0 ? 0 : dist)]; }

#define LO16(u) __uint_as_float((u) << 16)
#define HI16(u) __uint_as_float((u) & 0xffff0000u)

struct Args { const float* in[24]; float* out; unsigned char* ws; int ph_lo, ph_hi; };

struct Ctx {
    Args a;
#define CF(name, idx) __device__ __forceinline__ const float* name() const { return a.in[idx]; }
    CF(x, 0) CF(norm1_g, 1) CF(w_in, 2) CF(nsa_q_norm, 3) CF(nsa_k_norm, 4) CF(cmp_pos, 5) CF(cmp_w1, 6) CF(cmp_w2, 7) CF(diff_q_norm, 8) CF(diff_k_norm, 9)
    CF(diff_lambda, 10) CF(diff_out_norm, 11) CF(rel_bias, 12) CF(w_bn, 13) CF(w_bd, 14) CF(w_out, 15) CF(norm2_g, 16) CF(rg_w, 17) CF(rg_b, 18) CF(re_w, 19) CF(re_b, 20)
    CF(w_gate, 21) CF(w_up, 22) CF(w_down, 23)
#undef CF
#define CW(type, name, off) __device__ __forceinline__ type* name() const { return (type*)(a.ws + (off)); }
    CW(bf16, H1, WS_H1) CW(bf16, QN, WS_QN) CW(bf16, CT, WS_CT) CW(bf16, KS, WS_KS) CW(bf16, VS, WS_VS) CW(bf16, KW, WS_KW) CW(bf16, VW, WS_VW)
    CW(bf16, QD, WS_QD) CW(bf16, KD, WS_KD) CW(bf16, VD, WS_VD) CW(bf16, GM, WS_GM) CW(float, GN, WS_GN) CW(bf16, KCMP, WS_KCMP) CW(bf16, VCMP, WS_VCMP)
    CW(bf16, ONSAB, WS_ONSAB) CW(float, ROUTE, WS_ROUTE)
    CW(float, LAM, WS_LAM) CW(bf16, Y, WS_Y) CW(bf16, HID, WS_HID)
    CW(float, U, WS_U) CW(bf16, X2B, WS_X2B) CW(float, POSB, WS_POSB) CW(float, BIAS, WS_BIAS) CW(float, BIASV, WS_BIASV) CW(bf16, WIN, WS_WIN) CW(bf16, WOUT, WS_WOUT) CW(bf16, WBN, WS_WBN) CW(bf16, WBD, WS_WBD) CW(bf16, WC1, WS_WC1) CW(bf16, WGU, WS_WGU) CW(bf16, WDN, WS_WDN)
    __device__ __forceinline__ bf16* ODIFF() const { return (bf16*)a.out; }
#undef CW
    __device__ __forceinline__ float* out() const { return a.out; }
};

struct ChunkDesc { int src; int ncols; int mode; const float* gain; bf16* dst; float* dstf; int pitch; int dcol; float qscale;
    int img; int c0; int tile_bytes; int bstride; };
__device__ __forceinline__ ChunkDesc chunk_desc(const Ctx& c, int ch) {
    ChunkDesc d; d.src = 0; d.ncols = 64; d.mode = 0; d.gain = nullptr; d.dst = nullptr; d.dstf = nullptr; d.pitch = 0; d.dcol = 0; d.qscale = 1.f; d.img = 0; d.c0 = 0; d.tile_bytes = 0; d.bstride = 0;
    if (ch < 8) { d.src = C_QN + 64 * ch; d.mode = 1; d.gain = c.nsa_q_norm(); d.dst = c.QN(); d.pitch = 512; d.dcol = 64 * ch; d.qscale = 0.125f * 1.4426950408889634f; }
    else if (ch < 20) { const int j = ch - 8; d.src = C_KV + 64 * j; const int t = j >> 2, kv = (j >> 1) & 1, g = j & 1;
        if (t == 0) { d.dst = c.CT() + (size_t)(kv * 2 + g) * T * 64; d.pitch = 64; d.dcol = 0; }
        else { d.dst = ((t == 1) ? (kv ? c.VS() : c.KS()) : (kv ? c.VW() : c.KW())) + (size_t)g * 32 * 4096; d.img = kv ? 2 : 1; d.c0 = 0; d.tile_bytes = 8192; d.bstride = 2 * 32 * 8192;
               if (kv == 0) { d.mode = 1; d.gain = c.nsa_k_norm() + 64 * t; } } }
    else if (ch < 24) { if (ch == 20) { d.src = C_GN; d.ncols = 24; d.mode = 2; d.dstf = c.GN(); d.pitch = 24; d.dcol = 0; } else d.ncols = 0; }
    else if (ch < 32) { const int j = ch - 24; d.src = C_QD + 64 * j; d.mode = 1; d.gain = c.diff_q_norm() + 64 * (j & 1); d.dst = c.QD(); d.pitch = 512; d.dcol = 64 * j; d.qscale = 0.125f * 1.4426950408889634f; }
    else if (ch < 40) { const int j = ch - 32; d.src = C_KD + 64 * j; d.mode = 1; d.gain = c.diff_k_norm() + 64 * (j & 1); d.dst = c.KD() + (size_t)(j >> 1) * 32 * 8192; d.img = 1; d.c0 = (j & 1) * 8; d.tile_bytes = 16384; d.bstride = 4 * 32 * 16384; }
    else if (ch < 48) { const int j = ch - 40; d.src = C_VD + 64 * j; d.dst = c.VD() + (size_t)(j >> 1) * 32 * 8192; d.img = 2; d.c0 = (j & 1) * 2; d.tile_bytes = 16384; d.bstride = 4 * 32 * 16384; }
    else { const int j = ch - 48; d.src = C_GM + 64 * j; d.mode = 2; d.dst = c.GM(); d.pitch = 2048; d.dcol = 64 * j; }
    return d;
}


namespace pg8 {
typedef short bf16x8 __attribute__((ext_vector_type(8)));
typedef float f32x4 __attribute__((ext_vector_type(4)));
typedef unsigned u32x4 __attribute__((ext_vector_type(4)));
constexpr int BM = 256, BK = 64, HALF = 128, HTB = HALF * BK * 2, NXCD = 8, WGM = 8;
__device__ __forceinline__ int lds_byte(int r, int c) { const int st = (r >> 4) * 2 + (c >> 5), rr = r & 15, cc = c & 31, ob = rr * 64 + cc * 2; return st * 1024 + (ob ^ (((ob >> 9) & 1) << 5)); }
__device__ __forceinline__ void stage_rc(int b, int& R, int& C) { const int st = b / 1024, sb = b % 1024, swz = sb ^ (((sb >> 9) & 1) << 5); R = (st >> 1) * 16 + swz / 64; C = (st & 1) * 32 + (swz % 64) / 2; }
__device__ __forceinline__ int perm32(int rho) { const int n = rho >> 4, i = rho & 15; return 8 * (i >> 2) + 4 * n + (i & 3); }
__device__ __forceinline__ unsigned cvt_pk_bf16(float lo, float hi) { return pk2bf(lo, hi); }

struct Unit { int pm, pn, z; };
struct Ops { const bf16 *A0, *A1, *B0, *B1; int K;
    __device__ __forceinline__ const char* a(const Unit& u) const { return (const char*)((u.z ? A1 : A0) + (size_t)u.pm * BM * K); }
    __device__ __forceinline__ const char* b(const Unit& u) const { return (const char*)((u.z ? B1 : B0) + (size_t)u.pn * BM * K); } };

template <int NZ> struct StaticOrder {
    int nM, nN, nwg, G, c;
    __device__ __forceinline__ void init(int M, int N, int G_, int c_) { nM = M / BM; nN = N / BM; nwg = nM * nN; G = G_; c = c_; }
    __device__ __forceinline__ bool next(int i, Unit& u) const {
        const int it = i / NZ; u.z = i % NZ;
        const long L = (long)it * G + c; if (L >= nwg) return false;
        int wgid = (int)L; { const int q = nwg / NXCD, r = nwg % NXCD, xcd = wgid % NXCD, off = wgid / NXCD; wgid = (xcd < r ? xcd * (q + 1) : r * (q + 1) + (xcd - r) * q) + off; }
        const int nig = WGM * nN, gid = wgid / nig, fm = gid * WGM, gsz = (nM - fm) < WGM ? (nM - fm) : WGM;
        u.pm = fm + ((wgid % nig) % gsz); u.pn = (wgid % nig) / gsz; return true;
    }
};

template <class Epi, class Sched>
__device__ __forceinline__ void gemm_phase(LAS unsigned char* lds, const Ops g, const Sched& S, const Epi& E) {
    const int tid = threadIdx.x, wid = __builtin_amdgcn_readfirstlane(tid >> 6), lane = tid & 63, wr = wid >> 2, wc = wid & 3, fr = lane & 15, fq = lane >> 4;
    const int K = g.K, nt = K / BK;
    unsigned voffA[2], voffB[2];
#pragma unroll
    for (int i = 0; i < 2; ++i) { int R, C; stage_rc(tid * 16 + i * 8192, R, C); const int Rb = (R & ~31) + perm32(R & 31);
        voffA[i] = (unsigned)(R * K + C) * 2u; voffB[i] = (unsigned)(Rb * K + C) * 2u; }
    const size_t kstep = (size_t)(BK * 2);
    const size_t hstep = (size_t)HALF * K * 2;
    const unsigned ldsw = (unsigned)wid * 1024u;
    const int aoff = lds_byte(wr * 64 + fr, fq * 8), boff = lds_byte(wc * 32 + fr, fq * 8);
#define PG8_SA(b, h) (((b) * 2 + (h)) * HTB)
#define PG8_SB(b, h) ((4 + (b) * 2 + (h)) * HTB)
#define PG8_STAGE(bufoff, gbase, voff) do { _Pragma("unroll") for (int _i = 0; _i < 2; ++_i) \
        __builtin_amdgcn_global_load_lds((const unsigned*)((const char*)(gbase) + (voff)[_i]), (LAS unsigned*)(lds + (bufoff) + ldsw + _i * 8192), 16, 0, 0); } while (0)
#define PG8_LDA(dst, b, h) do { _Pragma("unroll") for (int m = 0; m < 4; ++m) _Pragma("unroll") for (int k = 0; k < 2; ++k) dst[m][k] = *(const LAS bf16x8*)(lds + PG8_SA(b, h) + aoff + m * 2048 + k * 1024); } while (0)
#define PG8_LDB(dst, b, h) do { _Pragma("unroll") for (int n = 0; n < 2; ++n) _Pragma("unroll") for (int k = 0; k < 2; ++k) dst[n][k] = *(const LAS bf16x8*)(lds + PG8_SB(b, h) + boff + n * 2048 + k * 1024); } while (0)
#define PG8_MMA(ai, bj, At, Bt) do { __builtin_amdgcn_s_setprio(1); _Pragma("unroll") for (int m = 0; m < 4; ++m) _Pragma("unroll") for (int n = 0; n < 2; ++n) _Pragma("unroll") for (int k = 0; k < 2; ++k) \
        acc[ai][bj][m][n] = __builtin_amdgcn_mfma_f32_16x16x32_bf16(Bt[n][k], At[m][k], acc[ai][bj][m][n], 0, 0, 0); __builtin_amdgcn_s_setprio(0); } while (0)
#define PG8_WAIT_V(n) asm volatile("s_waitcnt vmcnt(" #n ")" ::: "memory")
#define PG8_WAIT_L(n) asm volatile("s_waitcnt lgkmcnt(" #n ")" ::: "memory")
#define PG8_BAR __builtin_amdgcn_s_barrier()
#define PG8_SCHED __builtin_amdgcn_sched_barrier(0)
    Unit cur, nxt; int ui = 0;
    if (!S.next(0, cur)) return;
    f32x4 acc[2][2][4][2];
#pragma unroll
    for (int a = 0; a < 2; ++a)
#pragma unroll
        for (int b = 0; b < 2; ++b)
#pragma unroll
            for (int m = 0; m < 4; ++m)
#pragma unroll
                for (int n = 0; n < 2; ++n) acc[a][b][m][n] = (f32x4){0.f, 0.f, 0.f, 0.f};
    bf16x8 At[4][2], B0[2][2], B1[2][2];
    const char* cA = g.a(cur); const char* cB = g.b(cur);
    PG8_STAGE(PG8_SB(0, 0), cB, voffB); PG8_STAGE(PG8_SB(0, 1), cB + hstep, voffB); PG8_STAGE(PG8_SA(0, 0), cA, voffA); PG8_STAGE(PG8_SA(0, 1), cA + hstep, voffA);
    if (wr == 1) PG8_BAR;
    PG8_WAIT_V(2); PG8_BAR;
    PG8_STAGE(PG8_SB(1, 0), cB + kstep, voffB); PG8_STAGE(PG8_SA(1, 0), cA + kstep, voffA); PG8_STAGE(PG8_SB(1, 1), cB + hstep + kstep, voffB);
    PG8_WAIT_V(6); PG8_BAR;
    for (;;) {
        const bool has_next = S.next(ui + 1, nxt);
        const char* nA = has_next ? g.a(nxt) : cA; const char* nB = has_next ? g.b(nxt) : cB;
        for (int t = 0; t < nt; t += 2) {
            const bool last = (t == nt - 2);
            const char* a1 = cA + (size_t)(t + 1) * kstep;
            const char* a2 = last ? nA : cA + (size_t)(t + 2) * kstep; const char* b2 = last ? nB : cB + (size_t)(t + 2) * kstep;
            const char* a3 = a2 + kstep; const char* b3 = b2 + kstep;
            PG8_LDB(B0, 0, 0); PG8_LDB(B1, 0, 1); PG8_SCHED; PG8_LDA(At, 0, 0); PG8_STAGE(PG8_SA(1, 1), a1 + hstep, voffA);
            PG8_WAIT_V(8); PG8_WAIT_L(0); PG8_BAR; PG8_MMA(0, 0, At, B0); PG8_MMA(0, 1, At, B1); PG8_BAR; PG8_SCHED;
            PG8_LDA(At, 0, 1); PG8_STAGE(PG8_SB(0, 0), b2, voffB); PG8_STAGE(PG8_SB(0, 1), b2 + hstep, voffB); PG8_STAGE(PG8_SA(0, 0), a2, voffA);
            PG8_WAIT_V(8); PG8_WAIT_L(0); PG8_BAR; PG8_MMA(1, 0, At, B0); PG8_MMA(1, 1, At, B1); PG8_BAR; PG8_SCHED;
            PG8_LDB(B0, 1, 0); PG8_LDB(B1, 1, 1); PG8_SCHED; PG8_LDA(At, 1, 0); PG8_STAGE(PG8_SA(0, 1), a2 + hstep, voffA);
            PG8_WAIT_V(8); PG8_WAIT_L(0); PG8_BAR; PG8_MMA(0, 0, At, B0); PG8_MMA(0, 1, At, B1); PG8_BAR; PG8_SCHED;
            PG8_LDA(At, 1, 1); PG8_STAGE(PG8_SB(1, 0), b3, voffB); PG8_STAGE(PG8_SB(1, 1), b3 + hstep, voffB); PG8_STAGE(PG8_SA(1, 0), a3, voffA);
            PG8_WAIT_V(8); PG8_WAIT_L(0); PG8_BAR; PG8_MMA(1, 0, At, B0); PG8_MMA(1, 1, At, B1); PG8_BAR; PG8_SCHED;
        }
        if (wr == 0) PG8_BAR;
        const bool keep = E(acc, cur, wr, wc, fr, fq);
        if (!has_next) break;
        if (!keep) {
#pragma unroll
        for (int a = 0; a < 2; ++a)
#pragma unroll
            for (int b = 0; b < 2; ++b)
#pragma unroll
                for (int m = 0; m < 4; ++m)
#pragma unroll
                    for (int n = 0; n < 2; ++n) acc[a][b][m][n] = (f32x4){0.f, 0.f, 0.f, 0.f};
        }
        cur = nxt; cA = nA; cB = nB; ++ui;
        if (wr == 1) PG8_BAR;
    }
    PG8_WAIT_V(0);
    PG8_BAR;
#undef PG8_SA
#undef PG8_SB
#undef PG8_STAGE
#undef PG8_LDA
#undef PG8_LDB
#undef PG8_MMA
#undef PG8_WAIT_V
#undef PG8_WAIT_L
#undef PG8_BAR
#undef PG8_SCHED
}

template <class G, class Epi, class Sched>
__device__ __forceinline__ void gemm_phase_g(LAS unsigned char* lds, const G& g, const Sched& S, const Epi& E) {
    const int tid = threadIdx.x, wid = __builtin_amdgcn_readfirstlane(tid >> 6), lane = tid & 63, wr = wid >> 2, wc = wid & 3, fr = lane & 15, fq = lane >> 4;
    constexpr int nt = G::NT;
    unsigned voffB[2];
#pragma unroll
    for (int i = 0; i < 2; ++i) { int R, C; stage_rc(tid * 16 + i * 8192, R, C); const int Rb = (R & ~31) + perm32(R & 31); voffB[i] = (unsigned)(Rb * G::LDB + C) * 2u; }
#define PG8_RC int sR[2], sC[2]; stage_rc(tid * 16, sR[0], sC[0]); stage_rc(tid * 16 + 8192, sR[1], sC[1])
    const size_t kstep = (size_t)(BK * 2);
    const size_t hstepB = (size_t)HALF * G::LDB * 2;
    const unsigned ldsw = (unsigned)wid * 1024u;
    const int aoff = lds_byte(wr * 64 + fr, fq * 8), boff = lds_byte(wc * 32 + fr, fq * 8);
#define PG8_SA(b, h) (((b) * 2 + (h)) * HTB)
#define PG8_SB(b, h) ((4 + (b) * 2 + (h)) * HTB)
#define PG8_STAGE(bufoff, gbase, voff) do { _Pragma("unroll") for (int _i = 0; _i < 2; ++_i) \
        __builtin_amdgcn_global_load_lds((const unsigned*)((const char*)(gbase) + (voff)[_i]), (LAS unsigned*)(lds + (bufoff) + ldsw + _i * 8192), 16, 0, 0); } while (0)
#define PG8_LDA(dst, b, h) do { _Pragma("unroll") for (int m = 0; m < 4; ++m) _Pragma("unroll") for (int k = 0; k < 2; ++k) dst[m][k] = *(const LAS bf16x8*)(lds + PG8_SA(b, h) + aoff + m * 2048 + k * 1024); } while (0)
#define PG8_LDB(dst, b, h) do { _Pragma("unroll") for (int n = 0; n < 2; ++n) _Pragma("unroll") for (int k = 0; k < 2; ++k) dst[n][k] = *(const LAS bf16x8*)(lds + PG8_SB(b, h) + boff + n * 2048 + k * 1024); } while (0)
#define PG8_MMA(ai, bj, At, Bt) do { __builtin_amdgcn_s_setprio(1); _Pragma("unroll") for (int m = 0; m < 4; ++m) _Pragma("unroll") for (int n = 0; n < 2; ++n) _Pragma("unroll") for (int k = 0; k < 2; ++k) \
        acc[ai][bj][m][n] = __builtin_amdgcn_mfma_f32_16x16x32_bf16(Bt[n][k], At[m][k], acc[ai][bj][m][n], 0, 0, 0); __builtin_amdgcn_s_setprio(0); } while (0)
#define PG8_WAIT_V(n) asm volatile("s_waitcnt vmcnt(" #n ")" ::: "memory")
#define PG8_WAIT_L(n) asm volatile("s_waitcnt lgkmcnt(" #n ")" ::: "memory")
#define PG8_BAR __builtin_amdgcn_s_barrier()
#define PG8_SCHED __builtin_amdgcn_sched_barrier(0)
    Unit cur, nxt; int ui = 0;
    if (!S.next(0, cur)) return;
    unsigned vc[2][2], vn[2][2];
    bool has_next = S.next(1, nxt);
    {   PG8_RC; g.a_voff(cur, sR, sC, vc);
        if (has_next) g.a_voff(nxt, sR, sC, vn); }
    if (has_next) {} else { vn[0][0] = vc[0][0]; vn[0][1] = vc[0][1]; vn[1][0] = vc[1][0]; vn[1][1] = vc[1][1]; }
    f32x4 acc[2][2][4][2];
#pragma unroll
    for (int a = 0; a < 2; ++a)
#pragma unroll
        for (int b = 0; b < 2; ++b)
#pragma unroll
            for (int m = 0; m < 4; ++m)
#pragma unroll
                for (int n = 0; n < 2; ++n) acc[a][b][m][n] = (f32x4){0.f, 0.f, 0.f, 0.f};
    bf16x8 At[4][2], B0[2][2], B1[2][2];
    const char* cA = g.a_base(cur);
    const char *cb0, *cb1, *nb0, *nb1;
    g.bprep(cur, cb0, cb1);
    if (has_next) g.bprep(nxt, nb0, nb1); else { nb0 = cb0; nb1 = cb1; }
    {   const char* cB0 = G::bat(cb0, cb1, 0); const char* cB1 = G::bat(cb0, cb1, 1);
        PG8_STAGE(PG8_SB(0, 0), cB0, voffB); PG8_STAGE(PG8_SB(0, 1), cB0 + hstepB, voffB); PG8_STAGE(PG8_SA(0, 0), cA, vc[0]); PG8_STAGE(PG8_SA(0, 1), cA, vc[1]);
        if (wr == 1) PG8_BAR;
        PG8_WAIT_V(2); PG8_BAR;
        PG8_STAGE(PG8_SB(1, 0), cB1, voffB); PG8_STAGE(PG8_SA(1, 0), cA + kstep, vc[0]); PG8_STAGE(PG8_SB(1, 1), cB1 + hstepB, voffB);
        PG8_WAIT_V(6); PG8_BAR; }
    for (;;) {
        const char* nA = has_next ? g.a_base(nxt) : cA;
        for (int t = 0; t < nt; t += 2) {
            const bool last = (t == nt - 2);
            const char* a1 = cA + (size_t)(t + 1) * kstep;
            const char* a2 = last ? nA : cA + (size_t)(t + 2) * kstep; const char* a3 = a2 + kstep;
            const char* b2 = last ? G::bat(nb0, nb1, 0) : G::bat(cb0, cb1, t + 2); const char* b3 = last ? G::bat(nb0, nb1, 1) : G::bat(cb0, cb1, t + 3);
            PG8_LDB(B0, 0, 0); PG8_LDB(B1, 0, 1); PG8_SCHED; PG8_LDA(At, 0, 0); PG8_STAGE(PG8_SA(1, 1), a1, vc[1]);
            if (last) { vc[0][0] = vn[0][0]; vc[0][1] = vn[0][1]; vc[1][0] = vn[1][0]; vc[1][1] = vn[1][1]; }
            PG8_WAIT_V(8); PG8_WAIT_L(0); PG8_BAR; PG8_MMA(0, 0, At, B0); PG8_MMA(0, 1, At, B1); PG8_BAR; PG8_SCHED;
            PG8_LDA(At, 0, 1); PG8_STAGE(PG8_SB(0, 0), b2, voffB); PG8_STAGE(PG8_SB(0, 1), b2 + hstepB, voffB); PG8_STAGE(PG8_SA(0, 0), a2, vc[0]);
            PG8_WAIT_V(8); PG8_WAIT_L(0); PG8_BAR; PG8_MMA(1, 0, At, B0); PG8_MMA(1, 1, At, B1); PG8_BAR; PG8_SCHED;
            PG8_LDB(B0, 1, 0); PG8_LDB(B1, 1, 1); PG8_SCHED; PG8_LDA(At, 1, 0); PG8_STAGE(PG8_SA(0, 1), a2, vc[1]);
            PG8_WAIT_V(8); PG8_WAIT_L(0); PG8_BAR; PG8_MMA(0, 0, At, B0); PG8_MMA(0, 1, At, B1); PG8_BAR; PG8_SCHED;
            PG8_LDA(At, 1, 1); PG8_STAGE(PG8_SB(1, 0), b3, voffB); PG8_STAGE(PG8_SB(1, 1), b3 + hstepB, voffB); PG8_STAGE(PG8_SA(1, 0), a3, vc[0]);
            PG8_WAIT_V(8); PG8_WAIT_L(0); PG8_BAR; PG8_MMA(1, 0, At, B0); PG8_MMA(1, 1, At, B1); PG8_BAR; PG8_SCHED;
        }
        if (wr == 0) PG8_BAR;
        E(acc, cur, wr, wc, fr, fq);
        if (!has_next) break;
#pragma unroll
        for (int a = 0; a < 2; ++a)
#pragma unroll
            for (int b = 0; b < 2; ++b)
#pragma unroll
                for (int m = 0; m < 4; ++m)
#pragma unroll
                    for (int n = 0; n < 2; ++n) acc[a][b][m][n] = (f32x4){0.f, 0.f, 0.f, 0.f};
        cur = nxt; cA = nA; cb0 = nb0; cb1 = nb1; ++ui;
        has_next = S.next(ui + 1, nxt);
        if (has_next) { PG8_RC; g.a_voff(nxt, sR, sC, vn); g.bprep(nxt, nb0, nb1); }
        if (wr == 1) PG8_BAR;
    }
    PG8_WAIT_V(0);
    PG8_BAR;
#undef PG8_RC
#undef PG8_SA
#undef PG8_SB
#undef PG8_STAGE
#undef PG8_LDA
#undef PG8_LDB
#undef PG8_MMA
#undef PG8_WAIT_V
#undef PG8_WAIT_L
#undef PG8_BAR
#undef PG8_SCHED
}
}

struct EpiInProj {
    Ctx c;
    __device__ __forceinline__ bool operator()(pg8::f32x4 (&acc)[2][2][4][2], const pg8::Unit& u, int wr, int wc, int fr_, int fq_) const {
        int fr = fr_, fq = fq_; asm volatile("" : "+v"(fr), "+v"(fq));
        const ChunkDesc d = chunk_desc(c, u.pn * 4 + wc);
        if (d.ncols == 0) return false;
        const int row0 = u.pm * 256 + wr * 64 + fr;
        float gn[2][8];
        const float* gp = (d.mode == 1) ? d.gain : c.nsa_q_norm();
        pg8::f32x4 g4[4];
#pragma unroll
        for (int q = 0; q < 4; ++q) g4[q] = *(const pg8::f32x4*)(gp + 32 * (q >> 1) + 8 * fq + 4 * (q & 1));
#pragma unroll
        for (int q = 0; q < 4; ++q) asm volatile("" : "+v"(g4[q]));
#pragma unroll
        for (int bj = 0; bj < 2; ++bj)
#pragma unroll
            for (int i = 0; i < 8; ++i) gn[bj][i] = g4[2 * bj + (i >> 2)][i & 3] * d.qscale;
#pragma unroll
        for (int ai = 0; ai < 2; ++ai)
#pragma unroll
            for (int m = 0; m < 4; ++m) {
                const size_t row = (size_t)(row0 + ai * 128 + m * 16);
                float v[2][8];
#pragma unroll
                for (int bj = 0; bj < 2; ++bj)
#pragma unroll
                    for (int n = 0; n < 2; ++n)
#pragma unroll
                        for (int i = 0; i < 4; ++i) v[bj][4 * n + i] = acc[ai][bj][m][n][i];
                if (d.mode == 1) {
                    float ss = 0.f;
#pragma unroll
                    for (int bj = 0; bj < 2; ++bj)
#pragma unroll
                        for (int i = 0; i < 8; ++i) ss += v[bj][i] * v[bj][i];
                    ss += __shfl_xor(ss, 16); ss += __shfl_xor(ss, 32);
                    const float r = rsqrtf(ss * (1.f / 64.f) + RMS_EPS);
#pragma unroll
                    for (int bj = 0; bj < 2; ++bj)
#pragma unroll
                        for (int i = 0; i < 8; ++i) v[bj][i] = v[bj][i] * r * gn[bj][i];
                } else if (d.mode == 2) {
#pragma unroll
                    for (int bj = 0; bj < 2; ++bj)
#pragma unroll
                        for (int i = 0; i < 8; ++i) v[bj][i] = sigmoidf_(v[bj][i]);
                }
                if (d.dstf) {
                    if (fq < 3) { float4* p = (float4*)(d.dstf + row * 24 + 8 * fq); p[0] = make_float4(v[0][0], v[0][1], v[0][2], v[0][3]); p[1] = make_float4(v[0][4], v[0][5], v[0][6], v[0][7]); }
                } else {
#pragma unroll
                    for (int bj = 0; bj < 2; ++bj) { pg8::u32x4 w; w.x = pg8::cvt_pk_bf16(v[bj][0], v[bj][1]); w.y = pg8::cvt_pk_bf16(v[bj][2], v[bj][3]); w.z = pg8::cvt_pk_bf16(v[bj][4], v[bj][5]); w.w = pg8::cvt_pk_bf16(v[bj][6], v[bj][7]);
                        if (d.img == 0) *(pg8::u32x4*)(d.dst + row * d.pitch + d.dcol + 32 * bj + 8 * fq) = w;
                        else { const int bb = (int)(row >> 11), sq = (int)(row & 2047), key = sq & 63;
                            const size_t tb = (size_t)bb * d.bstride + (size_t)(sq >> 6) * d.tile_bytes;
                            const size_t off = (d.img == 1) ? tb + (size_t)(d.c0 + 4 * bj + fq) * 1024 + key * 16 : tb + (size_t)(d.c0 + bj) * 4096 + (key >> 4) * 1024 + (key & 15) * 64 + fq * 16;
                            *(pg8::u32x4*)((unsigned char*)d.dst + off) = w; } }
                }
            }
        return false;
    }
};
struct EpiMerge {
    bf16* Y; const bf16* GM;
    __device__ __forceinline__ bool operator()(pg8::f32x4 (&acc)[2][2][4][2], const pg8::Unit& u, int wr, int wc, int fr_, int fq_) const {
        int fr = fr_, fq = fq_; asm volatile("" : "+v"(fr), "+v"(fq));
        const int row0 = u.pm * 256 + wr * 64 + fr, col0 = u.pn * 256 + wc * 32 + 8 * fq;
#pragma unroll
        for (int ai = 0; ai < 2; ++ai)
#pragma unroll
            for (int m = 0; m < 4; ++m) {
                const size_t row = (size_t)(row0 + ai * 128 + m * 16);
#pragma unroll
                for (int bj = 0; bj < 2; ++bj) {
                    const int col = col0 + bj * 128;
                    const uint4 g1 = *(const uint4*)(GM + row * 2048 + 1024 + col);
                    float q1[8] = {LO16(g1.x), HI16(g1.x), LO16(g1.y), HI16(g1.y), LO16(g1.z), HI16(g1.z), LO16(g1.w), HI16(g1.w)};
                    if (u.z == 0) {
                        const uint4 g0 = *(const uint4*)(GM + row * 2048 + col);
                        const float q0[8] = {LO16(g0.x), HI16(g0.x), LO16(g0.y), HI16(g0.y), LO16(g0.z), HI16(g0.z), LO16(g0.w), HI16(g0.w)};
#pragma unroll
                        for (int n = 0; n < 2; ++n)
#pragma unroll
                            for (int i = 0; i < 4; ++i) acc[ai][bj][m][n][i] *= q0[4 * n + i] * __builtin_amdgcn_rcpf(fmaxf(q1[4 * n + i], 1e-30f));
                    } else {
                        float v[8];
#pragma unroll
                        for (int n = 0; n < 2; ++n)
#pragma unroll
                            for (int i = 0; i < 4; ++i) v[4 * n + i] = acc[ai][bj][m][n][i] * fmaxf(q1[4 * n + i], 1e-30f);
                        uint4 w; w.x = pg8::cvt_pk_bf16(v[0], v[1]); w.y = pg8::cvt_pk_bf16(v[2], v[3]); w.z = pg8::cvt_pk_bf16(v[4], v[5]); w.w = pg8::cvt_pk_bf16(v[6], v[7]);
                        *(uint4*)(Y + row * 1024 + col) = w;
                    }
                }
            }
        return u.z == 0;
    }
};
struct EpiResid {
    const float* X; bf16* O;
    __device__ __forceinline__ bool operator()(pg8::f32x4 (&acc)[2][2][4][2], const pg8::Unit& u, int wr, int wc, int fr_, int fq_) const {
        int fr = fr_, fq = fq_; asm volatile("" : "+v"(fr), "+v"(fq));
        const int row0 = u.pm * 256 + wr * 64 + fr, col0 = u.pn * 256 + wc * 32 + 8 * fq;
#pragma unroll
        for (int ai = 0; ai < 2; ++ai)
#pragma unroll
            for (int m = 0; m < 4; ++m) {
                const size_t row = (size_t)(row0 + ai * 128 + m * 16);
#pragma unroll
                for (int bj = 0; bj < 2; ++bj) { const size_t off = row * 1024 + col0 + bj * 128;
                    const float4 x0 = *(const float4*)(X + off), x1 = *(const float4*)(X + off + 4); const pg8::f32x4 a0 = acc[ai][bj][m][0], a1 = acc[ai][bj][m][1];
                    uint4 w; w.x = pk2bf(x0.x + a0[0], x0.y + a0[1]); w.y = pk2bf(x0.z + a0[2], x0.w + a0[3]); w.z = pk2bf(x1.x + a1[0], x1.y + a1[1]); w.w = pk2bf(x1.z + a1[2], x1.w + a1[3]);
                    *(uint4*)(O + off) = w; }
            }
        return false;
    }
};

struct EpiF32 {
    float* O; int ldc;
    __device__ __forceinline__ bool operator()(pg8::f32x4 (&acc)[2][2][4][2], const pg8::Unit& u, int wr, int wc, int fr_, int fq_) const {
        int fr = fr_, fq = fq_; asm volatile("" : "+v"(fr), "+v"(fq));
        const int row0 = u.pm * 256 + wr * 64 + fr, col0 = u.pn * 256 + wc * 32 + 8 * fq;
#pragma unroll
        for (int ai = 0; ai < 2; ++ai)
#pragma unroll
            for (int m = 0; m < 4; ++m)
#pragma unroll
                for (int bj = 0; bj < 2; ++bj)
#pragma unroll
                    for (int n = 0; n < 2; ++n) { const pg8::f32x4 a = acc[ai][bj][m][n];
                        *(float4*)(O + (size_t)(row0 + ai * 128 + m * 16) * ldc + col0 + bj * 128 + 4 * n) = make_float4(a[0], a[1], a[2], a[3]); }
        return false;
    }
};
struct SchedCmp { int c;
    __device__ __forceinline__ bool next(int i, pg8::Unit& u) const { if (i > 0 || c >= 32) return false; u.pm = c >> 1; u.pn = c & 1; u.z = c >> 4; return true; } };

__device__ __forceinline__ float4 posb_sum(const float* p) { float4 a = *(const float4*)p;
#pragma unroll
    for (int sl = 1; sl < 8; ++sl) { const float4 b = *(const float4*)(p + sl * 512); a.x += b.x; a.y += b.y; a.z += b.z; a.w += b.w; }
    return a; }

__device__ __forceinline__ void tr_item(const float* src, int ldn, int k0, int n0, int nvalid, bf16* dst, int ldk, int r0, LAS float* scr, int lane, const float* kgain = nullptr) {
    const int nn = lane & 31;
    float tv[32];
#pragma unroll
    for (int i = 0; i < 32; ++i) { const int kk = 2 * i + (lane >> 5); tv[i] = (nn < nvalid) ? __builtin_nontemporal_load(src + (size_t)(k0 + kk) * ldn + n0 + nn) : 0.f; }
#pragma unroll
    for (int i = 0; i < 32; ++i) { const int kk = 2 * i + (lane >> 5); scr[kk * 33 + nn] = kgain ? tv[i] * kgain[k0 + kk] : tv[i]; }
    asm volatile("s_waitcnt lgkmcnt(0)" ::: "memory");
    const int cch = lane & 7;
#pragma unroll
    for (int j = 0; j < 4; ++j) { const int n = (lane >> 3) + 8 * j; const LAS float* sp = scr + (8 * cch) * 33 + n;
        uint4 o; o.x = pg8::cvt_pk_bf16(sp[0 * 33], sp[1 * 33]); o.y = pg8::cvt_pk_bf16(sp[2 * 33], sp[3 * 33]); o.z = pg8::cvt_pk_bf16(sp[4 * 33], sp[5 * 33]); o.w = pg8::cvt_pk_bf16(sp[6 * 33], sp[7 * 33]);
        *(uint4*)(dst + (size_t)(r0 + n) * ldk + k0 + 8 * cch) = o; }
    asm volatile("s_waitcnt lgkmcnt(0)" ::: "memory");
}


namespace att {
typedef short bf16x8 __attribute__((ext_vector_type(8)));
typedef short s16x4 __attribute__((ext_vector_type(4)));
typedef short v4i16_t __attribute__((ext_vector_type(4)));
typedef float f32x16 __attribute__((ext_vector_type(16)));
typedef unsigned u32x4 __attribute__((ext_vector_type(4)));
typedef float f32x4v __attribute__((ext_vector_type(4)));
constexpr float C2 = 0.125f * 1.4426950408889634f;
constexpr float LOG2E = 1.4426950408889634f;
constexpr float NEGB = -1e30f, MFLOOR = -1e4f;
__device__ __forceinline__ int crow(int r, int hi) { return (r & 3) + 8 * (r >> 2) + 4 * hi; }
__device__ __forceinline__ s16x4 vtr(const LAS char* p) { return __builtin_bit_cast(s16x4, __builtin_amdgcn_ds_read_tr16_b64_v4i16((LAS v4i16_t*)p)); }
typedef float f32x2_t __attribute__((ext_vector_type(2))); typedef __bf16 bf16x2_t __attribute__((ext_vector_type(2)));
__device__ __forceinline__ unsigned cvtpk(float lo, float hi) { const f32x2_t v = {lo, hi}; const bf16x2_t b = __builtin_convertvector(v, bf16x2_t); return __builtin_bit_cast(unsigned, b); }
#define ATT_WAIT_BAR() asm volatile("s_waitcnt vmcnt(0) lgkmcnt(0)\n\ts_barrier" ::: "memory")

template <int NKB> __device__ __forceinline__ void stage_img(LAS unsigned char* dst, const unsigned char* src, int wid, int lane) {
#pragma unroll
    for (int c = 0; c < (NKB + 7) / 8; ++c) { const int pc = wid + 8 * c;
        if (NKB % 8 == 0 || pc < NKB) __builtin_amdgcn_global_load_lds((const unsigned*)(src + pc * 1024 + lane * 16), (LAS unsigned*)(dst + pc * 1024), 16, 0, 0); }
}
__device__ __forceinline__ void qk_tile(f32x16& p0, f32x16& p1, const LAS unsigned char* kt, int ch0, const bf16x8 (&qf)[4], int r32, int hi) {
    const LAS unsigned char* kb = kt + (ch0 + hi) * 1024 + r32 * 16;
    p0 = (f32x16){0.f, 0.f, 0.f, 0.f, 0.f, 0.f, 0.f, 0.f, 0.f, 0.f, 0.f, 0.f, 0.f, 0.f, 0.f, 0.f}; p1 = p0;
#pragma unroll
    for (int d0 = 0; d0 < 4; ++d0) {
        const bf16x8 a0 = *(const LAS bf16x8*)(kb + d0 * 2048), a1 = *(const LAS bf16x8*)(kb + d0 * 2048 + 512);
        p0 = __builtin_amdgcn_mfma_f32_32x32x16_bf16(a0, qf[d0], p0, 0, 0, 0);
        p1 = __builtin_amdgcn_mfma_f32_32x32x16_bf16(a1, qf[d0], p1, 0, 0, 0);
    }
}
template <int EB> __device__ __forceinline__ void pv_tile(f32x16 (&o)[EB], const LAS unsigned char* vt, const f32x16& p0, const f32x16& p1, int lane) {
    const int hi = lane >> 5;
    const LAS char* vb = (const LAS char*)vt + ((lane >> 4) & 1) * 32 + (lane & 3) * 8 + (4 * hi + ((lane & 15) >> 2)) * 64;
#pragma unroll
    for (int ks = 0; ks < 4; ++ks) {
        s16x4 lo[EB], hh[EB];
#pragma unroll
        for (int eb = 0; eb < EB; ++eb) { lo[eb] = vtr(vb + eb * 4096 + ks * 1024); hh[eb] = vtr(vb + eb * 4096 + ks * 1024 + 512); }
        const f32x16& p = (ks < 2) ? p0 : p1; const int rb = (ks & 1) * 8;
        const u32x4 w = (u32x4){cvtpk(p[rb + 0], p[rb + 1]), cvtpk(p[rb + 2], p[rb + 3]), cvtpk(p[rb + 4], p[rb + 5]), cvtpk(p[rb + 6], p[rb + 7])};
        const bf16x8 pa = __builtin_bit_cast(bf16x8, w);
#pragma unroll
        for (int eb = 0; eb < EB; ++eb) {
            const bf16x8 vf = (bf16x8){lo[eb][0], lo[eb][1], lo[eb][2], lo[eb][3], hh[eb][0], hh[eb][1], hh[eb][2], hh[eb][3]};
            o[eb] = __builtin_amdgcn_mfma_f32_32x32x16_bf16(pa, vf, o[eb], 0, 0, 0);
        }
    }
}
template <bool BIAS, bool CAUSAL, bool BAND> __device__ __forceinline__ void bias_mask(f32x16& p0, f32x16& p1, const LAS float* bl, int qabs, int kt0, int hi) {
#pragma unroll
    for (int r = 0; r < 16; ++r) {
        const int d0 = qabs - (kt0 + crow(r, hi)), d1 = d0 - 32;
        if (BIAS) { p0[r] += bl[d0 < 0 ? 0 : (d0 > 255 ? 255 : d0)]; p1[r] += bl[d1 < 0 ? 0 : (d1 > 255 ? 255 : d1)]; }
        if (CAUSAL) { if (d0 < 0) p0[r] = NEGB; if (d1 < 0) p1[r] = NEGB; }
        if (BAND) { if (d0 >= 512) p0[r] = NEGB; if (d1 >= 512) p1[r] = NEGB; }
    }
}
__device__ __forceinline__ void bias_vec(f32x16& p0, f32x16& p1, const LAS float* rt, int e0, int hi) {
    const int a = (-e0) & 3;
    const LAS float* bp = rt + a * 320 + (208 - e0 - a) + 4 * hi;
#pragma unroll
    for (int g4 = 0; g4 < 4; ++g4) { const f32x4v v0 = *(const LAS f32x4v*)(bp + 8 * g4), v1 = *(const LAS f32x4v*)(bp + 8 * g4 + 32);
        p0[4 * g4] += v0[0]; p0[4 * g4 + 1] += v0[1]; p0[4 * g4 + 2] += v0[2]; p0[4 * g4 + 3] += v0[3];
        p1[4 * g4] += v1[0]; p1[4 * g4 + 1] += v1[1]; p1[4 * g4 + 2] += v1[2]; p1[4 * g4 + 3] += v1[3]; }
}
constexpr float THR = 8.f;
__device__ __forceinline__ float max3f(float a, float b, float c) { return fmaxf(fmaxf(a, b), c); }
template <int EB> __device__ __forceinline__ void softmax_step(f32x16& p0, f32x16& p1, float& m, float& l, f32x16 (&o)[EB], LAS float* wsf, int r32, int hi) {
    if (__any(m != 0.f)) {
#pragma unroll
        for (int r = 0; r < 16; ++r) { p0[r] -= m; p1[r] -= m; }
    }
    float ra = max3f(p0[0], p0[1], p1[0]), rb2 = max3f(p0[2], p0[3], p1[1]); ra = max3f(ra, p1[2], p1[3]);
#pragma unroll
    for (int r = 4; r < 16; r += 4) { ra = max3f(ra, p0[r], p0[r + 1]); rb2 = max3f(rb2, p0[r + 2], p0[r + 3]); ra = max3f(ra, p1[r], p1[r + 1]); rb2 = max3f(rb2, p1[r + 2], p1[r + 3]); }
    float rm = fmaxf(ra, rb2);
    if (__any(rm > THR)) {
        rm = fmaxf(rm, __shfl_xor(rm, 32));
        const float dl = rm > THR ? rm : 0.f;
        const float al = __builtin_amdgcn_exp2f(-dl);
        m += dl; l *= al;
#pragma unroll
        for (int r = 0; r < 16; ++r) { p0[r] -= dl; p1[r] -= dl; }
        if (hi == 0) wsf[r32] = al;
#pragma unroll
        for (int g = 0; g < 4; ++g) { const f32x4v a4 = *(const LAS f32x4v*)(wsf + 8 * g + 4 * hi);
#pragma unroll
            for (int eb = 0; eb < EB; ++eb) { o[eb][4 * g + 0] *= a4.x; o[eb][4 * g + 1] *= a4.y; o[eb][4 * g + 2] *= a4.z; o[eb][4 * g + 3] *= a4.w; } }
    }
    float s0 = 0.f, s1 = 0.f;
#pragma unroll
    for (int r = 0; r < 16; ++r) { p0[r] = __builtin_amdgcn_exp2f(p0[r]); p1[r] = __builtin_amdgcn_exp2f(p1[r]); s0 += p0[r]; s1 += p1[r]; }
    l += s0 + s1;
}
template <int EB> __device__ __forceinline__ void scale_rows(f32x16 (&o)[EB], float f, LAS float* wsf, int r32, int hi) {
    if (hi == 0) wsf[r32] = f;
#pragma unroll
    for (int g = 0; g < 4; ++g) { const f32x4v a4 = *(const LAS f32x4v*)(wsf + 8 * g + 4 * hi);
#pragma unroll
        for (int eb = 0; eb < EB; ++eb) { o[eb][4 * g + 0] *= a4.x; o[eb][4 * g + 1] *= a4.y; o[eb][4 * g + 2] *= a4.z; o[eb][4 * g + 3] *= a4.w; } }
}

struct DiffArgs { const bf16 *Q, *K, *V; bf16* O; const float* biasv; const float* out_gain; float lam; };
__device__ __forceinline__ void diff_unit(LAS unsigned char* lds, const DiffArgs& A, int b, int h, int qt) {
    int tid_ = threadIdx.x; asm volatile("" : "+v"(tid_));
    const int tid = tid_, lane = tid & 63, r32 = lane & 31, hi = lane >> 5, wid = __builtin_amdgcn_readfirstlane(tid >> 6);
    const int cs = wid >> 2, wq = wid & 3, q0 = qt * 128, qw0 = q0 + wq * 32, qabs = qw0 + r32;
    LAS float* bl = (LAS float*)(lds + 81920);
    LAS float* wsf = (LAS float*)(lds + 83968) + wid * 64;
    const size_t rowb = (size_t)b * S;
    LAS float* rt = (LAS float*)(lds + 86016);
    for (int i = tid; i < 1280; i += 512) rt[i] = A.biasv[(8 + h) * 1280 + i];
    const unsigned char* Kh = (const unsigned char*)A.K + (size_t)(b * 4 + h) * 32 * 16384; const unsigned char* Vh = (const unsigned char*)A.V + (size_t)(b * 4 + h) * 32 * 16384;
    const int NT = (q0 + 128) / 64;
    stage_img<16>(lds, Kh, wid, lane); stage_img<16>(lds + 49152, Vh, wid, lane);
    stage_img<16>(lds + 16384, Kh + 16384, wid, lane);
    bf16x8 qf[4];
    { const bf16* qp = A.Q + (rowb + qabs) * 512 + h * 128 + cs * 64 + hi * 8;
#pragma unroll
      for (int d0 = 0; d0 < 4; ++d0) qf[d0] = *(const bf16x8*)(qp + d0 * 16); }
    f32x16 o[4];
#pragma unroll
    for (int eb = 0; eb < 4; ++eb) o[eb] = (f32x16){0.f, 0.f, 0.f, 0.f, 0.f, 0.f, 0.f, 0.f, 0.f, 0.f, 0.f, 0.f, 0.f, 0.f, 0.f, 0.f};
    float m = 0.f, l = 0.f;
    ATT_WAIT_BAR();
    if (wid >= 4) __builtin_amdgcn_s_setprio(1);
    f32x16 n0, n1;
    qk_tile(n0, n1, lds, cs * 8, qf, r32, hi);
    int kb_cur = 0, kb_nxt = 16384, kb_fre = 32768;
    for (int t = 0; t < NT; ++t) {
        if (t + 2 < NT) stage_img<16>(lds + kb_fre, Kh + (size_t)(t + 2) * 16384, wid, lane);
        if (t + 1 < NT) stage_img<16>(lds + 49152 + ((t + 1) & 1) * 16384, Vh + (size_t)(t + 1) * 16384, wid, lane);
        const int kt0 = t * 64;
        if (kt0 <= qw0 + 31) {
            f32x16 p0 = n0, p1 = n1;
            if (t + 1 < NT && kt0 + 64 <= qw0 + 31) qk_tile(n0, n1, lds + kb_nxt, cs * 8, qf, r32, hi);
            const bool causal = (kt0 + 63 > qw0), near_ = (qw0 - (kt0 + 63) < 113);
            if (causal || near_) bias_vec(p0, p1, rt, qabs - kt0, hi);
            softmax_step<4>(p0, p1, m, l, o, wsf, r32, hi);
            pv_tile<4>(o, lds + 49152 + (t & 1) * 16384, p0, p1, lane);
        }
        ATT_WAIT_BAR();
        { const int tmp = kb_cur; kb_cur = kb_nxt; kb_nxt = kb_fre; kb_fre = tmp; }
    }
    __builtin_amdgcn_s_setprio(0);
    l += __shfl_xor(l, 32);
    scale_rows<4>(o, (cs ? A.lam : 1.f) / l, wsf, r32, hi);
    LAS float* xch = (LAS float*)lds + (size_t)wq * 4096;
    if (cs == 1) {
#pragma unroll
        for (int eb = 0; eb < 4; ++eb)
#pragma unroll
            for (int r = 0; r < 16; ++r) xch[crow(r, hi) * 128 + eb * 32 + r32] = o[eb][r];
    }
    ATT_WAIT_BAR();
    if (cs == 0) {
        float ss[16];
#pragma unroll
        for (int r = 0; r < 16; ++r) ss[r] = 0.f;
#pragma unroll
        for (int eb = 0; eb < 4; ++eb)
#pragma unroll
            for (int r = 0; r < 16; ++r) { o[eb][r] -= xch[crow(r, hi) * 128 + eb * 32 + r32]; ss[r] += o[eb][r] * o[eb][r]; }
#pragma unroll
        for (int r = 0; r < 16; ++r) {
#pragma unroll
            for (int sft = 1; sft < 32; sft <<= 1) ss[r] += __shfl_xor(ss[r], sft);
            ss[r] = rsqrtf(ss[r] * (1.f / 128.f) + RMS_EPS) * (1.f - LAMBDA_INIT);
        }
        int hi_ = hi, r32_ = r32; asm volatile("" : "+v"(hi_), "+v"(r32_));
        bf16* op = A.O + (rowb + qw0 + 4 * hi_) * 512 + h * 128 + r32_;
#pragma unroll
        for (int eb = 0; eb < 4; ++eb) { const float gn = A.out_gain[eb * 32 + r32_];
#pragma unroll
            for (int r = 0; r < 16; ++r) op[(size_t)((r & 3) + 8 * (r >> 2)) * 512 + eb * 32] = f2bf(o[eb][r] * ss[r] * gn); }
    }
    ATT_WAIT_BAR();
}

struct NsaArgs { const bf16 *Q, *KS, *VS, *KW, *VW, *KC, *VC; const float* GN; bf16* O; const float* rel_bias; const float* biasv; };
__device__ __forceinline__ void imp_tile(const f32x16& p, int gbase, LAS float* ip, float inv, int hi, float& prevR) {
    float Av[4], Rv[4];
#pragma unroll
    for (int gq = 0; gq < 4; ++gq) { const float c3 = 0.5f * p[4 * gq + 3]; Av[gq] = p[4 * gq] + p[4 * gq + 1] + p[4 * gq + 2] + c3; Rv[gq] = __shfl_xor(c3, 32); }
#pragma unroll
    for (int gq = 0; gq < 4; ++gq) { const float add = hi ? Rv[gq] : (gq > 0 ? Rv[gq > 0 ? gq - 1 : 0] : prevR); ip[2 * (gbase + gq)] = (Av[gq] + add) * inv; }
    prevR = Rv[3];
}

__device__ __forceinline__ int cmp_class(int qw0, int n0) { return (16 * n0 > qw0) ? 2 : ((qw0 - 16 * (n0 + 31) - 31 >= 113) ? 0 : 1); }
__device__ __forceinline__ void cmp_bm1(f32x16& p, const LAS float* bl, int qabs, int n0, int hi) {
#pragma unroll
    for (int r = 0; r < 16; ++r) { const int d = qabs - 16 * (n0 + crow(r, hi)) - 31; p[r] += bl[d < 0 ? 0 : (d > 255 ? 255 : d)]; if (d < 0) p[r] = NEGB; }
}
__device__ __forceinline__ void cmp_pass(LAS unsigned char* lds, const bf16x8 (&qf)[4], const LAS float* bl, LAS float* ip, bool need_sel, float mref, int qw0, int qabs,
                                         int lane, int r32, int hi, f32x16 (&o)[2], float& l, float& rmax) {
    l = 0.f; rmax = NEGB; float prevR = 0.f;
    o[0] = (f32x16){0.f, 0.f, 0.f, 0.f, 0.f, 0.f, 0.f, 0.f, 0.f, 0.f, 0.f, 0.f, 0.f, 0.f, 0.f, 0.f}; o[1] = o[0];
#pragma unroll
    for (int tl = 0; tl < 2; ++tl) {
        const int c0 = cmp_class(qw0, 64 * tl), c1 = cmp_class(qw0, 64 * tl + 32);
        if (c0 == 2) {
            if (need_sel) {
#pragma unroll
                for (int gq = 0; gq < 8; ++gq) ip[2 * (8 * tl + gq)] = (gq == 0 && hi == 0) ? prevR : 0.f; }
            prevR = 0.f;
        } else {
            f32x16 p0, p1;
            qk_tile(p0, p1, lds + tl * 16384, 0, qf, r32, hi);
            if (c0 == 1) cmp_bm1(p0, bl, qabs, 64 * tl, hi);
            if (c1 == 1) cmp_bm1(p1, bl, qabs, 64 * tl + 32, hi);
            else if (c1 == 2) { p1 = (f32x16){NEGB, NEGB, NEGB, NEGB, NEGB, NEGB, NEGB, NEGB, NEGB, NEGB, NEGB, NEGB, NEGB, NEGB, NEGB, NEGB}; }
            float ra = max3f(p0[0], p0[1], p1[0]), rb2 = max3f(p0[2], p0[3], p1[1]); ra = max3f(ra, p1[2], p1[3]);
#pragma unroll
            for (int r = 4; r < 16; r += 4) { ra = max3f(ra, p0[r], p0[r + 1]); rb2 = max3f(rb2, p0[r + 2], p0[r + 3]); ra = max3f(ra, p1[r], p1[r + 1]); rb2 = max3f(rb2, p1[r + 2], p1[r + 3]); }
            rmax = max3f(rmax, ra, rb2);
            float s0 = 0.f, s1 = 0.f;
#pragma unroll
            for (int r = 0; r < 16; ++r) { p0[r] = __builtin_amdgcn_exp2f(p0[r] - mref); p1[r] = __builtin_amdgcn_exp2f(p1[r] - mref); s0 += p0[r]; s1 += p1[r]; }
            l += s0 + s1;
            if (need_sel) { imp_tile(p0, 8 * tl, ip, 1.f, hi, prevR); imp_tile(p1, 8 * tl + 4, ip, 1.f, hi, prevR); }
            pv_tile<2>(o, lds + tl * 16384 + 8192, p0, p1, lane);
        }
    }
}
__device__ __forceinline__ void nsa_unit(LAS unsigned char* lds, const NsaArgs& A, int b, int g, int qt) {
    int tid_ = threadIdx.x; asm volatile("" : "+v"(tid_));
    const int tid = tid_, wid = __builtin_amdgcn_readfirstlane(tid >> 6);
    int lane = tid & 63, r32 = lane & 31, hi = lane >> 5;
#define NSA_RELANE() do { asm volatile("" : "+v"(lane)); r32 = lane & 31; hi = lane >> 5; qabs = qw0 + r32; } while (0)
    const int hh = wid >> 1, head = g * 4 + hh, q0 = qt * 64, qw0 = q0 + (wid & 1) * 32; int qabs = qw0 + r32;
    LAS float* bl = (LAS float*)(lds + 32768) + hh * 256;
    LAS float* wsf = (LAS float*)(lds + 36864) + wid * 64;
    LAS float* ipart = (LAS float*)(lds + 40960);
    LAS float* itot = (LAS float*)(lds + 73728);
    LAS unsigned* sell = (LAS unsigned*)(lds + 81920);
    LAS float* invs = (LAS float*)(lds + 82176);
    LAS f32x16* otl = (LAS f32x16*)(lds + 86016) + (size_t)wid * 128 + lane;
    const size_t rowb = (size_t)b * S;
    for (int i = tid; i < 1024; i += 512) ((LAS float*)(lds + 32768))[i] = A.rel_bias[g * 1024 + i];
    { const unsigned char* Kc = (const unsigned char*)A.KC + (size_t)(b * 2 + g) * 16384; const unsigned char* Vc = (const unsigned char*)A.VC + (size_t)(b * 2 + g) * 16384;
      stage_img<8>(lds, Kc, wid, lane); stage_img<8>(lds + 8192, Vc, wid, lane);
      stage_img<8>(lds + 16384, Kc + 8192, wid, lane); stage_img<8>(lds + 24576, Vc + 8192, wid, lane); }
    bf16x8 qf[4];
    { const bf16* qp = A.Q + (rowb + qabs) * 512 + head * 64 + hi * 8;
#pragma unroll
      for (int d0 = 0; d0 < 4; ++d0) qf[d0] = *(const bf16x8*)(qp + d0 * 16); }
    ATT_WAIT_BAR();
    const bool need_sel = (qt >= 16);
    {
        NSA_RELANE();
        LAS float* ip = ipart + ((size_t)hh * 64 + (wid & 1) * 32 + r32) * 32 + hi;
        f32x16 o[2]; float l, rmax;
        cmp_pass(lds, qf, bl, ip, need_sel, 0.f, qw0, qabs, lane, r32, hi, o, l, rmax);
        if (__any(rmax > 64.f)) {
            rmax = fmaxf(rmax, __shfl_xor(rmax, 32));
            float dummy;
            cmp_pass(lds, qf, bl, ip, need_sel, fmaxf(rmax, 0.f), qw0, qabs, lane, r32, hi, o, l, dummy);
        }
        l += __shfl_xor(l, 32);
        const float inv = l > 0.f ? 1.f / l : 0.f;
        if (hi == 0) invs[hh * 64 + (wid & 1) * 32 + r32] = inv;
        { int qa = qabs; asm volatile("" : "+v"(qa)); scale_rows<2>(o, A.GN[(rowb + qa) * 24 + head] * inv, wsf, r32, hi); }
        otl[0] = o[0]; otl[64] = o[1];
    }
    ATT_WAIT_BAR();
    unsigned selq, un;
    if (need_sel) {
        {
            const int q = tid >> 3, j4 = (tid & 7) * 4;
#pragma unroll
            for (int jj = 0; jj < 4; ++jj) { const int j = j4 + jj; itot[q * 32 + j] = ((ipart[(0 * 64 + q) * 32 + j] * invs[q] + ipart[(1 * 64 + q) * 32 + j] * invs[64 + q]) + ipart[(2 * 64 + q) * 32 + j] * invs[128 + q]) + ipart[(3 * 64 + q) * 32 + j] * invs[192 + q]; }
        }
        ATT_WAIT_BAR();
        {
            const int j = lane & 31;
#pragma unroll 1
            for (int rd = 0; rd < 4; ++rd) {
                const int q = wid * 8 + rd * 2 + hi;
                const bool vj = j <= qt, fj = (j == 0) || (j == qt) || (j == qt - 1);
                const float sj = vj ? itot[q * 32 + j] + (fj ? 1e4f : 0.f) : -1e30f;
                int cnt = 0;
#pragma unroll 4
                for (int k = 0; k < 32; ++k) {
                    const bool vk = k <= qt, fk = (k == 0) || (k == qt) || (k == qt - 1);
                    const float sk = vk ? itot[q * 32 + k] + (fk ? 1e4f : 0.f) : -1e30f;
                    cnt += (sk > sj || (sk == sj && k < j)) ? 1 : 0;
                }
                const unsigned long long bal = __ballot(cnt < 16);
                if (lane == 0) sell[q] = (unsigned)bal;
                if (lane == 32) sell[q] = (unsigned)(bal >> 32);
            }
        }
        ATT_WAIT_BAR();
        NSA_RELANE();
        selq = sell[(wid & 1) * 32 + r32];
        un = sell[lane];
#pragma unroll
        for (int sft = 1; sft < 64; sft <<= 1) un |= __shfl_xor(un, sft);
        un = __builtin_amdgcn_readfirstlane(un) & (qt >= 31 ? 0xffffffffu : ((2u << qt) - 1u));
    } else {
        selq = (2u << qt) - 1u; un = selq;
    }
    for (int i = tid; i < 5120; i += 512) ipart[i] = A.biasv[(size_t)g * 5120 + i];
    const LAS float* rt = ipart + hh * 1280;
    {
        NSA_RELANE();
        const unsigned char* Kg = (const unsigned char*)A.KS + (size_t)(b * 2 + g) * 32 * 8192; const unsigned char* Vg = (const unsigned char*)A.VS + (size_t)(b * 2 + g) * 32 * 8192;
        f32x16 o[2]; o[0] = (f32x16){0.f, 0.f, 0.f, 0.f, 0.f, 0.f, 0.f, 0.f, 0.f, 0.f, 0.f, 0.f, 0.f, 0.f, 0.f, 0.f}; o[1] = o[0];
        float m = 0.f, l = 0.f;
        unsigned rem = un; int j = __builtin_ctz(rem); rem &= rem - 1u; int it = 0;
        stage_img<8>(lds, Kg + (size_t)j * 8192, wid, lane); stage_img<8>(lds + 8192, Vg + (size_t)j * 8192, wid, lane);
        ATT_WAIT_BAR();
        for (;;) {
            LAS unsigned char* cur = lds + (it & 1) * 16384; LAS unsigned char* nxt = lds + ((it + 1) & 1) * 16384;
            const int jn = rem ? __builtin_ctz(rem) : -1;
            if (jn >= 0) { rem &= rem - 1u; stage_img<8>(nxt, Kg + (size_t)jn * 8192, wid, lane); stage_img<8>(nxt + 8192, Vg + (size_t)jn * 8192, wid, lane); }
            const int kt0 = j * 64;
            if (kt0 <= qw0 + 31 && __any((selq >> j) & 1u)) {
                f32x16 p0, p1;
                qk_tile(p0, p1, cur, 0, qf, r32, hi);
                const bool causal = (kt0 + 63 > qw0), near_ = (qw0 - (kt0 + 63) < 113);
                if (causal || near_) bias_vec(p0, p1, rt, qabs - kt0, hi);
                if (!__all((selq >> j) & 1u)) {
                    const float off = ((selq >> j) & 1u) ? 0.f : NEGB;
#pragma unroll
                    for (int r = 0; r < 16; ++r) { p0[r] += off; p1[r] += off; } }
                softmax_step<2>(p0, p1, m, l, o, wsf, r32, hi);
                pv_tile<2>(o, cur + 8192, p0, p1, lane);
            }
            ATT_WAIT_BAR();
            if (jn < 0) break;
            j = jn; ++it;
        }
        l += __shfl_xor(l, 32);
        { int qa = qabs; asm volatile("" : "+v"(qa)); scale_rows<2>(o, A.GN[(rowb + qa) * 24 + 8 + head] / l, wsf, r32, hi); }
        otl[0] = otl[0] + o[0]; otl[64] = otl[64] + o[1];
    }
    f32x16 ot[2];
    {
        NSA_RELANE();
        const unsigned char* Kg = (const unsigned char*)A.KW + (size_t)(b * 2 + g) * 32 * 8192; const unsigned char* Vg = (const unsigned char*)A.VW + (size_t)(b * 2 + g) * 32 * 8192;
        f32x16 o[2]; o[0] = (f32x16){0.f, 0.f, 0.f, 0.f, 0.f, 0.f, 0.f, 0.f, 0.f, 0.f, 0.f, 0.f, 0.f, 0.f, 0.f, 0.f}; o[1] = o[0];
        float m = 0.f, l = 0.f;
        const int j0 = qt >= 8 ? qt - 8 : 0;
        stage_img<8>(lds, Kg + (size_t)j0 * 8192, wid, lane); stage_img<8>(lds + 8192, Vg + (size_t)j0 * 8192, wid, lane);
        ATT_WAIT_BAR();
        for (int j = j0; j <= qt; ++j) {
            const int it = j - j0;
            LAS unsigned char* cur = lds + (it & 1) * 16384; LAS unsigned char* nxt = lds + ((it + 1) & 1) * 16384;
            if (j < qt) { stage_img<8>(nxt, Kg + (size_t)(j + 1) * 8192, wid, lane); stage_img<8>(nxt + 8192, Vg + (size_t)(j + 1) * 8192, wid, lane); }
            const int kt0 = j * 64;
            if (kt0 <= qw0 + 31) {
                f32x16 p0, p1;
                qk_tile(p0, p1, cur, 0, qf, r32, hi);
                const bool causal = (kt0 + 63 > qw0), near_ = (qw0 - (kt0 + 63) < 113), band = (qw0 + 31 - kt0 >= 512);
                if (causal || near_) bias_vec(p0, p1, rt, qabs - kt0, hi);
                else if (band) bias_mask<false, false, true>(p0, p1, bl, qabs, kt0, hi);
                softmax_step<2>(p0, p1, m, l, o, wsf, r32, hi);
                pv_tile<2>(o, cur + 8192, p0, p1, lane);
            }
            ATT_WAIT_BAR();
        }
        l += __shfl_xor(l, 32);
        { int qa = qabs; asm volatile("" : "+v"(qa)); scale_rows<2>(o, A.GN[(rowb + qa) * 24 + 16 + head] / l, wsf, r32, hi); }
        ot[0] = otl[0] + o[0]; ot[1] = otl[64] + o[1];
    }
    {   int hi_ = hi, r32_ = r32; asm volatile("" : "+v"(hi_), "+v"(r32_));
        bf16* op = A.O + (rowb + qw0 + 4 * hi_) * 512 + head * 64 + r32_;
#pragma unroll
        for (int eb = 0; eb < 2; ++eb)
#pragma unroll
            for (int r = 0; r < 16; ++r) op[(size_t)((r & 3) + 8 * (r >> 2)) * 512 + eb * 32] = f2bf(ot[eb][r]); }
#undef NSA_RELANE
}
}

constexpr int NCLS = 24;
constexpr int CW_CMPD = 10752, CW_FIN = 11008;
constexpr int CW_WQ = 10240;
constexpr int CW_CNT = 8192;
constexpr size_t WS_LIST = 254 * MiB;
constexpr int MISC_OFF = 161792;
constexpr int TAB_OFF = MISC_OFF + 256;
__device__ __forceinline__ void class_experts(int c, int& ea, int& eb) {
    const int g = c / 6, p = c % 6; const int a = p < 3 ? 0 : (p < 5 ? 1 : 2); const int b = p < 3 ? p + 1 : (p < 5 ? p - 1 : 3); ea = g * 4 + a; eb = g * 4 + b; }
__device__ __forceinline__ void moe_build_tab(const unsigned* ctl, LAS int* tab) {
    if (threadIdx.x < 64) {
        const int lane = threadIdx.x;
        const int n = (lane < NCLS) ? (int)__hip_atomic_load(ctl + CW_CNT + 64 * lane, __ATOMIC_RELAXED, __HIP_MEMORY_SCOPE_AGENT) : 0;
        const int nt_ = (n + 255) >> 8;
        int pre = nt_;
#pragma unroll
        for (int o = 1; o < 32; o <<= 1) { const int v = __shfl_up(pre, o); if (lane >= o) pre += v; }
        const int first = pre - nt_;
        if (lane < NCLS) { tab[lane] = first; tab[32 + lane] = n; for (int j = 0; j < nt_; ++j) tab[64 + first + j] = lane; }
        if (lane == NCLS - 1) tab[NCLS] = pre;
    }
    __syncthreads();
}
struct OpsGU { const bf16* H2; const bf16* WGU; const unsigned* LIST; const LAS int* tab; static constexpr int NT = 16, LDB = 1024;
    __device__ __forceinline__ const char* a_base(const pg8::Unit&) const { return (const char*)H2; }
    __device__ __forceinline__ void a_voff(const pg8::Unit& u, const int (&R)[2], const int (&C)[2], unsigned (&out)[2][2]) const {
        const int c = tab[64 + u.pm], n = tab[32 + c], r0 = (u.pm - tab[c]) * 256;
#pragma unroll
        for (int h = 0; h < 2; ++h)
#pragma unroll
            for (int i = 0; i < 2; ++i) { const int r = r0 + h * 128 + R[i]; const unsigned tok = (r < n) ? LIST[(size_t)c * T + r] : 0u; out[h][i] = (tok * 1024u + (unsigned)C[i]) * 2u; } }
    __device__ __forceinline__ void bprep(const pg8::Unit& u, const char*& p0, const char*& p1) const {
        int ea, eb; class_experts(tab[64 + u.pm], ea, eb); const int e = u.z ? eb : ea; p0 = (const char*)(WGU + ((size_t)e * 1024 + u.pn * 256) * 1024); p1 = p0; }
    __device__ static __forceinline__ const char* bat(const char* p0, const char*, int kt) { return p0 + (size_t)kt * 128; } };
constexpr int CW_MQ = 10496;
constexpr int CW_DONE = 12288;
struct SchedGU { const LAS int* tab; int G, vcu;
    __device__ __forceinline__ bool next(int i, pg8::Unit& u) const { const int L = i * G + vcu; if (L >= tab[NCLS] * 8) return false; u.pm = L >> 3; u.z = (L >> 2) & 1; u.pn = L & 3; return true; } };
struct EpiGU { bf16* HID; const unsigned* LIST; const float* ROUTE; const LAS int* tab; unsigned* ctl;
    __device__ __forceinline__ void operator()(const pg8::f32x4 (&acc)[2][2][4][2], const pg8::Unit& u, int wr, int wc, int fr_, int fq_) const {
        int fr = fr_, fq = fq_; asm volatile("" : "+v"(fr), "+v"(fq));
        const int c = tab[64 + u.pm], n = tab[32 + c], r0 = (u.pm - tab[c]) * 256;
        const __amdgpu_buffer_rsrc_t rsrc = __builtin_amdgcn_make_buffer_rsrc((void*)HID, 0, 0x7fffffff, 0x00020000);
#pragma unroll
        for (int ai = 0; ai < 2; ++ai)
#pragma unroll
            for (int m = 0; m < 4; ++m) {
                const int rl = ai * 128 + wr * 64 + m * 16 + fr, r = r0 + rl;
                if (r < n) {
                    const unsigned tok = LIST[(size_t)c * T + r]; const float w = ROUTE[(size_t)tok * 4 + u.z], rs = ROUTE[(size_t)tok * 4 + 3];
                    float v[8];
#pragma unroll
                    for (int nn = 0; nn < 2; ++nn)
#pragma unroll
                        for (int i = 0; i < 4; ++i) { const float gt = acc[ai][0][m][nn][i] * rs, up = acc[ai][1][m][nn][i] * rs; v[4 * nn + i] = gt * __builtin_amdgcn_rcpf(1.f + __builtin_amdgcn_exp2f(-1.4426950408889634f * gt)) * up * w; }
                    uint4 o; o.x = pg8::cvt_pk_bf16(v[0], v[1]); o.y = pg8::cvt_pk_bf16(v[2], v[3]); o.z = pg8::cvt_pk_bf16(v[4], v[5]); o.w = pg8::cvt_pk_bf16(v[6], v[7]);
                    __builtin_amdgcn_raw_buffer_store_b128(__builtin_bit_cast(pg8::u32x4, o), rsrc, (int)(((unsigned)(u.pm * 256 + rl) * 1024u + (unsigned)(u.z * 512 + u.pn * 128 + wc * 32 + 8 * fq)) * 2u), 0, 16);
                }
                asm volatile("" ::: "memory");
            }
        asm volatile("s_waitcnt vmcnt(0)" ::: "memory");
        if (fr == 0 && fq == 0) __hip_atomic_fetch_add(ctl + CW_DONE + 64 * u.pm, 1u, __ATOMIC_RELAXED, __HIP_MEMORY_SCOPE_AGENT);
    }
};
struct OpsDN { const bf16* HID; const bf16* WDN; const LAS int* tab; static constexpr int NT = 16, LDB = 512;
    __device__ __forceinline__ const char* a_base(const pg8::Unit& u) const { return (const char*)(HID + (size_t)u.pm * 256 * 1024); }
    __device__ __forceinline__ void a_voff(const pg8::Unit&, const int (&R)[2], const int (&C)[2], unsigned (&out)[2][2]) const {
#pragma unroll
        for (int h = 0; h < 2; ++h)
#pragma unroll
            for (int i = 0; i < 2; ++i) out[h][i] = (unsigned)((h * 128 + R[i]) * 1024 + C[i]) * 2u; }
    __device__ __forceinline__ void bprep(const pg8::Unit& u, const char*& p0, const char*& p1) const {
        int ea, eb; class_experts(tab[64 + u.pm], ea, eb);
        p0 = (const char*)(WDN + ((size_t)ea * 1024 + u.pn * 256) * 512); p1 = (const char*)(WDN + ((size_t)eb * 1024 + u.pn * 256) * 512); }
    __device__ static __forceinline__ const char* bat(const char* p0, const char* p1, int kt) { return (kt < 8 ? p0 : p1) + (size_t)(kt & 7) * 128; } };
struct SchedDN { const LAS int* tab; unsigned* ctl; int G, vcu;
    __device__ __forceinline__ bool next(int i, pg8::Unit& u) const {
        const int total = tab[NCLS] * 4;
        int L = -1;
        if (i == 0) L = vcu; else if (i == 1) { const int e = G - 1 - vcu; if (G + e < total) L = G + e; }
        if (L < 0 || L >= total) L = -1;
        __builtin_amdgcn_s_barrier();
        if (threadIdx.x == 0 && L >= 0) {
            unsigned* dn = ctl + CW_DONE + 64 * (L >> 2); unsigned sp = 0;
            while (__hip_atomic_load(dn, __ATOMIC_RELAXED, __HIP_MEMORY_SCOPE_AGENT) < 64u) { __builtin_amdgcn_s_sleep(2); if (++sp > (1u << 22)) { atomicAdd(ctl + XB_TMO + CW_BAR, 1u); break; } }
            __builtin_amdgcn_fence(__ATOMIC_ACQUIRE, "agent");
            asm volatile("s_waitcnt vmcnt(0)" ::: "memory");
        }
        __builtin_amdgcn_s_barrier();
        if (L < 0) return false; u.pm = L >> 2; u.pn = L & 3; u.z = 0; return true; } };
struct EpiDN { float* O; const bf16* X2; const unsigned* LIST; const LAS int* tab;
    __device__ __forceinline__ void operator()(const pg8::f32x4 (&acc)[2][2][4][2], const pg8::Unit& u, int wr, int wc, int fr_, int fq_) const {
        int fr = fr_, fq = fq_; asm volatile("" : "+v"(fr), "+v"(fq));
        const int c = tab[64 + u.pm], n = tab[32 + c], r0 = (u.pm - tab[c]) * 256;
#pragma unroll
        for (int ai = 0; ai < 2; ++ai)
#pragma unroll
            for (int m = 0; m < 4; ++m) {
                const int r = r0 + ai * 128 + wr * 64 + m * 16 + fr;
                if (r < n) {
                    const unsigned tok = LIST[(size_t)c * T + r];
#pragma unroll
                    for (int bj = 0; bj < 2; ++bj) { const size_t off = (size_t)tok * 1024 + u.pn * 256 + bj * 128 + wc * 32 + 8 * fq;
                        const uint4 xw = *(const uint4*)(X2 + off); const pg8::f32x4 a0 = acc[ai][bj][m][0], a1 = acc[ai][bj][m][1];
                        const nt_f32x4 y0 = {LO16(xw.x) + a0[0], HI16(xw.x) + a0[1], LO16(xw.y) + a0[2], HI16(xw.y) + a0[3]}, y1 = {LO16(xw.z) + a1[0], HI16(xw.z) + a1[1], LO16(xw.w) + a1[2], HI16(xw.w) + a1[3]};
                        __builtin_nontemporal_store(y0, (nt_f32x4*)(O + off)); __builtin_nontemporal_store(y1, (nt_f32x4*)(O + off + 4)); }
                }
            }
    }
};

constexpr int NTHR = 512;
constexpr int LDS_BYTES = 163840;

__global__ void __launch_bounds__(NTHR, 2) fwd_kernel(Args args) {
    extern __shared__ __attribute__((aligned(16))) unsigned char lds[];
    const int tid = threadIdx.x, lane = tid & 63;
    const int gtid = blockIdx.x * NTHR + tid, nthreads = gridDim.x * NTHR;
    const int gwave = gtid >> 6, nwaves = nthreads >> 6;
    Ctx c; c.a = args; unsigned char* ws = args.ws;

    volatile LAS unsigned* MISC = (volatile LAS unsigned*)((LAS unsigned char*)lds + MISC_OFF);
    if (tid < 32) MISC[tid] = 0u;
    __syncthreads();
    XcdBarrier bar = xcd_barrier_post((unsigned*)(ws + WS_CTL) + CW_BAR, MISC + 8);
    const int lo = args.ph_lo, hi = args.ph_hi;
#ifdef ONLY_PHASE
#define IN(k) ((k) == ONLY_PHASE)
#else
#define IN(k) (lo <= (k) && (k) < hi)
#endif
#define SEAM(k) do { if (IN(k) && IN((k) + 1)) xcd_barrier(bar); } while (0)


    if (IN(0)) {
        for (int t = gwave * 2; t < T; t += nwaves * 2) {
            const float4* xr = (const float4*)(c.x() + (size_t)t * D) + lane;
            float4 v[8]; float s0 = 0.f, s1 = 0.f;
#pragma unroll
            for (int j = 0; j < 8; ++j) v[j] = xr[64 * j];
#pragma unroll
            for (int j = 0; j < 4; ++j) { s0 += v[j].x * v[j].x + v[j].y * v[j].y + v[j].z * v[j].z + v[j].w * v[j].w; s1 += v[4 + j].x * v[4 + j].x + v[4 + j].y * v[4 + j].y + v[4 + j].z * v[4 + j].z + v[4 + j].w * v[4 + j].w; }
            const float r0 = rsqrtf(wave_sum(s0) * (1.f / D) + RMS_EPS), r1 = rsqrtf(wave_sum(s1) * (1.f / D) + RMS_EPS);
#pragma unroll
            for (int j = 0; j < 8; ++j) { const float4 g = ((const float4*)c.norm1_g())[lane + 64 * (j & 3)]; const float r = j < 4 ? r0 : r1;
                uint2 o; o.x = pk2bf(v[j].x * r * g.x, v[j].y * r * g.y); o.y = pk2bf(v[j].z * r * g.z, v[j].w * r * g.w);
                ((uint2*)(c.H1() + (size_t)t * D))[lane + 64 * j] = o; }
        }
        {
            LAS float* scr = (LAS float*)((LAS unsigned char*)lds + (tid >> 6) * 16384);
            constexpr int I_IN = 16 * 160, I_OUT = 16 * 32, I_BR = 8 * 32, I_GU = 16 * 4 * 2 * 4 * 16, I_DN = 16 * 8 * 32, I_C1 = 512;
            for (int it = gwave; it < I_IN + I_OUT + 2 * I_BR + I_GU + I_DN + I_C1; it += nwaves) {
                int r = it;
                if (r < I_IN) { const int kb = r / 160, vb = r % 160, pn = vb >> 3, bj = (vb >> 2) & 1, wc = vb & 3;
                    const ChunkDesc d = chunk_desc(c, pn * 4 + wc); int nv = d.ncols - 32 * bj; nv = nv < 0 ? 0 : (nv > 32 ? 32 : nv);
                    tr_item(c.w_in(), INC, 64 * kb, d.src + 32 * bj, nv, c.WIN(), 1024, 256 * pn + 128 * bj + 32 * wc, scr, lane); continue; }
                r -= I_IN;
                if (r < I_OUT) { tr_item(c.w_out(), 1024, 64 * (r / 32), 32 * (r % 32), 32, c.WOUT(), 1024, 32 * (r % 32), scr, lane); continue; }
                r -= I_OUT;
                if (r < I_BR) { tr_item(c.w_bn(), 1024, 64 * (r / 32), 32 * (r % 32), 32, c.WBN(), 512, 32 * (r % 32), scr, lane); continue; }
                r -= I_BR;
                if (r < I_BR) { tr_item(c.w_bd(), 1024, 64 * (r / 32), 32 * (r % 32), 32, c.WBD(), 512, 32 * (r % 32), scr, lane); continue; }
                r -= I_BR;
                if (r < I_GU) { const int kb = r & 15, blk = (r >> 4) & 3, bj = (r >> 6) & 1, ntile = (r >> 7) & 3, e = r >> 9;
                    tr_item((bj ? c.w_up() : c.w_gate()) + (size_t)e * 1024 * 512, 512, 64 * kb, ntile * 128 + 32 * blk, 32, c.WGU() + (size_t)e * 1024 * 1024, 1024, 256 * ntile + 128 * bj + 32 * blk, scr, lane, c.norm2_g()); continue; }
                r -= I_GU;
                if (r < I_DN) { const int nb = r & 31, kb = (r >> 5) & 7, e = r >> 8;
                    tr_item(c.w_down() + (size_t)e * 512 * 1024, 1024, 64 * kb, 32 * nb, 32, c.WDN() + (size_t)e * 1024 * 512, 512, 32 * nb, scr, lane); continue; }
                r -= I_DN;
                { const int nb = r & 7, kb = (r >> 3) & 15, bot = (r >> 7) & 1, kv = r >> 8;
                    tr_item(c.cmp_w1() + (size_t)kv * 2048 * 256 + (size_t)bot * 1024 * 256, 256, 64 * kb, 32 * nb, 32, c.WC1() + (size_t)kv * 512 * 1024, 1024, bot * 256 + 32 * nb, scr, lane); }
            }
            if (gwave >= nwaves - 64) { const int w = gwave - (nwaves - 64), sl = w & 7, jb = (w >> 3) & 3, kv = w >> 5, j = jb * 64 + lane;
                const float* w1 = c.cmp_w1() + (size_t)kv * 2048 * 256 + (size_t)sl * 256 * 256 + j; const float* pos = c.cmp_pos() + kv * 2048 + sl * 256;
                float a0 = 0.f, a1 = 0.f, a2 = 0.f, a3 = 0.f;
                for (int k = 0; k < 256; k += 4) { a0 += pos[k] * w1[(size_t)k * 256]; a1 += pos[k + 1] * w1[(size_t)(k + 1) * 256]; a2 += pos[k + 2] * w1[(size_t)(k + 2) * 256]; a3 += pos[k + 3] * w1[(size_t)(k + 3) * 256]; }
                c.POSB()[(sl * 2 + kv) * 256 + j] = (a0 + a1) + (a2 + a3); }
            if (gtid >= 8192 && gtid < 8192 + 12 * 1280) { const int i = gtid - 8192, hd = i / 1280, a = (i % 1280) / 320, j = (i % 320) + a, d = 208 - j;
                c.BIASV()[i] = (d < 0) ? -1e30f : (d >= 113 ? 0.f : (c.rel_bias()[t5_bucket(d) * 12 + hd] - c.rel_bias()[31 * 12 + hd]) * 1.4426950408889634f); }
            if (gtid >= 4096 && gtid < 4096 + 3072) { const int i = gtid - 4096, hd = i >> 8, d = i & 255; c.BIAS()[i] = (c.rel_bias()[t5_bucket(d) * 12 + hd] - c.rel_bias()[31 * 12 + hd]) * 1.4426950408889634f; }
            if (gtid >= 512 && gtid < 512 + 2048) { const int i = gtid - 512, kv = i >> 10, bg = (i >> 6) & 15, e = i & 63; const size_t tb = ((size_t)bg * 2 + 1) * 4096; if (kv) c.VCMP()[tb + (e >> 5) * 2048 + 3 * 512 + 15 * 32 + (e & 31)] = 0; else c.KCMP()[tb + (e >> 3) * 512 + 63 * 8 + (e & 7)] = 0; }
        }
        if (gwave == 0) {
            const float a = wave_sum(c.diff_lambda()[lane] * c.diff_lambda()[64 + lane]);
            const float b = wave_sum(c.diff_lambda()[128 + lane] * c.diff_lambda()[192 + lane]);
            if (lane == 0) c.LAM()[0] = expf(a) - expf(b) + LAMBDA_INIT;
        }
    }
    xcd_barrier(bar);

    if (IN(1)) {
        pg8::Ops g; g.A0 = c.H1(); g.A1 = c.H1(); g.B0 = c.WIN(); g.B1 = c.WIN(); g.K = 1024;
        pg8::StaticOrder<1> So; So.init(T, 5120, (int)gridDim.x, (int)blockIdx.x);
        EpiInProj E; E.c = c;
        pg8::gemm_phase(( LAS unsigned char*)lds, g, So, E);
    }
    xcd_barrier(bar);

    if (IN(2)) {
        pg8::Ops g; g.A0 = c.CT(); g.A1 = c.CT(); g.B0 = c.WC1(); g.B1 = c.WC1() + 512 * 1024; g.K = 1024;
        SchedCmp So; So.c = (int)blockIdx.x;
        EpiF32 E; E.O = c.U(); E.ldc = 512;
        pg8::gemm_phase((LAS unsigned char*)lds, g, So, E);
        unsigned* ctl = (unsigned*)(ws + WS_CTL);
        volatile LAS int* wq = (volatile LAS int*)((LAS unsigned char*)lds + MISC_OFF + 64);
        if (blockIdx.x < 32 && tid == 0) { __builtin_amdgcn_fence(__ATOMIC_RELEASE, "agent"); asm volatile("s_waitcnt vmcnt(0)" ::: "memory");
            __hip_atomic_fetch_add(ctl + CW_CMPD, 1u, __ATOMIC_RELAXED, __HIP_MEMORY_SCOPE_AGENT); }
        {   att::DiffArgs A; A.Q = c.QD(); A.K = c.KD(); A.V = c.VD(); A.O = c.ODIFF(); A.biasv = c.BIASV(); A.out_gain = c.diff_out_norm(); A.lam = c.LAM()[0];
            for (;;) {
                __syncthreads();
                if (tid == 0) *wq = (int)atomicAdd(ctl + CW_WQ, 1u);
                __syncthreads();
                const int u = *wq;
                if (u >= 512) break;
                att::diff_unit((LAS unsigned char*)lds, A, (u & 31) >> 2, u & 3, 15 - (u >> 5));
            } }
        {   __syncthreads();
            if (tid == 0) { unsigned sp = 0;
                while (__hip_atomic_load(ctl + CW_CMPD, __ATOMIC_RELAXED, __HIP_MEMORY_SCOPE_AGENT) < 32u) { __builtin_amdgcn_s_sleep(2); if (++sp > (1u << 22)) { atomicAdd(ctl + XB_TMO + CW_BAR, 1u); break; } }
                __builtin_amdgcn_fence(__ATOMIC_ACQUIRE, "agent"); asm volatile("s_waitcnt vmcnt(0)" ::: "memory"); }
            __syncthreads();
            LAS float* hid = (LAS float*)((LAS unsigned char*)lds) + (tid >> 6) * 256;
            for (;;) {
                __syncthreads();
                if (tid == 0) *wq = (int)atomicAdd(ctl + CW_WQ + 128, 1u);
                __syncthreads();
                const int q = *wq;
                if (q >= 128) break;
                const int quarter = q & 3, b = (q >> 2) & 7, g = (q >> 5) & 1, kv = q >> 6;
                for (int jj = 0; jj < 4; ++jj) {
                    const int n = quarter * 32 + (tid >> 6) * 4 + jj;
                    if (n >= NCMP) continue;
                    const float* u1 = c.U() + ((size_t)(kv * 2 + g) * 1024 + b * 128 + n) * 512;
                    const float4 t4 = *(const float4*)(u1 + 4 * lane), b4 = *(const float4*)(u1 + 512 + 256 + 4 * lane), p4 = posb_sum(c.POSB() + kv * 256 + 4 * lane);
                    const float hv[4] = {t4.x + b4.x + p4.x, t4.y + b4.y + p4.y, t4.z + b4.z + p4.z, t4.w + b4.w + p4.w};
#pragma unroll
                    for (int i = 0; i < 4; ++i) { const float a = hv[i]; const float uu = 0.7978845608028654f * (a + 0.044715f * a * a * a); hid[4 * lane + i] = 0.5f * a * (1.f + tanhf(uu)); }
                    const float* w2 = c.cmp_w2() + (size_t)kv * 256 * 64 + lane;
                    float o = 0.f;
                    for (int j = 0; j < 256; ++j) o += hid[j] * w2[j * 64];
                    if (kv == 0) { const float ss = wave_sum(o * o); o = o * rsqrtf(ss * (1.f / 64.f) + RMS_EPS) * c.nsa_k_norm()[lane]; }
                    { const int key = n & 63, e = lane; const size_t tb = ((size_t)(b * 2 + g) * 2 + (n >> 6)) * 4096;
                      if (kv) c.VCMP()[tb + (e >> 5) * 2048 + (key >> 4) * 512 + (key & 15) * 32 + (e & 31)] = f2bf(o);
                      else c.KCMP()[tb + (e >> 3) * 512 + key * 8 + (e & 7)] = f2bf(o); }
                }
                asm volatile("s_waitcnt vmcnt(0)" ::: "memory");
                __syncthreads();
                if (tid == 0) { __builtin_amdgcn_fence(__ATOMIC_RELEASE, "agent"); asm volatile("s_waitcnt vmcnt(0)" ::: "memory");
                    __hip_atomic_fetch_add(ctl + CW_FIN + 64 * (b * 2 + g), 1u, __ATOMIC_RELAXED, __HIP_MEMORY_SCOPE_AGENT); }
            } }
        {   att::NsaArgs A; A.Q = c.QN(); A.KS = c.KS(); A.VS = c.VS(); A.KW = c.KW(); A.VW = c.VW(); A.KC = c.KCMP(); A.VC = c.VCMP(); A.GN = c.GN(); A.O = c.ONSAB(); A.rel_bias = c.BIAS(); A.biasv = c.BIASV();
            bool all_seen = false;
            for (;;) {
                __syncthreads();
                if (tid == 0) {
                    const int u = (int)atomicAdd(ctl + CW_WQ + 64, 1u);
                    if (u < 512 && !all_seen) {
                        unsigned* fc = ctl + CW_FIN + 64 * (u & 15); unsigned sp = 0;
                        while (__hip_atomic_load(fc, __ATOMIC_RELAXED, __HIP_MEMORY_SCOPE_AGENT) < 8u) { __builtin_amdgcn_s_sleep(2); if (++sp > (1u << 22)) { atomicAdd(ctl + XB_TMO + CW_BAR, 1u); break; } }
                        bool all = true;
                        for (int k = 0; k < 16; ++k) all = all && (__hip_atomic_load(ctl + CW_FIN + 64 * k, __ATOMIC_RELAXED, __HIP_MEMORY_SCOPE_AGENT) >= 8u);
                        __builtin_amdgcn_fence(__ATOMIC_ACQUIRE, "agent"); asm volatile("s_waitcnt vmcnt(0)" ::: "memory");
                        all_seen = all;
                    }
                    *wq = u;
                }
                __syncthreads();
                const int u = *wq;
                if (u >= 512) break;
                att::nsa_unit((LAS unsigned char*)lds, A, (u & 15) >> 1, u & 1, 31 - (u >> 4));
            } }
    }
    xcd_barrier(bar);
    if (IN(7)) {
        pg8::Ops g; g.A0 = c.ONSAB(); g.A1 = c.ODIFF(); g.B0 = c.WBN(); g.B1 = c.WBD(); g.K = 512;
        pg8::StaticOrder<2> So; So.init(T, 1024, (int)gridDim.x, (int)blockIdx.x);
        EpiMerge E; E.Y = c.Y(); E.GM = c.GM();
        pg8::gemm_phase((LAS unsigned char*)lds, g, So, E);
    }
    xcd_barrier(bar);
    if (IN(8)) {
        pg8::Ops g; g.A0 = c.Y(); g.A1 = c.Y(); g.B0 = c.WOUT(); g.B1 = c.WOUT(); g.K = 1024;
        pg8::StaticOrder<1> So; So.init(T, 1024, (int)gridDim.x, (int)blockIdx.x);
        EpiResid E; E.X = c.x(); E.O = c.X2B();
        pg8::gemm_phase((LAS unsigned char*)lds, g, So, E);
    }
    xcd_barrier(bar);
    if (IN(9)) {
        LAS int* smc = (LAS int*)((LAS unsigned char*)lds + 81920);
        LAS float* Wl = (LAS float*)lds;
        unsigned* ctl = (unsigned*)(ws + WS_CTL); unsigned* LIST = (unsigned*)(ws + WS_LIST);
        for (int k = tid; k < D; k += NTHR) {
            const float4 gw = *(const float4*)(c.rg_w() + (size_t)k * 4);
            Wl[0 * D + k] = gw.x; Wl[1 * D + k] = gw.y; Wl[2 * D + k] = gw.z; Wl[3 * D + k] = gw.w;
#pragma unroll
            for (int i4 = 0; i4 < 4; ++i4) { const float4 ew = *(const float4*)(c.re_w() + (size_t)k * 16 + 4 * i4);
                Wl[(4 + 4 * i4) * D + k] = ew.x; Wl[(5 + 4 * i4) * D + k] = ew.y; Wl[(6 + 4 * i4) * D + k] = ew.z; Wl[(7 + 4 * i4) * D + k] = ew.w; }
        }
        __syncthreads();
        for (int tb = blockIdx.x; tb < T / 64; tb += gridDim.x) {
#pragma unroll 1
            for (int j = 0; j < 8; j += 2) {
                const int tl0 = (tid >> 6) * 8 + j, t0 = tb * 64 + tl0;
                const uint2* xr = (const uint2*)(c.X2B() + (size_t)t0 * D) + lane;
                float4 v[8]; float ssa = 0.f, ssb = 0.f;
#pragma unroll
                for (int q = 0; q < 8; ++q) { const uint2 w = xr[64 * q]; v[q] = make_float4(LO16(w.x), HI16(w.x), LO16(w.y), HI16(w.y)); }
#pragma unroll
                for (int q = 0; q < 4; ++q) { ssa += v[q].x * v[q].x + v[q].y * v[q].y + v[q].z * v[q].z + v[q].w * v[q].w; ssb += v[4 + q].x * v[4 + q].x + v[4 + q].y * v[4 + q].y + v[4 + q].z * v[4 + q].z + v[4 + q].w * v[4 + q].w; }
                const float ra = rsqrtf(wave_sum(ssa) * (1.f / D) + RMS_EPS), rb = rsqrtf(wave_sum(ssb) * (1.f / D) + RMS_EPS);
                float ha[16], hb[16];
#pragma unroll
                for (int q = 0; q < 4; ++q) { const float4 g = ((const float4*)c.norm2_g())[lane + 64 * q];
                    ha[4 * q + 0] = v[q].x * ra * g.x; ha[4 * q + 1] = v[q].y * ra * g.y; ha[4 * q + 2] = v[q].z * ra * g.z; ha[4 * q + 3] = v[q].w * ra * g.w;
                    hb[4 * q + 0] = v[4 + q].x * rb * g.x; hb[4 * q + 1] = v[4 + q].y * rb * g.y; hb[4 * q + 2] = v[4 + q].z * rb * g.z; hb[4 * q + 3] = v[4 + q].w * rb * g.w; }
                float la[20], lb[20];
                const LAS float* wl = Wl + lane * 4;
#pragma unroll
                for (int i = 0; i < 20; ++i) {
                    float sa = 0.f, sb = 0.f;
#pragma unroll
                    for (int q = 0; q < 4; ++q) { const att::f32x4v w4 = *(const LAS att::f32x4v*)(wl + i * D + 256 * q);
                        sa += (ha[4 * q] * w4[0] + ha[4 * q + 1] * w4[1]) + (ha[4 * q + 2] * w4[2] + ha[4 * q + 3] * w4[3]);
                        sb += (hb[4 * q] * w4[0] + hb[4 * q + 1] * w4[1]) + (hb[4 * q + 2] * w4[2] + hb[4 * q + 3] * w4[3]); }
                    la[i] = sa; lb[i] = sb;
                    if ((i & 3) == 3) asm volatile("" ::: "memory");
                }
                const bool up = lane >= 32;
                float lg[20];
#pragma unroll
                for (int i = 0; i < 20; ++i) { const float keep = up ? lb[i] : la[i], send = up ? la[i] : lb[i]; float x = keep + __shfl_xor(send, 32);
                    x += __shfl_xor(x, 16); x += __shfl_xor(x, 8); x += __shfl_xor(x, 4); x += __shfl_xor(x, 2); x += __shfl_xor(x, 1); lg[i] = x; }
                const int tl = tl0 + (up ? 1 : 0), t = t0 + (up ? 1 : 0);
                if ((lane & 31) == 0) {
                    float gl[4];
#pragma unroll
                    for (int i = 0; i < 4; ++i) gl[i] = lg[i] + c.rg_b()[i];
                    int gt = 0; float gbest = gl[0];
#pragma unroll
                    for (int i = 1; i < 4; ++i) if (gl[i] > gbest) { gbest = gl[i]; gt = i; }
                    float gs = 0.f;
#pragma unroll
                    for (int i = 0; i < 4; ++i) gs += expf(gl[i] - gbest);
                    const float gp = 1.f / gs;
                    float el[4];
#pragma unroll
                    for (int i = 0; i < 4; ++i) { float v0 = 0.f;
#pragma unroll
                        for (int gg = 0; gg < 4; ++gg) v0 = (gg == gt) ? lg[4 + gg * 4 + i] + c.re_b()[gg * 4 + i] : v0;
                        el[i] = v0; }
                    int e0 = 0; float b0 = el[0];
#pragma unroll
                    for (int i = 1; i < 4; ++i) if (el[i] > b0) { b0 = el[i]; e0 = i; }
                    int e1 = -1; float b1 = -3.0e38f;
#pragma unroll
                    for (int i = 0; i < 4; ++i) if (i != e0 && el[i] > b1) { b1 = el[i]; e1 = i; }
                    const float p1 = expf(b1 - b0); const float w0 = gp / (1.f + p1), w1 = gp * p1 / (1.f + p1);
                    const int ea = e0 < e1 ? e0 : e1, eb = e0 < e1 ? e1 : e0;
                    const int pr = (ea == 0) ? eb - 1 : (ea == 1 ? eb + 1 : 5);
                    const int cls = gt * 6 + pr;
                    float* rp = c.ROUTE() + (size_t)t * 4;
                    rp[0] = e0 < e1 ? w0 : w1; rp[1] = e0 < e1 ? w1 : w0; rp[2] = __int_as_float(cls); rp[3] = up ? rb : ra;
                    smc[tl] = cls;
                }
            }
            __syncthreads();
            if (tid < 64) {
                const int mycls = smc[lane];
                int cnt_l = 0, rank = 0;
                for (int cc = 0; cc < NCLS; ++cc) {
                    const unsigned long long mask = __ballot(mycls == cc);
                    if (lane == cc) cnt_l = __popcll(mask);
                    if (mycls == cc) rank = __popcll(mask & ((1ull << lane) - 1ull));
                }
                unsigned base_l = 0u;
                if (lane < NCLS && cnt_l > 0) base_l = atomicAdd(ctl + CW_CNT + 64 * lane, (unsigned)cnt_l);
                const unsigned base = __shfl(base_l, mycls);
                LIST[(size_t)mycls * T + base + rank] = (unsigned)(tb * 64 + lane);
            }
            __syncthreads();
        }
    }
    xcd_barrier(bar);
    if (IN(10)) {
        LAS int* tab = (LAS int*)((LAS unsigned char*)lds + TAB_OFF);
        moe_build_tab((const unsigned*)(ws + WS_CTL), tab);
        unsigned* ctl = (unsigned*)(ws + WS_CTL);
        const int G = (int)gridDim.x, bx = (int)blockIdx.x, vcu = (G % 8 == 0) ? (bx % 8) * (G / 8) + bx / 8 : bx;
        {   OpsGU g; g.H2 = c.X2B(); g.WGU = c.WGU(); g.LIST = (const unsigned*)(ws + WS_LIST); g.tab = tab;
            SchedGU So; So.tab = tab; So.G = G; So.vcu = vcu;
            EpiGU E; E.HID = c.HID(); E.LIST = (const unsigned*)(ws + WS_LIST); E.ROUTE = c.ROUTE(); E.tab = tab; E.ctl = ctl;
            pg8::gemm_phase_g((LAS unsigned char*)lds, g, So, E); }
        {   OpsDN g; g.HID = c.HID(); g.WDN = c.WDN(); g.tab = tab;
            SchedDN So; So.tab = tab; So.ctl = ctl; So.G = G; So.vcu = vcu;
            EpiDN E; E.O = c.out(); E.X2 = c.X2B(); E.LIST = (const unsigned*)(ws + WS_LIST); E.tab = tab;
            pg8::gemm_phase_g((LAS unsigned char*)lds, g, So, E); }
    }
#undef IN
#undef SEAM
}

extern "C" void kernel_launch(void* const* d_in, const int* in_sizes, int n_in, void* d_out, int out_size, void* d_ws, size_t ws_size, hipStream_t stream) {
    static int grid = 0;
    if (grid == 0) {
        if (n_in != 24 || out_size != T * D || ws_size < WS_END) { fprintf(stderr, "kernel_launch: unexpected shapes (n_in %d out %d ws %zu)\n", n_in, out_size, ws_size); grid = -1; return; }
        int dev = 0, cus = 0, per_cu = 0;
        if (hipGetDevice(&dev) != hipSuccess || hipDeviceGetAttribute(&cus, hipDeviceAttributeMultiprocessorCount, dev) != hipSuccess) { grid = -1; return; }
        if (hipFuncSetAttribute((const void*)fwd_kernel, hipFuncAttributeMaxDynamicSharedMemorySize, LDS_BYTES) != hipSuccess) { fprintf(stderr, "kernel_launch: hipFuncSetAttribute failed\n"); grid = -1; return; }
        if (hipOccupancyMaxActiveBlocksPerMultiprocessor(&per_cu, (const void*)fwd_kernel, NTHR, LDS_BYTES) != hipSuccess || per_cu < 1) { fprintf(stderr, "kernel_launch: occupancy query says %d\n", per_cu); }
        (void)hipGetLastError();
        grid = cus;
    }
    if (grid < 0) return;
    (void)hipMemsetAsync((char*)d_ws + WS_CTL, 0, CTL_ZERO_BYTES, stream);
    Args a{};
    for (int i = 0; i < 24; ++i) a.in[i] = (const float*)d_in[i];
    a.out = (float*)d_out; a.ws = (unsigned char*)d_ws; a.ph_lo = 0; a.ph_hi = 11;
    hipLaunchKernelGGL(fwd_kernel, dim3(grid), dim3(NTHR), LDS_BYTES, stream, a);
}
```

```cpp
#include <hip/hip_runtime.h>
#include <cstdint>
#include <cstdio>

constexpr int NB = 8, S = 2048, D = 1024, T = NB * S;
constexpr int INC = 4888;
constexpr int C_QN = 0, C_KV = 512, C_GN = 1280, C_QD = 1304, C_KD = 1816, C_VD = 2328, C_GM = 2840;
constexpr int NCMP = 127;
constexpr float LAMBDA_INIT = 0.2f;
constexpr float RMS_EPS = 1e-6f;

typedef unsigned short bf16;
#define LAS __attribute__((address_space(3)))

constexpr size_t MiB = 1u << 20;
constexpr size_t WS_CTL = 0, CTL_ZERO_BYTES = 1 * MiB;
constexpr size_t WS_WIN = 1 * MiB;
constexpr size_t WS_WOUT = 11 * MiB;
constexpr size_t WS_WBN = 13 * MiB, WS_WBD = 14 * MiB;
constexpr size_t WS_WC1 = 15 * MiB;
constexpr size_t WS_WGU = 17 * MiB;
constexpr size_t WS_WDN = 49 * MiB;
constexpr size_t WS_H1 = 65 * MiB;
constexpr size_t WS_QN = 97 * MiB;
constexpr size_t WS_CT = 113 * MiB;
constexpr size_t WS_KS = 121 * MiB, WS_VS = 125 * MiB, WS_KW = 129 * MiB, WS_VW = 133 * MiB;
constexpr size_t WS_QD = 137 * MiB, WS_KD = 153 * MiB, WS_VD = 169 * MiB;
constexpr size_t WS_GM = 185 * MiB;
constexpr size_t WS_GN = 249 * MiB;
constexpr size_t WS_KCMP = 251 * MiB;
constexpr size_t WS_VCMP = 251 * MiB + 256 * 1024;
constexpr size_t WS_ROUTE = 252 * MiB + 512 * 1024;
constexpr size_t WS_LAM = 252 * MiB + 768 * 1024;
constexpr size_t WS_POSB = 252 * MiB + 800 * 1024;
constexpr size_t WS_BIAS = 252 * MiB + 832 * 1024;
constexpr size_t WS_BIASV = 252 * MiB + 848 * 1024;
constexpr size_t WS_WRT = 253 * MiB;
constexpr size_t WS_END = 256 * MiB;
constexpr size_t WS_U = WS_H1;
constexpr size_t WS_ONSAB = WS_H1 + 16 * MiB;
constexpr size_t WS_X2B = WS_H1;
constexpr size_t WS_Y = WS_QN;
constexpr size_t WS_HID = WS_GM;

constexpr int CW_BAR = 4096;

#define XB_TMO      128
#define XB_XCNT(j)  (256  + 64 * (j))
#define XB_XSUB(j)  (1280 + 64 * (j))
#define XB_XGEN(j)  (2304 + 64 * (j))
#define XB_TOP      3328
#define XB_TOPGEN   3392
#define XCD_BAR_WORDS 3456
#define XB_SPIN_CAP (1u << 22)

__device__ __forceinline__ unsigned xb_ld(unsigned* p)              { return __hip_atomic_load(p, __ATOMIC_RELAXED, __HIP_MEMORY_SCOPE_AGENT); }
__device__ __forceinline__ unsigned xb_add(unsigned* p, unsigned v) { return __hip_atomic_fetch_add(p, v, __ATOMIC_RELAXED, __HIP_MEMORY_SCOPE_AGENT); }
__device__ __forceinline__ unsigned xb_xcc_id() { return (unsigned)__builtin_amdgcn_s_getreg((3 << 11) | 20) & 0xFu; }
#define XB_SPIN(cond, bar) do { unsigned _sp = 0; while (cond) { __builtin_amdgcn_s_sleep(1); \
    if ((++_sp & 255u) == 0u) { if (xb_ld(&(bar)[XB_TMO])) break; if (_sp > XB_SPIN_CAP) { atomicAdd(&(bar)[XB_TMO], 1u); break; } } } } while (0)

struct XcdBarrier { unsigned* bar; unsigned x; volatile LAS unsigned* st; };

__device__ __forceinline__ XcdBarrier xcd_barrier_post(unsigned* bar, volatile LAS unsigned* st) {
    XcdBarrier b; b.bar = bar; b.x = xb_xcc_id(); b.st = st;
    if (threadIdx.x == 0) (void)xb_add(&bar[XB_XCNT(b.x)], 1u);
    return b;
}
__device__ __forceinline__ void xcd_barrier_complete(unsigned* bar, unsigned x, unsigned& nloc, unsigned& nx) {
    const unsigned G = gridDim.x * gridDim.y * gridDim.z;
    unsigned sum, cnt, mine, sp = 0u;
    for (;;) {
        sum = 0u; cnt = 0u; mine = 0u;
#pragma unroll
        for (unsigned j = 0; j < 16; ++j) { const unsigned c = xb_ld(&bar[XB_XCNT(j)]); sum += c; cnt += (c > 0u) ? 1u : 0u; mine = (j == x) ? c : mine; }
        if (sum == G) break;
        __builtin_amdgcn_s_sleep(1);
        if ((++sp & 255u) == 0u) { if (xb_ld(&bar[XB_TMO])) break; if (sp > XB_SPIN_CAP) { atomicAdd(&bar[XB_TMO], 1u); break; } }
    }
    nloc = mine > 0u ? mine : 1u; nx = cnt > 0u ? cnt : 1u;
}
__device__ __forceinline__ void xcd_barrier(const XcdBarrier& b) {
    asm volatile("s_waitcnt vmcnt(0)" ::: "memory");
    __syncthreads();
    if (threadIdx.x == 0) {
        unsigned* bar = b.bar;
        __builtin_amdgcn_s_waitcnt(0);
        unsigned nloc = b.st[0], nx = b.st[1];
        if (nloc == 0u) { xcd_barrier_complete(bar, b.x, nloc, nx); b.st[0] = nloc; b.st[1] = nx; }
        const unsigned old = xb_add(&bar[XB_XSUB(b.x)], 1u);
        const unsigned gen = old / nloc;
        if (old + 1u == (gen + 1u) * nloc) {
            __builtin_amdgcn_fence(__ATOMIC_RELEASE, "agent");
            asm volatile("s_waitcnt vmcnt(0)" ::: "memory");
            const unsigned og = xb_add(&bar[XB_TOP], 1u);
            const unsigned tg = og / nx;
            if (og + 1u == (tg + 1u) * nx) xb_add(&bar[XB_TOPGEN], 1u);
            else XB_SPIN(xb_ld(&bar[XB_TOPGEN]) == tg, bar);
            __builtin_amdgcn_fence(__ATOMIC_ACQUIRE, "agent");
            xb_add(&bar[XB_XGEN(b.x)], 1u);
            asm volatile("s_waitcnt vmcnt(0)" ::: "memory");
        } else {
            XB_SPIN(xb_ld(&bar[XB_XGEN(b.x)]) == gen, bar);
            __builtin_amdgcn_fence(__ATOMIC_ACQUIRE, "agent");
            asm volatile("s_waitcnt vmcnt(0)" ::: "memory");
        }
    }
    __syncthreads();
}

__device__ __forceinline__ bf16 f2bf(float f) { unsigned u = __float_as_uint(f); return (bf16)((u + 0x7fffu + ((u >> 16) & 1u)) >> 16); }
typedef float g_f32x2 __attribute__((ext_vector_type(2))); typedef __bf16 g_bf16x2 __attribute__((ext_vector_type(2)));
__device__ __forceinline__ unsigned pk2bf(float lo, float hi) { const g_f32x2 v = {lo, hi}; const g_bf16x2 b = __builtin_convertvector(v, g_bf16x2); return __builtin_bit_cast(unsigned, b); }
__device__ __forceinline__ float wave_sum(float v) {
#pragma unroll
    for (int o = 1; o < 64; o <<= 1) v += __shfl_xor(v, o);
    return v;
}
typedef float nt_f32x4 __attribute__((ext_vector_type(4)));
__device__ __forceinline__ float sigmoidf_(float x) { return __builtin_amdgcn_rcpf(1.f + __builtin_amdgcn_exp2f(-1.4426950408889634f * x)); }

__device__ const unsigned char T5B[128] = {0, 1, 2, 3, 4, 5, 6, 7, 8, 9, 10, 11, 12, 13, 14, 15, 16, 16, 16, 17, 17, 18, 18, 18, 19, 19, 19, 20, 20, 20, 20, 21, 21, 21, 21, 22, 22, 22, 22, 22, 23, 23, 23, 23, 23, 23, 24, 24, 24, 24, 24, 24, 25, 25, 25, 25, 25, 25, 25, 26, 26, 26, 26, 26, 26, 26, 26, 27, 27, 27, 27, 27, 27, 27, 27, 27, 27, 28, 28, 28, 28, 28, 28, 28, 28, 28, 28, 29, 29, 29, 29, 29, 29, 29, 29, 29, 29, 29, 29, 30, 30, 30, 30, 30, 30, 30, 30, 30, 30, 30, 30, 30, 30, 31, 31, 31, 31, 31, 31, 31, 31, 31, 31, 31, 31, 31, 31, 31};
__device__ __forceinline__ int t5_bucket(int dist) { return (int)T5B[dist > 127 ? 127 : (dist < 0 ? 0 : dist)]; }

#define LO16(u) __uint_as_float((u) << 16)
#define HI16(u) __uint_as_float((u) & 0xffff0000u)

struct Args { const float* in[24]; float* out; unsigned char* ws; int ph_lo, ph_hi; };

struct Ctx {
    Args a;
#define CF(name, idx) __device__ __forceinline__ const float* name() const { return a.in[idx]; }
    CF(x, 0) CF(norm1_g, 1) CF(w_in, 2) CF(nsa_q_norm, 3) CF(nsa_k_norm, 4) CF(cmp_pos, 5) CF(cmp_w1, 6) CF(cmp_w2, 7) CF(diff_q_norm, 8) CF(diff_k_norm, 9)
    CF(diff_lambda, 10) CF(diff_out_norm, 11) CF(rel_bias, 12) CF(w_bn, 13) CF(w_bd, 14) CF(w_out, 15) CF(norm2_g, 16) CF(rg_w, 17) CF(rg_b, 18) CF(re_w, 19) CF(re_b, 20)
    CF(w_gate, 21) CF(w_up, 22) CF(w_down, 23)
#undef CF
#define CW(type, name, off) __device__ __forceinline__ type* name() const { return (type*)(a.ws + (off)); }
    CW(bf16, H1, WS_H1) CW(bf16, QN, WS_QN) CW(bf16, CT, WS_CT) CW(bf16, KS, WS_KS) CW(bf16, VS, WS_VS) CW(bf16, KW, WS_KW) CW(bf16, VW, WS_VW)
    CW(bf16, QD, WS_QD) CW(bf16, KD, WS_KD) CW(bf16, VD, WS_VD) CW(bf16, GM, WS_GM) CW(float, GN, WS_GN) CW(bf16, KCMP, WS_KCMP) CW(bf16, VCMP, WS_VCMP)
    CW(bf16, ONSAB, WS_ONSAB) CW(float, ROUTE, WS_ROUTE)
    CW(float, LAM, WS_LAM) CW(bf16, Y, WS_Y) CW(bf16, HID, WS_HID)
    CW(float, U, WS_U) CW(bf16, X2B, WS_X2B) CW(float, POSB, WS_POSB) CW(float, BIAS, WS_BIAS) CW(float, BIASV, WS_BIASV) CW(bf16, WIN, WS_WIN) CW(bf16, WOUT, WS_WOUT) CW(bf16, WBN, WS_WBN) CW(bf16, WBD, WS_WBD) CW(bf16, WC1, WS_WC1) CW(bf16, WGU, WS_WGU) CW(bf16, WDN, WS_WDN) CW(bf16, WRT, WS_WRT)
    __device__ __forceinline__ bf16* ODIFF() const { return (bf16*)a.out; }
#undef CW
    __device__ __forceinline__ float* out() const { return a.out; }
};

struct ChunkDesc { int src; int ncols; int mode; const float* gain; bf16* dst; float* dstf; int pitch; int dcol; float qscale;
    int img; int c0; int tile_bytes; int bstride; };
__device__ __forceinline__ ChunkDesc chunk_desc(const Ctx& c, int ch) {
    ChunkDesc d; d.src = 0; d.ncols = 64; d.mode = 0; d.gain = nullptr; d.dst = nullptr; d.dstf = nullptr; d.pitch = 0; d.dcol = 0; d.qscale = 1.f; d.img = 0; d.c0 = 0; d.tile_bytes = 0; d.bstride = 0;
    if (ch < 8) { d.src = C_QN + 64 * ch; d.mode = 1; d.gain = c.nsa_q_norm(); d.dst = c.QN(); d.pitch = 512; d.dcol = 64 * ch; d.qscale = 0.125f * 1.4426950408889634f; }
    else if (ch < 20) { const int j = ch - 8; d.src = C_KV + 64 * j; const int t = j >> 2, kv = (j >> 1) & 1, g = j & 1;
        if (t == 0) { d.dst = c.CT() + (size_t)(kv * 2 + g) * T * 64; d.pitch = 64; d.dcol = 0; }
        else { d.dst = ((t == 1) ? (kv ? c.VS() : c.KS()) : (kv ? c.VW() : c.KW())) + (size_t)g * 32 * 4096; d.img = kv ? 2 : 1; d.c0 = 0; d.tile_bytes = 8192; d.bstride = 2 * 32 * 8192;
               if (kv == 0) { d.mode = 1; d.gain = c.nsa_k_norm() + 64 * t; } } }
    else if (ch < 24) { if (ch == 20) { d.src = C_GN; d.ncols = 24; d.mode = 2; d.dstf = c.GN(); d.pitch = 24; d.dcol = 0; } else d.ncols = 0; }
    else if (ch < 32) { const int j = ch - 24; d.src = C_QD + 64 * j; d.mode = 1; d.gain = c.diff_q_norm() + 64 * (j & 1); d.dst = c.QD(); d.pitch = 512; d.dcol = 64 * j; d.qscale = 0.125f * 1.4426950408889634f; }
    else if (ch < 40) { const int j = ch - 32; d.src = C_KD + 64 * j; d.mode = 1; d.gain = c.diff_k_norm() + 64 * (j & 1); d.dst = c.KD() + (size_t)(j >> 1) * 32 * 8192; d.img = 1; d.c0 = (j & 1) * 8; d.tile_bytes = 16384; d.bstride = 4 * 32 * 16384; }
    else if (ch < 48) { const int j = ch - 40; d.src = C_VD + 64 * j; d.dst = c.VD() + (size_t)(j >> 1) * 32 * 8192; d.img = 2; d.c0 = (j & 1) * 2; d.tile_bytes = 16384; d.bstride = 4 * 32 * 16384; }
    else { const int j = ch - 48; d.src = C_GM + 64 * j; d.mode = 2; d.dst = c.GM(); d.pitch = 2048; d.dcol = 64 * j; }
    return d;
}


namespace pg8 {
typedef short bf16x8 __attribute__((ext_vector_type(8)));
typedef float f32x4 __attribute__((ext_vector_type(4)));
typedef unsigned u32x4 __attribute__((ext_vector_type(4)));
constexpr int BM = 256, BK = 64, HALF = 128, HTB = HALF * BK * 2, NXCD = 8, WGM = 8;
__device__ __forceinline__ int lds_byte(int r, int c) { const int st = (r >> 4) * 2 + (c >> 5), rr = r & 15, cc = c & 31, ob = rr * 64 + cc * 2; return st * 1024 + (ob ^ (((ob >> 9) & 1) << 5)); }
__device__ __forceinline__ void stage_rc(int b, int& R, int& C) { const int st = b / 1024, sb = b % 1024, swz = sb ^ (((sb >> 9) & 1) << 5); R = (st >> 1) * 16 + swz / 64; C = (st & 1) * 32 + (swz % 64) / 2; }
__device__ __forceinline__ int perm32(int rho) { const int n = rho >> 4, i = rho & 15; return 8 * (i >> 2) + 4 * n + (i & 3); }
__device__ __forceinline__ unsigned cvt_pk_bf16(float lo, float hi) { return pk2bf(lo, hi); }

struct Unit { int pm, pn, z; };
struct Ops { const bf16 *A0, *A1, *B0, *B1; int K;
    __device__ __forceinline__ const char* a(const Unit& u) const { return (const char*)((u.z ? A1 : A0) + (size_t)u.pm * BM * K); }
    __device__ __forceinline__ const char* b(const Unit& u) const { return (const char*)((u.z ? B1 : B0) + (size_t)u.pn * BM * K); } };

template <int NZ> struct StaticOrder {
    int nM, nN, nwg, G, c;
    __device__ __forceinline__ void init(int M, int N, int G_, int c_) { nM = M / BM; nN = N / BM; nwg = nM * nN; G = G_; c = c_; }
    __device__ __forceinline__ bool next(int i, Unit& u) const {
        const int it = i / NZ; u.z = i % NZ;
        const long L = (long)it * G + c; if (L >= nwg) return false;
        int wgid = (int)L; { const int q = nwg / NXCD, r = nwg % NXCD, xcd = wgid % NXCD, off = wgid / NXCD; wgid = (xcd < r ? xcd * (q + 1) : r * (q + 1) + (xcd - r) * q) + off; }
        const int nig = WGM * nN, gid = wgid / nig, fm = gid * WGM, gsz = (nM - fm) < WGM ? (nM - fm) : WGM;
        u.pm = fm + ((wgid % nig) % gsz); u.pn = (wgid % nig) / gsz; return true;
    }
};

template <class Epi, class Sched>
__device__ __forceinline__ void gemm_phase(LAS unsigned char* lds, const Ops g, const Sched& S, const Epi& E) {
    const int tid = threadIdx.x, wid = __builtin_amdgcn_readfirstlane(tid >> 6), lane = tid & 63, wr = wid >> 2, wc = wid & 3, fr = lane & 15, fq = lane >> 4;
    const int K = g.K, nt = K / BK;
    unsigned voffA[2], voffB[2];
#pragma unroll
    for (int i = 0; i < 2; ++i) { int R, C; stage_rc(tid * 16 + i * 8192, R, C); const int Rb = (R & ~31) + perm32(R & 31);
        voffA[i] = (unsigned)(R * K + C) * 2u; voffB[i] = (unsigned)(Rb * K + C) * 2u; }
    const size_t kstep = (size_t)(BK * 2);
    const size_t hstep = (size_t)HALF * K * 2;
    const unsigned ldsw = (unsigned)wid * 1024u;
    const int aoff = lds_byte(wr * 64 + fr, fq * 8), boff = lds_byte(wc * 32 + fr, fq * 8);
#define PG8_SA(b, h) (((b) * 2 + (h)) * HTB)
#define PG8_SB(b, h) ((4 + (b) * 2 + (h)) * HTB)
#define PG8_STAGE(bufoff, gbase, voff) do { _Pragma("unroll") for (int _i = 0; _i < 2; ++_i) \
        __builtin_amdgcn_global_load_lds((const unsigned*)((const char*)(gbase) + (voff)[_i]), (LAS unsigned*)(lds + (bufoff) + ldsw + _i * 8192), 16, 0, 0); } while (0)
#define PG8_LDA(dst, b, h) do { _Pragma("unroll") for (int m = 0; m < 4; ++m) _Pragma("unroll") for (int k = 0; k < 2; ++k) dst[m][k] = *(const LAS bf16x8*)(lds + PG8_SA(b, h) + aoff + m * 2048 + k * 1024); } while (0)
#define PG8_LDB(dst, b, h) do { _Pragma("unroll") for (int n = 0; n < 2; ++n) _Pragma("unroll") for (int k = 0; k < 2; ++k) dst[n][k] = *(const LAS bf16x8*)(lds + PG8_SB(b, h) + boff + n * 2048 + k * 1024); } while (0)
#define PG8_MMA(ai, bj, At, Bt) do { __builtin_amdgcn_s_setprio(1); _Pragma("unroll") for (int m = 0; m < 4; ++m) _Pragma("unroll") for (int n = 0; n < 2; ++n) _Pragma("unroll") for (int k = 0; k < 2; ++k) \
        acc[ai][bj][m][n] = __builtin_amdgcn_mfma_f32_16x16x32_bf16(Bt[n][k], At[m][k], acc[ai][bj][m][n], 0, 0, 0); __builtin_amdgcn_s_setprio(0); } while (0)
#define PG8_WAIT_V(n) asm volatile("s_waitcnt vmcnt(" #n ")" ::: "memory")
#define PG8_WAIT_L(n) asm volatile("s_waitcnt lgkmcnt(" #n ")" ::: "memory")
#define PG8_BAR __builtin_amdgcn_s_barrier()
#define PG8_SCHED __builtin_amdgcn_sched_barrier(0)
    Unit cur, nxt; int ui = 0;
    if (!S.next(0, cur)) return;
    f32x4 acc[2][2][4][2];
#pragma unroll
    for (int a = 0; a < 2; ++a)
#pragma unroll
        for (int b = 0; b < 2; ++b)
#pragma unroll
            for (int m = 0; m < 4; ++m)
#pragma unroll
                for (int n = 0; n < 2; ++n) acc[a][b][m][n] = (f32x4){0.f, 0.f, 0.f, 0.f};
    bf16x8 At[4][2], B0[2][2], B1[2][2];
    const char* cA = g.a(cur); const char* cB = g.b(cur);
    PG8_STAGE(PG8_SB(0, 0), cB, voffB); PG8_STAGE(PG8_SB(0, 1), cB + hstep, voffB); PG8_STAGE(PG8_SA(0, 0), cA, voffA); PG8_STAGE(PG8_SA(0, 1), cA + hstep, voffA);
    if (wr == 1) PG8_BAR;
    PG8_WAIT_V(2); PG8_BAR;
    PG8_STAGE(PG8_SB(1, 0), cB + kstep, voffB); PG8_STAGE(PG8_SA(1, 0), cA + kstep, voffA); PG8_STAGE(PG8_SB(1, 1), cB + hstep + kstep, voffB);
    PG8_WAIT_V(6); PG8_BAR;
    for (;;) {
        const bool has_next = S.next(ui + 1, nxt);
        const char* nA = has_next ? g.a(nxt) : cA; const char* nB = has_next ? g.b(nxt) : cB;
        for (int t = 0; t < nt; t += 2) {
            const bool last = (t == nt - 2);
            const char* a1 = cA + (size_t)(t + 1) * kstep;
            const char* a2 = last ? nA : cA + (size_t)(t + 2) * kstep; const char* b2 = last ? nB : cB + (size_t)(t + 2) * kstep;
            const char* a3 = a2 + kstep; const char* b3 = b2 + kstep;
            PG8_LDB(B0, 0, 0); PG8_LDB(B1, 0, 1); PG8_SCHED; PG8_LDA(At, 0, 0); PG8_STAGE(PG8_SA(1, 1), a1 + hstep, voffA);
            PG8_WAIT_V(8); PG8_WAIT_L(0); PG8_BAR; PG8_MMA(0, 0, At, B0); PG8_MMA(0, 1, At, B1); PG8_BAR; PG8_SCHED;
            PG8_LDA(At, 0, 1); PG8_STAGE(PG8_SB(0, 0), b2, voffB); PG8_STAGE(PG8_SB(0, 1), b2 + hstep, voffB); PG8_STAGE(PG8_SA(0, 0), a2, voffA);
            PG8_WAIT_V(8); PG8_WAIT_L(0); PG8_BAR; PG8_MMA(1, 0, At, B0); PG8_MMA(1, 1, At, B1); PG8_BAR; PG8_SCHED;
            PG8_LDB(B0, 1, 0); PG8_LDB(B1, 1, 1); PG8_SCHED; PG8_LDA(At, 1, 0); PG8_STAGE(PG8_SA(0, 1), a2 + hstep, voffA);
            PG8_WAIT_V(8); PG8_WAIT_L(0); PG8_BAR; PG8_MMA(0, 0, At, B0); PG8_MMA(0, 1, At, B1); PG8_BAR; PG8_SCHED;
            PG8_LDA(At, 1, 1); PG8_STAGE(PG8_SB(1, 0), b3, voffB); PG8_STAGE(PG8_SB(1, 1), b3 + hstep, voffB); PG8_STAGE(PG8_SA(1, 0), a3, voffA);
            PG8_WAIT_V(8); PG8_WAIT_L(0); PG8_BAR; PG8_MMA(1, 0, At, B0); PG8_MMA(1, 1, At, B1); PG8_BAR; PG8_SCHED;
        }
        if (wr == 0) PG8_BAR;
        const bool keep = E(acc, cur, wr, wc, fr, fq);
        if (!has_next) break;
        if (!keep) {
#pragma unroll
        for (int a = 0; a < 2; ++a)
#pragma unroll
            for (int b = 0; b < 2; ++b)
#pragma unroll
                for (int m = 0; m < 4; ++m)
#pragma unroll
                    for (int n = 0; n < 2; ++n) acc[a][b][m][n] = (f32x4){0.f, 0.f, 0.f, 0.f};
        }
        cur = nxt; cA = nA; cB = nB; ++ui;
        if (wr == 1) PG8_BAR;
    }
    PG8_WAIT_V(0);
    PG8_BAR;
#undef PG8_SA
#undef PG8_SB
#undef PG8_STAGE
#undef PG8_LDA
#undef PG8_LDB
#undef PG8_MMA
#undef PG8_WAIT_V
#undef PG8_WAIT_L
#undef PG8_BAR
#undef PG8_SCHED
}

template <class G, class Epi, class Sched>
__device__ __forceinline__ void gemm_phase_g(LAS unsigned char* lds, const G& g, const Sched& S, const Epi& E) {
    const int tid = threadIdx.x, wid = __builtin_amdgcn_readfirstlane(tid >> 6), lane = tid & 63, wr = wid >> 2, wc = wid & 3, fr = lane & 15, fq = lane >> 4;
    constexpr int nt = G::NT;
    unsigned voffB[2];
#pragma unroll
    for (int i = 0; i < 2; ++i) { int R, C; stage_rc(tid * 16 + i * 8192, R, C); const int Rb = (R & ~31) + perm32(R & 31); voffB[i] = (unsigned)(Rb * G::LDB + C) * 2u; }
#define PG8_RC int sR[2], sC[2]; stage_rc(tid * 16, sR[0], sC[0]); stage_rc(tid * 16 + 8192, sR[1], sC[1])
    const size_t kstep = (size_t)(BK * 2);
    const size_t hstepB = (size_t)HALF * G::LDB * 2;
    const unsigned ldsw = (unsigned)wid * 1024u;
    const int aoff = lds_byte(wr * 64 + fr, fq * 8), boff = lds_byte(wc * 32 + fr, fq * 8);
#define PG8_SA(b, h) (((b) * 2 + (h)) * HTB)
#define PG8_SB(b, h) ((4 + (b) * 2 + (h)) * HTB)
#define PG8_STAGE(bufoff, gbase, voff) do { _Pragma("unroll") for (int _i = 0; _i < 2; ++_i) \
        __builtin_amdgcn_global_load_lds((const unsigned*)((const char*)(gbase) + (voff)[_i]), (LAS unsigned*)(lds + (bufoff) + ldsw + _i * 8192), 16, 0, 0); } while (0)
#define PG8_LDA(dst, b, h) do { _Pragma("unroll") for (int m = 0; m < 4; ++m) _Pragma("unroll") for (int k = 0; k < 2; ++k) dst[m][k] = *(const LAS bf16x8*)(lds + PG8_SA(b, h) + aoff + m * 2048 + k * 1024); } while (0)
#define PG8_LDB(dst, b, h) do { _Pragma("unroll") for (int n = 0; n < 2; ++n) _Pragma("unroll") for (int k = 0; k < 2; ++k) dst[n][k] = *(const LAS bf16x8*)(lds + PG8_SB(b, h) + boff + n * 2048 + k * 1024); } while (0)
#define PG8_MMA(ai, bj, At, Bt) do { __builtin_amdgcn_s_setprio(1); _Pragma("unroll") for (int m = 0; m < 4; ++m) _Pragma("unroll") for (int n = 0; n < 2; ++n) _Pragma("unroll") for (int k = 0; k < 2; ++k) \
        acc[ai][bj][m][n] = __builtin_amdgcn_mfma_f32_16x16x32_bf16(Bt[n][k], At[m][k], acc[ai][bj][m][n], 0, 0, 0); __builtin_amdgcn_s_setprio(0); } while (0)
#define PG8_WAIT_V(n) asm volatile("s_waitcnt vmcnt(" #n ")" ::: "memory")
#define PG8_WAIT_L(n) asm volatile("s_waitcnt lgkmcnt(" #n ")" ::: "memory")
#define PG8_BAR __builtin_amdgcn_s_barrier()
#define PG8_SCHED __builtin_amdgcn_sched_barrier(0)
    Unit cur, nxt; int ui = 0;
    if (!S.next(0, cur)) return;
    unsigned vc[2][2], vn[2][2];
    bool has_next = S.next(1, nxt);
    {   PG8_RC; g.a_voff(cur, sR, sC, vc);
        if (has_next) g.a_voff(nxt, sR, sC, vn); }
    if (has_next) {} else { vn[0][0] = vc[0][0]; vn[0][1] = vc[0][1]; vn[1][0] = vc[1][0]; vn[1][1] = vc[1][1]; }
    f32x4 acc[2][2][4][2];
#pragma unroll
    for (int a = 0; a < 2; ++a)
#pragma unroll
        for (int b = 0; b < 2; ++b)
#pragma unroll
            for (int m = 0; m < 4; ++m)
#pragma unroll
                for (int n = 0; n < 2; ++n) acc[a][b][m][n] = (f32x4){0.f, 0.f, 0.f, 0.f};
    bf16x8 At[4][2], B0[2][2], B1[2][2];
    const char* cA = g.a_base(cur);
    const char *cb0, *cb1, *nb0, *nb1;
    g.bprep(cur, cb0, cb1);
    if (has_next) g.bprep(nxt, nb0, nb1); else { nb0 = cb0; nb1 = cb1; }
    {   const char* cB0 = G::bat(cb0, cb1, 0); const char* cB1 = G::bat(cb0, cb1, 1);
        PG8_STAGE(PG8_SB(0, 0), cB0, voffB); PG8_STAGE(PG8_SB(0, 1), cB0 + hstepB, voffB); PG8_STAGE(PG8_SA(0, 0), cA, vc[0]); PG8_STAGE(PG8_SA(0, 1), cA, vc[1]);
        if (wr == 1) PG8_BAR;
        PG8_WAIT_V(2); PG8_BAR;
        PG8_STAGE(PG8_SB(1, 0), cB1, voffB); PG8_STAGE(PG8_SA(1, 0), cA + kstep, vc[0]); PG8_STAGE(PG8_SB(1, 1), cB1 + hstepB, voffB);
        PG8_WAIT_V(6); PG8_BAR; }
    for (;;) {
        const char* nA = has_next ? g.a_base(nxt) : cA;
        for (int t = 0; t < nt; t += 2) {
            const bool last = (t == nt - 2);
            const char* a1 = cA + (size_t)(t + 1) * kstep;
            const char* a2 = last ? nA : cA + (size_t)(t + 2) * kstep; const char* a3 = a2 + kstep;
            const char* b2 = last ? G::bat(nb0, nb1, 0) : G::bat(cb0, cb1, t + 2); const char* b3 = last ? G::bat(nb0, nb1, 1) : G::bat(cb0, cb1, t + 3);
            PG8_LDB(B0, 0, 0); PG8_LDB(B1, 0, 1); PG8_SCHED; PG8_LDA(At, 0, 0); PG8_STAGE(PG8_SA(1, 1), a1, vc[1]);
            if (last) { vc[0][0] = vn[0][0]; vc[0][1] = vn[0][1]; vc[1][0] = vn[1][0]; vc[1][1] = vn[1][1]; }
            PG8_WAIT_V(8); PG8_WAIT_L(0); PG8_BAR; PG8_MMA(0, 0, At, B0); PG8_MMA(0, 1, At, B1); PG8_BAR; PG8_SCHED;
            PG8_LDA(At, 0, 1); PG8_STAGE(PG8_SB(0, 0), b2, voffB); PG8_STAGE(PG8_SB(0, 1), b2 + hstepB, voffB); PG8_STAGE(PG8_SA(0, 0), a2, vc[0]);
            PG8_WAIT_V(8); PG8_WAIT_L(0); PG8_BAR; PG8_MMA(1, 0, At, B0); PG8_MMA(1, 1, At, B1); PG8_BAR; PG8_SCHED;
            PG8_LDB(B0, 1, 0); PG8_LDB(B1, 1, 1); PG8_SCHED; PG8_LDA(At, 1, 0); PG8_STAGE(PG8_SA(0, 1), a2, vc[1]);
            PG8_WAIT_V(8); PG8_WAIT_L(0); PG8_BAR; PG8_MMA(0, 0, At, B0); PG8_MMA(0, 1, At, B1); PG8_BAR; PG8_SCHED;
            PG8_LDA(At, 1, 1); PG8_STAGE(PG8_SB(1, 0), b3, voffB); PG8_STAGE(PG8_SB(1, 1), b3 + hstepB, voffB); PG8_STAGE(PG8_SA(1, 0), a3, vc[0]);
            PG8_WAIT_V(8); PG8_WAIT_L(0); PG8_BAR; PG8_MMA(1, 0, At, B0); PG8_MMA(1, 1, At, B1); PG8_BAR; PG8_SCHED;
        }
        if (wr == 0) PG8_BAR;
        E(acc, cur, wr, wc, fr, fq);
        if (!has_next) break;
#pragma unroll
        for (int a = 0; a < 2; ++a)
#pragma unroll
            for (int b = 0; b < 2; ++b)
#pragma unroll
                for (int m = 0; m < 4; ++m)
#pragma unroll
                    for (int n = 0; n < 2; ++n) acc[a][b][m][n] = (f32x4){0.f, 0.f, 0.f, 0.f};
        cur = nxt; cA = nA; cb0 = nb0; cb1 = nb1; ++ui;
        has_next = S.next(ui + 1, nxt);
        if (has_next) { PG8_RC; g.a_voff(nxt, sR, sC, vn); g.bprep(nxt, nb0, nb1); }
        if (wr == 1) PG8_BAR;
    }
    PG8_WAIT_V(0);
    PG8_BAR;
#undef PG8_RC
#undef PG8_SA
#undef PG8_SB
#undef PG8_STAGE
#undef PG8_LDA
#undef PG8_LDB
#undef PG8_MMA
#undef PG8_WAIT_V
#undef PG8_WAIT_L
#undef PG8_BAR
#undef PG8_SCHED
}
}

struct EpiInProj {
    Ctx c;
    __device__ __forceinline__ bool operator()(pg8::f32x4 (&acc)[2][2][4][2], const pg8::Unit& u, int wr, int wc, int fr_, int fq_) const {
        int fr = fr_, fq = fq_; asm volatile("" : "+v"(fr), "+v"(fq));
        const ChunkDesc d = chunk_desc(c, u.pn * 4 + wc);
        if (d.ncols == 0) return false;
        const int row0 = u.pm * 256 + wr * 64 + fr;
        float gn[2][8];
        const float* gp = (d.mode == 1) ? d.gain : c.nsa_q_norm();
        pg8::f32x4 g4[4];
#pragma unroll
        for (int q = 0; q < 4; ++q) g4[q] = *(const pg8::f32x4*)(gp + 32 * (q >> 1) + 8 * fq + 4 * (q & 1));
#pragma unroll
        for (int q = 0; q < 4; ++q) asm volatile("" : "+v"(g4[q]));
#pragma unroll
        for (int bj = 0; bj < 2; ++bj)
#pragma unroll
            for (int i = 0; i < 8; ++i) gn[bj][i] = g4[2 * bj + (i >> 2)][i & 3] * d.qscale;
#pragma unroll
        for (int ai = 0; ai < 2; ++ai)
#pragma unroll
            for (int m = 0; m < 4; ++m) {
                const size_t row = (size_t)(row0 + ai * 128 + m * 16);
                float v[2][8];
#pragma unroll
                for (int bj = 0; bj < 2; ++bj)
#pragma unroll
                    for (int n = 0; n < 2; ++n)
#pragma unroll
                        for (int i = 0; i < 4; ++i) v[bj][4 * n + i] = acc[ai][bj][m][n][i];
                if (d.mode == 1) {
                    float ss = 0.f;
#pragma unroll
                    for (int bj = 0; bj < 2; ++bj)
#pragma unroll
                        for (int i = 0; i < 8; ++i) ss += v[bj][i] * v[bj][i];
                    ss += __shfl_xor(ss, 16); ss += __shfl_xor(ss, 32);
                    const float r = rsqrtf(ss * (1.f / 64.f) + RMS_EPS);
#pragma unroll
                    for (int bj = 0; bj < 2; ++bj)
#pragma unroll
                        for (int i = 0; i < 8; ++i) v[bj][i] = v[bj][i] * r * gn[bj][i];
                } else if (d.mode == 2) {
#pragma unroll
                    for (int bj = 0; bj < 2; ++bj)
#pragma unroll
                        for (int i = 0; i < 8; ++i) v[bj][i] = sigmoidf_(v[bj][i]);
                }
                if (d.dstf) {
                    if (fq < 3) { float4* p = (float4*)(d.dstf + row * 24 + 8 * fq); p[0] = make_float4(v[0][0], v[0][1], v[0][2], v[0][3]); p[1] = make_float4(v[0][4], v[0][5], v[0][6], v[0][7]); }
                } else {
#pragma unroll
                    for (int bj = 0; bj < 2; ++bj) { pg8::u32x4 w; w.x = pg8::cvt_pk_bf16(v[bj][0], v[bj][1]); w.y = pg8::cvt_pk_bf16(v[bj][2], v[bj][3]); w.z = pg8::cvt_pk_bf16(v[bj][4], v[bj][5]); w.w = pg8::cvt_pk_bf16(v[bj][6], v[bj][7]);
                        if (d.img == 0) *(pg8::u32x4*)(d.dst + row * d.pitch + d.dcol + 32 * bj + 8 * fq) = w;
                        else { const int bb = (int)(row >> 11), sq = (int)(row & 2047), key = sq & 63;
                            const size_t tb = (size_t)bb * d.bstride + (size_t)(sq >> 6) * d.tile_bytes;
                            const size_t off = (d.img == 1) ? tb + (size_t)(d.c0 + 4 * bj + fq) * 1024 + key * 16 : tb + (size_t)(d.c0 + bj) * 4096 + (key >> 4) * 1024 + (key & 15) * 64 + fq * 16;
                            *(pg8::u32x4*)((unsigned char*)d.dst + off) = w; } }
                }
            }
        return false;
    }
};
struct EpiMerge {
    bf16* Y; const bf16* GM;
    __device__ __forceinline__ bool operator()(pg8::f32x4 (&acc)[2][2][4][2], const pg8::Unit& u, int wr, int wc, int fr_, int fq_) const {
        int fr = fr_, fq = fq_; asm volatile("" : "+v"(fr), "+v"(fq));
        const int row0 = u.pm * 256 + wr * 64 + fr, col0 = u.pn * 256 + wc * 32 + 8 * fq;
#pragma unroll
        for (int ai = 0; ai < 2; ++ai)
#pragma unroll
            for (int m = 0; m < 4; ++m) {
                const size_t row = (size_t)(row0 + ai * 128 + m * 16);
#pragma unroll
                for (int bj = 0; bj < 2; ++bj) {
                    const int col = col0 + bj * 128;
                    const uint4 g1 = *(const uint4*)(GM + row * 2048 + 1024 + col);
                    float q1[8] = {LO16(g1.x), HI16(g1.x), LO16(g1.y), HI16(g1.y), LO16(g1.z), HI16(g1.z), LO16(g1.w), HI16(g1.w)};
                    if (u.z == 0) {
                        const uint4 g0 = *(const uint4*)(GM + row * 2048 + col);
                        const float q0[8] = {LO16(g0.x), HI16(g0.x), LO16(g0.y), HI16(g0.y), LO16(g0.z), HI16(g0.z), LO16(g0.w), HI16(g0.w)};
#pragma unroll
                        for (int n = 0; n < 2; ++n)
#pragma unroll
                            for (int i = 0; i < 4; ++i) acc[ai][bj][m][n][i] *= q0[4 * n + i] * __builtin_amdgcn_rcpf(fmaxf(q1[4 * n + i], 1e-30f));
                    } else {
                        float v[8];
#pragma unroll
                        for (int n = 0; n < 2; ++n)
#pragma unroll
                            for (int i = 0; i < 4; ++i) v[4 * n + i] = acc[ai][bj][m][n][i] * fmaxf(q1[4 * n + i], 1e-30f);
                        uint4 w; w.x = pg8::cvt_pk_bf16(v[0], v[1]); w.y = pg8::cvt_pk_bf16(v[2], v[3]); w.z = pg8::cvt_pk_bf16(v[4], v[5]); w.w = pg8::cvt_pk_bf16(v[6], v[7]);
                        *(uint4*)(Y + row * 1024 + col) = w;
                    }
                }
            }
        return u.z == 0;
    }
};
struct EpiResid {
    const float* X; bf16* O;
    __device__ __forceinline__ bool operator()(pg8::f32x4 (&acc)[2][2][4][2], const pg8::Unit& u, int wr, int wc, int fr_, int fq_) const {
        int fr = fr_, fq = fq_; asm volatile("" : "+v"(fr), "+v"(fq));
        const int row0 = u.pm * 256 + wr * 64 + fr, col0 = u.pn * 256 + wc * 32 + 8 * fq;
#pragma unroll
        for (int ai = 0; ai < 2; ++ai)
#pragma unroll
            for (int m = 0; m < 4; ++m) {
                const size_t row = (size_t)(row0 + ai * 128 + m * 16);
#pragma unroll
                for (int bj = 0; bj < 2; ++bj) { const size_t off = row * 1024 + col0 + bj * 128;
                    const float4 x0 = *(const float4*)(X + off), x1 = *(const float4*)(X + off + 4); const pg8::f32x4 a0 = acc[ai][bj][m][0], a1 = acc[ai][bj][m][1];
                    uint4 w; w.x = pk2bf(x0.x + a0[0], x0.y + a0[1]); w.y = pk2bf(x0.z + a0[2], x0.w + a0[3]); w.z = pk2bf(x1.x + a1[0], x1.y + a1[1]); w.w = pk2bf(x1.z + a1[2], x1.w + a1[3]);
                    *(uint4*)(O + off) = w; }
            }
        return false;
    }
};

struct EpiF32 {
    float* O; int ldc;
    __device__ __forceinline__ bool operator()(pg8::f32x4 (&acc)[2][2][4][2], const pg8::Unit& u, int wr, int wc, int fr_, int fq_) const {
        int fr = fr_, fq = fq_; asm volatile("" : "+v"(fr), "+v"(fq));
        const int row0 = u.pm * 256 + wr * 64 + fr, col0 = u.pn * 256 + wc * 32 + 8 * fq;
#pragma unroll
        for (int ai = 0; ai < 2; ++ai)
#pragma unroll
            for (int m = 0; m < 4; ++m)
#pragma unroll
                for (int bj = 0; bj < 2; ++bj)
#pragma unroll
                    for (int n = 0; n < 2; ++n) { const pg8::f32x4 a = acc[ai][bj][m][n];
                        *(float4*)(O + (size_t)(row0 + ai * 128 + m * 16) * ldc + col0 + bj * 128 + 4 * n) = make_float4(a[0], a[1], a[2], a[3]); }
        return false;
    }
};
struct SchedCmp { int c;
    __device__ __forceinline__ bool next(int i, pg8::Unit& u) const { if (i > 0 || c >= 32) return false; u.pm = c >> 1; u.pn = c & 1; u.z = c >> 4; return true; } };

__device__ __forceinline__ float4 posb_sum(const float* p) { float4 a = *(const float4*)p;
#pragma unroll
    for (int sl = 1; sl < 8; ++sl) { const float4 b = *(const float4*)(p + sl * 512); a.x += b.x; a.y += b.y; a.z += b.z; a.w += b.w; }
    return a; }

__device__ __forceinline__ void tr_item(const float* src, int ldn, int k0, int n0, int nvalid, bf16* dst, int ldk, int r0, LAS float* scr, int lane, const float* kgain = nullptr) {
    const int nn = lane & 31;
    float tv[32];
#pragma unroll
    for (int i = 0; i < 32; ++i) { const int kk = 2 * i + (lane >> 5); tv[i] = (nn < nvalid) ? __builtin_nontemporal_load(src + (size_t)(k0 + kk) * ldn + n0 + nn) : 0.f; }
#pragma unroll
    for (int i = 0; i < 32; ++i) { const int kk = 2 * i + (lane >> 5); scr[kk * 33 + nn] = kgain ? tv[i] * kgain[k0 + kk] : tv[i]; }
    asm volatile("s_waitcnt lgkmcnt(0)" ::: "memory");
    const int cch = lane & 7;
#pragma unroll
    for (int j = 0; j < 4; ++j) { const int n = (lane >> 3) + 8 * j; const LAS float* sp = scr + (8 * cch) * 33 + n;
        uint4 o; o.x = pg8::cvt_pk_bf16(sp[0 * 33], sp[1 * 33]); o.y = pg8::cvt_pk_bf16(sp[2 * 33], sp[3 * 33]); o.z = pg8::cvt_pk_bf16(sp[4 * 33], sp[5 * 33]); o.w = pg8::cvt_pk_bf16(sp[6 * 33], sp[7 * 33]);
        *(uint4*)(dst + (size_t)(r0 + n) * ldk + k0 + 8 * cch) = o; }
    asm volatile("s_waitcnt lgkmcnt(0)" ::: "memory");
}


namespace att {
typedef short bf16x8 __attribute__((ext_vector_type(8)));
typedef short s16x4 __attribute__((ext_vector_type(4)));
typedef short v4i16_t __attribute__((ext_vector_type(4)));
typedef float f32x16 __attribute__((ext_vector_type(16)));
typedef unsigned u32x4 __attribute__((ext_vector_type(4)));
typedef float f32x4v __attribute__((ext_vector_type(4)));
constexpr float C2 = 0.125f * 1.4426950408889634f;
constexpr float LOG2E = 1.4426950408889634f;
constexpr float NEGB = -1e30f, MFLOOR = -1e4f;
__device__ __forceinline__ int crow(int r, int hi) { return (r & 3) + 8 * (r >> 2) + 4 * hi; }
__device__ __forceinline__ s16x4 vtr(const LAS char* p) { return __builtin_bit_cast(s16x4, __builtin_amdgcn_ds_read_tr16_b64_v4i16((LAS v4i16_t*)p)); }
typedef float f32x2_t __attribute__((ext_vector_type(2))); typedef __bf16 bf16x2_t __attribute__((ext_vector_type(2)));
__device__ __forceinline__ unsigned cvtpk(float lo, float hi) { const f32x2_t v = {lo, hi}; const bf16x2_t b = __builtin_convertvector(v, bf16x2_t); return __builtin_bit_cast(unsigned, b); }
#define ATT_WAIT_BAR() asm volatile("s_waitcnt vmcnt(0) lgkmcnt(0)\n\ts_barrier" ::: "memory")

template <int NKB> __device__ __forceinline__ void stage_img(LAS unsigned char* dst, const unsigned char* src, int wid, int lane) {
#pragma unroll
    for (int c = 0; c < (NKB + 7) / 8; ++c) { const int pc = wid + 8 * c;
        if (NKB % 8 == 0 || pc < NKB) __builtin_amdgcn_global_load_lds((const unsigned*)(src + pc * 1024 + lane * 16), (LAS unsigned*)(dst + pc * 1024), 16, 0, 0); }
}
__device__ __forceinline__ void qk_tile(f32x16& p0, f32x16& p1, const LAS unsigned char* kt, int ch0, const bf16x8 (&qf)[4], int r32, int hi) {
    const LAS unsigned char* kb = kt + (ch0 + hi) * 1024 + r32 * 16;
    p0 = (f32x16){0.f, 0.f, 0.f, 0.f, 0.f, 0.f, 0.f, 0.f, 0.f, 0.f, 0.f, 0.f, 0.f, 0.f, 0.f, 0.f}; p1 = p0;
#pragma unroll
    for (int d0 = 0; d0 < 4; ++d0) {
        const bf16x8 a0 = *(const LAS bf16x8*)(kb + d0 * 2048), a1 = *(const LAS bf16x8*)(kb + d0 * 2048 + 512);
        p0 = __builtin_amdgcn_mfma_f32_32x32x16_bf16(a0, qf[d0], p0, 0, 0, 0);
        p1 = __builtin_amdgcn_mfma_f32_32x32x16_bf16(a1, qf[d0], p1, 0, 0, 0);
    }
}
template <int EB> __device__ __forceinline__ void pv_tile(f32x16 (&o)[EB], const LAS unsigned char* vt, const f32x16& p0, const f32x16& p1, int lane) {
    const int hi = lane >> 5;
    const LAS char* vb = (const LAS char*)vt + ((lane >> 4) & 1) * 32 + (lane & 3) * 8 + (4 * hi + ((lane & 15) >> 2)) * 64;
#pragma unroll
    for (int ks = 0; ks < 4; ++ks) {
        s16x4 lo[EB], hh[EB];
#pragma unroll
        for (int eb = 0; eb < EB; ++eb) { lo[eb] = vtr(vb + eb * 4096 + ks * 1024); hh[eb] = vtr(vb + eb * 4096 + ks * 1024 + 512); }
        const f32x16& p = (ks < 2) ? p0 : p1; const int rb = (ks & 1) * 8;
        const u32x4 w = (u32x4){cvtpk(p[rb + 0], p[rb + 1]), cvtpk(p[rb + 2], p[rb + 3]), cvtpk(p[rb + 4], p[rb + 5]), cvtpk(p[rb + 6], p[rb + 7])};
        const bf16x8 pa = __builtin_bit_cast(bf16x8, w);
#pragma unroll
        for (int eb = 0; eb < EB; ++eb) {
            const bf16x8 vf = (bf16x8){lo[eb][0], lo[eb][1], lo[eb][2], lo[eb][3], hh[eb][0], hh[eb][1], hh[eb][2], hh[eb][3]};
            o[eb] = __builtin_amdgcn_mfma_f32_32x32x16_bf16(pa, vf, o[eb], 0, 0, 0);
        }
    }
}
template <bool BIAS, bool CAUSAL, bool BAND> __device__ __forceinline__ void bias_mask(f32x16& p0, f32x16& p1, const LAS float* bl, int qabs, int kt0, int hi) {
#pragma unroll
    for (int r = 0; r < 16; ++r) {
        const int d0 = qabs - (kt0 + crow(r, hi)), d1 = d0 - 32;
        if (BIAS) { p0[r] += bl[d0 < 0 ? 0 : (d0 > 255 ? 255 : d0)]; p1[r] += bl[d1 < 0 ? 0 : (d1 > 255 ? 255 : d1)]; }
        if (CAUSAL) { if (d0 < 0) p0[r] = NEGB; if (d1 < 0) p1[r] = NEGB; }
        if (BAND) { if (d0 >= 512) p0[r] = NEGB; if (d1 >= 512) p1[r] = NEGB; }
    }
}
__device__ __forceinline__ void bias_vec(f32x16& p0, f32x16& p1, const LAS float* rt, int e0, int hi) {
    const int a = (-e0) & 3;
    const LAS float* bp = rt + a * 320 + (208 - e0 - a) + 4 * hi;
#pragma unroll
    for (int g4 = 0; g4 < 4; ++g4) { const f32x4v v0 = *(const LAS f32x4v*)(bp + 8 * g4), v1 = *(const LAS f32x4v*)(bp + 8 * g4 + 32);
        p0[4 * g4] += v0[0]; p0[4 * g4 + 1] += v0[1]; p0[4 * g4 + 2] += v0[2]; p0[4 * g4 + 3] += v0[3];
        p1[4 * g4] += v1[0]; p1[4 * g4 + 1] += v1[1]; p1[4 * g4 + 2] += v1[2]; p1[4 * g4 + 3] += v1[3]; }
}
constexpr float THR = 8.f;
__device__ __forceinline__ float max3f(float a, float b, float c) { return fmaxf(fmaxf(a, b), c); }
template <int EB> __device__ __forceinline__ void softmax_step(f32x16& p0, f32x16& p1, float& m, float& l, f32x16 (&o)[EB], LAS float* wsf, int r32, int hi) {
    if (__any(m != 0.f)) {
#pragma unroll
        for (int r = 0; r < 16; ++r) { p0[r] -= m; p1[r] -= m; }
    }
    float ra = max3f(p0[0], p0[1], p1[0]), rb2 = max3f(p0[2], p0[3], p1[1]); ra = max3f(ra, p1[2], p1[3]);
#pragma unroll
    for (int r = 4; r < 16; r += 4) { ra = max3f(ra, p0[r], p0[r + 1]); rb2 = max3f(rb2, p0[r + 2], p0[r + 3]); ra = max3f(ra, p1[r], p1[r + 1]); rb2 = max3f(rb2, p1[r + 2], p1[r + 3]); }
    float rm = fmaxf(ra, rb2);
    if (__any(rm > THR)) {
        rm = fmaxf(rm, __shfl_xor(rm, 32));
        const float dl = rm > THR ? rm : 0.f;
        const float al = __builtin_amdgcn_exp2f(-dl);
        m += dl; l *= al;
#pragma unroll
        for (int r = 0; r < 16; ++r) { p0[r] -= dl; p1[r] -= dl; }
        if (hi == 0) wsf[r32] = al;
#pragma unroll
        for (int g = 0; g < 4; ++g) { const f32x4v a4 = *(const LAS f32x4v*)(wsf + 8 * g + 4 * hi);
#pragma unroll
            for (int eb = 0; eb < EB; ++eb) { o[eb][4 * g + 0] *= a4.x; o[eb][4 * g + 1] *= a4.y; o[eb][4 * g + 2] *= a4.z; o[eb][4 * g + 3] *= a4.w; } }
    }
    float s0 = 0.f, s1 = 0.f;
#pragma unroll
    for (int r = 0; r < 16; ++r) { p0[r] = __builtin_amdgcn_exp2f(p0[r]); p1[r] = __builtin_amdgcn_exp2f(p1[r]); s0 += p0[r]; s1 += p1[r]; }
    l += s0 + s1;
}
template <int EB> __device__ __forceinline__ void scale_rows(f32x16 (&o)[EB], float f, LAS float* wsf, int r32, int hi) {
    if (hi == 0) wsf[r32] = f;
#pragma unroll
    for (int g = 0; g < 4; ++g) { const f32x4v a4 = *(const LAS f32x4v*)(wsf + 8 * g + 4 * hi);
#pragma unroll
        for (int eb = 0; eb < EB; ++eb) { o[eb][4 * g + 0] *= a4.x; o[eb][4 * g + 1] *= a4.y; o[eb][4 * g + 2] *= a4.z; o[eb][4 * g + 3] *= a4.w; } }
}

struct DiffArgs { const bf16 *Q, *K, *V; bf16* O; const float* biasv; const float* out_gain; float lam; };
__device__ __forceinline__ void diff_unit(LAS unsigned char* lds, const DiffArgs& A, int b, int h, int qt) {
    int tid_ = threadIdx.x; asm volatile("" : "+v"(tid_));
    const int tid = tid_, lane = tid & 63, r32 = lane & 31, hi = lane >> 5, wid = __builtin_amdgcn_readfirstlane(tid >> 6);
    const int cs = wid >> 2, wq = wid & 3, q0 = qt * 128, qw0 = q0 + wq * 32, qabs = qw0 + r32;
    LAS float* bl = (LAS float*)(lds + 81920);
    LAS float* wsf = (LAS float*)(lds + 83968) + wid * 64;
    const size_t rowb = (size_t)b * S;
    LAS float* rt = (LAS float*)(lds + 86016);
    for (int i = tid; i < 1280; i += 512) rt[i] = A.biasv[(8 + h) * 1280 + i];
    const unsigned char* Kh = (const unsigned char*)A.K + (size_t)(b * 4 + h) * 32 * 16384; const unsigned char* Vh = (const unsigned char*)A.V + (size_t)(b * 4 + h) * 32 * 16384;
    const int NT = (q0 + 128) / 64;
    stage_img<16>(lds, Kh, wid, lane); stage_img<16>(lds + 49152, Vh, wid, lane);
    stage_img<16>(lds + 16384, Kh + 16384, wid, lane);
    bf16x8 qf[4];
    { const bf16* qp = A.Q + (rowb + qabs) * 512 + h * 128 + cs * 64 + hi * 8;
#pragma unroll
      for (int d0 = 0; d0 < 4; ++d0) qf[d0] = *(const bf16x8*)(qp + d0 * 16); }
    f32x16 o[4];
#pragma unroll
    for (int eb = 0; eb < 4; ++eb) o[eb] = (f32x16){0.f, 0.f, 0.f, 0.f, 0.f, 0.f, 0.f, 0.f, 0.f, 0.f, 0.f, 0.f, 0.f, 0.f, 0.f, 0.f};
    float m = 0.f, l = 0.f;
    ATT_WAIT_BAR();
    if (wid >= 4) __builtin_amdgcn_s_setprio(1);
    f32x16 n0, n1;
    qk_tile(n0, n1, lds, cs * 8, qf, r32, hi);
    int kb_cur = 0, kb_nxt = 16384, kb_fre = 32768;
    for (int t = 0; t < NT; ++t) {
        if (t + 2 < NT) stage_img<16>(lds + kb_fre, Kh + (size_t)(t + 2) * 16384, wid, lane);
        if (t + 1 < NT) stage_img<16>(lds + 49152 + ((t + 1) & 1) * 16384, Vh + (size_t)(t + 1) * 16384, wid, lane);
        const int kt0 = t * 64;
        if (kt0 <= qw0 + 31) {
            f32x16 p0 = n0, p1 = n1;
            if (t + 1 < NT && kt0 + 64 <= qw0 + 31) qk_tile(n0, n1, lds + kb_nxt, cs * 8, qf, r32, hi);
            const bool causal = (kt0 + 63 > qw0), near_ = (qw0 - (kt0 + 63) < 113);
            if (causal || near_) bias_vec(p0, p1, rt, qabs - kt0, hi);
            softmax_step<4>(p0, p1, m, l, o, wsf, r32, hi);
            pv_tile<4>(o, lds + 49152 + (t & 1) * 16384, p0, p1, lane);
        }
        ATT_WAIT_BAR();
        { const int tmp = kb_cur; kb_cur = kb_nxt; kb_nxt = kb_fre; kb_fre = tmp; }
    }
    __builtin_amdgcn_s_setprio(0);
    l += __shfl_xor(l, 32);
    scale_rows<4>(o, (cs ? A.lam : 1.f) / l, wsf, r32, hi);
    LAS float* xch = (LAS float*)lds + (size_t)wq * 4096;
    if (cs == 1) {
#pragma unroll
        for (int eb = 0; eb < 4; ++eb)
#pragma unroll
            for (int r = 0; r < 16; ++r) xch[crow(r, hi) * 128 + eb * 32 + r32] = o[eb][r];
    }
    ATT_WAIT_BAR();
    if (cs == 0) {
        float ss[16];
#pragma unroll
        for (int r = 0; r < 16; ++r) ss[r] = 0.f;
#pragma unroll
        for (int eb = 0; eb < 4; ++eb)
#pragma unroll
            for (int r = 0; r < 16; ++r) { o[eb][r] -= xch[crow(r, hi) * 128 + eb * 32 + r32]; ss[r] += o[eb][r] * o[eb][r]; }
#pragma unroll
        for (int r = 0; r < 16; ++r) {
#pragma unroll
            for (int sft = 1; sft < 32; sft <<= 1) ss[r] += __shfl_xor(ss[r], sft);
            ss[r] = rsqrtf(ss[r] * (1.f / 128.f) + RMS_EPS) * (1.f - LAMBDA_INIT);
        }
        int hi_ = hi, r32_ = r32; asm volatile("" : "+v"(hi_), "+v"(r32_));
        bf16* op = A.O + (rowb + qw0 + 4 * hi_) * 512 + h * 128 + r32_;
#pragma unroll
        for (int eb = 0; eb < 4; ++eb) { const float gn = A.out_gain[eb * 32 + r32_];
#pragma unroll
            for (int r = 0; r < 16; ++r) op[(size_t)((r & 3) + 8 * (r >> 2)) * 512 + eb * 32] = f2bf(o[eb][r] * ss[r] * gn); }
    }
    ATT_WAIT_BAR();
}

struct NsaArgs { const bf16 *Q, *KS, *VS, *KW, *VW, *KC, *VC; const float* GN; bf16* O; const float* rel_bias; const float* biasv; };
__device__ __forceinline__ void imp_tile(const f32x16& p, int gbase, LAS float* ip, float inv, int hi, float& prevR) {
    float Av[4], Rv[4];
#pragma unroll
    for (int gq = 0; gq < 4; ++gq) { const float c3 = 0.5f * p[4 * gq + 3]; Av[gq] = p[4 * gq] + p[4 * gq + 1] + p[4 * gq + 2] + c3; Rv[gq] = __shfl_xor(c3, 32); }
#pragma unroll
    for (int gq = 0; gq < 4; ++gq) { const float add = hi ? Rv[gq] : (gq > 0 ? Rv[gq > 0 ? gq - 1 : 0] : prevR); ip[2 * (gbase + gq)] = (Av[gq] + add) * inv; }
    prevR = Rv[3];
}

__device__ __forceinline__ int cmp_class(int qw0, int n0) { return (16 * n0 > qw0) ? 2 : ((qw0 - 16 * (n0 + 31) - 31 >= 113) ? 0 : 1); }
__device__ __forceinline__ void cmp_bm1(f32x16& p, const LAS float* bl, int qabs, int n0, int hi) {
#pragma unroll
    for (int r = 0; r < 16; ++r) { const int d = qabs - 16 * (n0 + crow(r, hi)) - 31; p[r] += bl[d < 0 ? 0 : (d > 255 ? 255 : d)]; if (d < 0) p[r] = NEGB; }
}
__device__ __forceinline__ void cmp_pass(LAS unsigned char* lds, const bf16x8 (&qf)[4], const LAS float* bl, LAS float* ip, bool need_sel, float mref, int qw0, int qabs,
                                         int lane, int r32, int hi, f32x16 (&o)[2], float& l, float& rmax) {
    l = 0.f; rmax = NEGB; float prevR = 0.f;
    o[0] = (f32x16){0.f, 0.f, 0.f, 0.f, 0.f, 0.f, 0.f, 0.f, 0.f, 0.f, 0.f, 0.f, 0.f, 0.f, 0.f, 0.f}; o[1] = o[0];
#pragma unroll
    for (int tl = 0; tl < 2; ++tl) {
        const int c0 = cmp_class(qw0, 64 * tl), c1 = cmp_class(qw0, 64 * tl + 32);
        if (c0 == 2) {
            if (need_sel) {
#pragma unroll
                for (int gq = 0; gq < 8; ++gq) ip[2 * (8 * tl + gq)] = (gq == 0 && hi == 0) ? prevR : 0.f; }
            prevR = 0.f;
        } else {
            f32x16 p0, p1;
            qk_tile(p0, p1, lds + tl * 16384, 0, qf, r32, hi);
            if (c0 == 1) cmp_bm1(p0, bl, qabs, 64 * tl, hi);
            if (c1 == 1) cmp_bm1(p1, bl, qabs, 64 * tl + 32, hi);
            else if (c1 == 2) { p1 = (f32x16){NEGB, NEGB, NEGB, NEGB, NEGB, NEGB, NEGB, NEGB, NEGB, NEGB, NEGB, NEGB, NEGB, NEGB, NEGB, NEGB}; }
            float ra = max3f(p0[0], p0[1], p1[0]), rb2 = max3f(p0[2], p0[3], p1[1]); ra = max3f(ra, p1[2], p1[3]);
#pragma unroll
            for (int r = 4; r < 16; r += 4) { ra = max3f(ra, p0[r], p0[r + 1]); rb2 = max3f(rb2, p0[r + 2], p0[r + 3]); ra = max3f(ra, p1[r], p1[r + 1]); rb2 = max3f(rb2, p1[r + 2], p1[r + 3]); }
            rmax = max3f(rmax, ra, rb2);
            float s0 = 0.f, s1 = 0.f;
#pragma unroll
            for (int r = 0; r < 16; ++r) { p0[r] = __builtin_amdgcn_exp2f(p0[r] - mref); p1[r] = __builtin_amdgcn_exp2f(p1[r] - mref); s0 += p0[r]; s1 += p1[r]; }
            l += s0 + s1;
            if (need_sel) { imp_tile(p0, 8 * tl, ip, 1.f, hi, prevR); imp_tile(p1, 8 * tl + 4, ip, 1.f, hi, prevR); }
            pv_tile<2>(o, lds + tl * 16384 + 8192, p0, p1, lane);
        }
    }
}
__device__ __forceinline__ void nsa_unit(LAS unsigned char* lds, const NsaArgs& A, int b, int g, int qt) {
    int tid_ = threadIdx.x; asm volatile("" : "+v"(tid_));
    const int tid = tid_, wid = __builtin_amdgcn_readfirstlane(tid >> 6);
    int lane = tid & 63, r32 = lane & 31, hi = lane >> 5;
#define NSA_RELANE() do { asm volatile("" : "+v"(lane)); r32 = lane & 31; hi = lane >> 5; qabs = qw0 + r32; } while (0)
    const int hh = wid >> 1, head = g * 4 + hh, q0 = qt * 64, qw0 = q0 + (wid & 1) * 32; int qabs = qw0 + r32;
    LAS float* bl = (LAS float*)(lds + 32768) + hh * 256;
    LAS float* wsf = (LAS float*)(lds + 36864) + wid * 64;
    LAS float* ipart = (LAS float*)(lds + 40960);
    LAS float* itot = (LAS float*)(lds + 73728);
    LAS unsigned* sell = (LAS unsigned*)(lds + 81920);
    LAS float* invs = (LAS float*)(lds + 82176);
    LAS f32x16* otl = (LAS f32x16*)(lds + 86016) + (size_t)wid * 128 + lane;
    const size_t rowb = (size_t)b * S;
    for (int i = tid; i < 1024; i += 512) ((LAS float*)(lds + 32768))[i] = A.rel_bias[g * 1024 + i];
    { const unsigned char* Kc = (const unsigned char*)A.KC + (size_t)(b * 2 + g) * 16384; const unsigned char* Vc = (const unsigned char*)A.VC + (size_t)(b * 2 + g) * 16384;
      stage_img<8>(lds, Kc, wid, lane); stage_img<8>(lds + 8192, Vc, wid, lane);
      stage_img<8>(lds + 16384, Kc + 8192, wid, lane); stage_img<8>(lds + 24576, Vc + 8192, wid, lane); }
    bf16x8 qf[4];
    { const bf16* qp = A.Q + (rowb + qabs) * 512 + head * 64 + hi * 8;
#pragma unroll
      for (int d0 = 0; d0 < 4; ++d0) qf[d0] = *(const bf16x8*)(qp + d0 * 16); }
    ATT_WAIT_BAR();
    const bool need_sel = (qt >= 16);
    {
        NSA_RELANE();
        LAS float* ip = ipart + ((size_t)hh * 64 + (wid & 1) * 32 + r32) * 32 + hi;
        f32x16 o[2]; float l, rmax;
        cmp_pass(lds, qf, bl, ip, need_sel, 0.f, qw0, qabs, lane, r32, hi, o, l, rmax);
        if (__any(rmax > 64.f)) {
            rmax = fmaxf(rmax, __shfl_xor(rmax, 32));
            float dummy;
            cmp_pass(lds, qf, bl, ip, need_sel, fmaxf(rmax, 0.f), qw0, qabs, lane, r32, hi, o, l, dummy);
        }
        l += __shfl_xor(l, 32);
        const float inv = l > 0.f ? 1.f / l : 0.f;
        if (hi == 0) invs[hh * 64 + (wid & 1) * 32 + r32] = inv;
        { int qa = qabs; asm volatile("" : "+v"(qa)); scale_rows<2>(o, A.GN[(rowb + qa) * 24 + head] * inv, wsf, r32, hi); }
        otl[0] = o[0]; otl[64] = o[1];
    }
    ATT_WAIT_BAR();
    unsigned selq, un;
    if (need_sel) {
        {
            const int q = tid >> 3, j4 = (tid & 7) * 4;
#pragma unroll
            for (int jj = 0; jj < 4; ++jj) { const int j = j4 + jj; itot[q * 32 + j] = ((ipart[(0 * 64 + q) * 32 + j] * invs[q] + ipart[(1 * 64 + q) * 32 + j] * invs[64 + q]) + ipart[(2 * 64 + q) * 32 + j] * invs[128 + q]) + ipart[(3 * 64 + q) * 32 + j] * invs[192 + q]; }
        }
        ATT_WAIT_BAR();
        {
            const int j = lane & 31;
#pragma unroll 1
            for (int rd = 0; rd < 4; ++rd) {
                const int q = wid * 8 + rd * 2 + hi;
                const bool vj = j <= qt, fj = (j == 0) || (j == qt) || (j == qt - 1);
                const float sj = vj ? itot[q * 32 + j] + (fj ? 1e4f : 0.f) : -1e30f;
                int cnt = 0;
#pragma unroll 4
                for (int k = 0; k < 32; ++k) {
                    const bool vk = k <= qt, fk = (k == 0) || (k == qt) || (k == qt - 1);
                    const float sk = vk ? itot[q * 32 + k] + (fk ? 1e4f : 0.f) : -1e30f;
                    cnt += (sk > sj || (sk == sj && k < j)) ? 1 : 0;
                }
                const unsigned long long bal = __ballot(cnt < 16);
                if (lane == 0) sell[q] = (unsigned)bal;
                if (lane == 32) sell[q] = (unsigned)(bal >> 32);
            }
        }
        ATT_WAIT_BAR();
        NSA_RELANE();
        selq = sell[(wid & 1) * 32 + r32];
        un = sell[lane];
#pragma unroll
        for (int sft = 1; sft < 64; sft <<= 1) un |= __shfl_xor(un, sft);
        un = __builtin_amdgcn_readfirstlane(un) & (qt >= 31 ? 0xffffffffu : ((2u << qt) - 1u));
    } else {
        selq = (2u << qt) - 1u; un = selq;
    }
    for (int i = tid; i < 5120; i += 512) ipart[i] = A.biasv[(size_t)g * 5120 + i];
    const LAS float* rt = ipart + hh * 1280;
    {
        NSA_RELANE();
        const unsigned char* Kg = (const unsigned char*)A.KS + (size_t)(b * 2 + g) * 32 * 8192; const unsigned char* Vg = (const unsigned char*)A.VS + (size_t)(b * 2 + g) * 32 * 8192;
        f32x16 o[2]; o[0] = (f32x16){0.f, 0.f, 0.f, 0.f, 0.f, 0.f, 0.f, 0.f, 0.f, 0.f, 0.f, 0.f, 0.f, 0.f, 0.f, 0.f}; o[1] = o[0];
        float m = 0.f, l = 0.f;
        unsigned rem = un; int j = __builtin_ctz(rem); rem &= rem - 1u; int it = 0;
        stage_img<8>(lds, Kg + (size_t)j * 8192, wid, lane); stage_img<8>(lds + 8192, Vg + (size_t)j * 8192, wid, lane);
        ATT_WAIT_BAR();
        for (;;) {
            LAS unsigned char* cur = lds + (it & 1) * 16384; LAS unsigned char* nxt = lds + ((it + 1) & 1) * 16384;
            const int jn = rem ? __builtin_ctz(rem) : -1;
            if (jn >= 0) { rem &= rem - 1u; stage_img<8>(nxt, Kg + (size_t)jn * 8192, wid, lane); stage_img<8>(nxt + 8192, Vg + (size_t)jn * 8192, wid, lane); }
            const int kt0 = j * 64;
            if (kt0 <= qw0 + 31 && __any((selq >> j) & 1u)) {
                f32x16 p0, p1;
                qk_tile(p0, p1, cur, 0, qf, r32, hi);
                const bool causal = (kt0 + 63 > qw0), near_ = (qw0 - (kt0 + 63) < 113);
                if (causal || near_) bias_vec(p0, p1, rt, qabs - kt0, hi);
                if (!__all((selq >> j) & 1u)) {
                    const float off = ((selq >> j) & 1u) ? 0.f : NEGB;
#pragma unroll
                    for (int r = 0; r < 16; ++r) { p0[r] += off; p1[r] += off; } }
                softmax_step<2>(p0, p1, m, l, o, wsf, r32, hi);
                pv_tile<2>(o, cur + 8192, p0, p1, lane);
            }
            ATT_WAIT_BAR();
            if (jn < 0) break;
            j = jn; ++it;
        }
        l += __shfl_xor(l, 32);
        { int qa = qabs; asm volatile("" : "+v"(qa)); scale_rows<2>(o, A.GN[(rowb + qa) * 24 + 8 + head] / l, wsf, r32, hi); }
        otl[0] = otl[0] + o[0]; otl[64] = otl[64] + o[1];
    }
    f32x16 ot[2];
    {
        NSA_RELANE();
        const unsigned char* Kg = (const unsigned char*)A.KW + (size_t)(b * 2 + g) * 32 * 8192; const unsigned char* Vg = (const unsigned char*)A.VW + (size_t)(b * 2 + g) * 32 * 8192;
        f32x16 o[2]; o[0] = (f32x16){0.f, 0.f, 0.f, 0.f, 0.f, 0.f, 0.f, 0.f, 0.f, 0.f, 0.f, 0.f, 0.f, 0.f, 0.f, 0.f}; o[1] = o[0];
        float m = 0.f, l = 0.f;
        const int j0 = qt >= 8 ? qt - 8 : 0;
        stage_img<8>(lds, Kg + (size_t)j0 * 8192, wid, lane); stage_img<8>(lds + 8192, Vg + (size_t)j0 * 8192, wid, lane);
        ATT_WAIT_BAR();
        for (int j = j0; j <= qt; ++j) {
            const int it = j - j0;
            LAS unsigned char* cur = lds + (it & 1) * 16384; LAS unsigned char* nxt = lds + ((it + 1) & 1) * 16384;
            if (j < qt) { stage_img<8>(nxt, Kg + (size_t)(j + 1) * 8192, wid, lane); stage_img<8>(nxt + 8192, Vg + (size_t)(j + 1) * 8192, wid, lane); }
            const int kt0 = j * 64;
            if (kt0 <= qw0 + 31) {
                f32x16 p0, p1;
                qk_tile(p0, p1, cur, 0, qf, r32, hi);
                const bool causal = (kt0 + 63 > qw0), near_ = (qw0 - (kt0 + 63) < 113), band = (qw0 + 31 - kt0 >= 512);
                if (causal || near_) bias_vec(p0, p1, rt, qabs - kt0, hi);
                else if (band) bias_mask<false, false, true>(p0, p1, bl, qabs, kt0, hi);
                softmax_step<2>(p0, p1, m, l, o, wsf, r32, hi);
                pv_tile<2>(o, cur + 8192, p0, p1, lane);
            }
            ATT_WAIT_BAR();
        }
        l += __shfl_xor(l, 32);
        { int qa = qabs; asm volatile("" : "+v"(qa)); scale_rows<2>(o, A.GN[(rowb + qa) * 24 + 16 + head] / l, wsf, r32, hi); }
        ot[0] = otl[0] + o[0]; ot[1] = otl[64] + o[1];
    }
    {   int hi_ = hi, r32_ = r32; asm volatile("" : "+v"(hi_), "+v"(r32_));
        bf16* op = A.O + (rowb + qw0 + 4 * hi_) * 512 + head * 64 + r32_;
#pragma unroll
        for (int eb = 0; eb < 2; ++eb)
#pragma unroll
            for (int r = 0; r < 16; ++r) op[(size_t)((r & 3) + 8 * (r >> 2)) * 512 + eb * 32] = f2bf(ot[eb][r]); }
#undef NSA_RELANE
}
}

constexpr int NCLS = 24;
constexpr int CW_CMPD = 10752, CW_FIN = 11008;
constexpr int CW_WQ = 10240;
constexpr int CW_CNT = 8192;
constexpr size_t WS_LIST = 254 * MiB;
constexpr int MISC_OFF = 161792;
constexpr int TAB_OFF = MISC_OFF + 256;
__device__ __forceinline__ void class_experts(int c, int& ea, int& eb) {
    const int g = c / 6, p = c % 6; const int a = p < 3 ? 0 : (p < 5 ? 1 : 2); const int b = p < 3 ? p + 1 : (p < 5 ? p - 1 : 3); ea = g * 4 + a; eb = g * 4 + b; }
__device__ __forceinline__ void moe_build_tab(const unsigned* ctl, LAS int* tab) {
    if (threadIdx.x < 64) {
        const int lane = threadIdx.x;
        const int n = (lane < NCLS) ? (int)__hip_atomic_load(ctl + CW_CNT + 64 * lane, __ATOMIC_RELAXED, __HIP_MEMORY_SCOPE_AGENT) : 0;
        const int nt_ = (n + 255) >> 8;
        int pre = nt_;
#pragma unroll
        for (int o = 1; o < 32; o <<= 1) { const int v = __shfl_up(pre, o); if (lane >= o) pre += v; }
        const int first = pre - nt_;
        if (lane < NCLS) { tab[lane] = first; tab[32 + lane] = n; for (int j = 0; j < nt_; ++j) tab[64 + first + j] = lane; }
        if (lane == NCLS - 1) tab[NCLS] = pre;
    }
    __syncthreads();
}
struct OpsGU { const bf16* H2; const bf16* WGU; const unsigned* LIST; const LAS int* tab; static constexpr int NT = 16, LDB = 1024;
    __device__ __forceinline__ const char* a_base(const pg8::Unit&) const { return (const char*)H2; }
    __device__ __forceinline__ void a_voff(const pg8::Unit& u, const int (&R)[2], const int (&C)[2], unsigned (&out)[2][2]) const {
        const int c = tab[64 + u.pm], n = tab[32 + c], r0 = (u.pm - tab[c]) * 256;
#pragma unroll
        for (int h = 0; h < 2; ++h)
#pragma unroll
            for (int i = 0; i < 2; ++i) { const int r = r0 + h * 128 + R[i]; const unsigned tok = (r < n) ? LIST[(size_t)c * T + r] : 0u; out[h][i] = (tok * 1024u + (unsigned)C[i]) * 2u; } }
    __device__ __forceinline__ void bprep(const pg8::Unit& u, const char*& p0, const char*& p1) const {
        int ea, eb; class_experts(tab[64 + u.pm], ea, eb); const int e = u.z ? eb : ea; p0 = (const char*)(WGU + ((size_t)e * 1024 + u.pn * 256) * 1024); p1 = p0; }
    __device__ static __forceinline__ const char* bat(const char* p0, const char*, int kt) { return p0 + (size_t)kt * 128; } };
constexpr int CW_MQ = 10496;
constexpr int CW_DONE = 12288;
struct SchedGU { const LAS int* tab; int G, vcu;
    __device__ __forceinline__ bool next(int i, pg8::Unit& u) const { const int L = i * G + vcu; if (L >= tab[NCLS] * 8) return false; u.pm = L >> 3; u.z = (L >> 2) & 1; u.pn = L & 3; return true; } };
struct EpiGU { bf16* HID; const unsigned* LIST; const float* ROUTE; const LAS int* tab; unsigned* ctl;
    __device__ __forceinline__ void operator()(const pg8::f32x4 (&acc)[2][2][4][2], const pg8::Unit& u, int wr, int wc, int fr_, int fq_) const {
        int fr = fr_, fq = fq_; asm volatile("" : "+v"(fr), "+v"(fq));
        const int c = tab[64 + u.pm], n = tab[32 + c], r0 = (u.pm - tab[c]) * 256;
        const __amdgpu_buffer_rsrc_t rsrc = __builtin_amdgcn_make_buffer_rsrc((void*)HID, 0, 0x7fffffff, 0x00020000);
#pragma unroll
        for (int ai = 0; ai < 2; ++ai)
#pragma unroll
            for (int m = 0; m < 4; ++m) {
                const int rl = ai * 128 + wr * 64 + m * 16 + fr, r = r0 + rl;
                if (r < n) {
                    const unsigned tok = LIST[(size_t)c * T + r]; const float w = ROUTE[(size_t)tok * 4 + u.z], rs = ROUTE[(size_t)tok * 4 + 3];
                    float v[8];
#pragma unroll
                    for (int nn = 0; nn < 2; ++nn)
#pragma unroll
                        for (int i = 0; i < 4; ++i) { const float gt = acc[ai][0][m][nn][i] * rs, up = acc[ai][1][m][nn][i] * rs; v[4 * nn + i] = gt * __builtin_amdgcn_rcpf(1.f + __builtin_amdgcn_exp2f(-1.4426950408889634f * gt)) * up * w; }
                    uint4 o; o.x = pg8::cvt_pk_bf16(v[0], v[1]); o.y = pg8::cvt_pk_bf16(v[2], v[3]); o.z = pg8::cvt_pk_bf16(v[4], v[5]); o.w = pg8::cvt_pk_bf16(v[6], v[7]);
                    __builtin_amdgcn_raw_buffer_store_b128(__builtin_bit_cast(pg8::u32x4, o), rsrc, (int)(((unsigned)(u.pm * 256 + rl) * 1024u + (unsigned)(u.z * 512 + u.pn * 128 + wc * 32 + 8 * fq)) * 2u), 0, 16);
                }
                asm volatile("" ::: "memory");
            }
        asm volatile("s_waitcnt vmcnt(0)" ::: "memory");
        if (fr == 0 && fq == 0) __hip_atomic_fetch_add(ctl + CW_DONE + 64 * u.pm, 1u, __ATOMIC_RELAXED, __HIP_MEMORY_SCOPE_AGENT);
    }
};
struct OpsDN { const bf16* HID; const bf16* WDN; const LAS int* tab; static constexpr int NT = 16, LDB = 512;
    __device__ __forceinline__ const char* a_base(const pg8::Unit& u) const { return (const char*)(HID + (size_t)u.pm * 256 * 1024); }
    __device__ __forceinline__ void a_voff(const pg8::Unit&, const int (&R)[2], const int (&C)[2], unsigned (&out)[2][2]) const {
#pragma unroll
        for (int h = 0; h < 2; ++h)
#pragma unroll
            for (int i = 0; i < 2; ++i) out[h][i] = (unsigned)((h * 128 + R[i]) * 1024 + C[i]) * 2u; }
    __device__ __forceinline__ void bprep(const pg8::Unit& u, const char*& p0, const char*& p1) const {
        int ea, eb; class_experts(tab[64 + u.pm], ea, eb);
        p0 = (const char*)(WDN + ((size_t)ea * 1024 + u.pn * 256) * 512); p1 = (const char*)(WDN + ((size_t)eb * 1024 + u.pn * 256) * 512); }
    __device__ static __forceinline__ const char* bat(const char* p0, const char* p1, int kt) { return (kt < 8 ? p0 : p1) + (size_t)(kt & 7) * 128; } };
struct SchedDN { const LAS int* tab; unsigned* ctl; int G, vcu;
    __device__ __forceinline__ bool next(int i, pg8::Unit& u) const {
        const int total = tab[NCLS] * 4;
        int L = -1;
        if (i == 0) L = vcu; else if (i == 1) { const int e = G - 1 - vcu; if (G + e < total) L = G + e; }
        if (L < 0 || L >= total) L = -1;
        __builtin_amdgcn_s_barrier();
        if (threadIdx.x == 0 && L >= 0) {
            unsigned* dn = ctl + CW_DONE + 64 * (L >> 2); unsigned sp = 0;
            while (__hip_atomic_load(dn, __ATOMIC_RELAXED, __HIP_MEMORY_SCOPE_AGENT) < 64u) { __builtin_amdgcn_s_sleep(2); if (++sp > (1u << 22)) { atomicAdd(ctl + XB_TMO + CW_BAR, 1u); break; } }
            __builtin_amdgcn_fence(__ATOMIC_ACQUIRE, "agent");
            asm volatile("s_waitcnt vmcnt(0)" ::: "memory");
        }
        __builtin_amdgcn_s_barrier();
        if (L < 0) return false; u.pm = L >> 2; u.pn = L & 3; u.z = 0; return true; } };
struct EpiDN { float* O; const bf16* X2; const unsigned* LIST; const LAS int* tab;
    __device__ __forceinline__ void operator()(const pg8::f32x4 (&acc)[2][2][4][2], const pg8::Unit& u, int wr, int wc, int fr_, int fq_) const {
        int fr = fr_, fq = fq_; asm volatile("" : "+v"(fr), "+v"(fq));
        const int c = tab[64 + u.pm], n = tab[32 + c], r0 = (u.pm - tab[c]) * 256;
#pragma unroll
        for (int ai = 0; ai < 2; ++ai)
#pragma unroll
            for (int m = 0; m < 4; ++m) {
                const int r = r0 + ai * 128 + wr * 64 + m * 16 + fr;
                if (r < n) {
                    const unsigned tok = LIST[(size_t)c * T + r];
#pragma unroll
                    for (int bj = 0; bj < 2; ++bj) { const size_t off = (size_t)tok * 1024 + u.pn * 256 + bj * 128 + wc * 32 + 8 * fq;
                        const uint4 xw = *(const uint4*)(X2 + off); const pg8::f32x4 a0 = acc[ai][bj][m][0], a1 = acc[ai][bj][m][1];
                        const nt_f32x4 y0 = {LO16(xw.x) + a0[0], HI16(xw.x) + a0[1], LO16(xw.y) + a0[2], HI16(xw.y) + a0[3]}, y1 = {LO16(xw.z) + a1[0], HI16(xw.z) + a1[1], LO16(xw.w) + a1[2], HI16(xw.w) + a1[3]};
                        __builtin_nontemporal_store(y0, (nt_f32x4*)(O + off)); __builtin_nontemporal_store(y1, (nt_f32x4*)(O + off + 4)); }
                }
            }
    }
};

constexpr int NTHR = 512;
constexpr int LDS_BYTES = 163840;

__global__ void __launch_bounds__(NTHR, 2) fwd_kernel(Args args) {
    extern __shared__ __attribute__((aligned(16))) unsigned char lds[];
    const int tid = threadIdx.x, lane = tid & 63;
    const int gtid = blockIdx.x * NTHR + tid, nthreads = gridDim.x * NTHR;
    const int gwave = gtid >> 6, nwaves = nthreads >> 6;
    Ctx c; c.a = args; unsigned char* ws = args.ws;

    volatile LAS unsigned* MISC = (volatile LAS unsigned*)((LAS unsigned char*)lds + MISC_OFF);
    if (tid < 32) MISC[tid] = 0u;
    __syncthreads();
    XcdBarrier bar = xcd_barrier_post((unsigned*)(ws + WS_CTL) + CW_BAR, MISC + 8);
    const int lo = args.ph_lo, hi = args.ph_hi;
#ifdef ONLY_PHASE
#define IN(k) ((k) == ONLY_PHASE)
#else
#define IN(k) (lo <= (k) && (k) < hi)
#endif
#define SEAM(k) do { if (IN(k) && IN((k) + 1)) xcd_barrier(bar); } while (0)


    if (IN(0)) {
        for (int t = gwave * 2; t < T; t += nwaves * 2) {
            const float4* xr = (const float4*)(c.x() + (size_t)t * D) + lane;
            float4 v[8]; float s0 = 0.f, s1 = 0.f;
#pragma unroll
            for (int j = 0; j < 8; ++j) v[j] = xr[64 * j];
#pragma unroll
            for (int j = 0; j < 4; ++j) { s0 += v[j].x * v[j].x + v[j].y * v[j].y + v[j].z * v[j].z + v[j].w * v[j].w; s1 += v[4 + j].x * v[4 + j].x + v[4 + j].y * v[4 + j].y + v[4 + j].z * v[4 + j].z + v[4 + j].w * v[4 + j].w; }
            const float r0 = rsqrtf(wave_sum(s0) * (1.f / D) + RMS_EPS), r1 = rsqrtf(wave_sum(s1) * (1.f / D) + RMS_EPS);
#pragma unroll
            for (int j = 0; j < 8; ++j) { const float4 g = ((const float4*)c.norm1_g())[lane + 64 * (j & 3)]; const float r = j < 4 ? r0 : r1;
                uint2 o; o.x = pk2bf(v[j].x * r * g.x, v[j].y * r * g.y); o.y = pk2bf(v[j].z * r * g.z, v[j].w * r * g.w);
                ((uint2*)(c.H1() + (size_t)t * D))[lane + 64 * j] = o; }
        }
        {
            LAS float* scr = (LAS float*)((LAS unsigned char*)lds + (tid >> 6) * 16384);
            constexpr int I_IN = 16 * 160, I_OUT = 16 * 32, I_BR = 8 * 32, I_GU = 16 * 4 * 2 * 4 * 16, I_DN = 16 * 8 * 32, I_C1 = 512;
            for (int it = gwave; it < I_IN + I_OUT + 2 * I_BR + I_GU + I_DN + I_C1; it += nwaves) {
                int r = it;
                if (r < I_IN) { const int kb = r / 160, vb = r % 160, pn = vb >> 3, bj = (vb >> 2) & 1, wc = vb & 3;
                    const ChunkDesc d = chunk_desc(c, pn * 4 + wc); int nv = d.ncols - 32 * bj; nv = nv < 0 ? 0 : (nv > 32 ? 32 : nv);
                    tr_item(c.w_in(), INC, 64 * kb, d.src + 32 * bj, nv, c.WIN(), 1024, 256 * pn + 128 * bj + 32 * wc, scr, lane); continue; }
                r -= I_IN;
                if (r < I_OUT) { tr_item(c.w_out(), 1024, 64 * (r / 32), 32 * (r % 32), 32, c.WOUT(), 1024, 32 * (r % 32), scr, lane); continue; }
                r -= I_OUT;
                if (r < I_BR) { tr_item(c.w_bn(), 1024, 64 * (r / 32), 32 * (r % 32), 32, c.WBN(), 512, 32 * (r % 32), scr, lane); continue; }
                r -= I_BR;
                if (r < I_BR) { tr_item(c.w_bd(), 1024, 64 * (r / 32), 32 * (r % 32), 32, c.WBD(), 512, 32 * (r % 32), scr, lane); continue; }
                r -= I_BR;
                if (r < I_GU) { const int kb = r & 15, blk = (r >> 4) & 3, bj = (r >> 6) & 1, ntile = (r >> 7) & 3, e = r >> 9;
                    tr_item((bj ? c.w_up() : c.w_gate()) + (size_t)e * 1024 * 512, 512, 64 * kb, ntile * 128 + 32 * blk, 32, c.WGU() + (size_t)e * 1024 * 1024, 1024, 256 * ntile + 128 * bj + 32 * blk, scr, lane, c.norm2_g()); continue; }
                r -= I_GU;
                if (r < I_DN) { const int nb = r & 31, kb = (r >> 5) & 7, e = r >> 8;
                    tr_item(c.w_down() + (size_t)e * 512 * 1024, 1024, 64 * kb, 32 * nb, 32, c.WDN() + (size_t)e * 1024 * 512, 512, 32 * nb, scr, lane); continue; }
                r -= I_DN;
                { const int nb = r & 7, kb = (r >> 3) & 15, bot = (r >> 7) & 1, kv = r >> 8;
                    tr_item(c.cmp_w1() + (size_t)kv * 2048 * 256 + (size_t)bot * 1024 * 256, 256, 64 * kb, 32 * nb, 32, c.WC1() + (size_t)kv * 512 * 1024, 1024, bot * 256 + 32 * nb, scr, lane); }
            }
            if (gwave >= nwaves - 64) { const int w = gwave - (nwaves - 64), sl = w & 7, jb = (w >> 3) & 3, kv = w >> 5, j = jb * 64 + lane;
                const float* w1 = c.cmp_w1() + (size_t)kv * 2048 * 256 + (size_t)sl * 256 * 256 + j; const float* pos = c.cmp_pos() + kv * 2048 + sl * 256;
                float a0 = 0.f, a1 = 0.f, a2 = 0.f, a3 = 0.f;
                for (int k = 0; k < 256; k += 4) { a0 += pos[k] * w1[(size_t)k * 256]; a1 += pos[k + 1] * w1[(size_t)(k + 1) * 256]; a2 += pos[k + 2] * w1[(size_t)(k + 2) * 256]; a3 += pos[k + 3] * w1[(size_t)(k + 3) * 256]; }
                c.POSB()[(sl * 2 + kv) * 256 + j] = (a0 + a1) + (a2 + a3); }
            if (gtid >= 8192 && gtid < 8192 + 12 * 1280) { const int i = gtid - 8192, hd = i / 1280, a = (i % 1280) / 320, j = (i % 320) + a, d = 208 - j;
                c.BIASV()[i] = (d < 0) ? -1e30f : (d >= 113 ? 0.f : (c.rel_bias()[t5_bucket(d) * 12 + hd] - c.rel_bias()[31 * 12 + hd]) * 1.4426950408889634f); }
            if (gtid >= 24576 && gtid < 24576 + 1024) { const int k = gtid - 24576; const float g = c.norm2_g()[k];
                const float4 gw = *(const float4*)(c.rg_w() + (size_t)k * 4);
                float w[20] = {gw.x, gw.y, gw.z, gw.w};
#pragma unroll
                for (int i4 = 0; i4 < 4; ++i4) { const float4 ew = *(const float4*)(c.re_w() + (size_t)k * 16 + 4 * i4); w[4 + 4 * i4] = ew.x; w[5 + 4 * i4] = ew.y; w[6 + 4 * i4] = ew.z; w[7 + 4 * i4] = ew.w; }
                bf16* wr = c.WRT() + k;
#pragma unroll
                for (int i = 0; i < 20; ++i) { const float v = w[i] * g; const bf16 h = f2bf(v); wr[(size_t)i * D] = h; wr[(size_t)(20 + i) * D] = f2bf(v - __uint_as_float((unsigned)h << 16)); }
#pragma unroll
                for (int i = 40; i < 48; ++i) wr[(size_t)i * D] = f2bf(0.f); }
            if (gtid >= 4096 && gtid < 4096 + 3072) { const int i = gtid - 4096, hd = i >> 8, d = i & 255; c.BIAS()[i] = (c.rel_bias()[t5_bucket(d) * 12 + hd] - c.rel_bias()[31 * 12 + hd]) * 1.4426950408889634f; }
            if (gtid >= 512 && gtid < 512 + 2048) { const int i = gtid - 512, kv = i >> 10, bg = (i >> 6) & 15, e = i & 63; const size_t tb = ((size_t)bg * 2 + 1) * 4096; if (kv) c.VCMP()[tb + (e >> 5) * 2048 + 3 * 512 + 15 * 32 + (e & 31)] = 0; else c.KCMP()[tb + (e >> 3) * 512 + 63 * 8 + (e & 7)] = 0; }
        }
        if (gwave == 0) {
            const float a = wave_sum(c.diff_lambda()[lane] * c.diff_lambda()[64 + lane]);
            const float b = wave_sum(c.diff_lambda()[128 + lane] * c.diff_lambda()[192 + lane]);
            if (lane == 0) c.LAM()[0] = expf(a) - expf(b) + LAMBDA_INIT;
        }
    }
    xcd_barrier(bar);

    if (IN(1)) {
        pg8::Ops g; g.A0 = c.H1(); g.A1 = c.H1(); g.B0 = c.WIN(); g.B1 = c.WIN(); g.K = 1024;
        pg8::StaticOrder<1> So; So.init(T, 5120, (int)gridDim.x, (int)blockIdx.x);
        EpiInProj E; E.c = c;
        pg8::gemm_phase(( LAS unsigned char*)lds, g, So, E);
    }
    xcd_barrier(bar);

    if (IN(2)) {
        pg8::Ops g; g.A0 = c.CT(); g.A1 = c.CT(); g.B0 = c.WC1(); g.B1 = c.WC1() + 512 * 1024; g.K = 1024;
        SchedCmp So; So.c = (int)blockIdx.x;
        EpiF32 E; E.O = c.U(); E.ldc = 512;
        pg8::gemm_phase((LAS unsigned char*)lds, g, So, E);
        unsigned* ctl = (unsigned*)(ws + WS_CTL);
        volatile LAS int* wq = (volatile LAS int*)((LAS unsigned char*)lds + MISC_OFF + 64);
        if (blockIdx.x < 32 && tid == 0) { __builtin_amdgcn_fence(__ATOMIC_RELEASE, "agent"); asm volatile("s_waitcnt vmcnt(0)" ::: "memory");
            __hip_atomic_fetch_add(ctl + CW_CMPD, 1u, __ATOMIC_RELAXED, __HIP_MEMORY_SCOPE_AGENT); }
        {   att::DiffArgs A; A.Q = c.QD(); A.K = c.KD(); A.V = c.VD(); A.O = c.ODIFF(); A.biasv = c.BIASV(); A.out_gain = c.diff_out_norm(); A.lam = c.LAM()[0];
            for (;;) {
                __syncthreads();
                if (tid == 0) *wq = (int)atomicAdd(ctl + CW_WQ, 1u);
                __syncthreads();
                const int u = *wq;
                if (u >= 512) break;
                att::diff_unit((LAS unsigned char*)lds, A, (u & 31) >> 2, u & 3, 15 - (u >> 5));
            } }
        {   __syncthreads();
            if (tid == 0) { unsigned sp = 0;
                while (__hip_atomic_load(ctl + CW_CMPD, __ATOMIC_RELAXED, __HIP_MEMORY_SCOPE_AGENT) < 32u) { __builtin_amdgcn_s_sleep(2); if (++sp > (1u << 22)) { atomicAdd(ctl + XB_TMO + CW_BAR, 1u); break; } }
                __builtin_amdgcn_fence(__ATOMIC_ACQUIRE, "agent"); asm volatile("s_waitcnt vmcnt(0)" ::: "memory"); }
            __syncthreads();
            LAS float* hid = (LAS float*)((LAS unsigned char*)lds) + (tid >> 6) * 256;
            for (;;) {
                __syncthreads();
                if (tid == 0) *wq = (int)atomicAdd(ctl + CW_WQ + 128, 1u);
                __syncthreads();
                const int q = *wq;
                if (q >= 128) break;
                const int quarter = q & 3, b = (q >> 2) & 7, g = (q >> 5) & 1, kv = q >> 6;
                for (int jj = 0; jj < 4; ++jj) {
                    const int n = quarter * 32 + (tid >> 6) * 4 + jj;
                    if (n >= NCMP) continue;
                    const float* u1 = c.U() + ((size_t)(kv * 2 + g) * 1024 + b * 128 + n) * 512;
                    const float4 t4 = *(const float4*)(u1 + 4 * lane), b4 = *(const float4*)(u1 + 512 + 256 + 4 * lane), p4 = posb_sum(c.POSB() + kv * 256 + 4 * lane);
                    const float hv[4] = {t4.x + b4.x + p4.x, t4.y + b4.y + p4.y, t4.z + b4.z + p4.z, t4.w + b4.w + p4.w};
#pragma unroll
                    for (int i = 0; i < 4; ++i) { const float a = hv[i]; const float uu = 0.7978845608028654f * (a + 0.044715f * a * a * a); hid[4 * lane + i] = 0.5f * a * (1.f + tanhf(uu)); }
                    const float* w2 = c.cmp_w2() + (size_t)kv * 256 * 64 + lane;
                    float o = 0.f;
                    for (int j = 0; j < 256; ++j) o += hid[j] * w2[j * 64];
                    if (kv == 0) { const float ss = wave_sum(o * o); o = o * rsqrtf(ss * (1.f / 64.f) + RMS_EPS) * c.nsa_k_norm()[lane]; }
                    { const int key = n & 63, e = lane; const size_t tb = ((size_t)(b * 2 + g) * 2 + (n >> 6)) * 4096;
                      if (kv) c.VCMP()[tb + (e >> 5) * 2048 + (key >> 4) * 512 + (key & 15) * 32 + (e & 31)] = f2bf(o);
                      else c.KCMP()[tb + (e >> 3) * 512 + key * 8 + (e & 7)] = f2bf(o); }
                }
                asm volatile("s_waitcnt vmcnt(0)" ::: "memory");
                __syncthreads();
                if (tid == 0) { __builtin_amdgcn_fence(__ATOMIC_RELEASE, "agent"); asm volatile("s_waitcnt vmcnt(0)" ::: "memory");
                    __hip_atomic_fetch_add(ctl + CW_FIN + 64 * (b * 2 + g), 1u, __ATOMIC_RELAXED, __HIP_MEMORY_SCOPE_AGENT); }
            } }
        {   att::NsaArgs A; A.Q = c.QN(); A.KS = c.KS(); A.VS = c.VS(); A.KW = c.KW(); A.VW = c.VW(); A.KC = c.KCMP(); A.VC = c.VCMP(); A.GN = c.GN(); A.O = c.ONSAB(); A.rel_bias = c.BIAS(); A.biasv = c.BIASV();
            bool all_seen = false;
            for (;;) {
                __syncthreads();
                if (tid == 0) {
                    const int u = (int)atomicAdd(ctl + CW_WQ + 64, 1u);
                    if (u < 512 && !all_seen) {
                        unsigned* fc = ctl + CW_FIN + 64 * (u & 15); unsigned sp = 0;
                        while (__hip_atomic_load(fc, __ATOMIC_RELAXED, __HIP_MEMORY_SCOPE_AGENT) < 8u) { __builtin_amdgcn_s_sleep(2); if (++sp > (1u << 22)) { atomicAdd(ctl + XB_TMO + CW_BAR, 1u); break; } }
                        bool all = true;
                        for (int k = 0; k < 16; ++k) all = all && (__hip_atomic_load(ctl + CW_FIN + 64 * k, __ATOMIC_RELAXED, __HIP_MEMORY_SCOPE_AGENT) >= 8u);
                        __builtin_amdgcn_fence(__ATOMIC_ACQUIRE, "agent"); asm volatile("s_waitcnt vmcnt(0)" ::: "memory");
                        all_seen = all;
                    }
                    *wq = u;
                }
                __syncthreads();
                const int u = *wq;
                if (u >= 512) break;
                att::nsa_unit((LAS unsigned char*)lds, A, (u & 15) >> 1, u & 1, 31 - (u >> 4));
            } }
    }
    xcd_barrier(bar);
    if (IN(7)) {
        pg8::Ops g; g.A0 = c.ONSAB(); g.A1 = c.ODIFF(); g.B0 = c.WBN(); g.B1 = c.WBD(); g.K = 512;
        pg8::StaticOrder<2> So; So.init(T, 1024, (int)gridDim.x, (int)blockIdx.x);
        EpiMerge E; E.Y = c.Y(); E.GM = c.GM();
        pg8::gemm_phase((LAS unsigned char*)lds, g, So, E);
    }
    xcd_barrier(bar);
    if (IN(8)) {
        pg8::Ops g; g.A0 = c.Y(); g.A1 = c.Y(); g.B0 = c.WOUT(); g.B1 = c.WOUT(); g.K = 1024;
        pg8::StaticOrder<1> So; So.init(T, 1024, (int)gridDim.x, (int)blockIdx.x);
        EpiResid E; E.X = c.x(); E.O = c.X2B();
        pg8::gemm_phase((LAS unsigned char*)lds, g, So, E);
    }
    xcd_barrier(bar);
    if (IN(9)) {
        unsigned* ctl = (unsigned*)(ws + WS_CTL); unsigned* LIST = (unsigned*)(ws + WS_LIST);
        LAS float* Pl = (LAS float*)lds;
        LAS float* Sl = (LAS float*)((LAS unsigned char*)lds + 24576);
        const int wid = tid >> 6, rt = wid & 3, kh = wid >> 2, fr = lane & 15, fq = lane >> 4;
        for (int tb = blockIdx.x; tb < T / 64; tb += gridDim.x) {
            const bf16* xp = c.X2B() + (size_t)(tb * 64 + rt * 16 + fr) * D + kh * 512 + fq * 8;
            const bf16* wp = c.WRT() + (size_t)fr * D + kh * 512 + fq * 8;
            pg8::f32x4 acc[3];
#pragma unroll
            for (int ct = 0; ct < 3; ++ct) acc[ct] = (pg8::f32x4){0.f, 0.f, 0.f, 0.f};
            float ss = 0.f;
#pragma unroll 8
            for (int ks = 0; ks < 16; ++ks) {
                const pg8::bf16x8 xv = *(const pg8::bf16x8*)(xp + 32 * ks);
                pg8::bf16x8 wv[3];
#pragma unroll
                for (int ct = 0; ct < 3; ++ct) wv[ct] = *(const pg8::bf16x8*)(wp + (size_t)ct * 16 * D + 32 * ks);
#pragma unroll
                for (int ct = 0; ct < 3; ++ct) acc[ct] = __builtin_amdgcn_mfma_f32_16x16x32_bf16(wv[ct], xv, acc[ct], 0, 0, 0);
                const pg8::u32x4 xu = __builtin_bit_cast(pg8::u32x4, xv);
#pragma unroll
                for (int q = 0; q < 4; ++q) { const float a = LO16(xu[q]), b = HI16(xu[q]); ss += a * a + b * b; }
            }
#pragma unroll
            for (int ct = 0; ct < 3; ++ct) *(LAS pg8::f32x4*)(Pl + (size_t)((kh * 64 + rt * 16 + fr) * 48 + 16 * ct + 4 * fq)) = acc[ct];
            Sl[(kh * 4 + fq) * 64 + rt * 16 + fr] = ss;
            __syncthreads();
            if (tid < 64) {
                const LAS float* p0 = Pl + (size_t)lane * 48; const LAS float* p1 = Pl + (size_t)(64 + lane) * 48;
                float ssum = 0.f;
#pragma unroll
                for (int q = 0; q < 8; ++q) ssum += Sl[q * 64 + lane];
                const float rr = rsqrtf(ssum * (1.f / D) + RMS_EPS);
                float gl[4];
#pragma unroll
                for (int i = 0; i < 4; ++i) gl[i] = ((p0[i] + p1[i]) + (p0[20 + i] + p1[20 + i])) * rr + c.rg_b()[i];
                int gt = 0; float gbest = gl[0];
#pragma unroll
                for (int i = 1; i < 4; ++i) if (gl[i] > gbest) { gbest = gl[i]; gt = i; }
                float gs = 0.f;
#pragma unroll
                for (int i = 0; i < 4; ++i) gs += expf(gl[i] - gbest);
                const float gp = 1.f / gs;
                float el[4];
#pragma unroll
                for (int i = 0; i < 4; ++i) { const int jx = 4 + gt * 4 + i; el[i] = ((p0[jx] + p1[jx]) + (p0[20 + jx] + p1[20 + jx])) * rr + c.re_b()[gt * 4 + i]; }
                int e0 = 0; float b0 = el[0];
#pragma unroll
                for (int i = 1; i < 4; ++i) if (el[i] > b0) { b0 = el[i]; e0 = i; }
                int e1 = -1; float b1 = -3.0e38f;
#pragma unroll
                for (int i = 0; i < 4; ++i) if (i != e0 && el[i] > b1) { b1 = el[i]; e1 = i; }
                const float p1e = expf(b1 - b0); const float w0 = gp / (1.f + p1e), w1 = gp * p1e / (1.f + p1e);
                const int ea = e0 < e1 ? e0 : e1, eb = e0 < e1 ? e1 : e0;
                const int pr = (ea == 0) ? eb - 1 : (ea == 1 ? eb + 1 : 5);
                const int mycls = gt * 6 + pr;
                *(float4*)(c.ROUTE() + (size_t)(tb * 64 + lane) * 4) = make_float4(e0 < e1 ? w0 : w1, e0 < e1 ? w1 : w0, __int_as_float(mycls), rr);
                int cnt_l = 0, rank = 0;
                for (int cc = 0; cc < NCLS; ++cc) {
                    const unsigned long long mask = __ballot(mycls == cc);
                    if (lane == cc) cnt_l = __popcll(mask);
                    if (mycls == cc) rank = __popcll(mask & ((1ull << lane) - 1ull));
                }
                unsigned base_l = 0u;
                if (lane < NCLS && cnt_l > 0) base_l = atomicAdd(ctl + CW_CNT + 64 * lane, (unsigned)cnt_l);
                const unsigned base = __shfl(base_l, mycls);
                LIST[(size_t)mycls * T + base + rank] = (unsigned)(tb * 64 + lane);
            }
            __syncthreads();
        }
    }
    xcd_barrier(bar);
    if (IN(10)) {
        LAS int* tab = (LAS int*)((LAS unsigned char*)lds + TAB_OFF);
        moe_build_tab((const unsigned*)(ws + WS_CTL), tab);
        unsigned* ctl = (unsigned*)(ws + WS_CTL);
        const int G = (int)gridDim.x, bx = (int)blockIdx.x, vcu = (G % 8 == 0) ? (bx % 8) * (G / 8) + bx / 8 : bx;
        {   OpsGU g; g.H2 = c.X2B(); g.WGU = c.WGU(); g.LIST = (const unsigned*)(ws + WS_LIST); g.tab = tab;
            SchedGU So; So.tab = tab; So.G = G; So.vcu = vcu;
            EpiGU E; E.HID = c.HID(); E.LIST = (const unsigned*)(ws + WS_LIST); E.ROUTE = c.ROUTE(); E.tab = tab; E.ctl = ctl;
            pg8::gemm_phase_g((LAS unsigned char*)lds, g, So, E); }
        {   OpsDN g; g.HID = c.HID(); g.WDN = c.WDN(); g.tab = tab;
            SchedDN So; So.tab = tab; So.ctl = ctl; So.G = G; So.vcu = vcu;
            EpiDN E; E.O = c.out(); E.X2 = c.X2B(); E.LIST = (const unsigned*)(ws + WS_LIST); E.tab = tab;
            pg8::gemm_phase_g((LAS unsigned char*)lds, g, So, E); }
    }
#undef IN
#undef SEAM
}

extern "C" void kernel_launch(void* const* d_in, const int* in_sizes, int n_in, void* d_out, int out_size, void* d_ws, size_t ws_size, hipStream_t stream) {
    static int grid = 0;
    if (grid == 0) {
        if (n_in != 24 || out_size != T * D || ws_size < WS_END) { fprintf(stderr, "kernel_launch: unexpected shapes (n_in %d out %d ws %zu)\n", n_in, out_size, ws_size); grid = -1; return; }
        int dev = 0, cus = 0, per_cu = 0;
        if (hipGetDevice(&dev) != hipSuccess || hipDeviceGetAttribute(&cus, hipDeviceAttributeMultiprocessorCount, dev) != hipSuccess) { grid = -1; return; }
        if (hipFuncSetAttribute((const void*)fwd_kernel, hipFuncAttributeMaxDynamicSharedMemorySize, LDS_BYTES) != hipSuccess) { fprintf(stderr, "kernel_launch: hipFuncSetAttribute failed\n"); grid = -1; return; }
        if (hipOccupancyMaxActiveBlocksPerMultiprocessor(&per_cu, (const void*)fwd_kernel, NTHR, LDS_BYTES) != hipSuccess || per_cu < 1) { fprintf(stderr, "kernel_launch: occupancy query says %d\n", per_cu); }
        (void)hipGetLastError();
        grid = cus;
    }
    if (grid < 0) return;
    (void)hipMemsetAsync((char*)d_ws + WS_CTL, 0, CTL_ZERO_BYTES, stream);
    Args a{};
    for (int i = 0; i < 24; ++i) a.in[i] = (const float*)d_in[i];
    a.out = (float*)d_out; a.ws = (unsigned char*)d_ws; a.ph_lo = 0; a.ph_hi = 11;
    hipLaunchKernelGGL(fwd_kernel, dim3(grid), dim3(NTHR), LDS_BYTES, stream, a);
}
```

```cpp
#include <hip/hip_runtime.h>
#include <cstdint>
#include <cstdio>

constexpr int NB = 8, S = 2048, D = 1024, T = NB * S;
constexpr int INC = 4888;
constexpr int C_QN = 0, C_KV = 512, C_GN = 1280, C_QD = 1304, C_KD = 1816, C_VD = 2328, C_GM = 2840;
constexpr int NCMP = 127;
constexpr float LAMBDA_INIT = 0.2f;
constexpr float RMS_EPS = 1e-6f;

typedef unsigned short bf16;
#define LAS __attribute__((address_space(3)))

constexpr size_t MiB = 1u << 20;
constexpr size_t WS_CTL = 0, CTL_ZERO_BYTES = 1 * MiB;
constexpr size_t WS_WIN = 1 * MiB;
constexpr size_t WS_WOUT = 11 * MiB;
constexpr size_t WS_WBN = 13 * MiB, WS_WBD = 14 * MiB;
constexpr size_t WS_WC1 = 15 * MiB;
constexpr size_t WS_WGU = 17 * MiB;
constexpr size_t WS_WDN = 49 * MiB;
constexpr size_t WS_H1 = 65 * MiB;
constexpr size_t WS_QN = 97 * MiB;
constexpr size_t WS_CT = 113 * MiB;
constexpr size_t WS_KS = 121 * MiB, WS_VS = 125 * MiB, WS_KW = 129 * MiB, WS_VW = 133 * MiB;
constexpr size_t WS_QD = 137 * MiB, WS_KD = 153 * MiB, WS_VD = 169 * MiB;
constexpr size_t WS_GM = 185 * MiB;
constexpr size_t WS_GN = 249 * MiB;
constexpr size_t WS_KCMP = 251 * MiB;
constexpr size_t WS_VCMP = 251 * MiB + 256 * 1024;
constexpr size_t WS_ROUTE = 252 * MiB + 512 * 1024;
constexpr size_t WS_LAM = 252 * MiB + 768 * 1024;
constexpr size_t WS_POSB = 252 * MiB + 800 * 1024;
constexpr size_t WS_BIAS = 252 * MiB + 832 * 1024;
constexpr size_t WS_BIASV = 252 * MiB + 848 * 1024;
constexpr size_t WS_WRT = 253 * MiB;
constexpr size_t WS_END = 256 * MiB;
constexpr size_t WS_U = WS_H1;
constexpr size_t WS_ONSAB = WS_H1 + 16 * MiB;
constexpr size_t WS_X2B = WS_H1;
constexpr size_t WS_Y = WS_QN;
constexpr size_t WS_HID = WS_GM;

constexpr int CW_BAR = 4096;

#define XB_TMO      128
#define XB_XCNT(j)  (256  + 64 * (j))
#define XB_XSUB(j)  (1280 + 64 * (j))
#define XB_XGEN(j)  (2304 + 64 * (j))
#define XB_TOP      3328
#define XB_TOPGEN   3392
#define XCD_BAR_WORDS 3456
#define XB_SPIN_CAP (1u << 22)

__device__ __forceinline__ unsigned xb_ld(unsigned* p)              { return __hip_atomic_load(p, __ATOMIC_RELAXED, __HIP_MEMORY_SCOPE_AGENT); }
__device__ __forceinline__ unsigned xb_add(unsigned* p, unsigned v) { return __hip_atomic_fetch_add(p, v, __ATOMIC_RELAXED, __HIP_MEMORY_SCOPE_AGENT); }
__device__ __forceinline__ unsigned xb_xcc_id() { return (unsigned)__builtin_amdgcn_s_getreg((3 << 11) | 20) & 0xFu; }
#define XB_SPIN(cond, bar) do { unsigned _sp = 0; while (cond) { __builtin_amdgcn_s_sleep(1); \
    if ((++_sp & 255u) == 0u) { if (xb_ld(&(bar)[XB_TMO])) break; if (_sp > XB_SPIN_CAP) { atomicAdd(&(bar)[XB_TMO], 1u); break; } } } } while (0)

struct XcdBarrier { unsigned* bar; unsigned x; volatile LAS unsigned* st; };

__device__ __forceinline__ XcdBarrier xcd_barrier_post(unsigned* bar, volatile LAS unsigned* st) {
    XcdBarrier b; b.bar = bar; b.x = xb_xcc_id(); b.st = st;
    if (threadIdx.x == 0) (void)xb_add(&bar[XB_XCNT(b.x)], 1u);
    return b;
}
__device__ __forceinline__ void xcd_barrier_complete(unsigned* bar, unsigned x, unsigned& nloc, unsigned& nx) {
    const unsigned G = gridDim.x * gridDim.y * gridDim.z;
    unsigned sum, cnt, mine, sp = 0u;
    for (;;) {
        sum = 0u; cnt = 0u; mine = 0u;
#pragma unroll
        for (unsigned j = 0; j < 16; ++j) { const unsigned c = xb_ld(&bar[XB_XCNT(j)]); sum += c; cnt += (c > 0u) ? 1u : 0u; mine = (j == x) ? c : mine; }
        if (sum == G) break;
        __builtin_amdgcn_s_sleep(1);
        if ((++sp & 255u) == 0u) { if (xb_ld(&bar[XB_TMO])) break; if (sp > XB_SPIN_CAP) { atomicAdd(&bar[XB_TMO], 1u); break; } }
    }
    nloc = mine > 0u ? mine : 1u; nx = cnt > 0u ? cnt : 1u;
}
__device__ __forceinline__ void xcd_barrier(const XcdBarrier& b) {
    asm volatile("s_waitcnt vmcnt(0)" ::: "memory");
    __syncthreads();
    if (threadIdx.x == 0) {
        unsigned* bar = b.bar;
        __builtin_amdgcn_s_waitcnt(0);
        unsigned nloc = b.st[0], nx = b.st[1];
        if (nloc == 0u) { xcd_barrier_complete(bar, b.x, nloc, nx); b.st[0] = nloc; b.st[1] = nx; }
        const unsigned old = xb_add(&bar[XB_XSUB(b.x)], 1u);
        const unsigned gen = old / nloc;
        if (old + 1u == (gen + 1u) * nloc) {
            __builtin_amdgcn_fence(__ATOMIC_RELEASE, "agent");
            asm volatile("s_waitcnt vmcnt(0)" ::: "memory");
            const unsigned og = xb_add(&bar[XB_TOP], 1u);
            const unsigned tg = og / nx;
            if (og + 1u == (tg + 1u) * nx) xb_add(&bar[XB_TOPGEN], 1u);
            else XB_SPIN(xb_ld(&bar[XB_TOPGEN]) == tg, bar);
            __builtin_amdgcn_fence(__ATOMIC_ACQUIRE, "agent");
            xb_add(&bar[XB_XGEN(b.x)], 1u);
            asm volatile("s_waitcnt vmcnt(0)" ::: "memory");
        } else {
            XB_SPIN(xb_ld(&bar[XB_XGEN(b.x)]) == gen, bar);
            __builtin_amdgcn_fence(__ATOMIC_ACQUIRE, "agent");
            asm volatile("s_waitcnt vmcnt(0)" ::: "memory");
        }
    }
    __syncthreads();
}

__device__ __forceinline__ bf16 f2bf(float f) { unsigned u = __float_as_uint(f); return (bf16)((u + 0x7fffu + ((u >> 16) & 1u)) >> 16); }
typedef float g_f32x2 __attribute__((ext_vector_type(2))); typedef __bf16 g_bf16x2 __attribute__((ext_vector_type(2)));
__device__ __forceinline__ unsigned pk2bf(float lo, float hi) { const g_f32x2 v = {lo, hi}; const g_bf16x2 b = __builtin_convertvector(v, g_bf16x2); return __builtin_bit_cast(unsigned, b); }
__device__ __forceinline__ float wave_sum(float v) {
#pragma unroll
    for (int o = 1; o < 64; o <<= 1) v += __shfl_xor(v, o);
    return v;
}
typedef float nt_f32x4 __attribute__((ext_vector_type(4)));
__device__ __forceinline__ float sigmoidf_(float x) { return __builtin_amdgcn_rcpf(1.f + __builtin_amdgcn_exp2f(-1.4426950408889634f * x)); }

__device__ const unsigned char T5B[128] = {0, 1, 2, 3, 4, 5, 6, 7, 8, 9, 10, 11, 12, 13, 14, 15, 16, 16, 16, 17, 17, 18, 18, 18, 19, 19, 19, 20, 20, 20, 20, 21, 21, 21, 21, 22, 22, 22, 22, 22, 23, 23, 23, 23, 23, 23, 24, 24, 24, 24, 24, 24, 25, 25, 25, 25, 25, 25, 25, 26, 26, 26, 26, 26, 26, 26, 26, 27, 27, 27, 27, 27, 27, 27, 27, 27, 27, 28, 28, 28, 28, 28, 28, 28, 28, 28, 28, 29, 29, 29, 29, 29, 29, 29, 29, 29, 29, 29, 29, 30, 30, 30, 30, 30, 30, 30, 30, 30, 30, 30, 30, 30, 30, 31, 31, 31, 31, 31, 31, 31, 31, 31, 31, 31, 31, 31, 31, 31};
__device__ __forceinline__ int t5_bucket(int dist) { return (int)T5B[dist > 127 ? 127 : (dist < 0 ? 0 : dist)]; }

#define LO16(u) __uint_as_float((u) << 16)
#define HI16(u) __uint_as_float((u) & 0xffff0000u)

struct Args { const float* in[24]; float* out; unsigned char* ws; int ph_lo, ph_hi; };

struct Ctx {
    Args a;
#define CF(name, idx) __device__ __forceinline__ const float* name() const { return a.in[idx]; }
    CF(x, 0) CF(norm1_g, 1) CF(w_in, 2) CF(nsa_q_norm, 3) CF(nsa_k_norm, 4) CF(cmp_pos, 5) CF(cmp_w1, 6) CF(cmp_w2, 7) CF(diff_q_norm, 8) CF(diff_k_norm, 9)
    CF(diff_lambda, 10) CF(diff_out_norm, 11) CF(rel_bias, 12) CF(w_bn, 13) CF(w_bd, 14) CF(w_out, 15) CF(norm2_g, 16) CF(rg_w, 17) CF(rg_b, 18) CF(re_w, 19) CF(re_b, 20)
    CF(w_gate, 21) CF(w_up, 22) CF(w_down, 23)
#undef CF
#define CW(type, name, off) __device__ __forceinline__ type* name() const { return (type*)(a.ws + (off)); }
    CW(bf16, H1, WS_H1) CW(bf16, QN, WS_QN) CW(bf16, CT, WS_CT) CW(bf16, KS, WS_KS) CW(bf16, VS, WS_VS) CW(bf16, KW, WS_KW) CW(bf16, VW, WS_VW)
    CW(bf16, QD, WS_QD) CW(bf16, KD, WS_KD) CW(bf16, VD, WS_VD) CW(bf16, GM, WS_GM) CW(float, GN, WS_GN) CW(bf16, KCMP, WS_KCMP) CW(bf16, VCMP, WS_VCMP)
    CW(bf16, ONSAB, WS_ONSAB) CW(float, ROUTE, WS_ROUTE)
    CW(float, LAM, WS_LAM) CW(bf16, Y, WS_Y) CW(bf16, HID, WS_HID)
    CW(float, U, WS_U) CW(bf16, X2B, WS_X2B) CW(float, POSB, WS_POSB) CW(float, BIAS, WS_BIAS) CW(float, BIASV, WS_BIASV) CW(bf16, WIN, WS_WIN) CW(bf16, WOUT, WS_WOUT) CW(bf16, WBN, WS_WBN) CW(bf16, WBD, WS_WBD) CW(bf16, WC1, WS_WC1) CW(bf16, WGU, WS_WGU) CW(bf16, WDN, WS_WDN) CW(bf16, WRT, WS_WRT)
    __device__ __forceinline__ bf16* ODIFF() const { return (bf16*)a.out; }
#undef CW
    __device__ __forceinline__ float* out() const { return a.out; }
};

struct ChunkDesc { int src; int ncols; int mode; const float* gain; bf16* dst; float* dstf; int pitch; int dcol; float qscale;
    int img; int c0; int tile_bytes; int bstride; };
__device__ __forceinline__ ChunkDesc chunk_desc(const Ctx& c, int ch) {
    ChunkDesc d; d.src = 0; d.ncols = 64; d.mode = 0; d.gain = nullptr; d.dst = nullptr; d.dstf = nullptr; d.pitch = 0; d.dcol = 0; d.qscale = 1.f; d.img = 0; d.c0 = 0; d.tile_bytes = 0; d.bstride = 0;
    if (ch < 8) { d.src = C_QN + 64 * ch; d.mode = 1; d.gain = c.nsa_q_norm(); d.dst = c.QN(); d.pitch = 512; d.dcol = 64 * ch; d.qscale = 0.125f * 1.4426950408889634f; }
    else if (ch < 20) { const int j = ch - 8; d.src = C_KV + 64 * j; const int t = j >> 2, kv = (j >> 1) & 1, g = j & 1;
        if (t == 0) { d.dst = c.CT() + (size_t)(kv * 2 + g) * T * 64; d.pitch = 64; d.dcol = 0; }
        else { d.dst = ((t == 1) ? (kv ? c.VS() : c.KS()) : (kv ? c.VW() : c.KW())) + (size_t)g * 32 * 4096; d.img = kv ? 2 : 1; d.c0 = 0; d.tile_bytes = 8192; d.bstride = 2 * 32 * 8192;
               if (kv == 0) { d.mode = 1; d.gain = c.nsa_k_norm() + 64 * t; } } }
    else if (ch < 24) { if (ch == 20) { d.src = C_GN; d.ncols = 24; d.mode = 2; d.dstf = c.GN(); d.pitch = 24; d.dcol = 0; } else d.ncols = 0; }
    else if (ch < 32) { const int j = ch - 24; d.src = C_QD + 64 * j; d.mode = 1; d.gain = c.diff_q_norm() + 64 * (j & 1); d.dst = c.QD(); d.pitch = 512; d.dcol = 64 * j; d.qscale = 0.125f * 1.4426950408889634f; }
    else if (ch < 40) { const int j = ch - 32; d.src = C_KD + 64 * j; d.mode = 1; d.gain = c.diff_k_norm() + 64 * (j & 1); d.dst = c.KD() + (size_t)(j >> 1) * 32 * 8192; d.img = 1; d.c0 = (j & 1) * 8; d.tile_bytes = 16384; d.bstride = 4 * 32 * 16384; }
    else if (ch < 48) { const int j = ch - 40; d.src = C_VD + 64 * j; d.dst = c.VD() + (size_t)(j >> 1) * 32 * 8192; d.img = 2; d.c0 = (j & 1) * 2; d.tile_bytes = 16384; d.bstride = 4 * 32 * 16384; }
    else { const int j = ch - 48; d.src = C_GM + 64 * j; d.mode = 2; d.dst = c.GM(); d.pitch = 2048; d.dcol = 64 * j; }
    return d;
}


namespace pg8 {
typedef short bf16x8 __attribute__((ext_vector_type(8)));
typedef float f32x4 __attribute__((ext_vector_type(4)));
typedef unsigned u32x4 __attribute__((ext_vector_type(4)));
constexpr int BM = 256, BK = 64, HALF = 128, HTB = HALF * BK * 2, NXCD = 8, WGM = 8;
__device__ __forceinline__ int lds_byte(int r, int c) { const int st = (r >> 4) * 2 + (c >> 5), rr = r & 15, cc = c & 31, ob = rr * 64 + cc * 2; return st * 1024 + (ob ^ (((ob >> 9) & 1) << 5)); }
__device__ __forceinline__ void stage_rc(int b, int& R, int& C) { const int st = b / 1024, sb = b % 1024, swz = sb ^ (((sb >> 9) & 1) << 5); R = (st >> 1) * 16 + swz / 64; C = (st & 1) * 32 + (swz % 64) / 2; }
__device__ __forceinline__ int perm32(int rho) { const int n = rho >> 4, i = rho & 15; return 8 * (i >> 2) + 4 * n + (i & 3); }
__device__ __forceinline__ unsigned cvt_pk_bf16(float lo, float hi) { return pk2bf(lo, hi); }

struct Unit { int pm, pn, z; };
struct Ops { const bf16 *A0, *A1, *B0, *B1; int K;
    __device__ __forceinline__ const char* a(const Unit& u) const { return (const char*)((u.z ? A1 : A0) + (size_t)u.pm * BM * K); }
    __device__ __forceinline__ const char* b(const Unit& u) const { return (const char*)((u.z ? B1 : B0) + (size_t)u.pn * BM * K); } };

template <int NZ> struct StaticOrder {
    int nM, nN, nwg, G, c;
    __device__ __forceinline__ void init(int M, int N, int G_, int c_) { nM = M / BM; nN = N / BM; nwg = nM * nN; G = G_; c = c_; }
    __device__ __forceinline__ bool next(int i, Unit& u) const {
        const int it = i / NZ; u.z = i % NZ;
        const long L = (long)it * G + c; if (L >= nwg) return false;
        int wgid = (int)L; { const int q = nwg / NXCD, r = nwg % NXCD, xcd = wgid % NXCD, off = wgid / NXCD; wgid = (xcd < r ? xcd * (q + 1) : r * (q + 1) + (xcd - r) * q) + off; }
        const int nig = WGM * nN, gid = wgid / nig, fm = gid * WGM, gsz = (nM - fm) < WGM ? (nM - fm) : WGM;
        u.pm = fm + ((wgid % nig) % gsz); u.pn = (wgid % nig) / gsz; return true;
    }
};

template <class Epi, class Sched>
__device__ __forceinline__ void gemm_phase(LAS unsigned char* lds, const Ops g, const Sched& S, const Epi& E) {
    const int tid = threadIdx.x, wid = __builtin_amdgcn_readfirstlane(tid >> 6), lane = tid & 63, wr = wid >> 2, wc = wid & 3, fr = lane & 15, fq = lane >> 4;
    const int K = g.K, nt = K / BK;
    unsigned voffA[2], voffB[2];
#pragma unroll
    for (int i = 0; i < 2; ++i) { int R, C; stage_rc(tid * 16 + i * 8192, R, C); const int Rb = (R & ~31) + perm32(R & 31);
        voffA[i] = (unsigned)(R * K + C) * 2u; voffB[i] = (unsigned)(Rb * K + C) * 2u; }
    const size_t kstep = (size_t)(BK * 2);
    const size_t hstep = (size_t)HALF * K * 2;
    const unsigned ldsw = (unsigned)wid * 1024u;
    const int aoff = lds_byte(wr * 64 + fr, fq * 8), boff = lds_byte(wc * 32 + fr, fq * 8);
#define PG8_SA(b, h) (((b) * 2 + (h)) * HTB)
#define PG8_SB(b, h) ((4 + (b) * 2 + (h)) * HTB)
#define PG8_STAGE(bufoff, gbase, voff) do { _Pragma("unroll") for (int _i = 0; _i < 2; ++_i) \
        __builtin_amdgcn_global_load_lds((const unsigned*)((const char*)(gbase) + (voff)[_i]), (LAS unsigned*)(lds + (bufoff) + ldsw + _i * 8192), 16, 0, 0); } while (0)
#define PG8_LDA(dst, b, h) do { _Pragma("unroll") for (int m = 0; m < 4; ++m) _Pragma("unroll") for (int k = 0; k < 2; ++k) dst[m][k] = *(const LAS bf16x8*)(lds + PG8_SA(b, h) + aoff + m * 2048 + k * 1024); } while (0)
#define PG8_LDB(dst, b, h) do { _Pragma("unroll") for (int n = 0; n < 2; ++n) _Pragma("unroll") for (int k = 0; k < 2; ++k) dst[n][k] = *(const LAS bf16x8*)(lds + PG8_SB(b, h) + boff + n * 2048 + k * 1024); } while (0)
#define PG8_MMA(ai, bj, At, Bt) do { __builtin_amdgcn_s_setprio(1); _Pragma("unroll") for (int m = 0; m < 4; ++m) _Pragma("unroll") for (int n = 0; n < 2; ++n) _Pragma("unroll") for (int k = 0; k < 2; ++k) \
        acc[ai][bj][m][n] = __builtin_amdgcn_mfma_f32_16x16x32_bf16(Bt[n][k], At[m][k], acc[ai][bj][m][n], 0, 0, 0); __builtin_amdgcn_s_setprio(0); } while (0)
#define PG8_WAIT_V(n) asm volatile("s_waitcnt vmcnt(" #n ")" ::: "memory")
#define PG8_WAIT_L(n) asm volatile("s_waitcnt lgkmcnt(" #n ")" ::: "memory")
#define PG8_BAR __builtin_amdgcn_s_barrier()
#define PG8_SCHED __builtin_amdgcn_sched_barrier(0)
    Unit cur, nxt; int ui = 0;
    if (!S.next(0, cur)) return;
    f32x4 acc[2][2][4][2];
#pragma unroll
    for (int a = 0; a < 2; ++a)
#pragma unroll
        for (int b = 0; b < 2; ++b)
#pragma unroll
            for (int m = 0; m < 4; ++m)
#pragma unroll
                for (int n = 0; n < 2; ++n) acc[a][b][m][n] = (f32x4){0.f, 0.f, 0.f, 0.f};
    bf16x8 At[4][2], B0[2][2], B1[2][2];
    const char* cA = g.a(cur); const char* cB = g.b(cur);
    PG8_STAGE(PG8_SB(0, 0), cB, voffB); PG8_STAGE(PG8_SB(0, 1), cB + hstep, voffB); PG8_STAGE(PG8_SA(0, 0), cA, voffA); PG8_STAGE(PG8_SA(0, 1), cA + hstep, voffA);
    if (wr == 1) PG8_BAR;
    PG8_WAIT_V(2); PG8_BAR;
    PG8_STAGE(PG8_SB(1, 0), cB + kstep, voffB); PG8_STAGE(PG8_SA(1, 0), cA + kstep, voffA); PG8_STAGE(PG8_SB(1, 1), cB + hstep + kstep, voffB);
    PG8_WAIT_V(6); PG8_BAR;
    for (;;) {
        const bool has_next = S.next(ui + 1, nxt);
        const char* nA = has_next ? g.a(nxt) : cA; const char* nB = has_next ? g.b(nxt) : cB;
        for (int t = 0; t < nt; t += 2) {
            const bool last = (t == nt - 2);
            const char* a1 = cA + (size_t)(t + 1) * kstep;
            const char* a2 = last ? nA : cA + (size_t)(t + 2) * kstep; const char* b2 = last ? nB : cB + (size_t)(t + 2) * kstep;
            const char* a3 = a2 + kstep; const char* b3 = b2 + kstep;
            PG8_LDB(B0, 0, 0); PG8_LDB(B1, 0, 1); PG8_SCHED; PG8_LDA(At, 0, 0); PG8_STAGE(PG8_SA(1, 1), a1 + hstep, voffA);
            PG8_WAIT_V(8); PG8_WAIT_L(0); PG8_BAR; PG8_MMA(0, 0, At, B0); PG8_MMA(0, 1, At, B1); PG8_BAR; PG8_SCHED;
            PG8_LDA(At, 0, 1); PG8_STAGE(PG8_SB(0, 0), b2, voffB); PG8_STAGE(PG8_SB(0, 1), b2 + hstep, voffB); PG8_STAGE(PG8_SA(0, 0), a2, voffA);
            PG8_WAIT_V(8); PG8_WAIT_L(0); PG8_BAR; PG8_MMA(1, 0, At, B0); PG8_MMA(1, 1, At, B1); PG8_BAR; PG8_SCHED;
            PG8_LDB(B0, 1, 0); PG8_LDB(B1, 1, 1); PG8_SCHED; PG8_LDA(At, 1, 0); PG8_STAGE(PG8_SA(0, 1), a2 + hstep, voffA);
            PG8_WAIT_V(8); PG8_WAIT_L(0); PG8_BAR; PG8_MMA(0, 0, At, B0); PG8_MMA(0, 1, At, B1); PG8_BAR; PG8_SCHED;
            PG8_LDA(At, 1, 1); PG8_STAGE(PG8_SB(1, 0), b3, voffB); PG8_STAGE(PG8_SB(1, 1), b3 + hstep, voffB); PG8_STAGE(PG8_SA(1, 0), a3, voffA);
            PG8_WAIT_V(8); PG8_WAIT_L(0); PG8_BAR; PG8_MMA(1, 0, At, B0); PG8_MMA(1, 1, At, B1); PG8_BAR; PG8_SCHED;
        }
        if (wr == 0) PG8_BAR;
        const bool keep = E(acc, cur, wr, wc, fr, fq);
        if (!has_next) break;
        if (!keep) {
#pragma unroll
        for (int a = 0; a < 2; ++a)
#pragma unroll
            for (int b = 0; b < 2; ++b)
#pragma unroll
                for (int m = 0; m < 4; ++m)
#pragma unroll
                    for (int n = 0; n < 2; ++n) acc[a][b][m][n] = (f32x4){0.f, 0.f, 0.f, 0.f};
        }
        cur = nxt; cA = nA; cB = nB; ++ui;
        if (wr == 1) PG8_BAR;
    }
    PG8_WAIT_V(0);
    PG8_BAR;
#undef PG8_SA
#undef PG8_SB
#undef PG8_STAGE
#undef PG8_LDA
#undef PG8_LDB
#undef PG8_MMA
#undef PG8_WAIT_V
#undef PG8_WAIT_L
#undef PG8_BAR
#undef PG8_SCHED
}

template <class G, class Epi, class Sched>
__device__ __forceinline__ void gemm_phase_g(LAS unsigned char* lds, const G& g, const Sched& S, const Epi& E) {
    const int tid = threadIdx.x, wid = __builtin_amdgcn_readfirstlane(tid >> 6), lane = tid & 63, wr = wid >> 2, wc = wid & 3, fr = lane & 15, fq = lane >> 4;
    constexpr int nt = G::NT;
    unsigned voffB[2];
#pragma unroll
    for (int i = 0; i < 2; ++i) { int R, C; stage_rc(tid * 16 + i * 8192, R, C); const int Rb = (R & ~31) + perm32(R & 31); voffB[i] = (unsigned)(Rb * G::LDB + C) * 2u; }
#define PG8_RC int sR[2], sC[2]; stage_rc(tid * 16, sR[0], sC[0]); stage_rc(tid * 16 + 8192, sR[1], sC[1])
    const size_t kstep = (size_t)(BK * 2);
    const size_t hstepB = (size_t)HALF * G::LDB * 2;
    const unsigned ldsw = (unsigned)wid * 1024u;
    const int aoff = lds_byte(wr * 64 + fr, fq * 8), boff = lds_byte(wc * 32 + fr, fq * 8);
#define PG8_SA(b, h) (((b) * 2 + (h)) * HTB)
#define PG8_SB(b, h) ((4 + (b) * 2 + (h)) * HTB)
#define PG8_STAGE(bufoff, gbase, voff) do { _Pragma("unroll") for (int _i = 0; _i < 2; ++_i) \
        __builtin_amdgcn_global_load_lds((const unsigned*)((const char*)(gbase) + (voff)[_i]), (LAS unsigned*)(lds + (bufoff) + ldsw + _i * 8192), 16, 0, 0); } while (0)
#define PG8_LDA(dst, b, h) do { _Pragma("unroll") for (int m = 0; m < 4; ++m) _Pragma("unroll") for (int k = 0; k < 2; ++k) dst[m][k] = *(const LAS bf16x8*)(lds + PG8_SA(b, h) + aoff + m * 2048 + k * 1024); } while (0)
#define PG8_LDB(dst, b, h) do { _Pragma("unroll") for (int n = 0; n < 2; ++n) _Pragma("unroll") for (int k = 0; k < 2; ++k) dst[n][k] = *(const LAS bf16x8*)(lds + PG8_SB(b, h) + boff + n * 2048 + k * 1024); } while (0)
#define PG8_MMA(ai, bj, At, Bt) do { __builtin_amdgcn_s_setprio(1); _Pragma("unroll") for (int m = 0; m < 4; ++m) _Pragma("unroll") for (int n = 0; n < 2; ++n) _Pragma("unroll") for (int k = 0; k < 2; ++k) \
        acc[ai][bj][m][n] = __builtin_amdgcn_mfma_f32_16x16x32_bf16(Bt[n][k], At[m][k], acc[ai][bj][m][n], 0, 0, 0); __builtin_amdgcn_s_setprio(0); } while (0)
#define PG8_WAIT_V(n) asm volatile("s_waitcnt vmcnt(" #n ")" ::: "memory")
#define PG8_WAIT_L(n) asm volatile("s_waitcnt lgkmcnt(" #n ")" ::: "memory")
#define PG8_BAR __builtin_amdgcn_s_barrier()
#define PG8_SCHED __builtin_amdgcn_sched_barrier(0)
    Unit cur, nxt; int ui = 0;
    if (!S.next(0, cur)) return;
    unsigned vc[2][2], vn[2][2];
    bool has_next = S.next(1, nxt);
    {   PG8_RC; g.a_voff(cur, sR, sC, vc);
        if (has_next) g.a_voff(nxt, sR, sC, vn); }
    if (has_next) {} else { vn[0][0] = vc[0][0]; vn[0][1] = vc[0][1]; vn[1][0] = vc[1][0]; vn[1][1] = vc[1][1]; }
    f32x4 acc[2][2][4][2];
#pragma unroll
    for (int a = 0; a < 2; ++a)
#pragma unroll
        for (int b = 0; b < 2; ++b)
#pragma unroll
            for (int m = 0; m < 4; ++m)
#pragma unroll
                for (int n = 0; n < 2; ++n) acc[a][b][m][n] = (f32x4){0.f, 0.f, 0.f, 0.f};
    bf16x8 At[4][2], B0[2][2], B1[2][2];
    const char* cA = g.a_base(cur);
    const char *cb0, *cb1, *nb0, *nb1;
    g.bprep(cur, cb0, cb1);
    if (has_next) g.bprep(nxt, nb0, nb1); else { nb0 = cb0; nb1 = cb1; }
    {   const char* cB0 = G::bat(cb0, cb1, 0); const char* cB1 = G::bat(cb0, cb1, 1);
        PG8_STAGE(PG8_SB(0, 0), cB0, voffB); PG8_STAGE(PG8_SB(0, 1), cB0 + hstepB, voffB); PG8_STAGE(PG8_SA(0, 0), cA, vc[0]); PG8_STAGE(PG8_SA(0, 1), cA, vc[1]);
        if (wr == 1) PG8_BAR;
        PG8_WAIT_V(2); PG8_BAR;
        PG8_STAGE(PG8_SB(1, 0), cB1, voffB); PG8_STAGE(PG8_SA(1, 0), cA + kstep, vc[0]); PG8_STAGE(PG8_SB(1, 1), cB1 + hstepB, voffB);
        PG8_WAIT_V(6); PG8_BAR; }
    for (;;) {
        const char* nA = has_next ? g.a_base(nxt) : cA;
        for (int t = 0; t < nt; t += 2) {
            const bool last = (t == nt - 2);
            const char* a1 = cA + (size_t)(t + 1) * kstep;
            const char* a2 = last ? nA : cA + (size_t)(t + 2) * kstep; const char* a3 = a2 + kstep;
            const char* b2 = last ? G::bat(nb0, nb1, 0) : G::bat(cb0, cb1, t + 2); const char* b3 = last ? G::bat(nb0, nb1, 1) : G::bat(cb0, cb1, t + 3);
            PG8_LDB(B0, 0, 0); PG8_LDB(B1, 0, 1); PG8_SCHED; PG8_LDA(At, 0, 0); PG8_STAGE(PG8_SA(1, 1), a1, vc[1]);
            if (last) { vc[0][0] = vn[0][0]; vc[0][1] = vn[0][1]; vc[1][0] = vn[1][0]; vc[1][1] = vn[1][1]; }
            PG8_WAIT_V(8); PG8_WAIT_L(0); PG8_BAR; PG8_MMA(0, 0, At, B0); PG8_MMA(0, 1, At, B1); PG8_BAR; PG8_SCHED;
            PG8_LDA(At, 0, 1); PG8_STAGE(PG8_SB(0, 0), b2, voffB); PG8_STAGE(PG8_SB(0, 1), b2 + hstepB, voffB); PG8_STAGE(PG8_SA(0, 0), a2, vc[0]);
            PG8_WAIT_V(8); PG8_WAIT_L(0); PG8_BAR; PG8_MMA(1, 0, At, B0); PG8_MMA(1, 1, At, B1); PG8_BAR; PG8_SCHED;
            PG8_LDB(B0, 1, 0); PG8_LDB(B1, 1, 1); PG8_SCHED; PG8_LDA(At, 1, 0); PG8_STAGE(PG8_SA(0, 1), a2, vc[1]);
            PG8_WAIT_V(8); PG8_WAIT_L(0); PG8_BAR; PG8_MMA(0, 0, At, B0); PG8_MMA(0, 1, At, B1); PG8_BAR; PG8_SCHED;
            PG8_LDA(At, 1, 1); PG8_STAGE(PG8_SB(1, 0), b3, voffB); PG8_STAGE(PG8_SB(1, 1), b3 + hstepB, voffB); PG8_STAGE(PG8_SA(1, 0), a3, vc[0]);
            PG8_WAIT_V(8); PG8_WAIT_L(0); PG8_BAR; PG8_MMA(1, 0, At, B0); PG8_MMA(1, 1, At, B1); PG8_BAR; PG8_SCHED;
        }
        if (wr == 0) PG8_BAR;
        E(acc, cur, wr, wc, fr, fq);
        if (!has_next) break;
#pragma unroll
        for (int a = 0; a < 2; ++a)
#pragma unroll
            for (int b = 0; b < 2; ++b)
#pragma unroll
                for (int m = 0; m < 4; ++m)
#pragma unroll
                    for (int n = 0; n < 2; ++n) acc[a][b][m][n] = (f32x4){0.f, 0.f, 0.f, 0.f};
        cur = nxt; cA = nA; cb0 = nb0; cb1 = nb1; ++ui;
        has_next = S.next(ui + 1, nxt);
        if (has_next) { PG8_RC; g.a_voff(nxt, sR, sC, vn); g.bprep(nxt, nb0, nb1); }
        if (wr == 1) PG8_BAR;
    }
    PG8_WAIT_V(0);
    PG8_BAR;
#undef PG8_RC
#undef PG8_SA
#undef PG8_SB
#undef PG8_STAGE
#undef PG8_LDA
#undef PG8_LDB
#undef PG8_MMA
#undef PG8_WAIT_V
#undef PG8_WAIT_L
#undef PG8_BAR
#undef PG8_SCHED
}
}

struct EpiInProj {
    Ctx c;
    __device__ __forceinline__ bool operator()(pg8::f32x4 (&acc)[2][2][4][2], const pg8::Unit& u, int wr, int wc, int fr_, int fq_) const {
        int fr = fr_, fq = fq_; asm volatile("" : "+v"(fr), "+v"(fq));
        const ChunkDesc d = chunk_desc(c, u.pn * 4 + wc);
        if (d.ncols == 0) return false;
        const int row0 = u.pm * 256 + wr * 64 + fr;
        float gn[2][8];
        const float* gp = (d.mode == 1) ? d.gain : c.nsa_q_norm();
        pg8::f32x4 g4[4];
#pragma unroll
        for (int q = 0; q < 4; ++q) g4[q] = *(const pg8::f32x4*)(gp + 32 * (q >> 1) + 8 * fq + 4 * (q & 1));
#pragma unroll
        for (int q = 0; q < 4; ++q) asm volatile("" : "+v"(g4[q]));
#pragma unroll
        for (int bj = 0; bj < 2; ++bj)
#pragma unroll
            for (int i = 0; i < 8; ++i) gn[bj][i] = g4[2 * bj + (i >> 2)][i & 3] * d.qscale;
#pragma unroll
        for (int ai = 0; ai < 2; ++ai)
#pragma unroll
            for (int m = 0; m < 4; ++m) {
                const size_t row = (size_t)(row0 + ai * 128 + m * 16);
                float v[2][8];
#pragma unroll
                for (int bj = 0; bj < 2; ++bj)
#pragma unroll
                    for (int n = 0; n < 2; ++n)
#pragma unroll
                        for (int i = 0; i < 4; ++i) v[bj][4 * n + i] = acc[ai][bj][m][n][i];
                if (d.mode == 1) {
                    float ss = 0.f;
#pragma unroll
                    for (int bj = 0; bj < 2; ++bj)
#pragma unroll
                        for (int i = 0; i < 8; ++i) ss += v[bj][i] * v[bj][i];
                    ss += __shfl_xor(ss, 16); ss += __shfl_xor(ss, 32);
                    const float r = rsqrtf(ss * (1.f / 64.f) + RMS_EPS);
#pragma unroll
                    for (int bj = 0; bj < 2; ++bj)
#pragma unroll
                        for (int i = 0; i < 8; ++i) v[bj][i] = v[bj][i] * r * gn[bj][i];
                } else if (d.mode == 2) {
#pragma unroll
                    for (int bj = 0; bj < 2; ++bj)
#pragma unroll
                        for (int i = 0; i < 8; ++i) v[bj][i] = sigmoidf_(v[bj][i]);
                }
                if (d.dstf) {
                    if (fq < 3) { float4* p = (float4*)(d.dstf + row * 24 + 8 * fq); p[0] = make_float4(v[0][0], v[0][1], v[0][2], v[0][3]); p[1] = make_float4(v[0][4], v[0][5], v[0][6], v[0][7]); }
                } else {
#pragma unroll
                    for (int bj = 0; bj < 2; ++bj) { pg8::u32x4 w; w.x = pg8::cvt_pk_bf16(v[bj][0], v[bj][1]); w.y = pg8::cvt_pk_bf16(v[bj][2], v[bj][3]); w.z = pg8::cvt_pk_bf16(v[bj][4], v[bj][5]); w.w = pg8::cvt_pk_bf16(v[bj][6], v[bj][7]);
                        if (d.img == 0) *(pg8::u32x4*)(d.dst + row * d.pitch + d.dcol + 32 * bj + 8 * fq) = w;
                        else { const int bb = (int)(row >> 11), sq = (int)(row & 2047), key = sq & 63;
                            const size_t tb = (size_t)bb * d.bstride + (size_t)(sq >> 6) * d.tile_bytes;
                            const size_t off = (d.img == 1) ? tb + (size_t)(d.c0 + 4 * bj + fq) * 1024 + key * 16 : tb + (size_t)(d.c0 + bj) * 4096 + (key >> 4) * 1024 + (key & 15) * 64 + fq * 16;
                            *(pg8::u32x4*)((unsigned char*)d.dst + off) = w; } }
                }
            }
        return false;
    }
};
struct EpiMerge {
    bf16* Y; const bf16* GM;
    __device__ __forceinline__ bool operator()(pg8::f32x4 (&acc)[2][2][4][2], const pg8::Unit& u, int wr, int wc, int fr_, int fq_) const {
        int fr = fr_, fq = fq_; asm volatile("" : "+v"(fr), "+v"(fq));
        const int row0 = u.pm * 256 + wr * 64 + fr, col0 = u.pn * 256 + wc * 32 + 8 * fq;
#pragma unroll
        for (int ai = 0; ai < 2; ++ai)
#pragma unroll
            for (int m = 0; m < 4; ++m) {
                const size_t row = (size_t)(row0 + ai * 128 + m * 16);
#pragma unroll
                for (int bj = 0; bj < 2; ++bj) {
                    const int col = col0 + bj * 128;
                    const uint4 g1 = *(const uint4*)(GM + row * 2048 + 1024 + col);
                    float q1[8] = {LO16(g1.x), HI16(g1.x), LO16(g1.y), HI16(g1.y), LO16(g1.z), HI16(g1.z), LO16(g1.w), HI16(g1.w)};
                    if (u.z == 0) {
                        const uint4 g0 = *(const uint4*)(GM + row * 2048 + col);
                        const float q0[8] = {LO16(g0.x), HI16(g0.x), LO16(g0.y), HI16(g0.y), LO16(g0.z), HI16(g0.z), LO16(g0.w), HI16(g0.w)};
#pragma unroll
                        for (int n = 0; n < 2; ++n)
#pragma unroll
                            for (int i = 0; i < 4; ++i) acc[ai][bj][m][n][i] *= q0[4 * n + i] * __builtin_amdgcn_rcpf(fmaxf(q1[4 * n + i], 1e-30f));
                    } else {
                        float v[8];
#pragma unroll
                        for (int n = 0; n < 2; ++n)
#pragma unroll
                            for (int i = 0; i < 4; ++i) v[4 * n + i] = acc[ai][bj][m][n][i] * fmaxf(q1[4 * n + i], 1e-30f);
                        uint4 w; w.x = pg8::cvt_pk_bf16(v[0], v[1]); w.y = pg8::cvt_pk_bf16(v[2], v[3]); w.z = pg8::cvt_pk_bf16(v[4], v[5]); w.w = pg8::cvt_pk_bf16(v[6], v[7]);
                        *(uint4*)(Y + row * 1024 + col) = w;
                    }
                }
            }
        return u.z == 0;
    }
};
struct EpiResid {
    const float* X; bf16* O;
    __device__ __forceinline__ bool operator()(pg8::f32x4 (&acc)[2][2][4][2], const pg8::Unit& u, int wr, int wc, int fr_, int fq_) const {
        int fr = fr_, fq = fq_; asm volatile("" : "+v"(fr), "+v"(fq));
        const int row0 = u.pm * 256 + wr * 64 + fr, col0 = u.pn * 256 + wc * 32 + 8 * fq;
#pragma unroll
        for (int ai = 0; ai < 2; ++ai)
#pragma unroll
            for (int m = 0; m < 4; ++m) {
                const size_t row = (size_t)(row0 + ai * 128 + m * 16);
#pragma unroll
                for (int bj = 0; bj < 2; ++bj) { const size_t off = row * 1024 + col0 + bj * 128;
                    const float4 x0 = *(const float4*)(X + off), x1 = *(const float4*)(X + off + 4); const pg8::f32x4 a0 = acc[ai][bj][m][0], a1 = acc[ai][bj][m][1];
                    uint4 w; w.x = pk2bf(x0.x + a0[0], x0.y + a0[1]); w.y = pk2bf(x0.z + a0[2], x0.w + a0[3]); w.z = pk2bf(x1.x + a1[0], x1.y + a1[1]); w.w = pk2bf(x1.z + a1[2], x1.w + a1[3]);
                    *(uint4*)(O + off) = w; }
            }
        return false;
    }
};

struct EpiF32 {
    float* O; int ldc;
    __device__ __forceinline__ bool operator()(pg8::f32x4 (&acc)[2][2][4][2], const pg8::Unit& u, int wr, int wc, int fr_, int fq_) const {
        int fr = fr_, fq = fq_; asm volatile("" : "+v"(fr), "+v"(fq));
        const int row0 = u.pm * 256 + wr * 64 + fr, col0 = u.pn * 256 + wc * 32 + 8 * fq;
#pragma unroll
        for (int ai = 0; ai < 2; ++ai)
#pragma unroll
            for (int m = 0; m < 4; ++m)
#pragma unroll
                for (int bj = 0; bj < 2; ++bj)
#pragma unroll
                    for (int n = 0; n < 2; ++n) { const pg8::f32x4 a = acc[ai][bj][m][n];
                        *(float4*)(O + (size_t)(row0 + ai * 128 + m * 16) * ldc + col0 + bj * 128 + 4 * n) = make_float4(a[0], a[1], a[2], a[3]); }
        return false;
    }
};
struct SchedCmp { int c;
    __device__ __forceinline__ bool next(int i, pg8::Unit& u) const { if (i > 0 || c >= 32) return false; u.pm = c >> 1; u.pn = c & 1; u.z = c >> 4; return true; } };

__device__ __forceinline__ float4 posb_sum(const float* p) { float4 a = *(const float4*)p;
#pragma unroll
    for (int sl = 1; sl < 8; ++sl) { const float4 b = *(const float4*)(p + sl * 512); a.x += b.x; a.y += b.y; a.z += b.z; a.w += b.w; }
    return a; }

__device__ __forceinline__ void tr_item(const float* src, int ldn, int k0, int n0, int nvalid, bf16* dst, int ldk, int r0, LAS float* scr, int lane, const float* kgain = nullptr) {
    const int nn = lane & 31;
    float tv[32];
#pragma unroll
    for (int i = 0; i < 32; ++i) { const int kk = 2 * i + (lane >> 5); tv[i] = (nn < nvalid) ? __builtin_nontemporal_load(src + (size_t)(k0 + kk) * ldn + n0 + nn) : 0.f; }
#pragma unroll
    for (int i = 0; i < 32; ++i) { const int kk = 2 * i + (lane >> 5); scr[kk * 33 + nn] = kgain ? tv[i] * kgain[k0 + kk] : tv[i]; }
    asm volatile("s_waitcnt lgkmcnt(0)" ::: "memory");
    const int cch = lane & 7;
#pragma unroll
    for (int j = 0; j < 4; ++j) { const int n = (lane >> 3) + 8 * j; const LAS float* sp = scr + (8 * cch) * 33 + n;
        uint4 o; o.x = pg8::cvt_pk_bf16(sp[0 * 33], sp[1 * 33]); o.y = pg8::cvt_pk_bf16(sp[2 * 33], sp[3 * 33]); o.z = pg8::cvt_pk_bf16(sp[4 * 33], sp[5 * 33]); o.w = pg8::cvt_pk_bf16(sp[6 * 33], sp[7 * 33]);
        *(uint4*)(dst + (size_t)(r0 + n) * ldk + k0 + 8 * cch) = o; }
    asm volatile("s_waitcnt lgkmcnt(0)" ::: "memory");
}


namespace att {
typedef short bf16x8 __attribute__((ext_vector_type(8)));
typedef short s16x4 __attribute__((ext_vector_type(4)));
typedef short v4i16_t __attribute__((ext_vector_type(4)));
typedef float f32x16 __attribute__((ext_vector_type(16)));
typedef unsigned u32x4 __attribute__((ext_vector_type(4)));
typedef float f32x4v __attribute__((ext_vector_type(4)));
constexpr float C2 = 0.125f * 1.4426950408889634f;
constexpr float LOG2E = 1.4426950408889634f;
constexpr float NEGB = -1e30f, MFLOOR = -1e4f;
__device__ __forceinline__ int crow(int r, int hi) { return (r & 3) + 8 * (r >> 2) + 4 * hi; }
__device__ __forceinline__ s16x4 vtr(const LAS char* p) { return __builtin_bit_cast(s16x4, __builtin_amdgcn_ds_read_tr16_b64_v4i16((LAS v4i16_t*)p)); }
typedef float f32x2_t __attribute__((ext_vector_type(2))); typedef __bf16 bf16x2_t __attribute__((ext_vector_type(2)));
__device__ __forceinline__ unsigned cvtpk(float lo, float hi) { const f32x2_t v = {lo, hi}; const bf16x2_t b = __builtin_convertvector(v, bf16x2_t); return __builtin_bit_cast(unsigned, b); }
#define ATT_WAIT_BAR() asm volatile("s_waitcnt vmcnt(0) lgkmcnt(0)\n\ts_barrier" ::: "memory")

template <int NKB> __device__ __forceinline__ void stage_img(LAS unsigned char* dst, const unsigned char* src, int wid, int lane) {
#pragma unroll
    for (int c = 0; c < (NKB + 7) / 8; ++c) { const int pc = wid + 8 * c;
        if (NKB % 8 == 0 || pc < NKB) __builtin_amdgcn_global_load_lds((const unsigned*)(src + pc * 1024 + lane * 16), (LAS unsigned*)(dst + pc * 1024), 16, 0, 0); }
}
__device__ __forceinline__ void qk_tile(f32x16& p0, f32x16& p1, const LAS unsigned char* kt, int ch0, const bf16x8 (&qf)[4], int r32, int hi) {
    const LAS unsigned char* kb = kt + (ch0 + hi) * 1024 + r32 * 16;
    p0 = (f32x16){0.f, 0.f, 0.f, 0.f, 0.f, 0.f, 0.f, 0.f, 0.f, 0.f, 0.f, 0.f, 0.f, 0.f, 0.f, 0.f}; p1 = p0;
#pragma unroll
    for (int d0 = 0; d0 < 4; ++d0) {
        const bf16x8 a0 = *(const LAS bf16x8*)(kb + d0 * 2048), a1 = *(const LAS bf16x8*)(kb + d0 * 2048 + 512);
        p0 = __builtin_amdgcn_mfma_f32_32x32x16_bf16(a0, qf[d0], p0, 0, 0, 0);
        p1 = __builtin_amdgcn_mfma_f32_32x32x16_bf16(a1, qf[d0], p1, 0, 0, 0);
    }
}
template <int EB> __device__ __forceinline__ void pv_tile(f32x16 (&o)[EB], const LAS unsigned char* vt, const f32x16& p0, const f32x16& p1, int lane) {
    const int hi = lane >> 5;
    const LAS char* vb = (const LAS char*)vt + ((lane >> 4) & 1) * 32 + (lane & 3) * 8 + (4 * hi + ((lane & 15) >> 2)) * 64;
#pragma unroll
    for (int ks = 0; ks < 4; ++ks) {
        s16x4 lo[EB], hh[EB];
#pragma unroll
        for (int eb = 0; eb < EB; ++eb) { lo[eb] = vtr(vb + eb * 4096 + ks * 1024); hh[eb] = vtr(vb + eb * 4096 + ks * 1024 + 512); }
        const f32x16& p = (ks < 2) ? p0 : p1; const int rb = (ks & 1) * 8;
        const u32x4 w = (u32x4){cvtpk(p[rb + 0], p[rb + 1]), cvtpk(p[rb + 2], p[rb + 3]), cvtpk(p[rb + 4], p[rb + 5]), cvtpk(p[rb + 6], p[rb + 7])};
        const bf16x8 pa = __builtin_bit_cast(bf16x8, w);
#pragma unroll
        for (int eb = 0; eb < EB; ++eb) {
            const bf16x8 vf = (bf16x8){lo[eb][0], lo[eb][1], lo[eb][2], lo[eb][3], hh[eb][0], hh[eb][1], hh[eb][2], hh[eb][3]};
            o[eb] = __builtin_amdgcn_mfma_f32_32x32x16_bf16(pa, vf, o[eb], 0, 0, 0);
        }
    }
}
template <bool BIAS, bool CAUSAL, bool BAND> __device__ __forceinline__ void bias_mask(f32x16& p0, f32x16& p1, const LAS float* bl, int qabs, int kt0, int hi) {
#pragma unroll
    for (int r = 0; r < 16; ++r) {
        const int d0 = qabs - (kt0 + crow(r, hi)), d1 = d0 - 32;
        if (BIAS) { p0[r] += bl[d0 < 0 ? 0 : (d0 > 255 ? 255 : d0)]; p1[r] += bl[d1 < 0 ? 0 : (d1 > 255 ? 255 : d1)]; }
        if (CAUSAL) { if (d0 < 0) p0[r] = NEGB; if (d1 < 0) p1[r] = NEGB; }
        if (BAND) { if (d0 >= 512) p0[r] = NEGB; if (d1 >= 512) p1[r] = NEGB; }
    }
}
__device__ __forceinline__ void bias_vec(f32x16& p0, f32x16& p1, const LAS float* rt, int e0, int hi) {
    const int a = (-e0) & 3;
    const LAS float* bp = rt + a * 320 + (208 - e0 - a) + 4 * hi;
#pragma unroll
    for (int g4 = 0; g4 < 4; ++g4) { const f32x4v v0 = *(const LAS f32x4v*)(bp + 8 * g4), v1 = *(const LAS f32x4v*)(bp + 8 * g4 + 32);
        p0[4 * g4] += v0[0]; p0[4 * g4 + 1] += v0[1]; p0[4 * g4 + 2] += v0[2]; p0[4 * g4 + 3] += v0[3];
        p1[4 * g4] += v1[0]; p1[4 * g4 + 1] += v1[1]; p1[4 * g4 + 2] += v1[2]; p1[4 * g4 + 3] += v1[3]; }
}
constexpr float THR = 8.f;
__device__ __forceinline__ float max3f(float a, float b, float c) { return fmaxf(fmaxf(a, b), c); }
template <int EB> __device__ __forceinline__ void softmax_step(f32x16& p0, f32x16& p1, float& m, float& l, f32x16 (&o)[EB], LAS float* wsf, int r32, int hi) {
    if (__any(m != 0.f)) {
#pragma unroll
        for (int r = 0; r < 16; ++r) { p0[r] -= m; p1[r] -= m; }
    }
    float ra = max3f(p0[0], p0[1], p1[0]), rb2 = max3f(p0[2], p0[3], p1[1]); ra = max3f(ra, p1[2], p1[3]);
#pragma unroll
    for (int r = 4; r < 16; r += 4) { ra = max3f(ra, p0[r], p0[r + 1]); rb2 = max3f(rb2, p0[r + 2], p0[r + 3]); ra = max3f(ra, p1[r], p1[r + 1]); rb2 = max3f(rb2, p1[r + 2], p1[r + 3]); }
    float rm = fmaxf(ra, rb2);
    if (__any(rm > THR)) {
        rm = fmaxf(rm, __shfl_xor(rm, 32));
        const float dl = rm > THR ? rm : 0.f;
        const float al = __builtin_amdgcn_exp2f(-dl);
        m += dl; l *= al;
#pragma unroll
        for (int r = 0; r < 16; ++r) { p0[r] -= dl; p1[r] -= dl; }
        if (hi == 0) wsf[r32] = al;
#pragma unroll
        for (int g = 0; g < 4; ++g) { const f32x4v a4 = *(const LAS f32x4v*)(wsf + 8 * g + 4 * hi);
#pragma unroll
            for (int eb = 0; eb < EB; ++eb) { o[eb][4 * g + 0] *= a4.x; o[eb][4 * g + 1] *= a4.y; o[eb][4 * g + 2] *= a4.z; o[eb][4 * g + 3] *= a4.w; } }
    }
    float s0 = 0.f, s1 = 0.f;
#pragma unroll
    for (int r = 0; r < 16; ++r) { p0[r] = __builtin_amdgcn_exp2f(p0[r]); p1[r] = __builtin_amdgcn_exp2f(p1[r]); s0 += p0[r]; s1 += p1[r]; }
    l += s0 + s1;
}
template <int EB> __device__ __forceinline__ void scale_rows(f32x16 (&o)[EB], float f, LAS float* wsf, int r32, int hi) {
    if (hi == 0) wsf[r32] = f;
#pragma unroll
    for (int g = 0; g < 4; ++g) { const f32x4v a4 = *(const LAS f32x4v*)(wsf + 8 * g + 4 * hi);
#pragma unroll
        for (int eb = 0; eb < EB; ++eb) { o[eb][4 * g + 0] *= a4.x; o[eb][4 * g + 1] *= a4.y; o[eb][4 * g + 2] *= a4.z; o[eb][4 * g + 3] *= a4.w; } }
}

struct DiffArgs { const bf16 *Q, *K, *V; bf16* O; const float* biasv; const float* out_gain; float lam; };
__device__ __forceinline__ void diff_unit(LAS unsigned char* lds, const DiffArgs& A, int b, int h, int qt) {
    int tid_ = threadIdx.x; asm volatile("" : "+v"(tid_));
    const int tid = tid_, lane = tid & 63, r32 = lane & 31, hi = lane >> 5, wid = __builtin_amdgcn_readfirstlane(tid >> 6);
    const int cs = wid >> 2, wq = wid & 3, q0 = qt * 128, qw0 = q0 + wq * 32, qabs = qw0 + r32;
    LAS float* bl = (LAS float*)(lds + 81920);
    LAS float* wsf = (LAS float*)(lds + 83968) + wid * 64;
    const size_t rowb = (size_t)b * S;
    LAS float* rt = (LAS float*)(lds + 86016);
    for (int i = tid; i < 1280; i += 512) rt[i] = A.biasv[(8 + h) * 1280 + i];
    const unsigned char* Kh = (const unsigned char*)A.K + (size_t)(b * 4 + h) * 32 * 16384; const unsigned char* Vh = (const unsigned char*)A.V + (size_t)(b * 4 + h) * 32 * 16384;
    const int NT = (q0 + 128) / 64;
    stage_img<16>(lds, Kh, wid, lane); stage_img<16>(lds + 49152, Vh, wid, lane);
    stage_img<16>(lds + 16384, Kh + 16384, wid, lane);
    bf16x8 qf[4];
    { const bf16* qp = A.Q + (rowb + qabs) * 512 + h * 128 + cs * 64 + hi * 8;
#pragma unroll
      for (int d0 = 0; d0 < 4; ++d0) qf[d0] = *(const bf16x8*)(qp + d0 * 16); }
    f32x16 o[4];
#pragma unroll
    for (int eb = 0; eb < 4; ++eb) o[eb] = (f32x16){0.f, 0.f, 0.f, 0.f, 0.f, 0.f, 0.f, 0.f, 0.f, 0.f, 0.f, 0.f, 0.f, 0.f, 0.f, 0.f};
    float m = 0.f, l = 0.f;
    ATT_WAIT_BAR();
    if (wid >= 4) __builtin_amdgcn_s_setprio(1);
    f32x16 n0, n1;
    qk_tile(n0, n1, lds, cs * 8, qf, r32, hi);
    int kb_cur = 0, kb_nxt = 16384, kb_fre = 32768;
    for (int t = 0; t < NT; ++t) {
        if (t + 2 < NT) stage_img<16>(lds + kb_fre, Kh + (size_t)(t + 2) * 16384, wid, lane);
        if (t + 1 < NT) stage_img<16>(lds + 49152 + ((t + 1) & 1) * 16384, Vh + (size_t)(t + 1) * 16384, wid, lane);
        const int kt0 = t * 64;
        if (kt0 <= qw0 + 31) {
            f32x16 p0 = n0, p1 = n1;
            if (t + 1 < NT && kt0 + 64 <= qw0 + 31) qk_tile(n0, n1, lds + kb_nxt, cs * 8, qf, r32, hi);
            const bool causal = (kt0 + 63 > qw0), near_ = (qw0 - (kt0 + 63) < 113);
            if (causal || near_) bias_vec(p0, p1, rt, qabs - kt0, hi);
            softmax_step<4>(p0, p1, m, l, o, wsf, r32, hi);
            pv_tile<4>(o, lds + 49152 + (t & 1) * 16384, p0, p1, lane);
        }
        ATT_WAIT_BAR();
        { const int tmp = kb_cur; kb_cur = kb_nxt; kb_nxt = kb_fre; kb_fre = tmp; }
    }
    __builtin_amdgcn_s_setprio(0);
    l += __shfl_xor(l, 32);
    scale_rows<4>(o, (cs ? A.lam : 1.f) / l, wsf, r32, hi);
    LAS float* xch = (LAS float*)lds + (size_t)wq * 4096;
    if (cs == 1) {
#pragma unroll
        for (int eb = 0; eb < 4; ++eb)
#pragma unroll
            for (int r = 0; r < 16; ++r) xch[crow(r, hi) * 128 + eb * 32 + r32] = o[eb][r];
    }
    ATT_WAIT_BAR();
    if (cs == 0) {
        float ss[16];
#pragma unroll
        for (int r = 0; r < 16; ++r) ss[r] = 0.f;
#pragma unroll
        for (int eb = 0; eb < 4; ++eb)
#pragma unroll
            for (int r = 0; r < 16; ++r) { o[eb][r] -= xch[crow(r, hi) * 128 + eb * 32 + r32]; ss[r] += o[eb][r] * o[eb][r]; }
#pragma unroll
        for (int r = 0; r < 16; ++r) {
#pragma unroll
            for (int sft = 1; sft < 32; sft <<= 1) ss[r] += __shfl_xor(ss[r], sft);
            ss[r] = rsqrtf(ss[r] * (1.f / 128.f) + RMS_EPS) * (1.f - LAMBDA_INIT);
        }
        int hi_ = hi, r32_ = r32; asm volatile("" : "+v"(hi_), "+v"(r32_));
        bf16* op = A.O + (rowb + qw0 + 4 * hi_) * 512 + h * 128 + r32_;
#pragma unroll
        for (int eb = 0; eb < 4; ++eb) { const float gn = A.out_gain[eb * 32 + r32_];
#pragma unroll
            for (int r = 0; r < 16; ++r) op[(size_t)((r & 3) + 8 * (r >> 2)) * 512 + eb * 32] = f2bf(o[eb][r] * ss[r] * gn); }
    }
    ATT_WAIT_BAR();
}

struct NsaArgs { const bf16 *Q, *KS, *VS, *KW, *VW, *KC, *VC; const float* GN; bf16* O; const float* rel_bias; const float* biasv; };
__device__ __forceinline__ void imp_tile(const f32x16& p, int gbase, LAS float* ip, float inv, int hi, float& prevR) {
    float Av[4], Rv[4];
#pragma unroll
    for (int gq = 0; gq < 4; ++gq) { const float c3 = 0.5f * p[4 * gq + 3]; Av[gq] = p[4 * gq] + p[4 * gq + 1] + p[4 * gq + 2] + c3; Rv[gq] = __shfl_xor(c3, 32); }
#pragma unroll
    for (int gq = 0; gq < 4; ++gq) { const float add = hi ? Rv[gq] : (gq > 0 ? Rv[gq > 0 ? gq - 1 : 0] : prevR); ip[2 * (gbase + gq)] = (Av[gq] + add) * inv; }
    prevR = Rv[3];
}

__device__ __forceinline__ int cmp_class(int qw0, int n0) { return (16 * n0 > qw0) ? 2 : ((qw0 - 16 * (n0 + 31) - 31 >= 113) ? 0 : 1); }
__device__ __forceinline__ void cmp_bm1(f32x16& p, const LAS float* bl, int qabs, int n0, int hi) {
#pragma unroll
    for (int r = 0; r < 16; ++r) { const int d = qabs - 16 * (n0 + crow(r, hi)) - 31; p[r] += bl[d < 0 ? 0 : (d > 255 ? 255 : d)]; if (d < 0) p[r] = NEGB; }
}
__device__ __forceinline__ void cmp_pass(LAS unsigned char* lds, const bf16x8 (&qf)[4], const LAS float* bl, LAS float* ip, bool need_sel, float mref, int qw0, int qabs,
                                         int lane, int r32, int hi, f32x16 (&o)[2], float& l, float& rmax) {
    l = 0.f; rmax = NEGB; float prevR = 0.f;
    o[0] = (f32x16){0.f, 0.f, 0.f, 0.f, 0.f, 0.f, 0.f, 0.f, 0.f, 0.f, 0.f, 0.f, 0.f, 0.f, 0.f, 0.f}; o[1] = o[0];
#pragma unroll
    for (int tl = 0; tl < 2; ++tl) {
        const int c0 = cmp_class(qw0, 64 * tl), c1 = cmp_class(qw0, 64 * tl + 32);
        if (c0 == 2) {
            if (need_sel) {
#pragma unroll
                for (int gq = 0; gq < 8; ++gq) ip[2 * (8 * tl + gq)] = (gq == 0 && hi == 0) ? prevR : 0.f; }
            prevR = 0.f;
        } else {
            f32x16 p0, p1;
            qk_tile(p0, p1, lds + tl * 16384, 0, qf, r32, hi);
            if (c0 == 1) cmp_bm1(p0, bl, qabs, 64 * tl, hi);
            if (c1 == 1) cmp_bm1(p1, bl, qabs, 64 * tl + 32, hi);
            else if (c1 == 2) { p1 = (f32x16){NEGB, NEGB, NEGB, NEGB, NEGB, NEGB, NEGB, NEGB, NEGB, NEGB, NEGB, NEGB, NEGB, NEGB, NEGB, NEGB}; }
            float ra = max3f(p0[0], p0[1], p1[0]), rb2 = max3f(p0[2], p0[3], p1[1]); ra = max3f(ra, p1[2], p1[3]);
#pragma unroll
            for (int r = 4; r < 16; r += 4) { ra = max3f(ra, p0[r], p0[r + 1]); rb2 = max3f(rb2, p0[r + 2], p0[r + 3]); ra = max3f(ra, p1[r], p1[r + 1]); rb2 = max3f(rb2, p1[r + 2], p1[r + 3]); }
            rmax = max3f(rmax, ra, rb2);
            float s0 = 0.f, s1 = 0.f;
#pragma unroll
            for (int r = 0; r < 16; ++r) { p0[r] = __builtin_amdgcn_exp2f(p0[r] - mref); p1[r] = __builtin_amdgcn_exp2f(p1[r] - mref); s0 += p0[r]; s1 += p1[r]; }
            l += s0 + s1;
            if (need_sel) { imp_tile(p0, 8 * tl, ip, 1.f, hi, prevR); imp_tile(p1, 8 * tl + 4, ip, 1.f, hi, prevR); }
            pv_tile<2>(o, lds + tl * 16384 + 8192, p0, p1, lane);
        }
    }
}
__device__ __forceinline__ void nsa_unit(LAS unsigned char* lds, const NsaArgs& A, int b, int g, int qt) {
    int tid_ = threadIdx.x; asm volatile("" : "+v"(tid_));
    const int tid = tid_, wid = __builtin_amdgcn_readfirstlane(tid >> 6);
    int lane = tid & 63, r32 = lane & 31, hi = lane >> 5;
#define NSA_RELANE() do { asm volatile("" : "+v"(lane)); r32 = lane & 31; hi = lane >> 5; qabs = qw0 + r32; } while (0)
    const int hh = wid >> 1, head = g * 4 + hh, q0 = qt * 64, qw0 = q0 + (wid & 1) * 32; int qabs = qw0 + r32;
    LAS float* bl = (LAS float*)(lds + 32768) + hh * 256;
    LAS float* wsf = (LAS float*)(lds + 36864) + wid * 64;
    LAS float* ipart = (LAS float*)(lds + 40960);
    LAS float* itot = (LAS float*)(lds + 73728);
    LAS unsigned* sell = (LAS unsigned*)(lds + 81920);
    LAS float* invs = (LAS float*)(lds + 82176);
    LAS f32x16* otl = (LAS f32x16*)(lds + 86016) + (size_t)wid * 128 + lane;
    const size_t rowb = (size_t)b * S;
    for (int i = tid; i < 1024; i += 512) ((LAS float*)(lds + 32768))[i] = A.rel_bias[g * 1024 + i];
    { const unsigned char* Kc = (const unsigned char*)A.KC + (size_t)(b * 2 + g) * 16384; const unsigned char* Vc = (const unsigned char*)A.VC + (size_t)(b * 2 + g) * 16384;
      stage_img<8>(lds, Kc, wid, lane); stage_img<8>(lds + 8192, Vc, wid, lane);
      stage_img<8>(lds + 16384, Kc + 8192, wid, lane); stage_img<8>(lds + 24576, Vc + 8192, wid, lane); }
    bf16x8 qf[4];
    { const bf16* qp = A.Q + (rowb + qabs) * 512 + head * 64 + hi * 8;
#pragma unroll
      for (int d0 = 0; d0 < 4; ++d0) qf[d0] = *(const bf16x8*)(qp + d0 * 16); }
    ATT_WAIT_BAR();
    const bool need_sel = (qt >= 16);
    {
        NSA_RELANE();
        LAS float* ip = ipart + ((size_t)hh * 64 + (wid & 1) * 32 + r32) * 32 + hi;
        f32x16 o[2]; float l, rmax;
        cmp_pass(lds, qf, bl, ip, need_sel, 0.f, qw0, qabs, lane, r32, hi, o, l, rmax);
        if (__any(rmax > 64.f)) {
            rmax = fmaxf(rmax, __shfl_xor(rmax, 32));
            float dummy;
            cmp_pass(lds, qf, bl, ip, need_sel, fmaxf(rmax, 0.f), qw0, qabs, lane, r32, hi, o, l, dummy);
        }
        l += __shfl_xor(l, 32);
        const float inv = l > 0.f ? 1.f / l : 0.f;
        if (hi == 0) invs[hh * 64 + (wid & 1) * 32 + r32] = inv;
        { int qa = qabs; asm volatile("" : "+v"(qa)); scale_rows<2>(o, A.GN[(rowb + qa) * 24 + head] * inv, wsf, r32, hi); }
        otl[0] = o[0]; otl[64] = o[1];
    }
    ATT_WAIT_BAR();
    unsigned selq, un;
    if (need_sel) {
        {
            const int q = tid >> 3, j4 = (tid & 7) * 4;
#pragma unroll
            for (int jj = 0; jj < 4; ++jj) { const int j = j4 + jj; itot[q * 32 + j] = ((ipart[(0 * 64 + q) * 32 + j] * invs[q] + ipart[(1 * 64 + q) * 32 + j] * invs[64 + q]) + ipart[(2 * 64 + q) * 32 + j] * invs[128 + q]) + ipart[(3 * 64 + q) * 32 + j] * invs[192 + q]; }
        }
        ATT_WAIT_BAR();
        {
            const int j = lane & 31;
#pragma unroll 1
            for (int rd = 0; rd < 4; ++rd) {
                const int q = wid * 8 + rd * 2 + hi;
                const bool vj = j <= qt, fj = (j == 0) || (j == qt) || (j == qt - 1);
                const float sj = vj ? itot[q * 32 + j] + (fj ? 1e4f : 0.f) : -1e30f;
                int cnt = 0;
#pragma unroll 4
                for (int k = 0; k < 32; ++k) {
                    const bool vk = k <= qt, fk = (k == 0) || (k == qt) || (k == qt - 1);
                    const float sk = vk ? itot[q * 32 + k] + (fk ? 1e4f : 0.f) : -1e30f;
                    cnt += (sk > sj || (sk == sj && k < j)) ? 1 : 0;
                }
                const unsigned long long bal = __ballot(cnt < 16);
                if (lane == 0) sell[q] = (unsigned)bal;
                if (lane == 32) sell[q] = (unsigned)(bal >> 32);
            }
        }
        ATT_WAIT_BAR();
        NSA_RELANE();
        selq = sell[(wid & 1) * 32 + r32];
        un = sell[lane];
#pragma unroll
        for (int sft = 1; sft < 64; sft <<= 1) un |= __shfl_xor(un, sft);
        un = __builtin_amdgcn_readfirstlane(un) & (qt >= 31 ? 0xffffffffu : ((2u << qt) - 1u));
    } else {
        selq = (2u << qt) - 1u; un = selq;
    }
    for (int i = tid; i < 5120; i += 512) ipart[i] = A.biasv[(size_t)g * 5120 + i];
    const LAS float* rt = ipart + hh * 1280;
    {
        NSA_RELANE();
        const unsigned char* Kg = (const unsigned char*)A.KS + (size_t)(b * 2 + g) * 32 * 8192; const unsigned char* Vg = (const unsigned char*)A.VS + (size_t)(b * 2 + g) * 32 * 8192;
        f32x16 o[2]; o[0] = (f32x16){0.f, 0.f, 0.f, 0.f, 0.f, 0.f, 0.f, 0.f, 0.f, 0.f, 0.f, 0.f, 0.f, 0.f, 0.f, 0.f}; o[1] = o[0];
        float m = 0.f, l = 0.f;
        unsigned rem = un; int j = __builtin_ctz(rem); rem &= rem - 1u; int it = 0;
        stage_img<8>(lds, Kg + (size_t)j * 8192, wid, lane); stage_img<8>(lds + 8192, Vg + (size_t)j * 8192, wid, lane);
        ATT_WAIT_BAR();
        for (;;) {
            LAS unsigned char* cur = lds + (it & 1) * 16384; LAS unsigned char* nxt = lds + ((it + 1) & 1) * 16384;
            const int jn = rem ? __builtin_ctz(rem) : -1;
            if (jn >= 0) { rem &= rem - 1u; stage_img<8>(nxt, Kg + (size_t)jn * 8192, wid, lane); stage_img<8>(nxt + 8192, Vg + (size_t)jn * 8192, wid, lane); }
            const int kt0 = j * 64;
            if (kt0 <= qw0 + 31 && __any((selq >> j) & 1u)) {
                f32x16 p0, p1;
                qk_tile(p0, p1, cur, 0, qf, r32, hi);
                const bool causal = (kt0 + 63 > qw0), near_ = (qw0 - (kt0 + 63) < 113);
                if (causal || near_) bias_vec(p0, p1, rt, qabs - kt0, hi);
                if (!__all((selq >> j) & 1u)) {
                    const float off = ((selq >> j) & 1u) ? 0.f : NEGB;
#pragma unroll
                    for (int r = 0; r < 16; ++r) { p0[r] += off; p1[r] += off; } }
                softmax_step<2>(p0, p1, m, l, o, wsf, r32, hi);
                pv_tile<2>(o, cur + 8192, p0, p1, lane);
            }
            ATT_WAIT_BAR();
            if (jn < 0) break;
            j = jn; ++it;
        }
        l += __shfl_xor(l, 32);
        { int qa = qabs; asm volatile("" : "+v"(qa)); scale_rows<2>(o, A.GN[(rowb + qa) * 24 + 8 + head] / l, wsf, r32, hi); }
        otl[0] = otl[0] + o[0]; otl[64] = otl[64] + o[1];
    }
    f32x16 ot[2];
    {
        NSA_RELANE();
        const unsigned char* Kg = (const unsigned char*)A.KW + (size_t)(b * 2 + g) * 32 * 8192; const unsigned char* Vg = (const unsigned char*)A.VW + (size_t)(b * 2 + g) * 32 * 8192;
        f32x16 o[2]; o[0] = (f32x16){0.f, 0.f, 0.f, 0.f, 0.f, 0.f, 0.f, 0.f, 0.f, 0.f, 0.f, 0.f, 0.f, 0.f, 0.f, 0.f}; o[1] = o[0];
        float m = 0.f, l = 0.f;
        const int j0 = qt >= 8 ? qt - 8 : 0;
        stage_img<8>(lds, Kg + (size_t)j0 * 8192, wid, lane); stage_img<8>(lds + 8192, Vg + (size_t)j0 * 8192, wid, lane);
        ATT_WAIT_BAR();
        for (int j = j0; j <= qt; ++j) {
            const int it = j - j0;
            LAS unsigned char* cur = lds + (it & 1) * 16384; LAS unsigned char* nxt = lds + ((it + 1) & 1) * 16384;
            if (j < qt) { stage_img<8>(nxt, Kg + (size_t)(j + 1) * 8192, wid, lane); stage_img<8>(nxt + 8192, Vg + (size_t)(j + 1) * 8192, wid, lane); }
            const int kt0 = j * 64;
            if (kt0 <= qw0 + 31) {
                f32x16 p0, p1;
                qk_tile(p0, p1, cur, 0, qf, r32, hi);
                const bool causal = (kt0 + 63 > qw0), near_ = (qw0 - (kt0 + 63) < 113), band = (qw0 + 31 - kt0 >= 512);
                if (causal || near_) bias_vec(p0, p1, rt, qabs - kt0, hi);
                else if (band) bias_mask<false, false, true>(p0, p1, bl, qabs, kt0, hi);
                softmax_step<2>(p0, p1, m, l, o, wsf, r32, hi);
                pv_tile<2>(o, cur + 8192, p0, p1, lane);
            }
            ATT_WAIT_BAR();
        }
        l += __shfl_xor(l, 32);
        { int qa = qabs; asm volatile("" : "+v"(qa)); scale_rows<2>(o, A.GN[(rowb + qa) * 24 + 16 + head] / l, wsf, r32, hi); }
        ot[0] = otl[0] + o[0]; ot[1] = otl[64] + o[1];
    }
    {   int hi_ = hi, r32_ = r32; asm volatile("" : "+v"(hi_), "+v"(r32_));
        bf16* op = A.O + (rowb + qw0 + 4 * hi_) * 512 + head * 64 + r32_;
#pragma unroll
        for (int eb = 0; eb < 2; ++eb)
#pragma unroll
            for (int r = 0; r < 16; ++r) op[(size_t)((r & 3) + 8 * (r >> 2)) * 512 + eb * 32] = f2bf(ot[eb][r]); }
#undef NSA_RELANE
}
}

constexpr int NCLS = 24;
constexpr int CW_CMPD = 10752, CW_FIN = 11008;
constexpr int CW_WQ = 10240;
constexpr int CW_CNT = 8192;
constexpr size_t WS_LIST = 254 * MiB;
constexpr int MISC_OFF = 161792;
constexpr int TAB_OFF = MISC_OFF + 256;
__device__ __forceinline__ void class_experts(int c, int& ea, int& eb) {
    const int g = c / 6, p = c % 6; const int a = p < 3 ? 0 : (p < 5 ? 1 : 2); const int b = p < 3 ? p + 1 : (p < 5 ? p - 1 : 3); ea = g * 4 + a; eb = g * 4 + b; }
__device__ __forceinline__ void moe_build_tab(const unsigned* ctl, LAS int* tab) {
    if (threadIdx.x < 64) {
        const int lane = threadIdx.x;
        const int n = (lane < NCLS) ? (int)__hip_atomic_load(ctl + CW_CNT + 64 * lane, __ATOMIC_RELAXED, __HIP_MEMORY_SCOPE_AGENT) : 0;
        const int nt_ = (n + 255) >> 8;
        int pre = nt_;
#pragma unroll
        for (int o = 1; o < 32; o <<= 1) { const int v = __shfl_up(pre, o); if (lane >= o) pre += v; }
        const int first = pre - nt_;
        if (lane < NCLS) { tab[lane] = first; tab[32 + lane] = n; for (int j = 0; j < nt_; ++j) tab[64 + first + j] = lane; }
        if (lane == NCLS - 1) tab[NCLS] = pre;
    }
    __syncthreads();
}
struct OpsGU { const bf16* H2; const bf16* WGU; const unsigned* LIST; const LAS int* tab; static constexpr int NT = 16, LDB = 1024;
    __device__ __forceinline__ const char* a_base(const pg8::Unit&) const { return (const char*)H2; }
    __device__ __forceinline__ void a_voff(const pg8::Unit& u, const int (&R)[2], const int (&C)[2], unsigned (&out)[2][2]) const {
        const int c = tab[64 + u.pm], n = tab[32 + c], r0 = (u.pm - tab[c]) * 256;
#pragma unroll
        for (int h = 0; h < 2; ++h)
#pragma unroll
            for (int i = 0; i < 2; ++i) { const int r = r0 + h * 128 + R[i]; const unsigned tok = (r < n) ? LIST[(size_t)c * T + r] : 0u; out[h][i] = (tok * 1024u + (unsigned)C[i]) * 2u; } }
    __device__ __forceinline__ void bprep(const pg8::Unit& u, const char*& p0, const char*& p1) const {
        int ea, eb; class_experts(tab[64 + u.pm], ea, eb); const int e = u.z ? eb : ea; p0 = (const char*)(WGU + ((size_t)e * 1024 + u.pn * 256) * 1024); p1 = p0; }
    __device__ static __forceinline__ const char* bat(const char* p0, const char*, int kt) { return p0 + (size_t)kt * 128; } };
constexpr int CW_MQ = 10496;
constexpr int CW_DONE = 12288;
struct SchedGU { const LAS int* tab; int G, vcu;
    __device__ __forceinline__ bool next(int i, pg8::Unit& u) const { const int L = i * G + vcu; if (L >= tab[NCLS] * 8) return false; u.pm = L >> 3; u.z = (L >> 2) & 1; u.pn = L & 3; return true; } };
struct EpiGU { bf16* HID; const unsigned* LIST; const float* ROUTE; const LAS int* tab; unsigned* ctl;
    __device__ __forceinline__ void operator()(const pg8::f32x4 (&acc)[2][2][4][2], const pg8::Unit& u, int wr, int wc, int fr_, int fq_) const {
        int fr = fr_, fq = fq_; asm volatile("" : "+v"(fr), "+v"(fq));
        const int c = tab[64 + u.pm], n = tab[32 + c], r0 = (u.pm - tab[c]) * 256;
        const __amdgpu_buffer_rsrc_t rsrc = __builtin_amdgcn_make_buffer_rsrc((void*)HID, 0, 0x7fffffff, 0x00020000);
#pragma unroll
        for (int ai = 0; ai < 2; ++ai)
#pragma unroll
            for (int m = 0; m < 4; ++m) {
                const int rl = ai * 128 + wr * 64 + m * 16 + fr, r = r0 + rl;
                if (r < n) {
                    const unsigned tok = LIST[(size_t)c * T + r]; const float w = ROUTE[(size_t)tok * 4 + u.z], rs = ROUTE[(size_t)tok * 4 + 3];
                    float v[8];
#pragma unroll
                    for (int nn = 0; nn < 2; ++nn)
#pragma unroll
                        for (int i = 0; i < 4; ++i) { const float gt = acc[ai][0][m][nn][i] * rs, up = acc[ai][1][m][nn][i] * rs; v[4 * nn + i] = gt * __builtin_amdgcn_rcpf(1.f + __builtin_amdgcn_exp2f(-1.4426950408889634f * gt)) * up * w; }
                    uint4 o; o.x = pg8::cvt_pk_bf16(v[0], v[1]); o.y = pg8::cvt_pk_bf16(v[2], v[3]); o.z = pg8::cvt_pk_bf16(v[4], v[5]); o.w = pg8::cvt_pk_bf16(v[6], v[7]);
                    __builtin_amdgcn_raw_buffer_store_b128(__builtin_bit_cast(pg8::u32x4, o), rsrc, (int)(((unsigned)(u.pm * 256 + rl) * 1024u + (unsigned)(u.z * 512 + u.pn * 128 + wc * 32 + 8 * fq)) * 2u), 0, 16);
                }
                asm volatile("" ::: "memory");
            }
        asm volatile("s_waitcnt vmcnt(0)" ::: "memory");
        if (fr == 0 && fq == 0) __hip_atomic_fetch_add(ctl + CW_DONE + 64 * u.pm, 1u, __ATOMIC_RELAXED, __HIP_MEMORY_SCOPE_AGENT);
    }
};
struct OpsDN { const bf16* HID; const bf16* WDN; const LAS int* tab; static constexpr int NT = 16, LDB = 512;
    __device__ __forceinline__ const char* a_base(const pg8::Unit& u) const { return (const char*)(HID + (size_t)u.pm * 256 * 1024); }
    __device__ __forceinline__ void a_voff(const pg8::Unit&, const int (&R)[2], const int (&C)[2], unsigned (&out)[2][2]) const {
#pragma unroll
        for (int h = 0; h < 2; ++h)
#pragma unroll
            for (int i = 0; i < 2; ++i) out[h][i] = (unsigned)((h * 128 + R[i]) * 1024 + C[i]) * 2u; }
    __device__ __forceinline__ void bprep(const pg8::Unit& u, const char*& p0, const char*& p1) const {
        int ea, eb; class_experts(tab[64 + u.pm], ea, eb);
        p0 = (const char*)(WDN + ((size_t)ea * 1024 + u.pn * 256) * 512); p1 = (const char*)(WDN + ((size_t)eb * 1024 + u.pn * 256) * 512); }
    __device__ static __forceinline__ const char* bat(const char* p0, const char* p1, int kt) { return (kt < 8 ? p0 : p1) + (size_t)(kt & 7) * 128; } };
struct SchedDN { const LAS int* tab; unsigned* ctl; int G, vcu;
    __device__ __forceinline__ bool next(int i, pg8::Unit& u) const {
        const int total = tab[NCLS] * 4;
        int L = -1;
        if (i == 0) L = vcu; else if (i == 1) { const int e = G - 1 - vcu; if (G + e < total) L = G + e; }
        if (L < 0 || L >= total) L = -1;
        __builtin_amdgcn_s_barrier();
        if (threadIdx.x == 0 && L >= 0) {
            unsigned* dn = ctl + CW_DONE + 64 * (L >> 2); unsigned sp = 0;
            while (__hip_atomic_load(dn, __ATOMIC_RELAXED, __HIP_MEMORY_SCOPE_AGENT) < 64u) { __builtin_amdgcn_s_sleep(2); if (++sp > (1u << 22)) { atomicAdd(ctl + XB_TMO + CW_BAR, 1u); break; } }
            __builtin_amdgcn_fence(__ATOMIC_ACQUIRE, "agent");
            asm volatile("s_waitcnt vmcnt(0)" ::: "memory");
        }
        __builtin_amdgcn_s_barrier();
        if (L < 0) return false; u.pm = L >> 2; u.pn = L & 3; u.z = 0; return true; } };
struct EpiDN { float* O; const bf16* X2; const unsigned* LIST; const LAS int* tab;
    __device__ __forceinline__ void operator()(const pg8::f32x4 (&acc)[2][2][4][2], const pg8::Unit& u, int wr, int wc, int fr_, int fq_) const {
        int fr = fr_, fq = fq_; asm volatile("" : "+v"(fr), "+v"(fq));
        const int c = tab[64 + u.pm], n = tab[32 + c], r0 = (u.pm - tab[c]) * 256;
#pragma unroll
        for (int ai = 0; ai < 2; ++ai)
#pragma unroll
            for (int m = 0; m < 4; ++m) {
                const int r = r0 + ai * 128 + wr * 64 + m * 16 + fr;
                if (r < n) {
                    const unsigned tok = LIST[(size_t)c * T + r];
#pragma unroll
                    for (int bj = 0; bj < 2; ++bj) { const size_t off = (size_t)tok * 1024 + u.pn * 256 + bj * 128 + wc * 32 + 8 * fq;
                        const uint4 xw = *(const uint4*)(X2 + off); const pg8::f32x4 a0 = acc[ai][bj][m][0], a1 = acc[ai][bj][m][1];
                        const nt_f32x4 y0 = {LO16(xw.x) + a0[0], HI16(xw.x) + a0[1], LO16(xw.y) + a0[2], HI16(xw.y) + a0[3]}, y1 = {LO16(xw.z) + a1[0], HI16(xw.z) + a1[1], LO16(xw.w) + a1[2], HI16(xw.w) + a1[3]};
                        __builtin_nontemporal_store(y0, (nt_f32x4*)(O + off)); __builtin_nontemporal_store(y1, (nt_f32x4*)(O + off + 4)); }
                }
            }
    }
};

constexpr int NTHR = 512;
constexpr int LDS_BYTES = 163840;

__global__ void __launch_bounds__(NTHR, 2) fwd_kernel(Args args) {
    extern __shared__ __attribute__((aligned(16))) unsigned char lds[];
    const int tid = threadIdx.x, lane = tid & 63;
    const int gtid = blockIdx.x * NTHR + tid, nthreads = gridDim.x * NTHR;
    const int gwave = gtid >> 6, nwaves = nthreads >> 6;
    Ctx c; c.a = args; unsigned char* ws = args.ws;

    volatile LAS unsigned* MISC = (volatile LAS unsigned*)((LAS unsigned char*)lds + MISC_OFF);
    if (tid < 32) MISC[tid] = 0u;
    __syncthreads();
    XcdBarrier bar = xcd_barrier_post((unsigned*)(ws + WS_CTL) + CW_BAR, MISC + 8);
    const int lo = args.ph_lo, hi = args.ph_hi;
#ifdef ONLY_PHASE
#define IN(k) ((k) == ONLY_PHASE)
#else
#define IN(k) (lo <= (k) && (k) < hi)
#endif
#define SEAM(k) do { if (IN(k) && IN((k) + 1)) xcd_barrier(bar); } while (0)


    if (IN(0)) {
        for (int t = gwave * 2; t < T; t += nwaves * 2) {
            const float4* xr = (const float4*)(c.x() + (size_t)t * D) + lane;
            float4 v[8]; float s0 = 0.f, s1 = 0.f;
#pragma unroll
            for (int j = 0; j < 8; ++j) v[j] = xr[64 * j];
#pragma unroll
            for (int j = 0; j < 4; ++j) { s0 += v[j].x * v[j].x + v[j].y * v[j].y + v[j].z * v[j].z + v[j].w * v[j].w; s1 += v[4 + j].x * v[4 + j].x + v[4 + j].y * v[4 + j].y + v[4 + j].z * v[4 + j].z + v[4 + j].w * v[4 + j].w; }
            const float r0 = rsqrtf(wave_sum(s0) * (1.f / D) + RMS_EPS), r1 = rsqrtf(wave_sum(s1) * (1.f / D) + RMS_EPS);
#pragma unroll
            for (int j = 0; j < 8; ++j) { const float4 g = ((const float4*)c.norm1_g())[lane + 64 * (j & 3)]; const float r = j < 4 ? r0 : r1;
                uint2 o; o.x = pk2bf(v[j].x * r * g.x, v[j].y * r * g.y); o.y = pk2bf(v[j].z * r * g.z, v[j].w * r * g.w);
                ((uint2*)(c.H1() + (size_t)t * D))[lane + 64 * j] = o; }
        }
        {
            LAS float* scr = (LAS float*)((LAS unsigned char*)lds + (tid >> 6) * 16384);
            constexpr int I_IN = 16 * 160, I_OUT = 16 * 32, I_BR = 8 * 32, I_GU = 16 * 4 * 2 * 4 * 16, I_DN = 16 * 8 * 32, I_C1 = 512;
            for (int it = gwave; it < I_IN + I_OUT + 2 * I_BR + I_GU + I_DN + I_C1; it += nwaves) {
                int r = it;
                if (r < I_IN) { const int kb = r / 160, vb = r % 160, pn = vb >> 3, bj = (vb >> 2) & 1, wc = vb & 3;
                    const ChunkDesc d = chunk_desc(c, pn * 4 + wc); int nv = d.ncols - 32 * bj; nv = nv < 0 ? 0 : (nv > 32 ? 32 : nv);
                    tr_item(c.w_in(), INC, 64 * kb, d.src + 32 * bj, nv, c.WIN(), 1024, 256 * pn + 128 * bj + 32 * wc, scr, lane); continue; }
                r -= I_IN;
                if (r < I_OUT) { tr_item(c.w_out(), 1024, 64 * (r / 32), 32 * (r % 32), 32, c.WOUT(), 1024, 32 * (r % 32), scr, lane); continue; }
                r -= I_OUT;
                if (r < I_BR) { tr_item(c.w_bn(), 1024, 64 * (r / 32), 32 * (r % 32), 32, c.WBN(), 512, 32 * (r % 32), scr, lane); continue; }
                r -= I_BR;
                if (r < I_BR) { tr_item(c.w_bd(), 1024, 64 * (r / 32), 32 * (r % 32), 32, c.WBD(), 512, 32 * (r % 32), scr, lane); continue; }
                r -= I_BR;
                if (r < I_GU) { const int kb = r & 15, blk = (r >> 4) & 3, bj = (r >> 6) & 1, ntile = (r >> 7) & 3, e = r >> 9;
                    tr_item((bj ? c.w_up() : c.w_gate()) + (size_t)e * 1024 * 512, 512, 64 * kb, ntile * 128 + 32 * blk, 32, c.WGU() + (size_t)e * 1024 * 1024, 1024, 256 * ntile + 128 * bj + 32 * blk, scr, lane, c.norm2_g()); continue; }
                r -= I_GU;
                if (r < I_DN) { const int nb = r & 31, kb = (r >> 5) & 7, e = r >> 8;
                    tr_item(c.w_down() + (size_t)e * 512 * 1024, 1024, 64 * kb, 32 * nb, 32, c.WDN() + (size_t)e * 1024 * 512, 512, 32 * nb, scr, lane); continue; }
                r -= I_DN;
                { const int nb = r & 7, kb = (r >> 3) & 15, bot = (r >> 7) & 1, kv = r >> 8;
                    tr_item(c.cmp_w1() + (size_t)kv * 2048 * 256 + (size_t)bot * 1024 * 256, 256, 64 * kb, 32 * nb, 32, c.WC1() + (size_t)kv * 512 * 1024, 1024, bot * 256 + 32 * nb, scr, lane); }
            }
            if (gwave >= nwaves - 64) { const int w = gwave - (nwaves - 64), sl = w & 7, jb = (w >> 3) & 3, kv = w >> 5, j = jb * 64 + lane;
                const float* w1 = c.cmp_w1() + (size_t)kv * 2048 * 256 + (size_t)sl * 256 * 256 + j; const float* pos = c.cmp_pos() + kv * 2048 + sl * 256;
                float a0 = 0.f, a1 = 0.f, a2 = 0.f, a3 = 0.f;
                for (int k = 0; k < 256; k += 4) { a0 += pos[k] * w1[(size_t)k * 256]; a1 += pos[k + 1] * w1[(size_t)(k + 1) * 256]; a2 += pos[k + 2] * w1[(size_t)(k + 2) * 256]; a3 += pos[k + 3] * w1[(size_t)(k + 3) * 256]; }
                c.POSB()[(sl * 2 + kv) * 256 + j] = (a0 + a1) + (a2 + a3); }
            if (gtid >= 8192 && gtid < 8192 + 12 * 1280) { const int i = gtid - 8192, hd = i / 1280, a = (i % 1280) / 320, j = (i % 320) + a, d = 208 - j;
                c.BIASV()[i] = (d < 0) ? -1e30f : (d >= 113 ? 0.f : (c.rel_bias()[t5_bucket(d) * 12 + hd] - c.rel_bias()[31 * 12 + hd]) * 1.4426950408889634f); }
            if (gtid >= 24576 && gtid < 24576 + 1024) { const int k = gtid - 24576; const float g = c.norm2_g()[k];
                const float4 gw = *(const float4*)(c.rg_w() + (size_t)k * 4);
                float w[20] = {gw.x, gw.y, gw.z, gw.w};
#pragma unroll
                for (int i4 = 0; i4 < 4; ++i4) { const float4 ew = *(const float4*)(c.re_w() + (size_t)k * 16 + 4 * i4); w[4 + 4 * i4] = ew.x; w[5 + 4 * i4] = ew.y; w[6 + 4 * i4] = ew.z; w[7 + 4 * i4] = ew.w; }
                bf16* wr = c.WRT() + k;
#pragma unroll
                for (int i = 0; i < 20; ++i) { const float v = w[i] * g; const bf16 h = f2bf(v); wr[(size_t)i * D] = h; wr[(size_t)(20 + i) * D] = f2bf(v - __uint_as_float((unsigned)h << 16)); }
#pragma unroll
                for (int i = 40; i < 48; ++i) wr[(size_t)i * D] = f2bf(0.f); }
            if (gtid >= 4096 && gtid < 4096 + 3072) { const int i = gtid - 4096, hd = i >> 8, d = i & 255; c.BIAS()[i] = (c.rel_bias()[t5_bucket(d) * 12 + hd] - c.rel_bias()[31 * 12 + hd]) * 1.4426950408889634f; }
            if (gtid >= 512 && gtid < 512 + 2048) { const int i = gtid - 512, kv = i >> 10, bg = (i >> 6) & 15, e = i & 63; const size_t tb = ((size_t)bg * 2 + 1) * 4096; if (kv) c.VCMP()[tb + (e >> 5) * 2048 + 3 * 512 + 15 * 32 + (e & 31)] = 0; else c.KCMP()[tb + (e >> 3) * 512 + 63 * 8 + (e & 7)] = 0; }
        }
        if (gwave == 0) {
            const float a = wave_sum(c.diff_lambda()[lane] * c.diff_lambda()[64 + lane]);
            const float b = wave_sum(c.diff_lambda()[128 + lane] * c.diff_lambda()[192 + lane]);
            if (lane == 0) c.LAM()[0] = expf(a) - expf(b) + LAMBDA_INIT;
        }
    }
    xcd_barrier(bar);

    if (IN(1)) {
        pg8::Ops g; g.A0 = c.H1(); g.A1 = c.H1(); g.B0 = c.WIN(); g.B1 = c.WIN(); g.K = 1024;
        pg8::StaticOrder<1> So; So.init(T, 5120, (int)gridDim.x, (int)blockIdx.x);
        EpiInProj E; E.c = c;
        pg8::gemm_phase(( LAS unsigned char*)lds, g, So, E);
    }
    xcd_barrier(bar);

    if (IN(2)) {
        pg8::Ops g; g.A0 = c.CT(); g.A1 = c.CT(); g.B0 = c.WC1(); g.B1 = c.WC1() + 512 * 1024; g.K = 1024;
        SchedCmp So; So.c = (int)blockIdx.x;
        EpiF32 E; E.O = c.U(); E.ldc = 512;
        pg8::gemm_phase((LAS unsigned char*)lds, g, So, E);
        unsigned* ctl = (unsigned*)(ws + WS_CTL);
        volatile LAS int* wq = (volatile LAS int*)((LAS unsigned char*)lds + MISC_OFF + 64);
        if (blockIdx.x < 32 && tid == 0) { __builtin_amdgcn_fence(__ATOMIC_RELEASE, "agent"); asm volatile("s_waitcnt vmcnt(0)" ::: "memory");
            __hip_atomic_fetch_add(ctl + CW_CMPD, 1u, __ATOMIC_RELAXED, __HIP_MEMORY_SCOPE_AGENT); }
        {   att::DiffArgs A; A.Q = c.QD(); A.K = c.KD(); A.V = c.VD(); A.O = c.ODIFF(); A.biasv = c.BIASV(); A.out_gain = c.diff_out_norm(); A.lam = c.LAM()[0];
            for (;;) {
                __syncthreads();
                if (tid == 0) *wq = (int)atomicAdd(ctl + CW_WQ, 1u);
                __syncthreads();
                const int u = *wq;
                if (u >= 512) break;
                att::diff_unit((LAS unsigned char*)lds, A, (u & 31) >> 2, u & 3, 15 - (u >> 5));
            } }
        {   __syncthreads();
            if (tid == 0) { unsigned sp = 0;
                while (__hip_atomic_load(ctl + CW_CMPD, __ATOMIC_RELAXED, __HIP_MEMORY_SCOPE_AGENT) < 32u) { __builtin_amdgcn_s_sleep(2); if (++sp > (1u << 22)) { atomicAdd(ctl + XB_TMO + CW_BAR, 1u); break; } }
                __builtin_amdgcn_fence(__ATOMIC_ACQUIRE, "agent"); asm volatile("s_waitcnt vmcnt(0)" ::: "memory"); }
            __syncthreads();
            LAS float* hid = (LAS float*)((LAS unsigned char*)lds) + (tid >> 6) * 256;
            for (;;) {
                __syncthreads();
                if (tid == 0) *wq = (int)atomicAdd(ctl + CW_WQ + 128, 1u);
                __syncthreads();
                const int q = *wq;
                if (q >= 128) break;
                const int quarter = q & 3, b = (q >> 2) & 7, g = (q >> 5) & 1, kv = q >> 6;
                for (int jj = 0; jj < 4; ++jj) {
                    const int n = quarter * 32 + (tid >> 6) * 4 + jj;
                    if (n >= NCMP) continue;
                    const float* u1 = c.U() + ((size_t)(kv * 2 + g) * 1024 + b * 128 + n) * 512;
                    const float4 t4 = *(const float4*)(u1 + 4 * lane), b4 = *(const float4*)(u1 + 512 + 256 + 4 * lane), p4 = posb_sum(c.POSB() + kv * 256 + 4 * lane);
                    const float hv[4] = {t4.x + b4.x + p4.x, t4.y + b4.y + p4.y, t4.z + b4.z + p4.z, t4.w + b4.w + p4.w};
#pragma unroll
                    for (int i = 0; i < 4; ++i) { const float a = hv[i]; const float uu = 0.7978845608028654f * (a + 0.044715f * a * a * a); hid[4 * lane + i] = 0.5f * a * (1.f + tanhf(uu)); }
                    const float* w2 = c.cmp_w2() + (size_t)kv * 256 * 64 + lane;
                    float o = 0.f;
                    for (int j = 0; j < 256; ++j) o += hid[j] * w2[j * 64];
                    if (kv == 0) { const float ss = wave_sum(o * o); o = o * rsqrtf(ss * (1.f / 64.f) + RMS_EPS) * c.nsa_k_norm()[lane]; }
                    { const int key = n & 63, e = lane; const size_t tb = ((size_t)(b * 2 + g) * 2 + (n >> 6)) * 4096;
                      if (kv) c.VCMP()[tb + (e >> 5) * 2048 + (key >> 4) * 512 + (key & 15) * 32 + (e & 31)] = f2bf(o);
                      else c.KCMP()[tb + (e >> 3) * 512 + key * 8 + (e & 7)] = f2bf(o); }
                }
                asm volatile("s_waitcnt vmcnt(0)" ::: "memory");
                __syncthreads();
                if (tid == 0) { __builtin_amdgcn_fence(__ATOMIC_RELEASE, "agent"); asm volatile("s_waitcnt vmcnt(0)" ::: "memory");
                    __hip_atomic_fetch_add(ctl + CW_FIN + 64 * (b * 2 + g), 1u, __ATOMIC_RELAXED, __HIP_MEMORY_SCOPE_AGENT); }
            } }
        {   att::NsaArgs A; A.Q = c.QN(); A.KS = c.KS(); A.VS = c.VS(); A.KW = c.KW(); A.VW = c.VW(); A.KC = c.KCMP(); A.VC = c.VCMP(); A.GN = c.GN(); A.O = c.ONSAB(); A.rel_bias = c.BIAS(); A.biasv = c.BIASV();
            bool all_seen = false;
            for (;;) {
                __syncthreads();
                if (tid == 0) {
                    const int u = (int)atomicAdd(ctl + CW_WQ + 64, 1u);
                    if (u < 512 && !all_seen) {
                        unsigned* fc = ctl + CW_FIN + 64 * (u & 15); unsigned sp = 0;
                        while (__hip_atomic_load(fc, __ATOMIC_RELAXED, __HIP_MEMORY_SCOPE_AGENT) < 8u) { __builtin_amdgcn_s_sleep(2); if (++sp > (1u << 22)) { atomicAdd(ctl + XB_TMO + CW_BAR, 1u); break; } }
                        bool all = true;
                        for (int k = 0; k < 16; ++k) all = all && (__hip_atomic_load(ctl + CW_FIN + 64 * k, __ATOMIC_RELAXED, __HIP_MEMORY_SCOPE_AGENT) >= 8u);
                        __builtin_amdgcn_fence(__ATOMIC_ACQUIRE, "agent"); asm volatile("s_waitcnt vmcnt(0)" ::: "memory");
                        all_seen = all;
                    }
                    *wq = u;
                }
                __syncthreads();
                const int u = *wq;
                if (u >= 512) break;
                att::nsa_unit((LAS unsigned char*)lds, A, (u & 15) >> 1, u & 1, 31 - (u >> 4));
            } }
    }
    xcd_barrier(bar);
    if (IN(7)) {
        pg8::Ops g; g.A0 = c.ONSAB(); g.A1 = c.ODIFF(); g.B0 = c.WBN(); g.B1 = c.WBD(); g.K = 512;
        pg8::StaticOrder<2> So; So.init(T, 1024, (int)gridDim.x, (int)blockIdx.x);
        EpiMerge E; E.Y = c.Y(); E.GM = c.GM();
        pg8::gemm_phase((LAS unsigned char*)lds, g, So, E);
    }
    xcd_barrier(bar);
    if (IN(8)) {
        pg8::Ops g; g.A0 = c.Y(); g.A1 = c.Y(); g.B0 = c.WOUT(); g.B1 = c.WOUT(); g.K = 1024;
        pg8::StaticOrder<1> So; So.init(T, 1024, (int)gridDim.x, (int)blockIdx.x);
        EpiResid E; E.X = c.x(); E.O = c.X2B();
        pg8::gemm_phase((LAS unsigned char*)lds, g, So, E);
    }
    xcd_barrier(bar);
    if (IN(9)) {
        unsigned* ctl = (unsigned*)(ws + WS_CTL); unsigned* LIST = (unsigned*)(ws + WS_LIST);
        LAS float* Pl = (LAS float*)lds;
        LAS float* Sl = (LAS float*)((LAS unsigned char*)lds + 24576);
        LAS unsigned char* Wl = (LAS unsigned char*)lds + 32768;
        const int wid = tid >> 6, rt = wid & 3, kh = wid >> 2, fr = lane & 15, fq = lane >> 4;
        for (int tb = blockIdx.x; tb < T / 64; tb += gridDim.x) {
            const bf16* xp = c.X2B() + (size_t)(tb * 64 + rt * 16 + fr) * D + kh * 512 + fq * 8;
            pg8::bf16x8 xv[16];
#pragma unroll
            for (int ks = 0; ks < 16; ++ks) xv[ks] = *(const pg8::bf16x8*)(xp + 32 * ks);
            if (tb == (int)blockIdx.x) {
                const pg8::u32x4* wsrc = (const pg8::u32x4*)c.WRT();
                pg8::u32x4 wq[12];
#pragma unroll
                for (int j = 0; j < 12; ++j) wq[j] = wsrc[tid + 512 * j];
#pragma unroll
                for (int j = 0; j < 12; ++j) { const int q = tid + 512 * j; *(LAS pg8::u32x4*)(Wl + (q >> 7) * 2080 + (q & 127) * 16) = wq[j]; } }
            __syncthreads();
            const LAS unsigned char* wl = Wl + fr * 2080 + (kh * 512 + fq * 8) * 2;
            pg8::f32x4 acc[3];
#pragma unroll
            for (int ct = 0; ct < 3; ++ct) acc[ct] = (pg8::f32x4){0.f, 0.f, 0.f, 0.f};
            float ss = 0.f;
#pragma unroll
            for (int ks = 0; ks < 16; ++ks) {
                pg8::bf16x8 wv[3];
#pragma unroll
                for (int ct = 0; ct < 3; ++ct) wv[ct] = *(const LAS pg8::bf16x8*)(wl + ct * 16 * 2080 + 64 * ks);
#pragma unroll
                for (int ct = 0; ct < 3; ++ct) acc[ct] = __builtin_amdgcn_mfma_f32_16x16x32_bf16(wv[ct], xv[ks], acc[ct], 0, 0, 0);
                const pg8::u32x4 xu = __builtin_bit_cast(pg8::u32x4, xv[ks]);
#pragma unroll
                for (int q = 0; q < 4; ++q) { const float a = LO16(xu[q]), b = HI16(xu[q]); ss += a * a + b * b; }
            }
#pragma unroll
            for (int ct = 0; ct < 3; ++ct) *(LAS pg8::f32x4*)(Pl + (size_t)((kh * 64 + rt * 16 + fr) * 48 + 16 * ct + 4 * fq)) = acc[ct];
            Sl[(kh * 4 + fq) * 64 + rt * 16 + fr] = ss;
            __syncthreads();
            if (tid < 64) {
                const LAS float* p0 = Pl + (size_t)lane * 48; const LAS float* p1 = Pl + (size_t)(64 + lane) * 48;
                float ssum = 0.f;
#pragma unroll
                for (int q = 0; q < 8; ++q) ssum += Sl[q * 64 + lane];
                const float rr = rsqrtf(ssum * (1.f / D) + RMS_EPS);
                float gl[4];
#pragma unroll
                for (int i = 0; i < 4; ++i) gl[i] = ((p0[i] + p1[i]) + (p0[20 + i] + p1[20 + i])) * rr + c.rg_b()[i];
                int gt = 0; float gbest = gl[0];
#pragma unroll
                for (int i = 1; i < 4; ++i) if (gl[i] > gbest) { gbest = gl[i]; gt = i; }
                float gs = 0.f;
#pragma unroll
                for (int i = 0; i < 4; ++i) gs += expf(gl[i] - gbest);
                const float gp = 1.f / gs;
                float el[4];
#pragma unroll
                for (int i = 0; i < 4; ++i) { const int jx = 4 + gt * 4 + i; el[i] = ((p0[jx] + p1[jx]) + (p0[20 + jx] + p1[20 + jx])) * rr + c.re_b()[gt * 4 + i]; }
                int e0 = 0; float b0 = el[0];
#pragma unroll
                for (int i = 1; i < 4; ++i) if (el[i] > b0) { b0 = el[i]; e0 = i; }
                int e1 = -1; float b1 = -3.0e38f;
#pragma unroll
                for (int i = 0; i < 4; ++i) if (i != e0 && el[i] > b1) { b1 = el[i]; e1 = i; }
                const float p1e = expf(b1 - b0); const float w0 = gp / (1.f + p1e), w1 = gp * p1e / (1.f + p1e);
                const int ea = e0 < e1 ? e0 : e1, eb = e0 < e1 ? e1 : e0;
                const int pr = (ea == 0) ? eb - 1 : (ea == 1 ? eb + 1 : 5);
                const int mycls = gt * 6 + pr;
                *(float4*)(c.ROUTE() + (size_t)(tb * 64 + lane) * 4) = make_float4(e0 < e1 ? w0 : w1, e0 < e1 ? w1 : w0, __int_as_float(mycls), rr);
                int cnt_l = 0, rank = 0;
                for (int cc = 0; cc < NCLS; ++cc) {
                    const unsigned long long mask = __ballot(mycls == cc);
                    if (lane == cc) cnt_l = __popcll(mask);
                    if (mycls == cc) rank = __popcll(mask & ((1ull << lane) - 1ull));
                }
                unsigned base_l = 0u;
                if (lane < NCLS && cnt_l > 0) base_l = atomicAdd(ctl + CW_CNT + 64 * lane, (unsigned)cnt_l);
                const unsigned base = __shfl(base_l, mycls);
                LIST[(size_t)mycls * T + base + rank] = (unsigned)(tb * 64 + lane);
            }
            __syncthreads();
        }
    }
    xcd_barrier(bar);
    if (IN(10)) {
        LAS int* tab = (LAS int*)((LAS unsigned char*)lds + TAB_OFF);
        moe_build_tab((const unsigned*)(ws + WS_CTL), tab);
        unsigned* ctl = (unsigned*)(ws + WS_CTL);
        const int G = (int)gridDim.x, bx = (int)blockIdx.x, vcu = (G % 8 == 0) ? (bx % 8) * (G / 8) + bx / 8 : bx;
        {   OpsGU g; g.H2 = c.X2B(); g.WGU = c.WGU(); g.LIST = (const unsigned*)(ws + WS_LIST); g.tab = tab;
            SchedGU So; So.tab = tab; So.G = G; So.vcu = vcu;
            EpiGU E; E.HID = c.HID(); E.LIST = (const unsigned*)(ws + WS_LIST); E.ROUTE = c.ROUTE(); E.tab = tab; E.ctl = ctl;
            pg8::gemm_phase_g((LAS unsigned char*)lds, g, So, E); }
        {   OpsDN g; g.HID = c.HID(); g.WDN = c.WDN(); g.tab = tab;
            SchedDN So; So.tab = tab; So.ctl = ctl; So.G = G; So.vcu = vcu;
            EpiDN E; E.O = c.out(); E.X2 = c.X2B(); E.LIST = (const unsigned*)(ws + WS_LIST); E.tab = tab;
            pg8::gemm_phase_g((LAS unsigned char*)lds, g, So, E); }
    }
#undef IN
#undef SEAM
}

extern "C" void kernel_launch(void* const* d_in, const int* in_sizes, int n_in, void* d_out, int out_size, void* d_ws, size_t ws_size, hipStream_t stream) {
    static int grid = 0;
    if (grid == 0) {
        if (n_in != 24 || out_size != T * D || ws_size < WS_END) { fprintf(stderr, "kernel_launch: unexpected shapes (n_in %d out %d ws %zu)\n", n_in, out_size, ws_size); grid = -1; return; }
        int dev = 0, cus = 0, per_cu = 0;
        if (hipGetDevice(&dev) != hipSuccess || hipDeviceGetAttribute(&cus, hipDeviceAttributeMultiprocessorCount, dev) != hipSuccess) { grid = -1; return; }
        if (hipFuncSetAttribute((const void*)fwd_kernel, hipFuncAttributeMaxDynamicSharedMemorySize, LDS_BYTES) != hipSuccess) { fprintf(stderr, "kernel_launch: hipFuncSetAttribute failed\n"); grid = -1; return; }
        if (hipOccupancyMaxActiveBlocksPerMultiprocessor(&per_cu, (const void*)fwd_kernel, NTHR, LDS_BYTES) != hipSuccess || per_cu < 1) { fprintf(stderr, "kernel_launch: occupancy query says %d\n", per_cu); }
        (void)hipGetLastError();
        grid = cus;
    }
    if (grid < 0) return;
    (void)hipMemsetAsync((char*)d_ws + WS_CTL, 0, CTL_ZERO_BYTES, stream);
    Args a{};
    for (int i = 0; i < 24; ++i) a.in[i] = (const float*)d_in[i];
    a.out = (float*)d_out; a.ws = (unsigned char*)d_ws; a.ph_lo = 0; a.ph_hi = 11;
    hipLaunchKernelGGL(fwd_kernel, dim3(grid), dim3(NTHR), LDS_BYTES, stream, a);
}
```

```cpp
#include <hip/hip_runtime.h>
#include <cstdint>
#include <cstdio>

constexpr int NB = 8, S = 2048, D = 1024, T = NB * S;
constexpr int INC = 4888;
constexpr int C_QN = 0, C_KV = 512, C_GN = 1280, C_QD = 1304, C_KD = 1816, C_VD = 2328, C_GM = 2840;
constexpr int NCMP = 127;
constexpr float LAMBDA_INIT = 0.2f;
constexpr float RMS_EPS = 1e-6f;

typedef unsigned short bf16;
#define LAS __attribute__((address_space(3)))

constexpr size_t MiB = 1u << 20;
constexpr size_t WS_CTL = 0, CTL_ZERO_BYTES = 1 * MiB;
constexpr size_t WS_WIN = 1 * MiB;
constexpr size_t WS_WOUT = 11 * MiB;
constexpr size_t WS_WBN = 13 * MiB, WS_WBD = 14 * MiB;
constexpr size_t WS_WC1 = 15 * MiB;
constexpr size_t WS_WGU = 17 * MiB;
constexpr size_t WS_WDN = 49 * MiB;
constexpr size_t WS_H1 = 65 * MiB;
constexpr size_t WS_QN = 97 * MiB;
constexpr size_t WS_CT = 113 * MiB;
constexpr size_t WS_KS = 121 * MiB, WS_VS = 125 * MiB, WS_KW = 129 * MiB, WS_VW = 133 * MiB;
constexpr size_t WS_QD = 137 * MiB, WS_KD = 153 * MiB, WS_VD = 169 * MiB;
constexpr size_t WS_GM = 185 * MiB;
constexpr size_t WS_GN = 249 * MiB;
constexpr size_t WS_KCMP = 251 * MiB;
constexpr size_t WS_VCMP = 251 * MiB + 256 * 1024;
constexpr size_t WS_ROUTE = 252 * MiB + 512 * 1024;
constexpr size_t WS_LAM = 252 * MiB + 768 * 1024;
constexpr size_t WS_POSB = 252 * MiB + 800 * 1024;
constexpr size_t WS_BIAS = 252 * MiB + 832 * 1024;
constexpr size_t WS_BIASV = 252 * MiB + 848 * 1024;
constexpr size_t WS_WRT = 253 * MiB;
constexpr size_t WS_END = 256 * MiB;
constexpr size_t WS_U = WS_H1;
constexpr size_t WS_ONSAB = WS_H1 + 16 * MiB;
constexpr size_t WS_X2B = WS_H1;
constexpr size_t WS_Y = WS_QN;
constexpr size_t WS_HID = WS_GM;

constexpr int CW_BAR = 4096;

#define XB_TMO      128
#define XB_XCNT(j)  (256  + 64 * (j))
#define XB_XSUB(j)  (1280 + 64 * (j))
#define XB_XGEN(j)  (2304 + 64 * (j))
#define XB_TOP      3328
#define XB_TOPGEN   3392
#define XCD_BAR_WORDS 3456
#define XB_SPIN_CAP (1u << 22)

__device__ __forceinline__ unsigned xb_ld(unsigned* p)              { return __hip_atomic_load(p, __ATOMIC_RELAXED, __HIP_MEMORY_SCOPE_AGENT); }
__device__ __forceinline__ unsigned xb_add(unsigned* p, unsigned v) { return __hip_atomic_fetch_add(p, v, __ATOMIC_RELAXED, __HIP_MEMORY_SCOPE_AGENT); }
__device__ __forceinline__ unsigned xb_xcc_id() { return (unsigned)__builtin_amdgcn_s_getreg((3 << 11) | 20) & 0xFu; }
#define XB_SPIN(cond, bar) do { unsigned _sp = 0; while (cond) { __builtin_amdgcn_s_sleep(1); \
    if ((++_sp & 255u) == 0u) { if (xb_ld(&(bar)[XB_TMO])) break; if (_sp > XB_SPIN_CAP) { atomicAdd(&(bar)[XB_TMO], 1u); break; } } } } while (0)

struct XcdBarrier { unsigned* bar; unsigned x; volatile LAS unsigned* st; };

__device__ __forceinline__ XcdBarrier xcd_barrier_post(unsigned* bar, volatile LAS unsigned* st) {
    XcdBarrier b; b.bar = bar; b.x = xb_xcc_id(); b.st = st;
    if (threadIdx.x == 0) (void)xb_add(&bar[XB_XCNT(b.x)], 1u);
    return b;
}
__device__ __forceinline__ void xcd_barrier_complete(unsigned* bar, unsigned x, unsigned& nloc, unsigned& nx) {
    const unsigned G = gridDim.x * gridDim.y * gridDim.z;
    unsigned sum, cnt, mine, sp = 0u;
    for (;;) {
        sum = 0u; cnt = 0u; mine = 0u;
#pragma unroll
        for (unsigned j = 0; j < 16; ++j) { const unsigned c = xb_ld(&bar[XB_XCNT(j)]); sum += c; cnt += (c > 0u) ? 1u : 0u; mine = (j == x) ? c : mine; }
        if (sum == G) break;
        __builtin_amdgcn_s_sleep(1);
        if ((++sp & 255u) == 0u) { if (xb_ld(&bar[XB_TMO])) break; if (sp > XB_SPIN_CAP) { atomicAdd(&bar[XB_TMO], 1u); break; } }
    }
    nloc = mine > 0u ? mine : 1u; nx = cnt > 0u ? cnt : 1u;
}
__device__ __forceinline__ void xcd_barrier(const XcdBarrier& b) {
    asm volatile("s_waitcnt vmcnt(0)" ::: "memory");
    __syncthreads();
    if (threadIdx.x == 0) {
        unsigned* bar = b.bar;
        __builtin_amdgcn_s_waitcnt(0);
        unsigned nloc = b.st[0], nx = b.st[1];
        if (nloc == 0u) { xcd_barrier_complete(bar, b.x, nloc, nx); b.st[0] = nloc; b.st[1] = nx; }
        const unsigned old = xb_add(&bar[XB_XSUB(b.x)], 1u);
        const unsigned gen = old / nloc;
        if (old + 1u == (gen + 1u) * nloc) {
            __builtin_amdgcn_fence(__ATOMIC_RELEASE, "agent");
            asm volatile("s_waitcnt vmcnt(0)" ::: "memory");
            const unsigned og = xb_add(&bar[XB_TOP], 1u);
            const unsigned tg = og / nx;
            if (og + 1u == (tg + 1u) * nx) xb_add(&bar[XB_TOPGEN], 1u);
            else XB_SPIN(xb_ld(&bar[XB_TOPGEN]) == tg, bar);
            __builtin_amdgcn_fence(__ATOMIC_ACQUIRE, "agent");
            xb_add(&bar[XB_XGEN(b.x)], 1u);
            asm volatile("s_waitcnt vmcnt(0)" ::: "memory");
        } else {
            XB_SPIN(xb_ld(&bar[XB_XGEN(b.x)]) == gen, bar);
            __builtin_amdgcn_fence(__ATOMIC_ACQUIRE, "agent");
            asm volatile("s_waitcnt vmcnt(0)" ::: "memory");
        }
    }
    __syncthreads();
}

__device__ __forceinline__ bf16 f2bf(float f) { unsigned u = __float_as_uint(f); return (bf16)((u + 0x7fffu + ((u >> 16) & 1u)) >> 16); }
typedef float g_f32x2 __attribute__((ext_vector_type(2))); typedef __bf16 g_bf16x2 __attribute__((ext_vector_type(2)));
__device__ __forceinline__ unsigned pk2bf(float lo, float hi) { const g_f32x2 v = {lo, hi}; const g_bf16x2 b = __builtin_convertvector(v, g_bf16x2); return __builtin_bit_cast(unsigned, b); }
__device__ __forceinline__ float wave_sum(float v) {
#pragma unroll
    for (int o = 1; o < 64; o <<= 1) v += __shfl_xor(v, o);
    return v;
}
typedef float nt_f32x4 __attribute__((ext_vector_type(4)));
__device__ __forceinline__ float sigmoidf_(float x) { return __builtin_amdgcn_rcpf(1.f + __builtin_amdgcn_exp2f(-1.4426950408889634f * x)); }

__device__ const unsigned char T5B[128] = {0, 1, 2, 3, 4, 5, 6, 7, 8, 9, 10, 11, 12, 13, 14, 15, 16, 16, 16, 17, 17, 18, 18, 18, 19, 19, 19, 20, 20, 20, 20, 21, 21, 21, 21, 22, 22, 22, 22, 22, 23, 23, 23, 23, 23, 23, 24, 24, 24, 24, 24, 24, 25, 25, 25, 25, 25, 25, 25, 26, 26, 26, 26, 26, 26, 26, 26, 27, 27, 27, 27, 27, 27, 27, 27, 27, 27, 28, 28, 28, 28, 28, 28, 28, 28, 28, 28, 29, 29, 29, 29, 29, 29, 29, 29, 29, 29, 29, 29, 30, 30, 30, 30, 30, 30, 30, 30, 30, 30, 30, 30, 30, 30, 31, 31, 31, 31, 31, 31, 31, 31, 31, 31, 31, 31, 31, 31, 31};
__device__ __forceinline__ int t5_bucket(int dist) { return (int)T5B[dist > 127 ? 127 : (dist < 0 ? 0 : dist)]; }

#define LO16(u) __uint_as_float((u) << 16)
#define HI16(u) __uint_as_float((u) & 0xffff0000u)

struct Args { const float* in[24]; float* out; unsigned char* ws; int ph_lo, ph_hi; };

struct Ctx {
    Args a;
#define CF(name, idx) __device__ __forceinline__ const float* name() const { return a.in[idx]; }
    CF(x, 0) CF(norm1_g, 1) CF(w_in, 2) CF(nsa_q_norm, 3) CF(nsa_k_norm, 4) CF(cmp_pos, 5) CF(cmp_w1, 6) CF(cmp_w2, 7) CF(diff_q_norm, 8) CF(diff_k_norm, 9)
    CF(diff_lambda, 10) CF(diff_out_norm, 11) CF(rel_bias, 12) CF(w_bn, 13) CF(w_bd, 14) CF(w_out, 15) CF(norm2_g, 16) CF(rg_w, 17) CF(rg_b, 18) CF(re_w, 19) CF(re_b, 20)
    CF(w_gate, 21) CF(w_up, 22) CF(w_down, 23)
#undef CF
#define CW(type, name, off) __device__ __forceinline__ type* name() const { return (type*)(a.ws + (off)); }
    CW(bf16, H1, WS_H1) CW(bf16, QN, WS_QN) CW(bf16, CT, WS_CT) CW(bf16, KS, WS_KS) CW(bf16, VS, WS_VS) CW(bf16, KW, WS_KW) CW(bf16, VW, WS_VW)
    CW(bf16, QD, WS_QD) CW(bf16, KD, WS_KD) CW(bf16, VD, WS_VD) CW(bf16, GM, WS_GM) CW(float, GN, WS_GN) CW(bf16, KCMP, WS_KCMP) CW(bf16, VCMP, WS_VCMP)
    CW(bf16, ONSAB, WS_ONSAB) CW(float, ROUTE, WS_ROUTE)
    CW(float, LAM, WS_LAM) CW(bf16, Y, WS_Y) CW(bf16, HID, WS_HID)
    CW(float, U, WS_U) CW(bf16, X2B, WS_X2B) CW(float, POSB, WS_POSB) CW(float, BIAS, WS_BIAS) CW(float, BIASV, WS_BIASV) CW(bf16, WIN, WS_WIN) CW(bf16, WOUT, WS_WOUT) CW(bf16, WBN, WS_WBN) CW(bf16, WBD, WS_WBD) CW(bf16, WC1, WS_WC1) CW(bf16, WGU, WS_WGU) CW(bf16, WDN, WS_WDN) CW(bf16, WRT, WS_WRT)
    __device__ __forceinline__ bf16* ODIFF() const { return (bf16*)a.out; }
#undef CW
    __device__ __forceinline__ float* out() const { return a.out; }
};

struct ChunkDesc { int src; int ncols; int mode; const float* gain; bf16* dst; float* dstf; int pitch; int dcol; float qscale;
    int img; int c0; int tile_bytes; int bstride; };
__device__ __forceinline__ ChunkDesc chunk_desc(const Ctx& c, int ch) {
    ChunkDesc d; d.src = 0; d.ncols = 64; d.mode = 0; d.gain = nullptr; d.dst = nullptr; d.dstf = nullptr; d.pitch = 0; d.dcol = 0; d.qscale = 1.f; d.img = 0; d.c0 = 0; d.tile_bytes = 0; d.bstride = 0;
    if (ch < 8) { d.src = C_QN + 64 * ch; d.mode = 1; d.gain = c.nsa_q_norm(); d.dst = c.QN(); d.pitch = 512; d.dcol = 64 * ch; d.qscale = 0.125f * 1.4426950408889634f; }
    else if (ch < 20) { const int j = ch - 8; d.src = C_KV + 64 * j; const int t = j >> 2, kv = (j >> 1) & 1, g = j & 1;
        if (t == 0) { d.dst = c.CT() + (size_t)(kv * 2 + g) * T * 64; d.pitch = 64; d.dcol = 0; }
        else { d.dst = ((t == 1) ? (kv ? c.VS() : c.KS()) : (kv ? c.VW() : c.KW())) + (size_t)g * 32 * 4096; d.img = kv ? 2 : 1; d.c0 = 0; d.tile_bytes = 8192; d.bstride = 2 * 32 * 8192;
               if (kv == 0) { d.mode = 1; d.gain = c.nsa_k_norm() + 64 * t; } } }
    else if (ch < 24) { if (ch == 20) { d.src = C_GN; d.ncols = 24; d.mode = 2; d.dstf = c.GN(); d.pitch = 24; d.dcol = 0; } else d.ncols = 0; }
    else if (ch < 32) { const int j = ch - 24; d.src = C_QD + 64 * j; d.mode = 1; d.gain = c.diff_q_norm() + 64 * (j & 1); d.dst = c.QD(); d.pitch = 512; d.dcol = 64 * j; d.qscale = 0.125f * 1.4426950408889634f; }
    else if (ch < 40) { const int j = ch - 32; d.src = C_KD + 64 * j; d.mode = 1; d.gain = c.diff_k_norm() + 64 * (j & 1); d.dst = c.KD() + (size_t)(j >> 1) * 32 * 8192; d.img = 1; d.c0 = (j & 1) * 8; d.tile_bytes = 16384; d.bstride = 4 * 32 * 16384; }
    else if (ch < 48) { const int j = ch - 40; d.src = C_VD + 64 * j; d.dst = c.VD() + (size_t)(j >> 1) * 32 * 8192; d.img = 2; d.c0 = (j & 1) * 2; d.tile_bytes = 16384; d.bstride = 4 * 32 * 16384; }
    else { const int j = ch - 48; d.src = C_GM + 64 * j; d.mode = 2; d.dst = c.GM(); d.pitch = 2048; d.dcol = 64 * j; }
    return d;
}


namespace pg8 {
typedef short bf16x8 __attribute__((ext_vector_type(8)));
typedef float f32x4 __attribute__((ext_vector_type(4)));
typedef unsigned u32x4 __attribute__((ext_vector_type(4)));
constexpr int BM = 256, BK = 64, HALF = 128, HTB = HALF * BK * 2, NXCD = 8, WGM = 8;
__device__ __forceinline__ int lds_byte(int r, int c) { const int st = (r >> 4) * 2 + (c >> 5), rr = r & 15, cc = c & 31, ob = rr * 64 + cc * 2; return st * 1024 + (ob ^ (((ob >> 9) & 1) << 5)); }
__device__ __forceinline__ void stage_rc(int b, int& R, int& C) { const int st = b / 1024, sb = b % 1024, swz = sb ^ (((sb >> 9) & 1) << 5); R = (st >> 1) * 16 + swz / 64; C = (st & 1) * 32 + (swz % 64) / 2; }
__device__ __forceinline__ int perm32(int rho) { const int n = rho >> 4, i = rho & 15; return 8 * (i >> 2) + 4 * n + (i & 3); }
__device__ __forceinline__ unsigned cvt_pk_bf16(float lo, float hi) { return pk2bf(lo, hi); }

struct Unit { int pm, pn, z; };
struct Ops { const bf16 *A0, *A1, *B0, *B1; int K;
    __device__ __forceinline__ const char* a(const Unit& u) const { return (const char*)((u.z ? A1 : A0) + (size_t)u.pm * BM * K); }
    __device__ __forceinline__ const char* b(const Unit& u) const { return (const char*)((u.z ? B1 : B0) + (size_t)u.pn * BM * K); } };

template <int NZ> struct StaticOrder {
    int nM, nN, nwg, G, c;
    __device__ __forceinline__ void init(int M, int N, int G_, int c_) { nM = M / BM; nN = N / BM; nwg = nM * nN; G = G_; c = c_; }
    __device__ __forceinline__ bool next(int i, Unit& u) const {
        const int it = i / NZ; u.z = i % NZ;
        const long L = (long)it * G + c; if (L >= nwg) return false;
        int wgid = (int)L; { const int q = nwg / NXCD, r = nwg % NXCD, xcd = wgid % NXCD, off = wgid / NXCD; wgid = (xcd < r ? xcd * (q + 1) : r * (q + 1) + (xcd - r) * q) + off; }
        const int nig = WGM * nN, gid = wgid / nig, fm = gid * WGM, gsz = (nM - fm) < WGM ? (nM - fm) : WGM;
        u.pm = fm + ((wgid % nig) % gsz); u.pn = (wgid % nig) / gsz; return true;
    }
};

template <class Epi, class Sched>
__device__ __forceinline__ void gemm_phase(LAS unsigned char* lds, const Ops g, const Sched& S, const Epi& E) {
    const int tid = threadIdx.x, wid = __builtin_amdgcn_readfirstlane(tid >> 6), lane = tid & 63, wr = wid >> 2, wc = wid & 3, fr = lane & 15, fq = lane >> 4;
    const int K = g.K, nt = K / BK;
    unsigned voffA[2], voffB[2];
#pragma unroll
    for (int i = 0; i < 2; ++i) { int R, C; stage_rc(tid * 16 + i * 8192, R, C); const int Rb = (R & ~31) + perm32(R & 31);
        voffA[i] = (unsigned)(R * K + C) * 2u; voffB[i] = (unsigned)(Rb * K + C) * 2u; }
    const size_t kstep = (size_t)(BK * 2);
    const size_t hstep = (size_t)HALF * K * 2;
    const unsigned ldsw = (unsigned)wid * 1024u;
    const int aoff = lds_byte(wr * 64 + fr, fq * 8), boff = lds_byte(wc * 32 + fr, fq * 8);
#define PG8_SA(b, h) (((b) * 2 + (h)) * HTB)
#define PG8_SB(b, h) ((4 + (b) * 2 + (h)) * HTB)
#define PG8_STAGE(bufoff, gbase, voff) do { _Pragma("unroll") for (int _i = 0; _i < 2; ++_i) \
        __builtin_amdgcn_global_load_lds((const unsigned*)((const char*)(gbase) + (voff)[_i]), (LAS unsigned*)(lds + (bufoff) + ldsw + _i * 8192), 16, 0, 0); } while (0)
#define PG8_LDA(dst, b, h) do { _Pragma("unroll") for (int m = 0; m < 4; ++m) _Pragma("unroll") for (int k = 0; k < 2; ++k) dst[m][k] = *(const LAS bf16x8*)(lds + PG8_SA(b, h) + aoff + m * 2048 + k * 1024); } while (0)
#define PG8_LDB(dst, b, h) do { _Pragma("unroll") for (int n = 0; n < 2; ++n) _Pragma("unroll") for (int k = 0; k < 2; ++k) dst[n][k] = *(const LAS bf16x8*)(lds + PG8_SB(b, h) + boff + n * 2048 + k * 1024); } while (0)
#define PG8_MMA(ai, bj, At, Bt) do { __builtin_amdgcn_s_setprio(1); _Pragma("unroll") for (int m = 0; m < 4; ++m) _Pragma("unroll") for (int n = 0; n < 2; ++n) _Pragma("unroll") for (int k = 0; k < 2; ++k) \
        acc[ai][bj][m][n] = __builtin_amdgcn_mfma_f32_16x16x32_bf16(Bt[n][k], At[m][k], acc[ai][bj][m][n], 0, 0, 0); __builtin_amdgcn_s_setprio(0); } while (0)
#define PG8_WAIT_V(n) asm volatile("s_waitcnt vmcnt(" #n ")" ::: "memory")
#define PG8_WAIT_L(n) asm volatile("s_waitcnt lgkmcnt(" #n ")" ::: "memory")
#define PG8_BAR __builtin_amdgcn_s_barrier()
#define PG8_SCHED __builtin_amdgcn_sched_barrier(0)
    Unit cur, nxt; int ui = 0;
    if (!S.next(0, cur)) return;
    f32x4 acc[2][2][4][2];
#pragma unroll
    for (int a = 0; a < 2; ++a)
#pragma unroll
        for (int b = 0; b < 2; ++b)
#pragma unroll
            for (int m = 0; m < 4; ++m)
#pragma unroll
                for (int n = 0; n < 2; ++n) acc[a][b][m][n] = (f32x4){0.f, 0.f, 0.f, 0.f};
    bf16x8 At[4][2], B0[2][2], B1[2][2];
    const char* cA = g.a(cur); const char* cB = g.b(cur);
    PG8_STAGE(PG8_SB(0, 0), cB, voffB); PG8_STAGE(PG8_SB(0, 1), cB + hstep, voffB); PG8_STAGE(PG8_SA(0, 0), cA, voffA); PG8_STAGE(PG8_SA(0, 1), cA + hstep, voffA);
    if (wr == 1) PG8_BAR;
    PG8_WAIT_V(2); PG8_BAR;
    PG8_STAGE(PG8_SB(1, 0), cB + kstep, voffB); PG8_STAGE(PG8_SA(1, 0), cA + kstep, voffA); PG8_STAGE(PG8_SB(1, 1), cB + hstep + kstep, voffB);
    PG8_WAIT_V(6); PG8_BAR;
    for (;;) {
        const bool has_next = S.next(ui + 1, nxt);
        const char* nA = has_next ? g.a(nxt) : cA; const char* nB = has_next ? g.b(nxt) : cB;
        for (int t = 0; t < nt; t += 2) {
            const bool last = (t == nt - 2);
            const char* a1 = cA + (size_t)(t + 1) * kstep;
            const char* a2 = last ? nA : cA + (size_t)(t + 2) * kstep; const char* b2 = last ? nB : cB + (size_t)(t + 2) * kstep;
            const char* a3 = a2 + kstep; const char* b3 = b2 + kstep;
            PG8_LDB(B0, 0, 0); PG8_LDB(B1, 0, 1); PG8_SCHED; PG8_LDA(At, 0, 0); PG8_STAGE(PG8_SA(1, 1), a1 + hstep, voffA);
            PG8_WAIT_V(8); PG8_WAIT_L(0); PG8_BAR; PG8_MMA(0, 0, At, B0); PG8_MMA(0, 1, At, B1); PG8_BAR; PG8_SCHED;
            PG8_LDA(At, 0, 1); PG8_STAGE(PG8_SB(0, 0), b2, voffB); PG8_STAGE(PG8_SB(0, 1), b2 + hstep, voffB); PG8_STAGE(PG8_SA(0, 0), a2, voffA);
            PG8_WAIT_V(8); PG8_WAIT_L(0); PG8_BAR; PG8_MMA(1, 0, At, B0); PG8_MMA(1, 1, At, B1); PG8_BAR; PG8_SCHED;
            PG8_LDB(B0, 1, 0); PG8_LDB(B1, 1, 1); PG8_SCHED; PG8_LDA(At, 1, 0); PG8_STAGE(PG8_SA(0, 1), a2 + hstep, voffA);
            PG8_WAIT_V(8); PG8_WAIT_L(0); PG8_BAR; PG8_MMA(0, 0, At, B0); PG8_MMA(0, 1, At, B1); PG8_BAR; PG8_SCHED;
            PG8_LDA(At, 1, 1); PG8_STAGE(PG8_SB(1, 0), b3, voffB); PG8_STAGE(PG8_SB(1, 1), b3 + hstep, voffB); PG8_STAGE(PG8_SA(1, 0), a3, voffA);
            PG8_WAIT_V(8); PG8_WAIT_L(0); PG8_BAR; PG8_MMA(1, 0, At, B0); PG8_MMA(1, 1, At, B1); PG8_BAR; PG8_SCHED;
        }
        if (wr == 0) PG8_BAR;
        const bool keep = E(acc, cur, wr, wc, fr, fq);
        if (!has_next) break;
        if (!keep) {
#pragma unroll
        for (int a = 0; a < 2; ++a)
#pragma unroll
            for (int b = 0; b < 2; ++b)
#pragma unroll
                for (int m = 0; m < 4; ++m)
#pragma unroll
                    for (int n = 0; n < 2; ++n) acc[a][b][m][n] = (f32x4){0.f, 0.f, 0.f, 0.f};
        }
        cur = nxt; cA = nA; cB = nB; ++ui;
        if (wr == 1) PG8_BAR;
    }
    PG8_WAIT_V(0);
    PG8_BAR;
#undef PG8_SA
#undef PG8_SB
#undef PG8_STAGE
#undef PG8_LDA
#undef PG8_LDB
#undef PG8_MMA
#undef PG8_WAIT_V
#undef PG8_WAIT_L
#undef PG8_BAR
#undef PG8_SCHED
}

template <class G, class Epi, class Sched>
__device__ __forceinline__ void gemm_phase_g(LAS unsigned char* lds, const G& g, const Sched& S, const Epi& E) {
    const int tid = threadIdx.x, wid = __builtin_amdgcn_readfirstlane(tid >> 6), lane = tid & 63, wr = wid >> 2, wc = wid & 3, fr = lane & 15, fq = lane >> 4;
    constexpr int nt = G::NT;
    unsigned voffB[2];
#pragma unroll
    for (int i = 0; i < 2; ++i) { int R, C; stage_rc(tid * 16 + i * 8192, R, C); const int Rb = (R & ~31) + perm32(R & 31); voffB[i] = (unsigned)(Rb * G::LDB + C) * 2u; }
#define PG8_RC int sR[2], sC[2]; stage_rc(tid * 16, sR[0], sC[0]); stage_rc(tid * 16 + 8192, sR[1], sC[1])
    const size_t kstep = (size_t)(BK * 2);
    const size_t hstepB = (size_t)HALF * G::LDB * 2;
    const unsigned ldsw = (unsigned)wid * 1024u;
    const int aoff = lds_byte(wr * 64 + fr, fq * 8), boff = lds_byte(wc * 32 + fr, fq * 8);
#define PG8_SA(b, h) (((b) * 2 + (h)) * HTB)
#define PG8_SB(b, h) ((4 + (b) * 2 + (h)) * HTB)
#define PG8_STAGE(bufoff, gbase, voff) do { _Pragma("unroll") for (int _i = 0; _i < 2; ++_i) \
        __builtin_amdgcn_global_load_lds((const unsigned*)((const char*)(gbase) + (voff)[_i]), (LAS unsigned*)(lds + (bufoff) + ldsw + _i * 8192), 16, 0, 0); } while (0)
#define PG8_LDA(dst, b, h) do { _Pragma("unroll") for (int m = 0; m < 4; ++m) _Pragma("unroll") for (int k = 0; k < 2; ++k) dst[m][k] = *(const LAS bf16x8*)(lds + PG8_SA(b, h) + aoff + m * 2048 + k * 1024); } while (0)
#define PG8_LDB(dst, b, h) do { _Pragma("unroll") for (int n = 0; n < 2; ++n) _Pragma("unroll") for (int k = 0; k < 2; ++k) dst[n][k] = *(const LAS bf16x8*)(lds + PG8_SB(b, h) + boff + n * 2048 + k * 1024); } while (0)
#define PG8_MMA(ai, bj, At, Bt) do { __builtin_amdgcn_s_setprio(1); _Pragma("unroll") for (int m = 0; m < 4; ++m) _Pragma("unroll") for (int n = 0; n < 2; ++n) _Pragma("unroll") for (int k = 0; k < 2; ++k) \
        acc[ai][bj][m][n] = __builtin_amdgcn_mfma_f32_16x16x32_bf16(Bt[n][k], At[m][k], acc[ai][bj][m][n], 0, 0, 0); __builtin_amdgcn_s_setprio(0); } while (0)
#define PG8_WAIT_V(n) asm volatile("s_waitcnt vmcnt(" #n ")" ::: "memory")
#define PG8_WAIT_L(n) asm volatile("s_waitcnt lgkmcnt(" #n ")" ::: "memory")
#define PG8_BAR __builtin_amdgcn_s_barrier()
#define PG8_SCHED __builtin_amdgcn_sched_barrier(0)
    Unit cur, nxt; int ui = 0;
    if (!S.next(0, cur)) return;
    unsigned vc[2][2], vn[2][2];
    bool has_next = S.next(1, nxt);
    {   PG8_RC; g.a_voff(cur, sR, sC, vc);
        if (has_next) g.a_voff(nxt, sR, sC, vn); }
    if (has_next) {} else { vn[0][0] = vc[0][0]; vn[0][1] = vc[0][1]; vn[1][0] = vc[1][0]; vn[1][1] = vc[1][1]; }
    f32x4 acc[2][2][4][2];
#pragma unroll
    for (int a = 0; a < 2; ++a)
#pragma unroll
        for (int b = 0; b < 2; ++b)
#pragma unroll
            for (int m = 0; m < 4; ++m)
#pragma unroll
                for (int n = 0; n < 2; ++n) acc[a][b][m][n] = (f32x4){0.f, 0.f, 0.f, 0.f};
    bf16x8 At[4][2], B0[2][2], B1[2][2];
    const char* cA = g.a_base(cur);
    const char *cb0, *cb1, *nb0, *nb1;
    g.bprep(cur, cb0, cb1);
    if (has_next) g.bprep(nxt, nb0, nb1); else { nb0 = cb0; nb1 = cb1; }
    {   const char* cB0 = G::bat(cb0, cb1, 0); const char* cB1 = G::bat(cb0, cb1, 1);
        PG8_STAGE(PG8_SB(0, 0), cB0, voffB); PG8_STAGE(PG8_SB(0, 1), cB0 + hstepB, voffB); PG8_STAGE(PG8_SA(0, 0), cA, vc[0]); PG8_STAGE(PG8_SA(0, 1), cA, vc[1]);
        if (wr == 1) PG8_BAR;
        PG8_WAIT_V(2); PG8_BAR;
        PG8_STAGE(PG8_SB(1, 0), cB1, voffB); PG8_STAGE(PG8_SA(1, 0), cA + kstep, vc[0]); PG8_STAGE(PG8_SB(1, 1), cB1 + hstepB, voffB);
        PG8_WAIT_V(6); PG8_BAR; }
    for (;;) {
        const char* nA = has_next ? g.a_base(nxt) : cA;
        for (int t = 0; t < nt; t += 2) {
            const bool last = (t == nt - 2);
            const char* a1 = cA + (size_t)(t + 1) * kstep;
            const char* a2 = last ? nA : cA + (size_t)(t + 2) * kstep; const char* a3 = a2 + kstep;
            const char* b2 = last ? G::bat(nb0, nb1, 0) : G::bat(cb0, cb1, t + 2); const char* b3 = last ? G::bat(nb0, nb1, 1) : G::bat(cb0, cb1, t + 3);
            PG8_LDB(B0, 0, 0); PG8_LDB(B1, 0, 1); PG8_SCHED; PG8_LDA(At, 0, 0); PG8_STAGE(PG8_SA(1, 1), a1, vc[1]);
            if (last) { vc[0][0] = vn[0][0]; vc[0][1] = vn[0][1]; vc[1][0] = vn[1][0]; vc[1][1] = vn[1][1]; }
            PG8_WAIT_V(8); PG8_WAIT_L(0); PG8_BAR; PG8_MMA(0, 0, At, B0); PG8_MMA(0, 1, At, B1); PG8_BAR; PG8_SCHED;
            PG8_LDA(At, 0, 1); PG8_STAGE(PG8_SB(0, 0), b2, voffB); PG8_STAGE(PG8_SB(0, 1), b2 + hstepB, voffB); PG8_STAGE(PG8_SA(0, 0), a2, vc[0]);
            PG8_WAIT_V(8); PG8_WAIT_L(0); PG8_BAR; PG8_MMA(1, 0, At, B0); PG8_MMA(1, 1, At, B1); PG8_BAR; PG8_SCHED;
            PG8_LDB(B0, 1, 0); PG8_LDB(B1, 1, 1); PG8_SCHED; PG8_LDA(At, 1, 0); PG8_STAGE(PG8_SA(0, 1), a2, vc[1]);
            PG8_WAIT_V(8); PG8_WAIT_L(0); PG8_BAR; PG8_MMA(0, 0, At, B0); PG8_MMA(0, 1, At, B1); PG8_BAR; PG8_SCHED;
            PG8_LDA(At, 1, 1); PG8_STAGE(PG8_SB(1, 0), b3, voffB); PG8_STAGE(PG8_SB(1, 1), b3 + hstepB, voffB); PG8_STAGE(PG8_SA(1, 0), a3, vc[0]);
            PG8_WAIT_V(8); PG8_WAIT_L(0); PG8_BAR; PG8_MMA(1, 0, At, B0); PG8_MMA(1, 1, At, B1); PG8_BAR; PG8_SCHED;
        }
        if (wr == 0) PG8_BAR;
        E(acc, cur, wr, wc, fr, fq);
        if (!has_next) break;
#pragma unroll
        for (int a = 0; a < 2; ++a)
#pragma unroll
            for (int b = 0; b < 2; ++b)
#pragma unroll
                for (int m = 0; m < 4; ++m)
#pragma unroll
                    for (int n = 0; n < 2; ++n) acc[a][b][m][n] = (f32x4){0.f, 0.f, 0.f, 0.f};
        cur = nxt; cA = nA; cb0 = nb0; cb1 = nb1; ++ui;
        has_next = S.next(ui + 1, nxt);
        if (has_next) { PG8_RC; g.a_voff(nxt, sR, sC, vn); g.bprep(nxt, nb0, nb1); }
        if (wr == 1) PG8_BAR;
    }
    PG8_WAIT_V(0);
    PG8_BAR;
#undef PG8_RC
#undef PG8_SA
#undef PG8_SB
#undef PG8_STAGE
#undef PG8_LDA
#undef PG8_LDB
#undef PG8_MMA
#undef PG8_WAIT_V
#undef PG8_WAIT_L
#undef PG8_BAR
#undef PG8_SCHED
}
}

struct EpiInProj {
    Ctx c;
    __device__ __forceinline__ bool operator()(pg8::f32x4 (&acc)[2][2][4][2], const pg8::Unit& u, int wr, int wc, int fr_, int fq_) const {
        int fr = fr_, fq = fq_; asm volatile("" : "+v"(fr), "+v"(fq));
        const ChunkDesc d = chunk_desc(c, u.pn * 4 + wc);
        if (d.ncols == 0) return false;
        const int row0 = u.pm * 256 + wr * 64 + fr;
        float gn[2][8];
        const float* gp = (d.mode == 1) ? d.gain : c.nsa_q_norm();
        pg8::f32x4 g4[4];
#pragma unroll
        for (int q = 0; q < 4; ++q) g4[q] = *(const pg8::f32x4*)(gp + 32 * (q >> 1) + 8 * fq + 4 * (q & 1));
#pragma unroll
        for (int q = 0; q < 4; ++q) asm volatile("" : "+v"(g4[q]));
#pragma unroll
        for (int bj = 0; bj < 2; ++bj)
#pragma unroll
            for (int i = 0; i < 8; ++i) gn[bj][i] = g4[2 * bj + (i >> 2)][i & 3] * d.qscale;
#pragma unroll
        for (int ai = 0; ai < 2; ++ai)
#pragma unroll
            for (int m = 0; m < 4; ++m) {
                const size_t row = (size_t)(row0 + ai * 128 + m * 16);
                float v[2][8];
#pragma unroll
                for (int bj = 0; bj < 2; ++bj)
#pragma unroll
                    for (int n = 0; n < 2; ++n)
#pragma unroll
                        for (int i = 0; i < 4; ++i) v[bj][4 * n + i] = acc[ai][bj][m][n][i];
                if (d.mode == 1) {
                    float ss = 0.f;
#pragma unroll
                    for (int bj = 0; bj < 2; ++bj)
#pragma unroll
                        for (int i = 0; i < 8; ++i) ss += v[bj][i] * v[bj][i];
                    ss += __shfl_xor(ss, 16); ss += __shfl_xor(ss, 32);
                    const float r = rsqrtf(ss * (1.f / 64.f) + RMS_EPS);
#pragma unroll
                    for (int bj = 0; bj < 2; ++bj)
#pragma unroll
                        for (int i = 0; i < 8; ++i) v[bj][i] = v[bj][i] * r * gn[bj][i];
                } else if (d.mode == 2) {
#pragma unroll
                    for (int bj = 0; bj < 2; ++bj)
#pragma unroll
                        for (int i = 0; i < 8; ++i) v[bj][i] = sigmoidf_(v[bj][i]);
                }
                if (d.dstf) {
                    if (fq < 3) { float4* p = (float4*)(d.dstf + row * 24 + 8 * fq); p[0] = make_float4(v[0][0], v[0][1], v[0][2], v[0][3]); p[1] = make_float4(v[0][4], v[0][5], v[0][6], v[0][7]); }
                } else {
#pragma unroll
                    for (int bj = 0; bj < 2; ++bj) { pg8::u32x4 w; w.x = pg8::cvt_pk_bf16(v[bj][0], v[bj][1]); w.y = pg8::cvt_pk_bf16(v[bj][2], v[bj][3]); w.z = pg8::cvt_pk_bf16(v[bj][4], v[bj][5]); w.w = pg8::cvt_pk_bf16(v[bj][6], v[bj][7]);
                        if (d.img == 0) *(pg8::u32x4*)(d.dst + row * d.pitch + d.dcol + 32 * bj + 8 * fq) = w;
                        else { const int bb = (int)(row >> 11), sq = (int)(row & 2047), key = sq & 63;
                            const size_t tb = (size_t)bb * d.bstride + (size_t)(sq >> 6) * d.tile_bytes;
                            const size_t off = (d.img == 1) ? tb + (size_t)(d.c0 + 4 * bj + fq) * 1024 + key * 16 : tb + (size_t)(d.c0 + bj) * 4096 + (key >> 4) * 1024 + (key & 15) * 64 + fq * 16;
                            *(pg8::u32x4*)((unsigned char*)d.dst + off) = w; } }
                }
            }
        return false;
    }
};
struct EpiMerge {
    bf16* Y; const bf16* GM;
    __device__ __forceinline__ bool operator()(pg8::f32x4 (&acc)[2][2][4][2], const pg8::Unit& u, int wr, int wc, int fr_, int fq_) const {
        int fr = fr_, fq = fq_; asm volatile("" : "+v"(fr), "+v"(fq));
        const int row0 = u.pm * 256 + wr * 64 + fr, col0 = u.pn * 256 + wc * 32 + 8 * fq;
#pragma unroll
        for (int ai = 0; ai < 2; ++ai)
#pragma unroll
            for (int m = 0; m < 4; ++m) {
                const size_t row = (size_t)(row0 + ai * 128 + m * 16);
#pragma unroll
                for (int bj = 0; bj < 2; ++bj) {
                    const int col = col0 + bj * 128;
                    const uint4 g1 = *(const uint4*)(GM + row * 2048 + 1024 + col);
                    float q1[8] = {LO16(g1.x), HI16(g1.x), LO16(g1.y), HI16(g1.y), LO16(g1.z), HI16(g1.z), LO16(g1.w), HI16(g1.w)};
                    if (u.z == 0) {
                        const uint4 g0 = *(const uint4*)(GM + row * 2048 + col);
                        const float q0[8] = {LO16(g0.x), HI16(g0.x), LO16(g0.y), HI16(g0.y), LO16(g0.z), HI16(g0.z), LO16(g0.w), HI16(g0.w)};
#pragma unroll
                        for (int n = 0; n < 2; ++n)
#pragma unroll
                            for (int i = 0; i < 4; ++i) acc[ai][bj][m][n][i] *= q0[4 * n + i] * __builtin_amdgcn_rcpf(fmaxf(q1[4 * n + i], 1e-30f));
                    } else {
                        float v[8];
#pragma unroll
                        for (int n = 0; n < 2; ++n)
#pragma unroll
                            for (int i = 0; i < 4; ++i) v[4 * n + i] = acc[ai][bj][m][n][i] * fmaxf(q1[4 * n + i], 1e-30f);
                        uint4 w; w.x = pg8::cvt_pk_bf16(v[0], v[1]); w.y = pg8::cvt_pk_bf16(v[2], v[3]); w.z = pg8::cvt_pk_bf16(v[4], v[5]); w.w = pg8::cvt_pk_bf16(v[6], v[7]);
                        *(uint4*)(Y + row * 1024 + col) = w;
                    }
                }
            }
        return u.z == 0;
    }
};
struct EpiResid {
    const float* X; bf16* O;
    __device__ __forceinline__ bool operator()(pg8::f32x4 (&acc)[2][2][4][2], const pg8::Unit& u, int wr, int wc, int fr_, int fq_) const {
        int fr = fr_, fq = fq_; asm volatile("" : "+v"(fr), "+v"(fq));
        const int row0 = u.pm * 256 + wr * 64 + fr, col0 = u.pn * 256 + wc * 32 + 8 * fq;
#pragma unroll
        for (int ai = 0; ai < 2; ++ai)
#pragma unroll
            for (int m = 0; m < 4; ++m) {
                const size_t row = (size_t)(row0 + ai * 128 + m * 16);
#pragma unroll
                for (int bj = 0; bj < 2; ++bj) { const size_t off = row * 1024 + col0 + bj * 128;
                    const float4 x0 = *(const float4*)(X + off), x1 = *(const float4*)(X + off + 4); const pg8::f32x4 a0 = acc[ai][bj][m][0], a1 = acc[ai][bj][m][1];
                    uint4 w; w.x = pk2bf(x0.x + a0[0], x0.y + a0[1]); w.y = pk2bf(x0.z + a0[2], x0.w + a0[3]); w.z = pk2bf(x1.x + a1[0], x1.y + a1[1]); w.w = pk2bf(x1.z + a1[2], x1.w + a1[3]);
                    *(uint4*)(O + off) = w; }
            }
        return false;
    }
};

struct EpiF32 {
    float* O; int ldc;
    __device__ __forceinline__ bool operator()(pg8::f32x4 (&acc)[2][2][4][2], const pg8::Unit& u, int wr, int wc, int fr_, int fq_) const {
        int fr = fr_, fq = fq_; asm volatile("" : "+v"(fr), "+v"(fq));
        const int row0 = u.pm * 256 + wr * 64 + fr, col0 = u.pn * 256 + wc * 32 + 8 * fq;
#pragma unroll
        for (int ai = 0; ai < 2; ++ai)
#pragma unroll
            for (int m = 0; m < 4; ++m)
#pragma unroll
                for (int bj = 0; bj < 2; ++bj)
#pragma unroll
                    for (int n = 0; n < 2; ++n) { const pg8::f32x4 a = acc[ai][bj][m][n];
                        *(float4*)(O + (size_t)(row0 + ai * 128 + m * 16) * ldc + col0 + bj * 128 + 4 * n) = make_float4(a[0], a[1], a[2], a[3]); }
        return false;
    }
};
struct SchedCmp { int c;
    __device__ __forceinline__ bool next(int i, pg8::Unit& u) const { if (i > 0 || c >= 32) return false; u.pm = c >> 1; u.pn = c & 1; u.z = c >> 4; return true; } };

__device__ __forceinline__ float4 posb_sum(const float* p) { float4 a = *(const float4*)p;
#pragma unroll
    for (int sl = 1; sl < 8; ++sl) { const float4 b = *(const float4*)(p + sl * 512); a.x += b.x; a.y += b.y; a.z += b.z; a.w += b.w; }
    return a; }

__device__ __forceinline__ void tr_item(const float* src, int ldn, int k0, int n0, int nvalid, bf16* dst, int ldk, int r0, LAS float* scr, int lane, const float* kgain = nullptr) {
    const int nn = lane & 31;
    float tv[32];
#pragma unroll
    for (int i = 0; i < 32; ++i) { const int kk = 2 * i + (lane >> 5); tv[i] = (nn < nvalid) ? __builtin_nontemporal_load(src + (size_t)(k0 + kk) * ldn + n0 + nn) : 0.f; }
#pragma unroll
    for (int i = 0; i < 32; ++i) { const int kk = 2 * i + (lane >> 5); scr[kk * 33 + nn] = kgain ? tv[i] * kgain[k0 + kk] : tv[i]; }
    asm volatile("s_waitcnt lgkmcnt(0)" ::: "memory");
    const int cch = lane & 7;
#pragma unroll
    for (int j = 0; j < 4; ++j) { const int n = (lane >> 3) + 8 * j; const LAS float* sp = scr + (8 * cch) * 33 + n;
        uint4 o; o.x = pg8::cvt_pk_bf16(sp[0 * 33], sp[1 * 33]); o.y = pg8::cvt_pk_bf16(sp[2 * 33], sp[3 * 33]); o.z = pg8::cvt_pk_bf16(sp[4 * 33], sp[5 * 33]); o.w = pg8::cvt_pk_bf16(sp[6 * 33], sp[7 * 33]);
        *(uint4*)(dst + (size_t)(r0 + n) * ldk + k0 + 8 * cch) = o; }
    asm volatile("s_waitcnt lgkmcnt(0)" ::: "memory");
}


namespace att {
typedef short bf16x8 __attribute__((ext_vector_type(8)));
typedef short s16x4 __attribute__((ext_vector_type(4)));
typedef short v4i16_t __attribute__((ext_vector_type(4)));
typedef float f32x16 __attribute__((ext_vector_type(16)));
typedef unsigned u32x4 __attribute__((ext_vector_type(4)));
typedef float f32x4v __attribute__((ext_vector_type(4)));
constexpr float C2 = 0.125f * 1.4426950408889634f;
constexpr float LOG2E = 1.4426950408889634f;
constexpr float NEGB = -1e30f, MFLOOR = -1e4f;
__device__ __forceinline__ int crow(int r, int hi) { return (r & 3) + 8 * (r >> 2) + 4 * hi; }
__device__ __forceinline__ s16x4 vtr(const LAS char* p) { return __builtin_bit_cast(s16x4, __builtin_amdgcn_ds_read_tr16_b64_v4i16((LAS v4i16_t*)p)); }
typedef float f32x2_t __attribute__((ext_vector_type(2))); typedef __bf16 bf16x2_t __attribute__((ext_vector_type(2)));
__device__ __forceinline__ unsigned cvtpk(float lo, float hi) { const f32x2_t v = {lo, hi}; const bf16x2_t b = __builtin_convertvector(v, bf16x2_t); return __builtin_bit_cast(unsigned, b); }
#define ATT_WAIT_BAR() asm volatile("s_waitcnt vmcnt(0) lgkmcnt(0)\n\ts_barrier" ::: "memory")

template <int NKB> __device__ __forceinline__ void stage_img(LAS unsigned char* dst, const unsigned char* src, int wid, int lane) {
#pragma unroll
    for (int c = 0; c < (NKB + 7) / 8; ++c) { const int pc = wid + 8 * c;
        if (NKB % 8 == 0 || pc < NKB) __builtin_amdgcn_global_load_lds((const unsigned*)(src + pc * 1024 + lane * 16), (LAS unsigned*)(dst + pc * 1024), 16, 0, 0); }
}
__device__ __forceinline__ void qk_tile(f32x16& p0, f32x16& p1, const LAS unsigned char* kt, int ch0, const bf16x8 (&qf)[4], int r32, int hi) {
    const LAS unsigned char* kb = kt + (ch0 + hi) * 1024 + r32 * 16;
    p0 = (f32x16){0.f, 0.f, 0.f, 0.f, 0.f, 0.f, 0.f, 0.f, 0.f, 0.f, 0.f, 0.f, 0.f, 0.f, 0.f, 0.f}; p1 = p0;
#pragma unroll
    for (int d0 = 0; d0 < 4; ++d0) {
        const bf16x8 a0 = *(const LAS bf16x8*)(kb + d0 * 2048), a1 = *(const LAS bf16x8*)(kb + d0 * 2048 + 512);
        p0 = __builtin_amdgcn_mfma_f32_32x32x16_bf16(a0, qf[d0], p0, 0, 0, 0);
        p1 = __builtin_amdgcn_mfma_f32_32x32x16_bf16(a1, qf[d0], p1, 0, 0, 0);
    }
}
template <int EB> __device__ __forceinline__ void pv_tile(f32x16 (&o)[EB], const LAS unsigned char* vt, const f32x16& p0, const f32x16& p1, int lane) {
    const int hi = lane >> 5;
    const LAS char* vb = (const LAS char*)vt + ((lane >> 4) & 1) * 32 + (lane & 3) * 8 + (4 * hi + ((lane & 15) >> 2)) * 64;
#pragma unroll
    for (int ks = 0; ks < 4; ++ks) {
        s16x4 lo[EB], hh[EB];
#pragma unroll
        for (int eb = 0; eb < EB; ++eb) { lo[eb] = vtr(vb + eb * 4096 + ks * 1024); hh[eb] = vtr(vb + eb * 4096 + ks * 1024 + 512); }
        const f32x16& p = (ks < 2) ? p0 : p1; const int rb = (ks & 1) * 8;
        const u32x4 w = (u32x4){cvtpk(p[rb + 0], p[rb + 1]), cvtpk(p[rb + 2], p[rb + 3]), cvtpk(p[rb + 4], p[rb + 5]), cvtpk(p[rb + 6], p[rb + 7])};
        const bf16x8 pa = __builtin_bit_cast(bf16x8, w);
#pragma unroll
        for (int eb = 0; eb < EB; ++eb) {
            const bf16x8 vf = (bf16x8){lo[eb][0], lo[eb][1], lo[eb][2], lo[eb][3], hh[eb][0], hh[eb][1], hh[eb][2], hh[eb][3]};
            o[eb] = __builtin_amdgcn_mfma_f32_32x32x16_bf16(pa, vf, o[eb], 0, 0, 0);
        }
    }
}
template <bool BIAS, bool CAUSAL, bool BAND> __device__ __forceinline__ void bias_mask(f32x16& p0, f32x16& p1, const LAS float* bl, int qabs, int kt0, int hi) {
#pragma unroll
    for (int r = 0; r < 16; ++r) {
        const int d0 = qabs - (kt0 + crow(r, hi)), d1 = d0 - 32;
        if (BIAS) { p0[r] += bl[d0 < 0 ? 0 : (d0 > 255 ? 255 : d0)]; p1[r] += bl[d1 < 0 ? 0 : (d1 > 255 ? 255 : d1)]; }
        if (CAUSAL) { if (d0 < 0) p0[r] = NEGB; if (d1 < 0) p1[r] = NEGB; }
        if (BAND) { if (d0 >= 512) p0[r] = NEGB; if (d1 >= 512) p1[r] = NEGB; }
    }
}
__device__ __forceinline__ void bias_vec(f32x16& p0, f32x16& p1, const LAS float* rt, int e0, int hi) {
    const int a = (-e0) & 3;
    const LAS float* bp = rt + a * 320 + (208 - e0 - a) + 4 * hi;
#pragma unroll
    for (int g4 = 0; g4 < 4; ++g4) { const f32x4v v0 = *(const LAS f32x4v*)(bp + 8 * g4), v1 = *(const LAS f32x4v*)(bp + 8 * g4 + 32);
        p0[4 * g4] += v0[0]; p0[4 * g4 + 1] += v0[1]; p0[4 * g4 + 2] += v0[2]; p0[4 * g4 + 3] += v0[3];
        p1[4 * g4] += v1[0]; p1[4 * g4 + 1] += v1[1]; p1[4 * g4 + 2] += v1[2]; p1[4 * g4 + 3] += v1[3]; }
}
constexpr float THR = 8.f;
__device__ __forceinline__ float max3f(float a, float b, float c) { return fmaxf(fmaxf(a, b), c); }
template <int EB> __device__ __forceinline__ void softmax_step(f32x16& p0, f32x16& p1, float& m, float& l, f32x16 (&o)[EB], LAS float* wsf, int r32, int hi) {
    if (__any(m != 0.f)) {
#pragma unroll
        for (int r = 0; r < 16; ++r) { p0[r] -= m; p1[r] -= m; }
    }
    float ra = max3f(p0[0], p0[1], p1[0]), rb2 = max3f(p0[2], p0[3], p1[1]); ra = max3f(ra, p1[2], p1[3]);
#pragma unroll
    for (int r = 4; r < 16; r += 4) { ra = max3f(ra, p0[r], p0[r + 1]); rb2 = max3f(rb2, p0[r + 2], p0[r + 3]); ra = max3f(ra, p1[r], p1[r + 1]); rb2 = max3f(rb2, p1[r + 2], p1[r + 3]); }
    float rm = fmaxf(ra, rb2);
    if (__any(rm > THR)) {
        rm = fmaxf(rm, __shfl_xor(rm, 32));
        const float dl = rm > THR ? rm : 0.f;
        const float al = __builtin_amdgcn_exp2f(-dl);
        m += dl; l *= al;
#pragma unroll
        for (int r = 0; r < 16; ++r) { p0[r] -= dl; p1[r] -= dl; }
        if (hi == 0) wsf[r32] = al;
#pragma unroll
        for (int g = 0; g < 4; ++g) { const f32x4v a4 = *(const LAS f32x4v*)(wsf + 8 * g + 4 * hi);
#pragma unroll
            for (int eb = 0; eb < EB; ++eb) { o[eb][4 * g + 0] *= a4.x; o[eb][4 * g + 1] *= a4.y; o[eb][4 * g + 2] *= a4.z; o[eb][4 * g + 3] *= a4.w; } }
    }
    float s0 = 0.f, s1 = 0.f;
#pragma unroll
    for (int r = 0; r < 16; ++r) { p0[r] = __builtin_amdgcn_exp2f(p0[r]); p1[r] = __builtin_amdgcn_exp2f(p1[r]); s0 += p0[r]; s1 += p1[r]; }
    l += s0 + s1;
}
template <int EB> __device__ __forceinline__ void scale_rows(f32x16 (&o)[EB], float f, LAS float* wsf, int r32, int hi) {
    if (hi == 0) wsf[r32] = f;
#pragma unroll
    for (int g = 0; g < 4; ++g) { const f32x4v a4 = *(const LAS f32x4v*)(wsf + 8 * g + 4 * hi);
#pragma unroll
        for (int eb = 0; eb < EB; ++eb) { o[eb][4 * g + 0] *= a4.x; o[eb][4 * g + 1] *= a4.y; o[eb][4 * g + 2] *= a4.z; o[eb][4 * g + 3] *= a4.w; } }
}

struct DiffArgs { const bf16 *Q, *K, *V; bf16* O; const float* biasv; const float* out_gain; float lam; };
__device__ __forceinline__ void diff_unit(LAS unsigned char* lds, const DiffArgs& A, int b, int h, int qt) {
    int tid_ = threadIdx.x; asm volatile("" : "+v"(tid_));
    const int tid = tid_, lane = tid & 63, r32 = lane & 31, hi = lane >> 5, wid = __builtin_amdgcn_readfirstlane(tid >> 6);
    const int cs = wid >> 2, wq = wid & 3, q0 = qt * 128, qw0 = q0 + wq * 32, qabs = qw0 + r32;
    LAS float* bl = (LAS float*)(lds + 81920);
    LAS float* wsf = (LAS float*)(lds + 83968) + wid * 64;
    const size_t rowb = (size_t)b * S;
    LAS float* rt = (LAS float*)(lds + 86016);
    for (int i = tid; i < 1280; i += 512) rt[i] = A.biasv[(8 + h) * 1280 + i];
    const unsigned char* Kh = (const unsigned char*)A.K + (size_t)(b * 4 + h) * 32 * 16384; const unsigned char* Vh = (const unsigned char*)A.V + (size_t)(b * 4 + h) * 32 * 16384;
    const int NT = (q0 + 128) / 64;
    stage_img<16>(lds, Kh, wid, lane); stage_img<16>(lds + 49152, Vh, wid, lane);
    stage_img<16>(lds + 16384, Kh + 16384, wid, lane);
    bf16x8 qf[4];
    { const bf16* qp = A.Q + (rowb + qabs) * 512 + h * 128 + cs * 64 + hi * 8;
#pragma unroll
      for (int d0 = 0; d0 < 4; ++d0) qf[d0] = *(const bf16x8*)(qp + d0 * 16); }
    f32x16 o[4];
#pragma unroll
    for (int eb = 0; eb < 4; ++eb) o[eb] = (f32x16){0.f, 0.f, 0.f, 0.f, 0.f, 0.f, 0.f, 0.f, 0.f, 0.f, 0.f, 0.f, 0.f, 0.f, 0.f, 0.f};
    float m = 0.f, l = 0.f;
    ATT_WAIT_BAR();
    if (wid >= 4) __builtin_amdgcn_s_setprio(1);
    f32x16 n0, n1;
    qk_tile(n0, n1, lds, cs * 8, qf, r32, hi);
    int kb_cur = 0, kb_nxt = 16384, kb_fre = 32768;
    for (int t = 0; t < NT; ++t) {
        if (t + 2 < NT) stage_img<16>(lds + kb_fre, Kh + (size_t)(t + 2) * 16384, wid, lane);
        if (t + 1 < NT) stage_img<16>(lds + 49152 + ((t + 1) & 1) * 16384, Vh + (size_t)(t + 1) * 16384, wid, lane);
        const int kt0 = t * 64;
        if (kt0 <= qw0 + 31) {
            f32x16 p0 = n0, p1 = n1;
            if (t + 1 < NT && kt0 + 64 <= qw0 + 31) qk_tile(n0, n1, lds + kb_nxt, cs * 8, qf, r32, hi);
            const bool causal = (kt0 + 63 > qw0), near_ = (qw0 - (kt0 + 63) < 113);
            if (causal || near_) bias_vec(p0, p1, rt, qabs - kt0, hi);
            softmax_step<4>(p0, p1, m, l, o, wsf, r32, hi);
            pv_tile<4>(o, lds + 49152 + (t & 1) * 16384, p0, p1, lane);
        }
        ATT_WAIT_BAR();
        { const int tmp = kb_cur; kb_cur = kb_nxt; kb_nxt = kb_fre; kb_fre = tmp; }
    }
    __builtin_amdgcn_s_setprio(0);
    l += __shfl_xor(l, 32);
    scale_rows<4>(o, (cs ? A.lam : 1.f) / l, wsf, r32, hi);
    LAS float* xch = (LAS float*)lds + (size_t)wq * 4096;
    if (cs == 1) {
#pragma unroll
        for (int eb = 0; eb < 4; ++eb)
#pragma unroll
            for (int r = 0; r < 16; ++r) xch[crow(r, hi) * 128 + eb * 32 + r32] = o[eb][r];
    }
    ATT_WAIT_BAR();
    if (cs == 0) {
        float ss[16];
#pragma unroll
        for (int r = 0; r < 16; ++r) ss[r] = 0.f;
#pragma unroll
        for (int eb = 0; eb < 4; ++eb)
#pragma unroll
            for (int r = 0; r < 16; ++r) { o[eb][r] -= xch[crow(r, hi) * 128 + eb * 32 + r32]; ss[r] += o[eb][r] * o[eb][r]; }
#pragma unroll
        for (int r = 0; r < 16; ++r) {
#pragma unroll
            for (int sft = 1; sft < 32; sft <<= 1) ss[r] += __shfl_xor(ss[r], sft);
            ss[r] = rsqrtf(ss[r] * (1.f / 128.f) + RMS_EPS) * (1.f - LAMBDA_INIT);
        }
        int hi_ = hi, r32_ = r32; asm volatile("" : "+v"(hi_), "+v"(r32_));
        bf16* op = A.O + (rowb + qw0 + 4 * hi_) * 512 + h * 128 + r32_;
#pragma unroll
        for (int eb = 0; eb < 4; ++eb) { const float gn = A.out_gain[eb * 32 + r32_];
#pragma unroll
            for (int r = 0; r < 16; ++r) op[(size_t)((r & 3) + 8 * (r >> 2)) * 512 + eb * 32] = f2bf(o[eb][r] * ss[r] * gn); }
    }
    ATT_WAIT_BAR();
}

struct NsaArgs { const bf16 *Q, *KS, *VS, *KW, *VW, *KC, *VC; const float* GN; bf16* O; const float* rel_bias; const float* biasv; };
__device__ __forceinline__ void imp_tile(const f32x16& p, int gbase, LAS float* ip, float inv, int hi, float& prevR) {
    float Av[4], Rv[4];
#pragma unroll
    for (int gq = 0; gq < 4; ++gq) { const float c3 = 0.5f * p[4 * gq + 3]; Av[gq] = p[4 * gq] + p[4 * gq + 1] + p[4 * gq + 2] + c3; Rv[gq] = __shfl_xor(c3, 32); }
#pragma unroll
    for (int gq = 0; gq < 4; ++gq) { const float add = hi ? Rv[gq] : (gq > 0 ? Rv[gq > 0 ? gq - 1 : 0] : prevR); ip[2 * (gbase + gq)] = (Av[gq] + add) * inv; }
    prevR = Rv[3];
}

__device__ __forceinline__ int cmp_class(int qw0, int n0) { return (16 * n0 > qw0) ? 2 : ((qw0 - 16 * (n0 + 31) - 31 >= 113) ? 0 : 1); }
__device__ __forceinline__ void cmp_bm1(f32x16& p, const LAS float* bl, int qabs, int n0, int hi) {
#pragma unroll
    for (int r = 0; r < 16; ++r) { const int d = qabs - 16 * (n0 + crow(r, hi)) - 31; p[r] += bl[d < 0 ? 0 : (d > 255 ? 255 : d)]; if (d < 0) p[r] = NEGB; }
}
__device__ __forceinline__ void cmp_pass(LAS unsigned char* lds, const bf16x8 (&qf)[4], const LAS float* bl, LAS float* ip, bool need_sel, float mref, int qw0, int qabs,
                                         int lane, int r32, int hi, f32x16 (&o)[2], float& l, float& rmax) {
    l = 0.f; rmax = NEGB; float prevR = 0.f;
    o[0] = (f32x16){0.f, 0.f, 0.f, 0.f, 0.f, 0.f, 0.f, 0.f, 0.f, 0.f, 0.f, 0.f, 0.f, 0.f, 0.f, 0.f}; o[1] = o[0];
#pragma unroll
    for (int tl = 0; tl < 2; ++tl) {
        const int c0 = cmp_class(qw0, 64 * tl), c1 = cmp_class(qw0, 64 * tl + 32);
        if (c0 == 2) {
            if (need_sel) {
#pragma unroll
                for (int gq = 0; gq < 8; ++gq) ip[2 * (8 * tl + gq)] = (gq == 0 && hi == 0) ? prevR : 0.f; }
            prevR = 0.f;
        } else {
            f32x16 p0, p1;
            qk_tile(p0, p1, lds + tl * 16384, 0, qf, r32, hi);
            if (c0 == 1) cmp_bm1(p0, bl, qabs, 64 * tl, hi);
            if (c1 == 1) cmp_bm1(p1, bl, qabs, 64 * tl + 32, hi);
            else if (c1 == 2) { p1 = (f32x16){NEGB, NEGB, NEGB, NEGB, NEGB, NEGB, NEGB, NEGB, NEGB, NEGB, NEGB, NEGB, NEGB, NEGB, NEGB, NEGB}; }
            float ra = max3f(p0[0], p0[1], p1[0]), rb2 = max3f(p0[2], p0[3], p1[1]); ra = max3f(ra, p1[2], p1[3]);
#pragma unroll
            for (int r = 4; r < 16; r += 4) { ra = max3f(ra, p0[r], p0[r + 1]); rb2 = max3f(rb2, p0[r + 2], p0[r + 3]); ra = max3f(ra, p1[r], p1[r + 1]); rb2 = max3f(rb2, p1[r + 2], p1[r + 3]); }
            rmax = max3f(rmax, ra, rb2);
            float s0 = 0.f, s1 = 0.f;
#pragma unroll
            for (int r = 0; r < 16; ++r) { p0[r] = __builtin_amdgcn_exp2f(p0[r] - mref); p1[r] = __builtin_amdgcn_exp2f(p1[r] - mref); s0 += p0[r]; s1 += p1[r]; }
            l += s0 + s1;
            if (need_sel) { imp_tile(p0, 8 * tl, ip, 1.f, hi, prevR); imp_tile(p1, 8 * tl + 4, ip, 1.f, hi, prevR); }
            pv_tile<2>(o, lds + tl * 16384 + 8192, p0, p1, lane);
        }
    }
}
__device__ __forceinline__ void nsa_unit(LAS unsigned char* lds, const NsaArgs& A, int b, int g, int qt) {
    int tid_ = threadIdx.x; asm volatile("" : "+v"(tid_));
    const int tid = tid_, wid = __builtin_amdgcn_readfirstlane(tid >> 6);
    int lane = tid & 63, r32 = lane & 31, hi = lane >> 5;
#define NSA_RELANE() do { asm volatile("" : "+v"(lane)); r32 = lane & 31; hi = lane >> 5; qabs = qw0 + r32; } while (0)
    const int hh = wid >> 1, head = g * 4 + hh, q0 = qt * 64, qw0 = q0 + (wid & 1) * 32; int qabs = qw0 + r32;
    LAS float* bl = (LAS float*)(lds + 32768) + hh * 256;
    LAS float* wsf = (LAS float*)(lds + 36864) + wid * 64;
    LAS float* ipart = (LAS float*)(lds + 40960);
    LAS float* itot = (LAS float*)(lds + 73728);
    LAS unsigned* sell = (LAS unsigned*)(lds + 81920);
    LAS float* invs = (LAS float*)(lds + 82176);
    LAS f32x16* otl = (LAS f32x16*)(lds + 86016) + (size_t)wid * 128 + lane;
    const size_t rowb = (size_t)b * S;
    for (int i = tid; i < 1024; i += 512) ((LAS float*)(lds + 32768))[i] = A.rel_bias[g * 1024 + i];
    { const unsigned char* Kc = (const unsigned char*)A.KC + (size_t)(b * 2 + g) * 16384; const unsigned char* Vc = (const unsigned char*)A.VC + (size_t)(b * 2 + g) * 16384;
      stage_img<8>(lds, Kc, wid, lane); stage_img<8>(lds + 8192, Vc, wid, lane);
      stage_img<8>(lds + 16384, Kc + 8192, wid, lane); stage_img<8>(lds + 24576, Vc + 8192, wid, lane); }
    bf16x8 qf[4];
    { const bf16* qp = A.Q + (rowb + qabs) * 512 + head * 64 + hi * 8;
#pragma unroll
      for (int d0 = 0; d0 < 4; ++d0) qf[d0] = *(const bf16x8*)(qp + d0 * 16); }
    ATT_WAIT_BAR();
    const bool need_sel = (qt >= 16);
    {
        NSA_RELANE();
        LAS float* ip = ipart + ((size_t)hh * 64 + (wid & 1) * 32 + r32) * 32 + hi;
        f32x16 o[2]; float l, rmax;
        cmp_pass(lds, qf, bl, ip, need_sel, 0.f, qw0, qabs, lane, r32, hi, o, l, rmax);
        if (__any(rmax > 64.f)) {
            rmax = fmaxf(rmax, __shfl_xor(rmax, 32));
            float dummy;
            cmp_pass(lds, qf, bl, ip, need_sel, fmaxf(rmax, 0.f), qw0, qabs, lane, r32, hi, o, l, dummy);
        }
        l += __shfl_xor(l, 32);
        const float inv = l > 0.f ? 1.f / l : 0.f;
        if (hi == 0) invs[hh * 64 + (wid & 1) * 32 + r32] = inv;
        { int qa = qabs; asm volatile("" : "+v"(qa)); scale_rows<2>(o, A.GN[(rowb + qa) * 24 + head] * inv, wsf, r32, hi); }
        otl[0] = o[0]; otl[64] = o[1];
    }
    ATT_WAIT_BAR();
    unsigned selq, un;
    if (need_sel) {
        {
            const int q = tid >> 3, j4 = (tid & 7) * 4;
#pragma unroll
            for (int jj = 0; jj < 4; ++jj) { const int j = j4 + jj; itot[q * 32 + j] = ((ipart[(0 * 64 + q) * 32 + j] * invs[q] + ipart[(1 * 64 + q) * 32 + j] * invs[64 + q]) + ipart[(2 * 64 + q) * 32 + j] * invs[128 + q]) + ipart[(3 * 64 + q) * 32 + j] * invs[192 + q]; }
        }
        ATT_WAIT_BAR();
        {
            const int j = lane & 31;
#pragma unroll 1
            for (int rd = 0; rd < 4; ++rd) {
                const int q = wid * 8 + rd * 2 + hi;
                const bool vj = j <= qt, fj = (j == 0) || (j == qt) || (j == qt - 1);
                const float sj = vj ? itot[q * 32 + j] + (fj ? 1e4f : 0.f) : -1e30f;
                int cnt = 0;
#pragma unroll 4
                for (int k = 0; k < 32; ++k) {
                    const bool vk = k <= qt, fk = (k == 0) || (k == qt) || (k == qt - 1);
                    const float sk = vk ? itot[q * 32 + k] + (fk ? 1e4f : 0.f) : -1e30f;
                    cnt += (sk > sj || (sk == sj && k < j)) ? 1 : 0;
                }
                const unsigned long long bal = __ballot(cnt < 16);
                if (lane == 0) sell[q] = (unsigned)bal;
                if (lane == 32) sell[q] = (unsigned)(bal >> 32);
            }
        }
        ATT_WAIT_BAR();
        NSA_RELANE();
        selq = sell[(wid & 1) * 32 + r32];
        un = sell[lane];
#pragma unroll
        for (int sft = 1; sft < 64; sft <<= 1) un |= __shfl_xor(un, sft);
        un = __builtin_amdgcn_readfirstlane(un) & (qt >= 31 ? 0xffffffffu : ((2u << qt) - 1u));
    } else {
        selq = (2u << qt) - 1u; un = selq;
    }
    for (int i = tid; i < 5120; i += 512) ipart[i] = A.biasv[(size_t)g * 5120 + i];
    const LAS float* rt = ipart + hh * 1280;
    {
        NSA_RELANE();
        const unsigned char* Kg = (const unsigned char*)A.KS + (size_t)(b * 2 + g) * 32 * 8192; const unsigned char* Vg = (const unsigned char*)A.VS + (size_t)(b * 2 + g) * 32 * 8192;
        f32x16 o[2]; o[0] = (f32x16){0.f, 0.f, 0.f, 0.f, 0.f, 0.f, 0.f, 0.f, 0.f, 0.f, 0.f, 0.f, 0.f, 0.f, 0.f, 0.f}; o[1] = o[0];
        float m = 0.f, l = 0.f;
        unsigned rem = un; int j = __builtin_ctz(rem); rem &= rem - 1u; int it = 0;
        stage_img<8>(lds, Kg + (size_t)j * 8192, wid, lane); stage_img<8>(lds + 8192, Vg + (size_t)j * 8192, wid, lane);
        ATT_WAIT_BAR();
        for (;;) {
            LAS unsigned char* cur = lds + (it & 1) * 16384; LAS unsigned char* nxt = lds + ((it + 1) & 1) * 16384;
            const int jn = rem ? __builtin_ctz(rem) : -1;
            if (jn >= 0) { rem &= rem - 1u; stage_img<8>(nxt, Kg + (size_t)jn * 8192, wid, lane); stage_img<8>(nxt + 8192, Vg + (size_t)jn * 8192, wid, lane); }
            const int kt0 = j * 64;
            if (kt0 <= qw0 + 31 && __any((selq >> j) & 1u)) {
                f32x16 p0, p1;
                qk_tile(p0, p1, cur, 0, qf, r32, hi);
                const bool causal = (kt0 + 63 > qw0), near_ = (qw0 - (kt0 + 63) < 113);
                if (causal || near_) bias_vec(p0, p1, rt, qabs - kt0, hi);
                if (!__all((selq >> j) & 1u)) {
                    const float off = ((selq >> j) & 1u) ? 0.f : NEGB;
#pragma unroll
                    for (int r = 0; r < 16; ++r) { p0[r] += off; p1[r] += off; } }
                softmax_step<2>(p0, p1, m, l, o, wsf, r32, hi);
                pv_tile<2>(o, cur + 8192, p0, p1, lane);
            }
            ATT_WAIT_BAR();
            if (jn < 0) break;
            j = jn; ++it;
        }
        l += __shfl_xor(l, 32);
        { int qa = qabs; asm volatile("" : "+v"(qa)); scale_rows<2>(o, A.GN[(rowb + qa) * 24 + 8 + head] / l, wsf, r32, hi); }
        otl[0] = otl[0] + o[0]; otl[64] = otl[64] + o[1];
    }
    f32x16 ot[2];
    {
        NSA_RELANE();
        const unsigned char* Kg = (const unsigned char*)A.KW + (size_t)(b * 2 + g) * 32 * 8192; const unsigned char* Vg = (const unsigned char*)A.VW + (size_t)(b * 2 + g) * 32 * 8192;
        f32x16 o[2]; o[0] = (f32x16){0.f, 0.f, 0.f, 0.f, 0.f, 0.f, 0.f, 0.f, 0.f, 0.f, 0.f, 0.f, 0.f, 0.f, 0.f, 0.f}; o[1] = o[0];
        float m = 0.f, l = 0.f;
        const int j0 = qt >= 8 ? qt - 8 : 0;
        stage_img<8>(lds, Kg + (size_t)j0 * 8192, wid, lane); stage_img<8>(lds + 8192, Vg + (size_t)j0 * 8192, wid, lane);
        ATT_WAIT_BAR();
        for (int j = j0; j <= qt; ++j) {
            const int it = j - j0;
            LAS unsigned char* cur = lds + (it & 1) * 16384; LAS unsigned char* nxt = lds + ((it + 1) & 1) * 16384;
            if (j < qt) { stage_img<8>(nxt, Kg + (size_t)(j + 1) * 8192, wid, lane); stage_img<8>(nxt + 8192, Vg + (size_t)(j + 1) * 8192, wid, lane); }
            const int kt0 = j * 64;
            if (kt0 <= qw0 + 31) {
                f32x16 p0, p1;
                qk_tile(p0, p1, cur, 0, qf, r32, hi);
                const bool causal = (kt0 + 63 > qw0), near_ = (qw0 - (kt0 + 63) < 113), band = (qw0 + 31 - kt0 >= 512);
                if (causal || near_) bias_vec(p0, p1, rt, qabs - kt0, hi);
                else if (band) bias_mask<false, false, true>(p0, p1, bl, qabs, kt0, hi);
                softmax_step<2>(p0, p1, m, l, o, wsf, r32, hi);
                pv_tile<2>(o, cur + 8192, p0, p1, lane);
            }
            ATT_WAIT_BAR();
        }
        l += __shfl_xor(l, 32);
        { int qa = qabs; asm volatile("" : "+v"(qa)); scale_rows<2>(o, A.GN[(rowb + qa) * 24 + 16 + head] / l, wsf, r32, hi); }
        ot[0] = otl[0] + o[0]; ot[1] = otl[64] + o[1];
    }
    {   int hi_ = hi, r32_ = r32; asm volatile("" : "+v"(hi_), "+v"(r32_));
        bf16* op = A.O + (rowb + qw0 + 4 * hi_) * 512 + head * 64 + r32_;
#pragma unroll
        for (int eb = 0; eb < 2; ++eb)
#pragma unroll
            for (int r = 0; r < 16; ++r) op[(size_t)((r & 3) + 8 * (r >> 2)) * 512 + eb * 32] = f2bf(ot[eb][r]); }
#undef NSA_RELANE
}
}

constexpr int NCLS = 24;
constexpr int CW_CMPD = 10752, CW_FIN = 11008;
constexpr int CW_WQ = 10240;
constexpr int CW_CNT = 8192;
constexpr size_t WS_LIST = 254 * MiB;
constexpr int MISC_OFF = 161792;
constexpr int TAB_OFF = MISC_OFF + 256;
__device__ __forceinline__ void class_experts(int c, int& ea, int& eb) {
    const int g = c / 6, p = c % 6; const int a = p < 3 ? 0 : (p < 5 ? 1 : 2); const int b = p < 3 ? p + 1 : (p < 5 ? p - 1 : 3); ea = g * 4 + a; eb = g * 4 + b; }
__device__ __forceinline__ void moe_build_tab(const unsigned* ctl, LAS int* tab) {
    if (threadIdx.x < 64) {
        const int lane = threadIdx.x;
        const int n = (lane < NCLS) ? (int)__hip_atomic_load(ctl + CW_CNT + 64 * lane, __ATOMIC_RELAXED, __HIP_MEMORY_SCOPE_AGENT) : 0;
        const int nt_ = (n + 255) >> 8;
        int pre = nt_;
#pragma unroll
        for (int o = 1; o < 32; o <<= 1) { const int v = __shfl_up(pre, o); if (lane >= o) pre += v; }
        const int first = pre - nt_;
        if (lane < NCLS) { tab[lane] = first; tab[32 + lane] = n; for (int j = 0; j < nt_; ++j) tab[64 + first + j] = lane; }
        if (lane == NCLS - 1) tab[NCLS] = pre;
    }
    __syncthreads();
}
struct OpsGU { const bf16* H2; const bf16* WGU; const unsigned* LIST; const LAS int* tab; static constexpr int NT = 16, LDB = 1024;
    __device__ __forceinline__ const char* a_base(const pg8::Unit&) const { return (const char*)H2; }
    __device__ __forceinline__ void a_voff(const pg8::Unit& u, const int (&R)[2], const int (&C)[2], unsigned (&out)[2][2]) const {
        const int c = tab[64 + u.pm], n = tab[32 + c], r0 = (u.pm - tab[c]) * 256;
#pragma unroll
        for (int h = 0; h < 2; ++h)
#pragma unroll
            for (int i = 0; i < 2; ++i) { const int r = r0 + h * 128 + R[i]; const unsigned tok = (r < n) ? LIST[(size_t)c * T + r] : 0u; out[h][i] = (tok * 1024u + (unsigned)C[i]) * 2u; } }
    __device__ __forceinline__ void bprep(const pg8::Unit& u, const char*& p0, const char*& p1) const {
        int ea, eb; class_experts(tab[64 + u.pm], ea, eb); const int e = u.z ? eb : ea; p0 = (const char*)(WGU + ((size_t)e * 1024 + u.pn * 256) * 1024); p1 = p0; }
    __device__ static __forceinline__ const char* bat(const char* p0, const char*, int kt) { return p0 + (size_t)kt * 128; } };
constexpr int CW_MQ = 10496;
constexpr int CW_DONE = 12288;
struct SchedGU { const LAS int* tab; int G, vcu;
    __device__ __forceinline__ bool next(int i, pg8::Unit& u) const { const int L = i * G + vcu; if (L >= tab[NCLS] * 8) return false; u.pm = L >> 3; u.z = (L >> 2) & 1; u.pn = L & 3; return true; } };
struct EpiGU { bf16* HID; const unsigned* LIST; const float* ROUTE; const LAS int* tab; unsigned* ctl;
    __device__ __forceinline__ void operator()(const pg8::f32x4 (&acc)[2][2][4][2], const pg8::Unit& u, int wr, int wc, int fr_, int fq_) const {
        int fr = fr_, fq = fq_; asm volatile("" : "+v"(fr), "+v"(fq));
        const int c = tab[64 + u.pm], n = tab[32 + c], r0 = (u.pm - tab[c]) * 256;
        const __amdgpu_buffer_rsrc_t rsrc = __builtin_amdgcn_make_buffer_rsrc((void*)HID, 0, 0x7fffffff, 0x00020000);
#pragma unroll
        for (int ai = 0; ai < 2; ++ai)
#pragma unroll
            for (int m = 0; m < 4; ++m) {
                const int rl = ai * 128 + wr * 64 + m * 16 + fr, r = r0 + rl;
                if (r < n) {
                    const unsigned tok = LIST[(size_t)c * T + r]; const float w = ROUTE[(size_t)tok * 4 + u.z], rs = ROUTE[(size_t)tok * 4 + 3];
                    float v[8];
#pragma unroll
                    for (int nn = 0; nn < 2; ++nn)
#pragma unroll
                        for (int i = 0; i < 4; ++i) { const float gt = acc[ai][0][m][nn][i] * rs, up = acc[ai][1][m][nn][i] * rs; v[4 * nn + i] = gt * __builtin_amdgcn_rcpf(1.f + __builtin_amdgcn_exp2f(-1.4426950408889634f * gt)) * up * w; }
                    uint4 o; o.x = pg8::cvt_pk_bf16(v[0], v[1]); o.y = pg8::cvt_pk_bf16(v[2], v[3]); o.z = pg8::cvt_pk_bf16(v[4], v[5]); o.w = pg8::cvt_pk_bf16(v[6], v[7]);
                    __builtin_amdgcn_raw_buffer_store_b128(__builtin_bit_cast(pg8::u32x4, o), rsrc, (int)(((unsigned)(u.pm * 256 + rl) * 1024u + (unsigned)(u.z * 512 + u.pn * 128 + wc * 32 + 8 * fq)) * 2u), 0, 16);
                }
                asm volatile("" ::: "memory");
            }
        asm volatile("s_waitcnt vmcnt(0)" ::: "memory");
        if (fr == 0 && fq == 0) __hip_atomic_fetch_add(ctl + CW_DONE + 64 * u.pm, 1u, __ATOMIC_RELAXED, __HIP_MEMORY_SCOPE_AGENT);
    }
};
struct OpsDN { const bf16* HID; const bf16* WDN; const LAS int* tab; static constexpr int NT = 16, LDB = 512;
    __device__ __forceinline__ const char* a_base(const pg8::Unit& u) const { return (const char*)(HID + (size_t)u.pm * 256 * 1024); }
    __device__ __forceinline__ void a_voff(const pg8::Unit&, const int (&R)[2], const int (&C)[2], unsigned (&out)[2][2]) const {
#pragma unroll
        for (int h = 0; h < 2; ++h)
#pragma unroll
            for (int i = 0; i < 2; ++i) out[h][i] = (unsigned)((h * 128 + R[i]) * 1024 + C[i]) * 2u; }
    __device__ __forceinline__ void bprep(const pg8::Unit& u, const char*& p0, const char*& p1) const {
        int ea, eb; class_experts(tab[64 + u.pm], ea, eb);
        p0 = (const char*)(WDN + ((size_t)ea * 1024 + u.pn * 256) * 512); p1 = (const char*)(WDN + ((size_t)eb * 1024 + u.pn * 256) * 512); }
    __device__ static __forceinline__ const char* bat(const char* p0, const char* p1, int kt) { return (kt < 8 ? p0 : p1) + (size_t)(kt & 7) * 128; } };
struct SchedDN { const LAS int* tab; unsigned* ctl; int G, vcu;
    __device__ __forceinline__ bool next(int i, pg8::Unit& u) const {
        const int total = tab[NCLS] * 4;
        int L = -1;
        if (i == 0) L = vcu; else if (i == 1) { const int e = G - 1 - vcu; if (G + e < total) L = G + e; }
        if (L < 0 || L >= total) L = -1;
        __builtin_amdgcn_s_barrier();
        if (threadIdx.x == 0 && L >= 0) {
            unsigned* dn = ctl + CW_DONE + 64 * (L >> 2); unsigned sp = 0;
            while (__hip_atomic_load(dn, __ATOMIC_RELAXED, __HIP_MEMORY_SCOPE_AGENT) < 64u) { __builtin_amdgcn_s_sleep(2); if (++sp > (1u << 22)) { atomicAdd(ctl + XB_TMO + CW_BAR, 1u); break; } }
            __builtin_amdgcn_fence(__ATOMIC_ACQUIRE, "agent");
            asm volatile("s_waitcnt vmcnt(0)" ::: "memory");
        }
        __builtin_amdgcn_s_barrier();
        if (L < 0) return false; u.pm = L >> 2; u.pn = L & 3; u.z = 0; return true; } };
struct EpiDN { float* O; const bf16* X2; const unsigned* LIST; const LAS int* tab;
    __device__ __forceinline__ void operator()(const pg8::f32x4 (&acc)[2][2][4][2], const pg8::Unit& u, int wr, int wc, int fr_, int fq_) const {
        int fr = fr_, fq = fq_; asm volatile("" : "+v"(fr), "+v"(fq));
        const int c = tab[64 + u.pm], n = tab[32 + c], r0 = (u.pm - tab[c]) * 256;
#pragma unroll
        for (int ai = 0; ai < 2; ++ai)
#pragma unroll
            for (int m = 0; m < 4; ++m) {
                const int r = r0 + ai * 128 + wr * 64 + m * 16 + fr;
                if (r < n) {
                    const unsigned tok = LIST[(size_t)c * T + r];
#pragma unroll
                    for (int bj = 0; bj < 2; ++bj) { const size_t off = (size_t)tok * 1024 + u.pn * 256 + bj * 128 + wc * 32 + 8 * fq;
                        const uint4 xw = *(const uint4*)(X2 + off); const pg8::f32x4 a0 = acc[ai][bj][m][0], a1 = acc[ai][bj][m][1];
                        const nt_f32x4 y0 = {LO16(xw.x) + a0[0], HI16(xw.x) + a0[1], LO16(xw.y) + a0[2], HI16(xw.y) + a0[3]}, y1 = {LO16(xw.z) + a1[0], HI16(xw.z) + a1[1], LO16(xw.w) + a1[2], HI16(xw.w) + a1[3]};
                        __builtin_nontemporal_store(y0, (nt_f32x4*)(O + off)); __builtin_nontemporal_store(y1, (nt_f32x4*)(O + off + 4)); }
                }
            }
    }
};

constexpr int NTHR = 512;
constexpr int LDS_BYTES = 163840;

__global__ void __launch_bounds__(NTHR, 2) fwd_kernel(Args args) {
    extern __shared__ __attribute__((aligned(16))) unsigned char lds[];
    const int tid = threadIdx.x, lane = tid & 63;
    const int gtid = blockIdx.x * NTHR + tid, nthreads = gridDim.x * NTHR;
    const int gwave = gtid >> 6, nwaves = nthreads >> 6;
    Ctx c; c.a = args; unsigned char* ws = args.ws;

    volatile LAS unsigned* MISC = (volatile LAS unsigned*)((LAS unsigned char*)lds + MISC_OFF);
    if (tid < 32) MISC[tid] = 0u;
    __syncthreads();
    XcdBarrier bar = xcd_barrier_post((unsigned*)(ws + WS_CTL) + CW_BAR, MISC + 8);
    const int lo = args.ph_lo, hi = args.ph_hi;
#ifdef ONLY_PHASE
#define IN(k) ((k) == ONLY_PHASE)
#else
#define IN(k) (lo <= (k) && (k) < hi)
#endif
#define SEAM(k) do { if (IN(k) && IN((k) + 1)) xcd_barrier(bar); } while (0)


    if (IN(0)) {
        for (int t = gwave * 2; t < T; t += nwaves * 2) {
            const float4* xr = (const float4*)(c.x() + (size_t)t * D) + lane;
            float4 v[8]; float s0 = 0.f, s1 = 0.f;
#pragma unroll
            for (int j = 0; j < 8; ++j) v[j] = xr[64 * j];
#pragma unroll
            for (int j = 0; j < 4; ++j) { s0 += v[j].x * v[j].x + v[j].y * v[j].y + v[j].z * v[j].z + v[j].w * v[j].w; s1 += v[4 + j].x * v[4 + j].x + v[4 + j].y * v[4 + j].y + v[4 + j].z * v[4 + j].z + v[4 + j].w * v[4 + j].w; }
            const float r0 = rsqrtf(wave_sum(s0) * (1.f / D) + RMS_EPS), r1 = rsqrtf(wave_sum(s1) * (1.f / D) + RMS_EPS);
#pragma unroll
            for (int j = 0; j < 8; ++j) { const float4 g = ((const float4*)c.norm1_g())[lane + 64 * (j & 3)]; const float r = j < 4 ? r0 : r1;
                uint2 o; o.x = pk2bf(v[j].x * r * g.x, v[j].y * r * g.y); o.y = pk2bf(v[j].z * r * g.z, v[j].w * r * g.w);
                ((uint2*)(c.H1() + (size_t)t * D))[lane + 64 * j] = o; }
        }
        {
            LAS float* scr = (LAS float*)((LAS unsigned char*)lds + (tid >> 6) * 16384);
            constexpr int I_IN = 16 * 160, I_OUT = 16 * 32, I_BR = 8 * 32, I_GU = 16 * 4 * 2 * 4 * 16, I_DN = 16 * 8 * 32, I_C1 = 512;
            for (int it = gwave; it < I_IN + I_OUT + 2 * I_BR + I_GU + I_DN + I_C1; it += nwaves) {
                int r = it;
                if (r < I_IN) { const int kb = r / 160, vb = r % 160, pn = vb >> 3, bj = (vb >> 2) & 1, wc = vb & 3;
                    const ChunkDesc d = chunk_desc(c, pn * 4 + wc); int nv = d.ncols - 32 * bj; nv = nv < 0 ? 0 : (nv > 32 ? 32 : nv);
                    tr_item(c.w_in(), INC, 64 * kb, d.src + 32 * bj, nv, c.WIN(), 1024, 256 * pn + 128 * bj + 32 * wc, scr, lane); continue; }
                r -= I_IN;
                if (r < I_OUT) { tr_item(c.w_out(), 1024, 64 * (r / 32), 32 * (r % 32), 32, c.WOUT(), 1024, 32 * (r % 32), scr, lane); continue; }
                r -= I_OUT;
                if (r < I_BR) { tr_item(c.w_bn(), 1024, 64 * (r / 32), 32 * (r % 32), 32, c.WBN(), 512, 32 * (r % 32), scr, lane); continue; }
                r -= I_BR;
                if (r < I_BR) { tr_item(c.w_bd(), 1024, 64 * (r / 32), 32 * (r % 32), 32, c.WBD(), 512, 32 * (r % 32), scr, lane); continue; }
                r -= I_BR;
                if (r < I_GU) { const int kb = r & 15, blk = (r >> 4) & 3, bj = (r >> 6) & 1, ntile = (r >> 7) & 3, e = r >> 9;
                    tr_item((bj ? c.w_up() : c.w_gate()) + (size_t)e * 1024 * 512, 512, 64 * kb, ntile * 128 + 32 * blk, 32, c.WGU() + (size_t)e * 1024 * 1024, 1024, 256 * ntile + 128 * bj + 32 * blk, scr, lane, c.norm2_g()); continue; }
                r -= I_GU;
                if (r < I_DN) { const int nb = r & 31, kb = (r >> 5) & 7, e = r >> 8;
                    tr_item(c.w_down() + (size_t)e * 512 * 1024, 1024, 64 * kb, 32 * nb, 32, c.WDN() + (size_t)e * 1024 * 512, 512, 32 * nb, scr, lane); continue; }
                r -= I_DN;
                { const int nb = r & 7, kb = (r >> 3) & 15, bot = (r >> 7) & 1, kv = r >> 8;
                    tr_item(c.cmp_w1() + (size_t)kv * 2048 * 256 + (size_t)bot * 1024 * 256, 256, 64 * kb, 32 * nb, 32, c.WC1() + (size_t)kv * 512 * 1024, 1024, bot * 256 + 32 * nb, scr, lane); }
            }
            if (gwave >= nwaves - 64) { const int w = gwave - (nwaves - 64), sl = w & 7, jb = (w >> 3) & 3, kv = w >> 5, j = jb * 64 + lane;
                const float* w1 = c.cmp_w1() + (size_t)kv * 2048 * 256 + (size_t)sl * 256 * 256 + j; const float* pos = c.cmp_pos() + kv * 2048 + sl * 256;
                float a0 = 0.f, a1 = 0.f, a2 = 0.f, a3 = 0.f;
                for (int k = 0; k < 256; k += 4) { a0 += pos[k] * w1[(size_t)k * 256]; a1 += pos[k + 1] * w1[(size_t)(k + 1) * 256]; a2 += pos[k + 2] * w1[(size_t)(k + 2) * 256]; a3 += pos[k + 3] * w1[(size_t)(k + 3) * 256]; }
                c.POSB()[(sl * 2 + kv) * 256 + j] = (a0 + a1) + (a2 + a3); }
            if (gtid >= 8192 && gtid < 8192 + 12 * 1280) { const int i = gtid - 8192, hd = i / 1280, a = (i % 1280) / 320, j = (i % 320) + a, d = 208 - j;
                c.BIASV()[i] = (d < 0) ? -1e30f : (d >= 113 ? 0.f : (c.rel_bias()[t5_bucket(d) * 12 + hd] - c.rel_bias()[31 * 12 + hd]) * 1.4426950408889634f); }
            if (gtid >= 24576 && gtid < 24576 + 1024) { const int k = gtid - 24576; const float g = c.norm2_g()[k];
                const float4 gw = *(const float4*)(c.rg_w() + (size_t)k * 4);
                float w[20] = {gw.x, gw.y, gw.z, gw.w};
#pragma unroll
                for (int i4 = 0; i4 < 4; ++i4) { const float4 ew = *(const float4*)(c.re_w() + (size_t)k * 16 + 4 * i4); w[4 + 4 * i4] = ew.x; w[5 + 4 * i4] = ew.y; w[6 + 4 * i4] = ew.z; w[7 + 4 * i4] = ew.w; }
                bf16* wr = c.WRT() + k;
#pragma unroll
                for (int i = 0; i < 20; ++i) { const float v = w[i] * g; const bf16 h = f2bf(v); wr[(size_t)i * D] = h; wr[(size_t)(20 + i) * D] = f2bf(v - __uint_as_float((unsigned)h << 16)); }
#pragma unroll
                for (int i = 40; i < 48; ++i) wr[(size_t)i * D] = f2bf(0.f); }
            if (gtid >= 4096 && gtid < 4096 + 3072) { const int i = gtid - 4096, hd = i >> 8, d = i & 255; c.BIAS()[i] = (c.rel_bias()[t5_bucket(d) * 12 + hd] - c.rel_bias()[31 * 12 + hd]) * 1.4426950408889634f; }
            if (gtid >= 512 && gtid < 512 + 2048) { const int i = gtid - 512, kv = i >> 10, bg = (i >> 6) & 15, e = i & 63; const size_t tb = ((size_t)bg * 2 + 1) * 4096; if (kv) c.VCMP()[tb + (e >> 5) * 2048 + 3 * 512 + 15 * 32 + (e & 31)] = 0; else c.KCMP()[tb + (e >> 3) * 512 + 63 * 8 + (e & 7)] = 0; }
        }
        if (gwave == 0) {
            const float a = wave_sum(c.diff_lambda()[lane] * c.diff_lambda()[64 + lane]);
            const float b = wave_sum(c.diff_lambda()[128 + lane] * c.diff_lambda()[192 + lane]);
            if (lane == 0) c.LAM()[0] = expf(a) - expf(b) + LAMBDA_INIT;
        }
    }
    xcd_barrier(bar);

    if (IN(1)) {
        pg8::Ops g; g.A0 = c.H1(); g.A1 = c.H1(); g.B0 = c.WIN(); g.B1 = c.WIN(); g.K = 1024;
        pg8::StaticOrder<1> So; So.init(T, 5120, (int)gridDim.x, (int)blockIdx.x);
        EpiInProj E; E.c = c;
        pg8::gemm_phase(( LAS unsigned char*)lds, g, So, E);
    }
    xcd_barrier(bar);

    if (IN(2)) {
        pg8::Ops g; g.A0 = c.CT(); g.A1 = c.CT(); g.B0 = c.WC1(); g.B1 = c.WC1() + 512 * 1024; g.K = 1024;
        SchedCmp So; So.c = (int)blockIdx.x;
        EpiF32 E; E.O = c.U(); E.ldc = 512;
        pg8::gemm_phase((LAS unsigned char*)lds, g, So, E);
        unsigned* ctl = (unsigned*)(ws + WS_CTL);
        volatile LAS int* wq = (volatile LAS int*)((LAS unsigned char*)lds + MISC_OFF + 64);
        if (blockIdx.x < 32 && tid == 0) { __builtin_amdgcn_fence(__ATOMIC_RELEASE, "agent"); asm volatile("s_waitcnt vmcnt(0)" ::: "memory");
            __hip_atomic_fetch_add(ctl + CW_CMPD, 1u, __ATOMIC_RELAXED, __HIP_MEMORY_SCOPE_AGENT); }
        {   att::DiffArgs A; A.Q = c.QD(); A.K = c.KD(); A.V = c.VD(); A.O = c.ODIFF(); A.biasv = c.BIASV(); A.out_gain = c.diff_out_norm(); A.lam = c.LAM()[0];
            LAS float* hid = (LAS float*)((LAS unsigned char*)lds) + (tid >> 6) * 1024;
            bool cmpd_seen = false;
            for (;;) {
                __syncthreads();
                if (tid == 0) {
                    const int u = (int)atomicAdd(ctl + CW_WQ, 1u);
                    if (u >= 256 && u < 384 && !cmpd_seen) { unsigned sp = 0;
                        while (__hip_atomic_load(ctl + CW_CMPD, __ATOMIC_RELAXED, __HIP_MEMORY_SCOPE_AGENT) < 32u) { __builtin_amdgcn_s_sleep(2); if (++sp > (1u << 22)) { atomicAdd(ctl + XB_TMO + CW_BAR, 1u); break; } }
                        __builtin_amdgcn_fence(__ATOMIC_ACQUIRE, "agent"); asm volatile("s_waitcnt vmcnt(0)" ::: "memory"); cmpd_seen = true; }
                    *wq = u;
                }
                __syncthreads();
                const int u = *wq;
                if (u >= 640) break;
                if (u < 256 || u >= 384) { const int du = u < 256 ? u : u - 128; att::diff_unit((LAS unsigned char*)lds, A, (du & 31) >> 2, du & 3, 15 - (du >> 5)); continue; }
                const int q = u - 256;
                const int quarter = q & 3, b = (q >> 2) & 7, g = (q >> 5) & 1, kv = q >> 6;
                const int n0 = quarter * 32 + (tid >> 6) * 4;
#pragma unroll
                for (int jj = 0; jj < 4; ++jj) {
                    const int n = (n0 + jj < NCMP) ? n0 + jj : NCMP - 1;
                    const float* u1 = c.U() + ((size_t)(kv * 2 + g) * 1024 + b * 128 + n) * 512;
                    const float4 t4 = *(const float4*)(u1 + 4 * lane), b4 = *(const float4*)(u1 + 512 + 256 + 4 * lane), p4 = posb_sum(c.POSB() + kv * 256 + 4 * lane);
                    const float hv[4] = {t4.x + b4.x + p4.x, t4.y + b4.y + p4.y, t4.z + b4.z + p4.z, t4.w + b4.w + p4.w};
#pragma unroll
                    for (int i = 0; i < 4; ++i) { const float a = hv[i]; const float uu = 0.7978845608028654f * (a + 0.044715f * a * a * a); hid[jj * 256 + 4 * lane + i] = 0.5f * a * (1.f + tanhf(uu)); }
                }
                const float* w2 = c.cmp_w2() + (size_t)kv * 256 * 64 + lane;
                float o[4] = {0.f, 0.f, 0.f, 0.f};
#pragma unroll 16
                for (int j = 0; j < 256; ++j) { const float w = w2[j * 64]; o[0] += hid[j] * w; o[1] += hid[256 + j] * w; o[2] += hid[512 + j] * w; o[3] += hid[768 + j] * w; }
#pragma unroll
                for (int jj = 0; jj < 4; ++jj) {
                    const int n = n0 + jj; float ov = o[jj];
                    if (kv == 0) { const float ss = wave_sum(ov * ov); ov = ov * rsqrtf(ss * (1.f / 64.f) + RMS_EPS) * c.nsa_k_norm()[lane]; }
                    if (n < NCMP) { const int key = n & 63, e = lane; const size_t tb = ((size_t)(b * 2 + g) * 2 + (n >> 6)) * 4096;
                      if (kv) c.VCMP()[tb + (e >> 5) * 2048 + (key >> 4) * 512 + (key & 15) * 32 + (e & 31)] = f2bf(ov);
                      else c.KCMP()[tb + (e >> 3) * 512 + key * 8 + (e & 7)] = f2bf(ov); }
                }
                asm volatile("s_waitcnt vmcnt(0)" ::: "memory");
                __syncthreads();
                if (tid == 0) { __builtin_amdgcn_fence(__ATOMIC_RELEASE, "agent"); asm volatile("s_waitcnt vmcnt(0)" ::: "memory");
                    __hip_atomic_fetch_add(ctl + CW_FIN + 64 * (b * 2 + g), 1u, __ATOMIC_RELAXED, __HIP_MEMORY_SCOPE_AGENT); }
            } }
        {   att::NsaArgs A; A.Q = c.QN(); A.KS = c.KS(); A.VS = c.VS(); A.KW = c.KW(); A.VW = c.VW(); A.KC = c.KCMP(); A.VC = c.VCMP(); A.GN = c.GN(); A.O = c.ONSAB(); A.rel_bias = c.BIAS(); A.biasv = c.BIASV();
            bool all_seen = false;
            for (;;) {
                __syncthreads();
                if (tid == 0) {
                    const int u = (int)atomicAdd(ctl + CW_WQ + 64, 1u);
                    if (u < 512 && !all_seen) {
                        unsigned* fc = ctl + CW_FIN + 64 * (u & 15); unsigned sp = 0;
                        while (__hip_atomic_load(fc, __ATOMIC_RELAXED, __HIP_MEMORY_SCOPE_AGENT) < 8u) { __builtin_amdgcn_s_sleep(2); if (++sp > (1u << 22)) { atomicAdd(ctl + XB_TMO + CW_BAR, 1u); break; } }
                        bool all = true;
                        for (int k = 0; k < 16; ++k) all = all && (__hip_atomic_load(ctl + CW_FIN + 64 * k, __ATOMIC_RELAXED, __HIP_MEMORY_SCOPE_AGENT) >= 8u);
                        __builtin_amdgcn_fence(__ATOMIC_ACQUIRE, "agent"); asm volatile("s_waitcnt vmcnt(0)" ::: "memory");
                        all_seen = all;
                    }
                    *wq = u;
                }
                __syncthreads();
                const int u = *wq;
                if (u >= 512) break;
                att::nsa_unit((LAS unsigned char*)lds, A, (u & 15) >> 1, u & 1, 31 - (u >> 4));
            } }
    }
    xcd_barrier(bar);
    if (IN(7)) {
        pg8::Ops g; g.A0 = c.ONSAB(); g.A1 = c.ODIFF(); g.B0 = c.WBN(); g.B1 = c.WBD(); g.K = 512;
        pg8::StaticOrder<2> So; So.init(T, 1024, (int)gridDim.x, (int)blockIdx.x);
        EpiMerge E; E.Y = c.Y(); E.GM = c.GM();
        pg8::gemm_phase((LAS unsigned char*)lds, g, So, E);
    }
    xcd_barrier(bar);
    if (IN(8)) {
        pg8::Ops g; g.A0 = c.Y(); g.A1 = c.Y(); g.B0 = c.WOUT(); g.B1 = c.WOUT(); g.K = 1024;
        pg8::StaticOrder<1> So; So.init(T, 1024, (int)gridDim.x, (int)blockIdx.x);
        EpiResid E; E.X = c.x(); E.O = c.X2B();
        pg8::gemm_phase((LAS unsigned char*)lds, g, So, E);
    }
    xcd_barrier(bar);
    if (IN(9)) {
        unsigned* ctl = (unsigned*)(ws + WS_CTL); unsigned* LIST = (unsigned*)(ws + WS_LIST);
        LAS float* Pl = (LAS float*)lds;
        LAS float* Sl = (LAS float*)((LAS unsigned char*)lds + 24576);
        LAS unsigned char* Wl = (LAS unsigned char*)lds + 32768;
        const int wid = tid >> 6, rt = wid & 3, kh = wid >> 2, fr = lane & 15, fq = lane >> 4;
        for (int tb = blockIdx.x; tb < T / 64; tb += gridDim.x) {
            const bf16* xp = c.X2B() + (size_t)(tb * 64 + rt * 16 + fr) * D + kh * 512 + fq * 8;
            pg8::bf16x8 xv[16];
#pragma unroll
            for (int ks = 0; ks < 16; ++ks) xv[ks] = *(const pg8::bf16x8*)(xp + 32 * ks);
            if (tb == (int)blockIdx.x) {
                const pg8::u32x4* wsrc = (const pg8::u32x4*)c.WRT();
                pg8::u32x4 wq[12];
#pragma unroll
                for (int j = 0; j < 12; ++j) wq[j] = wsrc[tid + 512 * j];
#pragma unroll
                for (int j = 0; j < 12; ++j) { const int q = tid + 512 * j; *(LAS pg8::u32x4*)(Wl + (q >> 7) * 2080 + (q & 127) * 16) = wq[j]; } }
            __syncthreads();
            const LAS unsigned char* wl = Wl + fr * 2080 + (kh * 512 + fq * 8) * 2;
            pg8::f32x4 acc[3];
#pragma unroll
            for (int ct = 0; ct < 3; ++ct) acc[ct] = (pg8::f32x4){0.f, 0.f, 0.f, 0.f};
            float ss = 0.f;
#pragma unroll
            for (int ks = 0; ks < 16; ++ks) {
                pg8::bf16x8 wv[3];
#pragma unroll
                for (int ct = 0; ct < 3; ++ct) wv[ct] = *(const LAS pg8::bf16x8*)(wl + ct * 16 * 2080 + 64 * ks);
#pragma unroll
                for (int ct = 0; ct < 3; ++ct) acc[ct] = __builtin_amdgcn_mfma_f32_16x16x32_bf16(wv[ct], xv[ks], acc[ct], 0, 0, 0);
                const pg8::u32x4 xu = __builtin_bit_cast(pg8::u32x4, xv[ks]);
#pragma unroll
                for (int q = 0; q < 4; ++q) { const float a = LO16(xu[q]), b = HI16(xu[q]); ss += a * a + b * b; }
            }
#pragma unroll
            for (int ct = 0; ct < 3; ++ct) *(LAS pg8::f32x4*)(Pl + (size_t)((kh * 64 + rt * 16 + fr) * 48 + 16 * ct + 4 * fq)) = acc[ct];
            Sl[(kh * 4 + fq) * 64 + rt * 16 + fr] = ss;
            __syncthreads();
            if (tid < 64) {
                const LAS float* p0 = Pl + (size_t)lane * 48; const LAS float* p1 = Pl + (size_t)(64 + lane) * 48;
                float ssum = 0.f;
#pragma unroll
                for (int q = 0; q < 8; ++q) ssum += Sl[q * 64 + lane];
                const float rr = rsqrtf(ssum * (1.f / D) + RMS_EPS);
                float gl[4];
#pragma unroll
                for (int i = 0; i < 4; ++i) gl[i] = ((p0[i] + p1[i]) + (p0[20 + i] + p1[20 + i])) * rr + c.rg_b()[i];
                int gt = 0; float gbest = gl[0];
#pragma unroll
                for (int i = 1; i < 4; ++i) if (gl[i] > gbest) { gbest = gl[i]; gt = i; }
                float gs = 0.f;
#pragma unroll
                for (int i = 0; i < 4; ++i) gs += expf(gl[i] - gbest);
                const float gp = 1.f / gs;
                float el[4];
#pragma unroll
                for (int i = 0; i < 4; ++i) { const int jx = 4 + gt * 4 + i; el[i] = ((p0[jx] + p1[jx]) + (p0[20 + jx] + p1[20 + jx])) * rr + c.re_b()[gt * 4 + i]; }
                int e0 = 0; float b0 = el[0];
#pragma unroll
                for (int i = 1; i < 4; ++i) if (el[i] > b0) { b0 = el[i]; e0 = i; }
                int e1 = -1; float b1 = -3.0e38f;
#pragma unroll
                for (int i = 0; i < 4; ++i) if (i != e0 && el[i] > b1) { b1 = el[i]; e1 = i; }
                const float p1e = expf(b1 - b0); const float w0 = gp / (1.f + p1e), w1 = gp * p1e / (1.f + p1e);
                const int ea = e0 < e1 ? e0 : e1, eb = e0 < e1 ? e1 : e0;
                const int pr = (ea == 0) ? eb - 1 : (ea == 1 ? eb + 1 : 5);
                const int mycls = gt * 6 + pr;
                *(float4*)(c.ROUTE() + (size_t)(tb * 64 + lane) * 4) = make_float4(e0 < e1 ? w0 : w1, e0 < e1 ? w1 : w0, __int_as_float(mycls), rr);
                int cnt_l = 0, rank = 0;
                for (int cc = 0; cc < NCLS; ++cc) {
                    const unsigned long long mask = __ballot(mycls == cc);
                    if (lane == cc) cnt_l = __popcll(mask);
                    if (mycls == cc) rank = __popcll(mask & ((1ull << lane) - 1ull));
                }
                unsigned base_l = 0u;
                if (lane < NCLS && cnt_l > 0) base_l = atomicAdd(ctl + CW_CNT + 64 * lane, (unsigned)cnt_l);
                const unsigned base = __shfl(base_l, mycls);
                LIST[(size_t)mycls * T + base + rank] = (unsigned)(tb * 64 + lane);
            }
            __syncthreads();
        }
    }
    xcd_barrier(bar);
    if (IN(10)) {
        LAS int* tab = (LAS int*)((LAS unsigned char*)lds + TAB_OFF);
        moe_build_tab((const unsigned*)(ws + WS_CTL), tab);
        unsigned* ctl = (unsigned*)(ws + WS_CTL);
        const int G = (int)gridDim.x, bx = (int)blockIdx.x, vcu = (G % 8 == 0) ? (bx % 8) * (G / 8) + bx / 8 : bx;
        {   OpsGU g; g.H2 = c.X2B(); g.WGU = c.WGU(); g.LIST = (const unsigned*)(ws + WS_LIST); g.tab = tab;
            SchedGU So; So.tab = tab; So.G = G; So.vcu = vcu;
            EpiGU E; E.HID = c.HID(); E.LIST = (const unsigned*)(ws + WS_LIST); E.ROUTE = c.ROUTE(); E.tab = tab; E.ctl = ctl;
            pg8::gemm_phase_g((LAS unsigned char*)lds, g, So, E); }
        {   OpsDN g; g.HID = c.HID(); g.WDN = c.WDN(); g.tab = tab;
            SchedDN So; So.tab = tab; So.ctl = ctl; So.G = G; So.vcu = vcu;
            EpiDN E; E.O = c.out(); E.X2 = c.X2B(); E.LIST = (const unsigned*)(ws + WS_LIST); E.tab = tab;
            pg8::gemm_phase_g((LAS unsigned char*)lds, g, So, E); }
    }
#undef IN
#undef SEAM
}

extern "C" void kernel_launch(void* const* d_in, const int* in_sizes, int n_in, void* d_out, int out_size, void* d_ws, size_t ws_size, hipStream_t stream) {
    static int grid = 0;
    if (grid == 0) {
        if (n_in != 24 || out_size != T * D || ws_size < WS_END) { fprintf(stderr, "kernel_launch: unexpected shapes (n_in %d out %d ws %zu)\n", n_in, out_size, ws_size); grid = -1; return; }
        int dev = 0, cus = 0, per_cu = 0;
        if (hipGetDevice(&dev) != hipSuccess || hipDeviceGetAttribute(&cus, hipDeviceAttributeMultiprocessorCount, dev) != hipSuccess) { grid = -1; return; }
        if (hipFuncSetAttribute((const void*)fwd_kernel, hipFuncAttributeMaxDynamicSharedMemorySize, LDS_BYTES) != hipSuccess) { fprintf(stderr, "kernel_launch: hipFuncSetAttribute failed\n"); grid = -1; return; }
        if (hipOccupancyMaxActiveBlocksPerMultiprocessor(&per_cu, (const void*)fwd_kernel, NTHR, LDS_BYTES) != hipSuccess || per_cu < 1) { fprintf(stderr, "kernel_launch: occupancy query says %d\n", per_cu); }
        (void)hipGetLastError();
        grid = cus;
    }
    if (grid < 0) return;
    (void)hipMemsetAsync((char*)d_ws + WS_CTL, 0, CTL_ZERO_BYTES, stream);
    Args a{};
    for (int i = 0; i < 24; ++i) a.in[i] = (const float*)d_in[i];
    a.out = (float*)d_out; a.ws = (unsigned char*)d_ws; a.ph_lo = 0; a.ph_hi = 11;
    hipLaunchKernelGGL(fwd_kernel, dim3(grid), dim3(NTHR), LDS_BYTES, stream, a);
}
```

```cpp
#include <hip/hip_runtime.h>
#include <cstdint>
#include <cstdio>

constexpr int NB = 8, S = 2048, D = 1024, T = NB * S;
constexpr int INC = 4888;
constexpr int C_QN = 0, C_KV = 512, C_GN = 1280, C_QD = 1304, C_KD = 1816, C_VD = 2328, C_GM = 2840;
constexpr int NCMP = 127;
constexpr float LAMBDA_INIT = 0.2f;
constexpr float RMS_EPS = 1e-6f;

typedef unsigned short bf16;
#define LAS __attribute__((address_space(3)))

constexpr size_t MiB = 1u << 20;
constexpr size_t WS_CTL = 0, CTL_ZERO_BYTES = 1 * MiB;
constexpr size_t WS_WIN = 1 * MiB;
constexpr size_t WS_WOUT = 11 * MiB;
constexpr size_t WS_WBN = 13 * MiB, WS_WBD = 14 * MiB;
constexpr size_t WS_WC1 = 15 * MiB;
constexpr size_t WS_WGU = 17 * MiB;
constexpr size_t WS_WDN = 49 * MiB;
constexpr size_t WS_H1 = 65 * MiB;
constexpr size_t WS_QN = 97 * MiB;
constexpr size_t WS_CT = 113 * MiB;
constexpr size_t WS_KS = 121 * MiB, WS_VS = 125 * MiB, WS_KW = 129 * MiB, WS_VW = 133 * MiB;
constexpr size_t WS_QD = 137 * MiB, WS_KD = 153 * MiB, WS_VD = 169 * MiB;
constexpr size_t WS_GM = 185 * MiB;
constexpr size_t WS_GN = 249 * MiB;
constexpr size_t WS_KCMP = 251 * MiB;
constexpr size_t WS_VCMP = 251 * MiB + 256 * 1024;
constexpr size_t WS_ROUTE = 252 * MiB + 512 * 1024;
constexpr size_t WS_LAM = 252 * MiB + 768 * 1024;
constexpr size_t WS_POSB = 252 * MiB + 800 * 1024;
constexpr size_t WS_BIAS = 252 * MiB + 832 * 1024;
constexpr size_t WS_BIASV = 252 * MiB + 848 * 1024;
constexpr size_t WS_WRT = 253 * MiB;
constexpr size_t WS_END = 256 * MiB;
constexpr size_t WS_U = WS_H1;
constexpr size_t WS_ONSAB = WS_H1 + 16 * MiB;
constexpr size_t WS_X2B = WS_H1;
constexpr size_t WS_Y = WS_QN;
constexpr size_t WS_HID = WS_GM;

constexpr int CW_BAR = 4096;

#define XB_TMO      128
#define XB_XCNT(j)  (256  + 64 * (j))
#define XB_XSUB(j)  (1280 + 64 * (j))
#define XB_XGEN(j)  (2304 + 64 * (j))
#define XB_TOP      3328
#define XB_TOPGEN   3392
#define XCD_BAR_WORDS 3456
#define XB_SPIN_CAP (1u << 22)

__device__ __forceinline__ unsigned xb_ld(unsigned* p)              { return __hip_atomic_load(p, __ATOMIC_RELAXED, __HIP_MEMORY_SCOPE_AGENT); }
__device__ __forceinline__ unsigned xb_add(unsigned* p, unsigned v) { return __hip_atomic_fetch_add(p, v, __ATOMIC_RELAXED, __HIP_MEMORY_SCOPE_AGENT); }
__device__ __forceinline__ unsigned xb_xcc_id() { return (unsigned)__builtin_amdgcn_s_getreg((3 << 11) | 20) & 0xFu; }
#define XB_SPIN(cond, bar) do { unsigned _sp = 0; while (cond) { __builtin_amdgcn_s_sleep(1); \
    if ((++_sp & 255u) == 0u) { if (xb_ld(&(bar)[XB_TMO])) break; if (_sp > XB_SPIN_CAP) { atomicAdd(&(bar)[XB_TMO], 1u); break; } } } } while (0)

struct XcdBarrier { unsigned* bar; unsigned x; volatile LAS unsigned* st; };

__device__ __forceinline__ XcdBarrier xcd_barrier_post(unsigned* bar, volatile LAS unsigned* st) {
    XcdBarrier b; b.bar = bar; b.x = xb_xcc_id(); b.st = st;
    if (threadIdx.x == 0) (void)xb_add(&bar[XB_XCNT(b.x)], 1u);
    return b;
}
__device__ __forceinline__ void xcd_barrier_complete(unsigned* bar, unsigned x, unsigned& nloc, unsigned& nx) {
    const unsigned G = gridDim.x * gridDim.y * gridDim.z;
    unsigned sum, cnt, mine, sp = 0u;
    for (;;) {
        sum = 0u; cnt = 0u; mine = 0u;
#pragma unroll
        for (unsigned j = 0; j < 16; ++j) { const unsigned c = xb_ld(&bar[XB_XCNT(j)]); sum += c; cnt += (c > 0u) ? 1u : 0u; mine = (j == x) ? c : mine; }
        if (sum == G) break;
        __builtin_amdgcn_s_sleep(1);
        if ((++sp & 255u) == 0u) { if (xb_ld(&bar[XB_TMO])) break; if (sp > XB_SPIN_CAP) { atomicAdd(&bar[XB_TMO], 1u); break; } }
    }
    nloc = mine > 0u ? mine : 1u; nx = cnt > 0u ? cnt : 1u;
}
__device__ __forceinline__ void xcd_barrier(const XcdBarrier& b) {
    asm volatile("s_waitcnt vmcnt(0)" ::: "memory");
    __syncthreads();
    if (threadIdx.x == 0) {
        unsigned* bar = b.bar;
        __builtin_amdgcn_s_waitcnt(0);
        unsigned nloc = b.st[0], nx = b.st[1];
        if (nloc == 0u) { xcd_barrier_complete(bar, b.x, nloc, nx); b.st[0] = nloc; b.st[1] = nx; }
        const unsigned old = xb_add(&bar[XB_XSUB(b.x)], 1u);
        const unsigned gen = old / nloc;
        if (old + 1u == (gen + 1u) * nloc) {
            __builtin_amdgcn_fence(__ATOMIC_RELEASE, "agent");
            asm volatile("s_waitcnt vmcnt(0)" ::: "memory");
            const unsigned og = xb_add(&bar[XB_TOP], 1u);
            const unsigned tg = og / nx;
            if (og + 1u == (tg + 1u) * nx) xb_add(&bar[XB_TOPGEN], 1u);
            else XB_SPIN(xb_ld(&bar[XB_TOPGEN]) == tg, bar);
            __builtin_amdgcn_fence(__ATOMIC_ACQUIRE, "agent");
            xb_add(&bar[XB_XGEN(b.x)], 1u);
            asm volatile("s_waitcnt vmcnt(0)" ::: "memory");
        } else {
            XB_SPIN(xb_ld(&bar[XB_XGEN(b.x)]) == gen, bar);
            __builtin_amdgcn_fence(__ATOMIC_ACQUIRE, "agent");
            asm volatile("s_waitcnt vmcnt(0)" ::: "memory");
        }
    }
    __syncthreads();
}

__device__ __forceinline__ bf16 f2bf(float f) { unsigned u = __float_as_uint(f); return (bf16)((u + 0x7fffu + ((u >> 16) & 1u)) >> 16); }
typedef float g_f32x2 __attribute__((ext_vector_type(2))); typedef __bf16 g_bf16x2 __attribute__((ext_vector_type(2)));
__device__ __forceinline__ unsigned pk2bf(float lo, float hi) { const g_f32x2 v = {lo, hi}; const g_bf16x2 b = __builtin_convertvector(v, g_bf16x2); return __builtin_bit_cast(unsigned, b); }
__device__ __forceinline__ float wave_sum(float v) {
#pragma unroll
    for (int o = 1; o < 64; o <<= 1) v += __shfl_xor(v, o);
    return v;
}
typedef float nt_f32x4 __attribute__((ext_vector_type(4)));
__device__ __forceinline__ float sigmoidf_(float x) { return __builtin_amdgcn_rcpf(1.f + __builtin_amdgcn_exp2f(-1.4426950408889634f * x)); }

__device__ const unsigned char T5B[128] = {0, 1, 2, 3, 4, 5, 6, 7, 8, 9, 10, 11, 12, 13, 14, 15, 16, 16, 16, 17, 17, 18, 18, 18, 19, 19, 19, 20, 20, 20, 20, 21, 21, 21, 21, 22, 22, 22, 22, 22, 23, 23, 23, 23, 23, 23, 24, 24, 24, 24, 24, 24, 25, 25, 25, 25, 25, 25, 25, 26, 26, 26, 26, 26, 26, 26, 26, 27, 27, 27, 27, 27, 27, 27, 27, 27, 27, 28, 28, 28, 28, 28, 28, 28, 28, 28, 28, 29, 29, 29, 29, 29, 29, 29, 29, 29, 29, 29, 29, 30, 30, 30, 30, 30, 30, 30, 30, 30, 30, 30, 30, 30, 30, 31, 31, 31, 31, 31, 31, 31, 31, 31, 31, 31, 31, 31, 31, 31};
__device__ __forceinline__ int t5_bucket(int dist) { return (int)T5B[dist > 127 ? 127 : (dist < 0 ? 0 : dist)]; }

#define LO16(u) __uint_as_float((u) << 16)
#define HI16(u) __uint_as_float((u) & 0xffff0000u)

struct Args { const float* in[24]; float* out; unsigned char* ws; int ph_lo, ph_hi; };

struct Ctx {
    Args a;
#define CF(name, idx) __device__ __forceinline__ const float* name() const { return a.in[idx]; }
    CF(x, 0) CF(norm1_g, 1) CF(w_in, 2) CF(nsa_q_norm, 3) CF(nsa_k_norm, 4) CF(cmp_pos, 5) CF(cmp_w1, 6) CF(cmp_w2, 7) CF(diff_q_norm, 8) CF(diff_k_norm, 9)
    CF(diff_lambda, 10) CF(diff_out_norm, 11) CF(rel_bias, 12) CF(w_bn, 13) CF(w_bd, 14) CF(w_out, 15) CF(norm2_g, 16) CF(rg_w, 17) CF(rg_b, 18) CF(re_w, 19) CF(re_b, 20)
    CF(w_gate, 21) CF(w_up, 22) CF(w_down, 23)
#undef CF
#define CW(type, name, off) __device__ __forceinline__ type* name() const { return (type*)(a.ws + (off)); }
    CW(bf16, H1, WS_H1) CW(bf16, QN, WS_QN) CW(bf16, CT, WS_CT) CW(bf16, KS, WS_KS) CW(bf16, VS, WS_VS) CW(bf16, KW, WS_KW) CW(bf16, VW, WS_VW)
    CW(bf16, QD, WS_QD) CW(bf16, KD, WS_KD) CW(bf16, VD, WS_VD) CW(bf16, GM, WS_GM) CW(float, GN, WS_GN) CW(bf16, KCMP, WS_KCMP) CW(bf16, VCMP, WS_VCMP)
    CW(bf16, ONSAB, WS_ONSAB) CW(float, ROUTE, WS_ROUTE)
    CW(float, LAM, WS_LAM) CW(bf16, Y, WS_Y) CW(bf16, HID, WS_HID)
    CW(float, U, WS_U) CW(bf16, X2B, WS_X2B) CW(float, POSB, WS_POSB) CW(float, BIAS, WS_BIAS) CW(float, BIASV, WS_BIASV) CW(bf16, WIN, WS_WIN) CW(bf16, WOUT, WS_WOUT) CW(bf16, WBN, WS_WBN) CW(bf16, WBD, WS_WBD) CW(bf16, WC1, WS_WC1) CW(bf16, WGU, WS_WGU) CW(bf16, WDN, WS_WDN) CW(bf16, WRT, WS_WRT)
    __device__ __forceinline__ bf16* ODIFF() const { return (bf16*)a.out; }
#undef CW
    __device__ __forceinline__ float* out() const { return a.out; }
};

struct ChunkDesc { int src; int ncols; int mode; const float* gain; bf16* dst; float* dstf; int pitch; int dcol; float qscale;
    int img; int c0; int tile_bytes; int bstride; };
__device__ __forceinline__ ChunkDesc chunk_desc(const Ctx& c, int ch) {
    ChunkDesc d; d.src = 0; d.ncols = 64; d.mode = 0; d.gain = nullptr; d.dst = nullptr; d.dstf = nullptr; d.pitch = 0; d.dcol = 0; d.qscale = 1.f; d.img = 0; d.c0 = 0; d.tile_bytes = 0; d.bstride = 0;
    if (ch < 8) { d.src = C_QN + 64 * ch; d.mode = 1; d.gain = c.nsa_q_norm(); d.dst = c.QN(); d.pitch = 512; d.dcol = 64 * ch; d.qscale = 0.125f * 1.4426950408889634f; }
    else if (ch < 20) { const int j = ch - 8; d.src = C_KV + 64 * j; const int t = j >> 2, kv = (j >> 1) & 1, g = j & 1;
        if (t == 0) { d.dst = c.CT() + (size_t)(kv * 2 + g) * T * 64; d.pitch = 64; d.dcol = 0; }
        else { d.dst = ((t == 1) ? (kv ? c.VS() : c.KS()) : (kv ? c.VW() : c.KW())) + (size_t)g * 32 * 4096; d.img = kv ? 2 : 1; d.c0 = 0; d.tile_bytes = 8192; d.bstride = 2 * 32 * 8192;
               if (kv == 0) { d.mode = 1; d.gain = c.nsa_k_norm() + 64 * t; } } }
    else if (ch < 24) { if (ch == 20) { d.src = C_GN; d.ncols = 24; d.mode = 2; d.dstf = c.GN(); d.pitch = 24; d.dcol = 0; } else d.ncols = 0; }
    else if (ch < 32) { const int j = ch - 24; d.src = C_QD + 64 * j; d.mode = 1; d.gain = c.diff_q_norm() + 64 * (j & 1); d.dst = c.QD(); d.pitch = 512; d.dcol = 64 * j; d.qscale = 0.125f * 1.4426950408889634f; }
    else if (ch < 40) { const int j = ch - 32; d.src = C_KD + 64 * j; d.mode = 1; d.gain = c.diff_k_norm() + 64 * (j & 1); d.dst = c.KD() + (size_t)(j >> 1) * 32 * 8192; d.img = 1; d.c0 = (j & 1) * 8; d.tile_bytes = 16384; d.bstride = 4 * 32 * 16384; }
    else if (ch < 48) { const int j = ch - 40; d.src = C_VD + 64 * j; d.dst = c.VD() + (size_t)(j >> 1) * 32 * 8192; d.img = 2; d.c0 = (j & 1) * 2; d.tile_bytes = 16384; d.bstride = 4 * 32 * 16384; }
    else { const int j = ch - 48; d.src = C_GM + 64 * j; d.mode = 2; d.dst = c.GM(); d.pitch = 2048; d.dcol = 64 * j; }
    return d;
}


namespace pg8 {
typedef short bf16x8 __attribute__((ext_vector_type(8)));
typedef float f32x4 __attribute__((ext_vector_type(4)));
typedef unsigned u32x4 __attribute__((ext_vector_type(4)));
constexpr int BM = 256, BK = 64, HALF = 128, HTB = HALF * BK * 2, NXCD = 8, WGM = 8;
__device__ __forceinline__ int lds_byte(int r, int c) { const int st = (r >> 4) * 2 + (c >> 5), rr = r & 15, cc = c & 31, ob = rr * 64 + cc * 2; return st * 1024 + (ob ^ (((ob >> 9) & 1) << 5)); }
__device__ __forceinline__ void stage_rc(int b, int& R, int& C) { const int st = b / 1024, sb = b % 1024, swz = sb ^ (((sb >> 9) & 1) << 5); R = (st >> 1) * 16 + swz / 64; C = (st & 1) * 32 + (swz % 64) / 2; }
__device__ __forceinline__ int perm32(int rho) { const int n = rho >> 4, i = rho & 15; return 8 * (i >> 2) + 4 * n + (i & 3); }
__device__ __forceinline__ unsigned cvt_pk_bf16(float lo, float hi) { return pk2bf(lo, hi); }

struct Unit { int pm, pn, z; };
struct Ops { const bf16 *A0, *A1, *B0, *B1; int K;
    __device__ __forceinline__ const char* a(const Unit& u) const { return (const char*)((u.z ? A1 : A0) + (size_t)u.pm * BM * K); }
    __device__ __forceinline__ const char* b(const Unit& u) const { return (const char*)((u.z ? B1 : B0) + (size_t)u.pn * BM * K); } };

template <int NZ> struct StaticOrder {
    int nM, nN, nwg, G, c;
    __device__ __forceinline__ void init(int M, int N, int G_, int c_) { nM = M / BM; nN = N / BM; nwg = nM * nN; G = G_; c = c_; }
    __device__ __forceinline__ bool next(int i, Unit& u) const {
        const int it = i / NZ; u.z = i % NZ;
        const long L = (long)it * G + c; if (L >= nwg) return false;
        int wgid = (int)L; { const int q = nwg / NXCD, r = nwg % NXCD, xcd = wgid % NXCD, off = wgid / NXCD; wgid = (xcd < r ? xcd * (q + 1) : r * (q + 1) + (xcd - r) * q) + off; }
        const int nig = WGM * nN, gid = wgid / nig, fm = gid * WGM, gsz = (nM - fm) < WGM ? (nM - fm) : WGM;
        u.pm = fm + ((wgid % nig) % gsz); u.pn = (wgid % nig) / gsz; return true;
    }
};

template <class Epi, class Sched>
__device__ __forceinline__ void gemm_phase(LAS unsigned char* lds, const Ops g, const Sched& S, const Epi& E) {
    const int tid = threadIdx.x, wid = __builtin_amdgcn_readfirstlane(tid >> 6), lane = tid & 63, wr = wid >> 2, wc = wid & 3, fr = lane & 15, fq = lane >> 4;
    const int K = g.K, nt = K / BK;
    unsigned voffA[2], voffB[2];
#pragma unroll
    for (int i = 0; i < 2; ++i) { int R, C; stage_rc(tid * 16 + i * 8192, R, C); const int Rb = (R & ~31) + perm32(R & 31);
        voffA[i] = (unsigned)(R * K + C) * 2u; voffB[i] = (unsigned)(Rb * K + C) * 2u; }
    const size_t kstep = (size_t)(BK * 2);
    const size_t hstep = (size_t)HALF * K * 2;
    const unsigned ldsw = (unsigned)wid * 1024u;
    const int aoff = lds_byte(wr * 64 + fr, fq * 8), boff = lds_byte(wc * 32 + fr, fq * 8);
#define PG8_SA(b, h) (((b) * 2 + (h)) * HTB)
#define PG8_SB(b, h) ((4 + (b) * 2 + (h)) * HTB)
#define PG8_STAGE(bufoff, gbase, voff) do { _Pragma("unroll") for (int _i = 0; _i < 2; ++_i) \
        __builtin_amdgcn_global_load_lds((const unsigned*)((const char*)(gbase) + (voff)[_i]), (LAS unsigned*)(lds + (bufoff) + ldsw + _i * 8192), 16, 0, 0); } while (0)
#define PG8_LDA(dst, b, h) do { _Pragma("unroll") for (int m = 0; m < 4; ++m) _Pragma("unroll") for (int k = 0; k < 2; ++k) dst[m][k] = *(const LAS bf16x8*)(lds + PG8_SA(b, h) + aoff + m * 2048 + k * 1024); } while (0)
#define PG8_LDB(dst, b, h) do { _Pragma("unroll") for (int n = 0; n < 2; ++n) _Pragma("unroll") for (int k = 0; k < 2; ++k) dst[n][k] = *(const LAS bf16x8*)(lds + PG8_SB(b, h) + boff + n * 2048 + k * 1024); } while (0)
#define PG8_MMA(ai, bj, At, Bt) do { __builtin_amdgcn_s_setprio(1); _Pragma("unroll") for (int m = 0; m < 4; ++m) _Pragma("unroll") for (int n = 0; n < 2; ++n) _Pragma("unroll") for (int k = 0; k < 2; ++k) \
        acc[ai][bj][m][n] = __builtin_amdgcn_mfma_f32_16x16x32_bf16(Bt[n][k], At[m][k], acc[ai][bj][m][n], 0, 0, 0); __builtin_amdgcn_s_setprio(0); } while (0)
#define PG8_WAIT_V(n) asm volatile("s_waitcnt vmcnt(" #n ")" ::: "memory")
#define PG8_WAIT_L(n) asm volatile("s_waitcnt lgkmcnt(" #n ")" ::: "memory")
#define PG8_BAR __builtin_amdgcn_s_barrier()
#define PG8_SCHED __builtin_amdgcn_sched_barrier(0)
    Unit cur, nxt; int ui = 0;
    if (!S.next(0, cur)) return;
    f32x4 acc[2][2][4][2];
#pragma unroll
    for (int a = 0; a < 2; ++a)
#pragma unroll
        for (int b = 0; b < 2; ++b)
#pragma unroll
            for (int m = 0; m < 4; ++m)
#pragma unroll
                for (int n = 0; n < 2; ++n) acc[a][b][m][n] = (f32x4){0.f, 0.f, 0.f, 0.f};
    bf16x8 At[4][2], B0[2][2], B1[2][2];
    const char* cA = g.a(cur); const char* cB = g.b(cur);
    PG8_STAGE(PG8_SB(0, 0), cB, voffB); PG8_STAGE(PG8_SB(0, 1), cB + hstep, voffB); PG8_STAGE(PG8_SA(0, 0), cA, voffA); PG8_STAGE(PG8_SA(0, 1), cA + hstep, voffA);
    if (wr == 1) PG8_BAR;
    PG8_WAIT_V(2); PG8_BAR;
    PG8_STAGE(PG8_SB(1, 0), cB + kstep, voffB); PG8_STAGE(PG8_SA(1, 0), cA + kstep, voffA); PG8_STAGE(PG8_SB(1, 1), cB + hstep + kstep, voffB);
    PG8_WAIT_V(6); PG8_BAR;
    for (;;) {
        const bool has_next = S.next(ui + 1, nxt);
        const char* nA = has_next ? g.a(nxt) : cA; const char* nB = has_next ? g.b(nxt) : cB;
        for (int t = 0; t < nt; t += 2) {
            const bool last = (t == nt - 2);
            const char* a1 = cA + (size_t)(t + 1) * kstep;
            const char* a2 = last ? nA : cA + (size_t)(t + 2) * kstep; const char* b2 = last ? nB : cB + (size_t)(t + 2) * kstep;
            const char* a3 = a2 + kstep; const char* b3 = b2 + kstep;
            PG8_LDB(B0, 0, 0); PG8_LDB(B1, 0, 1); PG8_SCHED; PG8_LDA(At, 0, 0); PG8_STAGE(PG8_SA(1, 1), a1 + hstep, voffA);
            PG8_WAIT_V(8); PG8_WAIT_L(0); PG8_BAR; PG8_MMA(0, 0, At, B0); PG8_MMA(0, 1, At, B1); PG8_BAR; PG8_SCHED;
            PG8_LDA(At, 0, 1); PG8_STAGE(PG8_SB(0, 0), b2, voffB); PG8_STAGE(PG8_SB(0, 1), b2 + hstep, voffB); PG8_STAGE(PG8_SA(0, 0), a2, voffA);
            PG8_WAIT_V(8); PG8_WAIT_L(0); PG8_BAR; PG8_MMA(1, 0, At, B0); PG8_MMA(1, 1, At, B1); PG8_BAR; PG8_SCHED;
            PG8_LDB(B0, 1, 0); PG8_LDB(B1, 1, 1); PG8_SCHED; PG8_LDA(At, 1, 0); PG8_STAGE(PG8_SA(0, 1), a2 + hstep, voffA);
            PG8_WAIT_V(8); PG8_WAIT_L(0); PG8_BAR; PG8_MMA(0, 0, At, B0); PG8_MMA(0, 1, At, B1); PG8_BAR; PG8_SCHED;
            PG8_LDA(At, 1, 1); PG8_STAGE(PG8_SB(1, 0), b3, voffB); PG8_STAGE(PG8_SB(1, 1), b3 + hstep, voffB); PG8_STAGE(PG8_SA(1, 0), a3, voffA);
            PG8_WAIT_V(8); PG8_WAIT_L(0); PG8_BAR; PG8_MMA(1, 0, At, B0); PG8_MMA(1, 1, At, B1); PG8_BAR; PG8_SCHED;
        }
        if (wr == 0) PG8_BAR;
        const bool keep = E(acc, cur, wr, wc, fr, fq);
        if (!has_next) break;
        if (!keep) {
#pragma unroll
        for (int a = 0; a < 2; ++a)
#pragma unroll
            for (int b = 0; b < 2; ++b)
#pragma unroll
                for (int m = 0; m < 4; ++m)
#pragma unroll
                    for (int n = 0; n < 2; ++n) acc[a][b][m][n] = (f32x4){0.f, 0.f, 0.f, 0.f};
        }
        cur = nxt; cA = nA; cB = nB; ++ui;
        if (wr == 1) PG8_BAR;
    }
    PG8_WAIT_V(0);
    PG8_BAR;
#undef PG8_SA
#undef PG8_SB
#undef PG8_STAGE
#undef PG8_LDA
#undef PG8_LDB
#undef PG8_MMA
#undef PG8_WAIT_V
#undef PG8_WAIT_L
#undef PG8_BAR
#undef PG8_SCHED
}

template <class G, class Epi, class Sched>
__device__ __forceinline__ void gemm_phase_g(LAS unsigned char* lds, const G& g, const Sched& S, const Epi& E) {
    const int tid = threadIdx.x, wid = __builtin_amdgcn_readfirstlane(tid >> 6), lane = tid & 63, wr = wid >> 2, wc = wid & 3, fr = lane & 15, fq = lane >> 4;
    constexpr int nt = G::NT;
    unsigned voffB[2];
#pragma unroll
    for (int i = 0; i < 2; ++i) { int R, C; stage_rc(tid * 16 + i * 8192, R, C); const int Rb = (R & ~31) + perm32(R & 31); voffB[i] = (unsigned)(Rb * G::LDB + C) * 2u; }
#define PG8_RC int sR[2], sC[2]; stage_rc(tid * 16, sR[0], sC[0]); stage_rc(tid * 16 + 8192, sR[1], sC[1])
    const size_t kstep = (size_t)(BK * 2);
    const size_t hstepB = (size_t)HALF * G::LDB * 2;
    const unsigned ldsw = (unsigned)wid * 1024u;
    const int aoff = lds_byte(wr * 64 + fr, fq * 8), boff = lds_byte(wc * 32 + fr, fq * 8);
#define PG8_SA(b, h) (((b) * 2 + (h)) * HTB)
#define PG8_SB(b, h) ((4 + (b) * 2 + (h)) * HTB)
#define PG8_STAGE(bufoff, gbase, voff) do { _Pragma("unroll") for (int _i = 0; _i < 2; ++_i) \
        __builtin_amdgcn_global_load_lds((const unsigned*)((const char*)(gbase) + (voff)[_i]), (LAS unsigned*)(lds + (bufoff) + ldsw + _i * 8192), 16, 0, 0); } while (0)
#define PG8_LDA(dst, b, h) do { _Pragma("unroll") for (int m = 0; m < 4; ++m) _Pragma("unroll") for (int k = 0; k < 2; ++k) dst[m][k] = *(const LAS bf16x8*)(lds + PG8_SA(b, h) + aoff + m * 2048 + k * 1024); } while (0)
#define PG8_LDB(dst, b, h) do { _Pragma("unroll") for (int n = 0; n < 2; ++n) _Pragma("unroll") for (int k = 0; k < 2; ++k) dst[n][k] = *(const LAS bf16x8*)(lds + PG8_SB(b, h) + boff + n * 2048 + k * 1024); } while (0)
#define PG8_MMA(ai, bj, At, Bt) do { __builtin_amdgcn_s_setprio(1); _Pragma("unroll") for (int m = 0; m < 4; ++m) _Pragma("unroll") for (int n = 0; n < 2; ++n) _Pragma("unroll") for (int k = 0; k < 2; ++k) \
        acc[ai][bj][m][n] = __builtin_amdgcn_mfma_f32_16x16x32_bf16(Bt[n][k], At[m][k], acc[ai][bj][m][n], 0, 0, 0); __builtin_amdgcn_s_setprio(0); } while (0)
#define PG8_WAIT_V(n) asm volatile("s_waitcnt vmcnt(" #n ")" ::: "memory")
#define PG8_WAIT_L(n) asm volatile("s_waitcnt lgkmcnt(" #n ")" ::: "memory")
#define PG8_BAR __builtin_amdgcn_s_barrier()
#define PG8_SCHED __builtin_amdgcn_sched_barrier(0)
    Unit cur, nxt; int ui = 0;
    if (!S.next(0, cur)) return;
    unsigned vc[2][2], vn[2][2];
    bool has_next = S.next(1, nxt);
    {   PG8_RC; g.a_voff(cur, sR, sC, vc);
        if (has_next) g.a_voff(nxt, sR, sC, vn); }
    if (has_next) {} else { vn[0][0] = vc[0][0]; vn[0][1] = vc[0][1]; vn[1][0] = vc[1][0]; vn[1][1] = vc[1][1]; }
    f32x4 acc[2][2][4][2];
#pragma unroll
    for (int a = 0; a < 2; ++a)
#pragma unroll
        for (int b = 0; b < 2; ++b)
#pragma unroll
            for (int m = 0; m < 4; ++m)
#pragma unroll
                for (int n = 0; n < 2; ++n) acc[a][b][m][n] = (f32x4){0.f, 0.f, 0.f, 0.f};
    bf16x8 At[4][2], B0[2][2], B1[2][2];
    const char* cA = g.a_base(cur);
    const char *cb0, *cb1, *nb0, *nb1;
    g.bprep(cur, cb0, cb1);
    if (has_next) g.bprep(nxt, nb0, nb1); else { nb0 = cb0; nb1 = cb1; }
    {   const char* cB0 = G::bat(cb0, cb1, 0); const char* cB1 = G::bat(cb0, cb1, 1);
        PG8_STAGE(PG8_SB(0, 0), cB0, voffB); PG8_STAGE(PG8_SB(0, 1), cB0 + hstepB, voffB); PG8_STAGE(PG8_SA(0, 0), cA, vc[0]); PG8_STAGE(PG8_SA(0, 1), cA, vc[1]);
        if (wr == 1) PG8_BAR;
        PG8_WAIT_V(2); PG8_BAR;
        PG8_STAGE(PG8_SB(1, 0), cB1, voffB); PG8_STAGE(PG8_SA(1, 0), cA + kstep, vc[0]); PG8_STAGE(PG8_SB(1, 1), cB1 + hstepB, voffB);
        PG8_WAIT_V(6); PG8_BAR; }
    for (;;) {
        const char* nA = has_next ? g.a_base(nxt) : cA;
        for (int t = 0; t < nt; t += 2) {
            const bool last = (t == nt - 2);
            const char* a1 = cA + (size_t)(t + 1) * kstep;
            const char* a2 = last ? nA : cA + (size_t)(t + 2) * kstep; const char* a3 = a2 + kstep;
            const char* b2 = last ? G::bat(nb0, nb1, 0) : G::bat(cb0, cb1, t + 2); const char* b3 = last ? G::bat(nb0, nb1, 1) : G::bat(cb0, cb1, t + 3);
            PG8_LDB(B0, 0, 0); PG8_LDB(B1, 0, 1); PG8_SCHED; PG8_LDA(At, 0, 0); PG8_STAGE(PG8_SA(1, 1), a1, vc[1]);
            if (last) { vc[0][0] = vn[0][0]; vc[0][1] = vn[0][1]; vc[1][0] = vn[1][0]; vc[1][1] = vn[1][1]; }
            PG8_WAIT_V(8); PG8_WAIT_L(0); PG8_BAR; PG8_MMA(0, 0, At, B0); PG8_MMA(0, 1, At, B1); PG8_BAR; PG8_SCHED;
            PG8_LDA(At, 0, 1); PG8_STAGE(PG8_SB(0, 0), b2, voffB); PG8_STAGE(PG8_SB(0, 1), b2 + hstepB, voffB); PG8_STAGE(PG8_SA(0, 0), a2, vc[0]);
            PG8_WAIT_V(8); PG8_WAIT_L(0); PG8_BAR; PG8_MMA(1, 0, At, B0); PG8_MMA(1, 1, At, B1); PG8_BAR; PG8_SCHED;
            PG8_LDB(B0, 1, 0); PG8_LDB(B1, 1, 1); PG8_SCHED; PG8_LDA(At, 1, 0); PG8_STAGE(PG8_SA(0, 1), a2, vc[1]);
            PG8_WAIT_V(8); PG8_WAIT_L(0); PG8_BAR; PG8_MMA(0, 0, At, B0); PG8_MMA(0, 1, At, B1); PG8_BAR; PG8_SCHED;
            PG8_LDA(At, 1, 1); PG8_STAGE(PG8_SB(1, 0), b3, voffB); PG8_STAGE(PG8_SB(1, 1), b3 + hstepB, voffB); PG8_STAGE(PG8_SA(1, 0), a3, vc[0]);
            PG8_WAIT_V(8); PG8_WAIT_L(0); PG8_BAR; PG8_MMA(1, 0, At, B0); PG8_MMA(1, 1, At, B1); PG8_BAR; PG8_SCHED;
        }
        if (wr == 0) PG8_BAR;
        E(acc, cur, wr, wc, fr, fq);
        if (!has_next) break;
#pragma unroll
        for (int a = 0; a < 2; ++a)
#pragma unroll
            for (int b = 0; b < 2; ++b)
#pragma unroll
                for (int m = 0; m < 4; ++m)
#pragma unroll
                    for (int n = 0; n < 2; ++n) acc[a][b][m][n] = (f32x4){0.f, 0.f, 0.f, 0.f};
        cur = nxt; cA = nA; cb0 = nb0; cb1 = nb1; ++ui;
        has_next = S.next(ui + 1, nxt);
        if (has_next) { PG8_RC; g.a_voff(nxt, sR, sC, vn); g.bprep(nxt, nb0, nb1); }
        if (wr == 1) PG8_BAR;
    }
    PG8_WAIT_V(0);
    PG8_BAR;
#undef PG8_RC
#undef PG8_SA
#undef PG8_SB
#undef PG8_STAGE
#undef PG8_LDA
#undef PG8_LDB
#undef PG8_MMA
#undef PG8_WAIT_V
#undef PG8_WAIT_L
#undef PG8_BAR
#undef PG8_SCHED
}
}

struct EpiInProj {
    Ctx c;
    __device__ __forceinline__ bool operator()(pg8::f32x4 (&acc)[2][2][4][2], const pg8::Unit& u, int wr, int wc, int fr_, int fq_) const {
        int fr = fr_, fq = fq_; asm volatile("" : "+v"(fr), "+v"(fq));
        const ChunkDesc d = chunk_desc(c, u.pn * 4 + wc);
        if (d.ncols == 0) return false;
        const int row0 = u.pm * 256 + wr * 64 + fr;
        float gn[2][8];
        const float* gp = (d.mode == 1) ? d.gain : c.nsa_q_norm();
        pg8::f32x4 g4[4];
#pragma unroll
        for (int q = 0; q < 4; ++q) g4[q] = *(const pg8::f32x4*)(gp + 32 * (q >> 1) + 8 * fq + 4 * (q & 1));
#pragma unroll
        for (int q = 0; q < 4; ++q) asm volatile("" : "+v"(g4[q]));
#pragma unroll
        for (int bj = 0; bj < 2; ++bj)
#pragma unroll
            for (int i = 0; i < 8; ++i) gn[bj][i] = g4[2 * bj + (i >> 2)][i & 3] * d.qscale;
#pragma unroll
        for (int ai = 0; ai < 2; ++ai)
#pragma unroll
            for (int m = 0; m < 4; ++m) {
                const size_t row = (size_t)(row0 + ai * 128 + m * 16);
                float v[2][8];
#pragma unroll
                for (int bj = 0; bj < 2; ++bj)
#pragma unroll
                    for (int n = 0; n < 2; ++n)
#pragma unroll
                        for (int i = 0; i < 4; ++i) v[bj][4 * n + i] = acc[ai][bj][m][n][i];
                if (d.mode == 1) {
                    float ss = 0.f;
#pragma unroll
                    for (int bj = 0; bj < 2; ++bj)
#pragma unroll
                        for (int i = 0; i < 8; ++i) ss += v[bj][i] * v[bj][i];
                    ss += __shfl_xor(ss, 16); ss += __shfl_xor(ss, 32);
                    const float r = rsqrtf(ss * (1.f / 64.f) + RMS_EPS);
#pragma unroll
                    for (int bj = 0; bj < 2; ++bj)
#pragma unroll
                        for (int i = 0; i < 8; ++i) v[bj][i] = v[bj][i] * r * gn[bj][i];
                } else if (d.mode == 2) {
#pragma unroll
                    for (int bj = 0; bj < 2; ++bj)
#pragma unroll
                        for (int i = 0; i < 8; ++i) v[bj][i] = sigmoidf_(v[bj][i]);
                }
                if (d.dstf) {
                    if (fq < 3) { float4* p = (float4*)(d.dstf + row * 24 + 8 * fq); p[0] = make_float4(v[0][0], v[0][1], v[0][2], v[0][3]); p[1] = make_float4(v[0][4], v[0][5], v[0][6], v[0][7]); }
                } else {
#pragma unroll
                    for (int bj = 0; bj < 2; ++bj) { pg8::u32x4 w; w.x = pg8::cvt_pk_bf16(v[bj][0], v[bj][1]); w.y = pg8::cvt_pk_bf16(v[bj][2], v[bj][3]); w.z = pg8::cvt_pk_bf16(v[bj][4], v[bj][5]); w.w = pg8::cvt_pk_bf16(v[bj][6], v[bj][7]);
                        if (d.img == 0) *(pg8::u32x4*)(d.dst + row * d.pitch + d.dcol + 32 * bj + 8 * fq) = w;
                        else { const int bb = (int)(row >> 11), sq = (int)(row & 2047), key = sq & 63;
                            const size_t tb = (size_t)bb * d.bstride + (size_t)(sq >> 6) * d.tile_bytes;
                            const size_t off = (d.img == 1) ? tb + (size_t)(d.c0 + 4 * bj + fq) * 1024 + key * 16 : tb + (size_t)(d.c0 + bj) * 4096 + (key >> 4) * 1024 + (key & 15) * 64 + fq * 16;
                            *(pg8::u32x4*)((unsigned char*)d.dst + off) = w; } }
                }
            }
        return false;
    }
};
struct EpiMerge {
    bf16* Y; const bf16* GM;
    __device__ __forceinline__ bool operator()(pg8::f32x4 (&acc)[2][2][4][2], const pg8::Unit& u, int wr, int wc, int fr_, int fq_) const {
        int fr = fr_, fq = fq_; asm volatile("" : "+v"(fr), "+v"(fq));
        const int row0 = u.pm * 256 + wr * 64 + fr, col0 = u.pn * 256 + wc * 32 + 8 * fq;
#pragma unroll
        for (int ai = 0; ai < 2; ++ai)
#pragma unroll
            for (int m = 0; m < 4; ++m) {
                const size_t row = (size_t)(row0 + ai * 128 + m * 16);
#pragma unroll
                for (int bj = 0; bj < 2; ++bj) {
                    const int col = col0 + bj * 128;
                    const uint4 g1 = *(const uint4*)(GM + row * 2048 + 1024 + col);
                    float q1[8] = {LO16(g1.x), HI16(g1.x), LO16(g1.y), HI16(g1.y), LO16(g1.z), HI16(g1.z), LO16(g1.w), HI16(g1.w)};
                    if (u.z == 0) {
                        const uint4 g0 = *(const uint4*)(GM + row * 2048 + col);
                        const float q0[8] = {LO16(g0.x), HI16(g0.x), LO16(g0.y), HI16(g0.y), LO16(g0.z), HI16(g0.z), LO16(g0.w), HI16(g0.w)};
#pragma unroll
                        for (int n = 0; n < 2; ++n)
#pragma unroll
                            for (int i = 0; i < 4; ++i) acc[ai][bj][m][n][i] *= q0[4 * n + i] * __builtin_amdgcn_rcpf(fmaxf(q1[4 * n + i], 1e-30f));
                    } else {
                        float v[8];
#pragma unroll
                        for (int n = 0; n < 2; ++n)
#pragma unroll
                            for (int i = 0; i < 4; ++i) v[4 * n + i] = acc[ai][bj][m][n][i] * fmaxf(q1[4 * n + i], 1e-30f);
                        uint4 w; w.x = pg8::cvt_pk_bf16(v[0], v[1]); w.y = pg8::cvt_pk_bf16(v[2], v[3]); w.z = pg8::cvt_pk_bf16(v[4], v[5]); w.w = pg8::cvt_pk_bf16(v[6], v[7]);
                        *(uint4*)(Y + row * 1024 + col) = w;
                    }
                }
            }
        return u.z == 0;
    }
};
struct EpiResid {
    const float* X; bf16* O;
    __device__ __forceinline__ bool operator()(pg8::f32x4 (&acc)[2][2][4][2], const pg8::Unit& u, int wr, int wc, int fr_, int fq_) const {
        int fr = fr_, fq = fq_; asm volatile("" : "+v"(fr), "+v"(fq));
        const int row0 = u.pm * 256 + wr * 64 + fr, col0 = u.pn * 256 + wc * 32 + 8 * fq;
#pragma unroll
        for (int ai = 0; ai < 2; ++ai)
#pragma unroll
            for (int m = 0; m < 4; ++m) {
                const size_t row = (size_t)(row0 + ai * 128 + m * 16);
#pragma unroll
                for (int bj = 0; bj < 2; ++bj) { const size_t off = row * 1024 + col0 + bj * 128;
                    const float4 x0 = *(const float4*)(X + off), x1 = *(const float4*)(X + off + 4); const pg8::f32x4 a0 = acc[ai][bj][m][0], a1 = acc[ai][bj][m][1];
                    uint4 w; w.x = pk2bf(x0.x + a0[0], x0.y + a0[1]); w.y = pk2bf(x0.z + a0[2], x0.w + a0[3]); w.z = pk2bf(x1.x + a1[0], x1.y + a1[1]); w.w = pk2bf(x1.z + a1[2], x1.w + a1[3]);
                    *(uint4*)(O + off) = w; }
            }
        return false;
    }
};

struct EpiF32 {
    float* O; int ldc;
    __device__ __forceinline__ bool operator()(pg8::f32x4 (&acc)[2][2][4][2], const pg8::Unit& u, int wr, int wc, int fr_, int fq_) const {
        int fr = fr_, fq = fq_; asm volatile("" : "+v"(fr), "+v"(fq));
        const int row0 = u.pm * 256 + wr * 64 + fr, col0 = u.pn * 256 + wc * 32 + 8 * fq;
#pragma unroll
        for (int ai = 0; ai < 2; ++ai)
#pragma unroll
            for (int m = 0; m < 4; ++m)
#pragma unroll
                for (int bj = 0; bj < 2; ++bj)
#pragma unroll
                    for (int n = 0; n < 2; ++n) { const pg8::f32x4 a = acc[ai][bj][m][n];
                        *(float4*)(O + (size_t)(row0 + ai * 128 + m * 16) * ldc + col0 + bj * 128 + 4 * n) = make_float4(a[0], a[1], a[2], a[3]); }
        return false;
    }
};
struct SchedCmp { int c;
    __device__ __forceinline__ bool next(int i, pg8::Unit& u) const { if (i > 0 || c >= 32) return false; u.pm = c >> 1; u.pn = c & 1; u.z = c >> 4; return true; } };

__device__ __forceinline__ float4 posb_sum(const float* p) { float4 a = *(const float4*)p;
#pragma unroll
    for (int sl = 1; sl < 8; ++sl) { const float4 b = *(const float4*)(p + sl * 512); a.x += b.x; a.y += b.y; a.z += b.z; a.w += b.w; }
    return a; }

__device__ __forceinline__ void tr_item(const float* src, int ldn, int k0, int n0, int nvalid, bf16* dst, int ldk, int r0, LAS float* scr, int lane, const float* kgain = nullptr) {
    const int nn = lane & 31;
    float tv[32];
#pragma unroll
    for (int i = 0; i < 32; ++i) { const int kk = 2 * i + (lane >> 5); tv[i] = (nn < nvalid) ? __builtin_nontemporal_load(src + (size_t)(k0 + kk) * ldn + n0 + nn) : 0.f; }
#pragma unroll
    for (int i = 0; i < 32; ++i) { const int kk = 2 * i + (lane >> 5); scr[kk * 33 + nn] = kgain ? tv[i] * kgain[k0 + kk] : tv[i]; }
    asm volatile("s_waitcnt lgkmcnt(0)" ::: "memory");
    const int cch = lane & 7;
#pragma unroll
    for (int j = 0; j < 4; ++j) { const int n = (lane >> 3) + 8 * j; const LAS float* sp = scr + (8 * cch) * 33 + n;
        uint4 o; o.x = pg8::cvt_pk_bf16(sp[0 * 33], sp[1 * 33]); o.y = pg8::cvt_pk_bf16(sp[2 * 33], sp[3 * 33]); o.z = pg8::cvt_pk_bf16(sp[4 * 33], sp[5 * 33]); o.w = pg8::cvt_pk_bf16(sp[6 * 33], sp[7 * 33]);
        *(uint4*)(dst + (size_t)(r0 + n) * ldk + k0 + 8 * cch) = o; }
    asm volatile("s_waitcnt lgkmcnt(0)" ::: "memory");
}


namespace att {
typedef short bf16x8 __attribute__((ext_vector_type(8)));
typedef short s16x4 __attribute__((ext_vector_type(4)));
typedef short v4i16_t __attribute__((ext_vector_type(4)));
typedef float f32x16 __attribute__((ext_vector_type(16)));
typedef unsigned u32x4 __attribute__((ext_vector_type(4)));
typedef float f32x4v __attribute__((ext_vector_type(4)));
constexpr float C2 = 0.125f * 1.4426950408889634f;
constexpr float LOG2E = 1.4426950408889634f;
constexpr float NEGB = -1e30f, MFLOOR = -1e4f;
__device__ __forceinline__ int crow(int r, int hi) { return (r & 3) + 8 * (r >> 2) + 4 * hi; }
__device__ __forceinline__ s16x4 vtr(const LAS char* p) { return __builtin_bit_cast(s16x4, __builtin_amdgcn_ds_read_tr16_b64_v4i16((LAS v4i16_t*)p)); }
typedef float f32x2_t __attribute__((ext_vector_type(2))); typedef __bf16 bf16x2_t __attribute__((ext_vector_type(2)));
__device__ __forceinline__ unsigned cvtpk(float lo, float hi) { const f32x2_t v = {lo, hi}; const bf16x2_t b = __builtin_convertvector(v, bf16x2_t); return __builtin_bit_cast(unsigned, b); }
#define ATT_WAIT_BAR() asm volatile("s_waitcnt vmcnt(0) lgkmcnt(0)\n\ts_barrier" ::: "memory")

template <int NKB> __device__ __forceinline__ void stage_img(LAS unsigned char* dst, const unsigned char* src, int wid, int lane) {
#pragma unroll
    for (int c = 0; c < (NKB + 7) / 8; ++c) { const int pc = wid + 8 * c;
        if (NKB % 8 == 0 || pc < NKB) __builtin_amdgcn_global_load_lds((const unsigned*)(src + pc * 1024 + lane * 16), (LAS unsigned*)(dst + pc * 1024), 16, 0, 0); }
}
__device__ __forceinline__ void qk_tile(f32x16& p0, f32x16& p1, const LAS unsigned char* kt, int ch0, const bf16x8 (&qf)[4], int r32, int hi) {
    const LAS unsigned char* kb = kt + (ch0 + hi) * 1024 + r32 * 16;
    p0 = (f32x16){0.f, 0.f, 0.f, 0.f, 0.f, 0.f, 0.f, 0.f, 0.f, 0.f, 0.f, 0.f, 0.f, 0.f, 0.f, 0.f}; p1 = p0;
#pragma unroll
    for (int d0 = 0; d0 < 4; ++d0) {
        const bf16x8 a0 = *(const LAS bf16x8*)(kb + d0 * 2048), a1 = *(const LAS bf16x8*)(kb + d0 * 2048 + 512);
        p0 = __builtin_amdgcn_mfma_f32_32x32x16_bf16(a0, qf[d0], p0, 0, 0, 0);
        p1 = __builtin_amdgcn_mfma_f32_32x32x16_bf16(a1, qf[d0], p1, 0, 0, 0);
    }
}
template <int EB> __device__ __forceinline__ void pv_tile(f32x16 (&o)[EB], const LAS unsigned char* vt, const f32x16& p0, const f32x16& p1, int lane) {
    const int hi = lane >> 5;
    const LAS char* vb = (const LAS char*)vt + ((lane >> 4) & 1) * 32 + (lane & 3) * 8 + (4 * hi + ((lane & 15) >> 2)) * 64;
#pragma unroll
    for (int ks = 0; ks < 4; ++ks) {
        s16x4 lo[EB], hh[EB];
#pragma unroll
        for (int eb = 0; eb < EB; ++eb) { lo[eb] = vtr(vb + eb * 4096 + ks * 1024); hh[eb] = vtr(vb + eb * 4096 + ks * 1024 + 512); }
        const f32x16& p = (ks < 2) ? p0 : p1; const int rb = (ks & 1) * 8;
        const u32x4 w = (u32x4){cvtpk(p[rb + 0], p[rb + 1]), cvtpk(p[rb + 2], p[rb + 3]), cvtpk(p[rb + 4], p[rb + 5]), cvtpk(p[rb + 6], p[rb + 7])};
        const bf16x8 pa = __builtin_bit_cast(bf16x8, w);
#pragma unroll
        for (int eb = 0; eb < EB; ++eb) {
            const bf16x8 vf = (bf16x8){lo[eb][0], lo[eb][1], lo[eb][2], lo[eb][3], hh[eb][0], hh[eb][1], hh[eb][2], hh[eb][3]};
            o[eb] = __builtin_amdgcn_mfma_f32_32x32x16_bf16(pa, vf, o[eb], 0, 0, 0);
        }
    }
}
template <bool BIAS, bool CAUSAL, bool BAND> __device__ __forceinline__ void bias_mask(f32x16& p0, f32x16& p1, const LAS float* bl, int qabs, int kt0, int hi) {
#pragma unroll
    for (int r = 0; r < 16; ++r) {
        const int d0 = qabs - (kt0 + crow(r, hi)), d1 = d0 - 32;
        if (BIAS) { p0[r] += bl[d0 < 0 ? 0 : (d0 > 255 ? 255 : d0)]; p1[r] += bl[d1 < 0 ? 0 : (d1 > 255 ? 255 : d1)]; }
        if (CAUSAL) { if (d0 < 0) p0[r] = NEGB; if (d1 < 0) p1[r] = NEGB; }
        if (BAND) { if (d0 >= 512) p0[r] = NEGB; if (d1 >= 512) p1[r] = NEGB; }
    }
}
__device__ __forceinline__ void bias_vec(f32x16& p0, f32x16& p1, const LAS float* rt, int e0, int hi) {
    const int a = (-e0) & 3;
    const LAS float* bp = rt + a * 320 + (208 - e0 - a) + 4 * hi;
#pragma unroll
    for (int g4 = 0; g4 < 4; ++g4) { const f32x4v v0 = *(const LAS f32x4v*)(bp + 8 * g4), v1 = *(const LAS f32x4v*)(bp + 8 * g4 + 32);
        p0[4 * g4] += v0[0]; p0[4 * g4 + 1] += v0[1]; p0[4 * g4 + 2] += v0[2]; p0[4 * g4 + 3] += v0[3];
        p1[4 * g4] += v1[0]; p1[4 * g4 + 1] += v1[1]; p1[4 * g4 + 2] += v1[2]; p1[4 * g4 + 3] += v1[3]; }
}
constexpr float THR = 8.f;
__device__ __forceinline__ float max3f(float a, float b, float c) { return fmaxf(fmaxf(a, b), c); }
template <int EB> __device__ __forceinline__ void softmax_step(f32x16& p0, f32x16& p1, float& m, float& l, f32x16 (&o)[EB], LAS float* wsf, int r32, int hi) {
    if (__any(m != 0.f)) {
#pragma unroll
        for (int r = 0; r < 16; ++r) { p0[r] -= m; p1[r] -= m; }
    }
    float ra = max3f(p0[0], p0[1], p1[0]), rb2 = max3f(p0[2], p0[3], p1[1]); ra = max3f(ra, p1[2], p1[3]);
#pragma unroll
    for (int r = 4; r < 16; r += 4) { ra = max3f(ra, p0[r], p0[r + 1]); rb2 = max3f(rb2, p0[r + 2], p0[r + 3]); ra = max3f(ra, p1[r], p1[r + 1]); rb2 = max3f(rb2, p1[r + 2], p1[r + 3]); }
    float rm = fmaxf(ra, rb2);
    if (__any(rm > THR)) {
        rm = fmaxf(rm, __shfl_xor(rm, 32));
        const float dl = rm > THR ? rm : 0.f;
        const float al = __builtin_amdgcn_exp2f(-dl);
        m += dl; l *= al;
#pragma unroll
        for (int r = 0; r < 16; ++r) { p0[r] -= dl; p1[r] -= dl; }
        if (hi == 0) wsf[r32] = al;
#pragma unroll
        for (int g = 0; g < 4; ++g) { const f32x4v a4 = *(const LAS f32x4v*)(wsf + 8 * g + 4 * hi);
#pragma unroll
            for (int eb = 0; eb < EB; ++eb) { o[eb][4 * g + 0] *= a4.x; o[eb][4 * g + 1] *= a4.y; o[eb][4 * g + 2] *= a4.z; o[eb][4 * g + 3] *= a4.w; } }
    }
    float s0 = 0.f, s1 = 0.f;
#pragma unroll
    for (int r = 0; r < 16; ++r) { p0[r] = __builtin_amdgcn_exp2f(p0[r]); p1[r] = __builtin_amdgcn_exp2f(p1[r]); s0 += p0[r]; s1 += p1[r]; }
    l += s0 + s1;
}
template <int EB> __device__ __forceinline__ void scale_rows(f32x16 (&o)[EB], float f, LAS float* wsf, int r32, int hi) {
    if (hi == 0) wsf[r32] = f;
#pragma unroll
    for (int g = 0; g < 4; ++g) { const f32x4v a4 = *(const LAS f32x4v*)(wsf + 8 * g + 4 * hi);
#pragma unroll
        for (int eb = 0; eb < EB; ++eb) { o[eb][4 * g + 0] *= a4.x; o[eb][4 * g + 1] *= a4.y; o[eb][4 * g + 2] *= a4.z; o[eb][4 * g + 3] *= a4.w; } }
}

struct DiffArgs { const bf16 *Q, *K, *V; bf16* O; const float* biasv; const float* out_gain; float lam; };
__device__ __forceinline__ void diff_unit(LAS unsigned char* lds, const DiffArgs& A, int b, int h, int qt) {
    int tid_ = threadIdx.x; asm volatile("" : "+v"(tid_));
    const int tid = tid_, lane = tid & 63, r32 = lane & 31, hi = lane >> 5, wid = __builtin_amdgcn_readfirstlane(tid >> 6);
    const int cs = wid >> 2, wq = wid & 3, q0 = qt * 128, qw0 = q0 + wq * 32, qabs = qw0 + r32;
    LAS float* bl = (LAS float*)(lds + 81920);
    LAS float* wsf = (LAS float*)(lds + 83968) + wid * 64;
    const size_t rowb = (size_t)b * S;
    LAS float* rt = (LAS float*)(lds + 86016);
    for (int i = tid; i < 1280; i += 512) rt[i] = A.biasv[(8 + h) * 1280 + i];
    const unsigned char* Kh = (const unsigned char*)A.K + (size_t)(b * 4 + h) * 32 * 16384; const unsigned char* Vh = (const unsigned char*)A.V + (size_t)(b * 4 + h) * 32 * 16384;
    const int NT = (q0 + 128) / 64;
    stage_img<16>(lds, Kh, wid, lane); stage_img<16>(lds + 49152, Vh, wid, lane);
    stage_img<16>(lds + 16384, Kh + 16384, wid, lane);
    bf16x8 qf[4];
    { const bf16* qp = A.Q + (rowb + qabs) * 512 + h * 128 + cs * 64 + hi * 8;
#pragma unroll
      for (int d0 = 0; d0 < 4; ++d0) qf[d0] = *(const bf16x8*)(qp + d0 * 16); }
    f32x16 o[4];
#pragma unroll
    for (int eb = 0; eb < 4; ++eb) o[eb] = (f32x16){0.f, 0.f, 0.f, 0.f, 0.f, 0.f, 0.f, 0.f, 0.f, 0.f, 0.f, 0.f, 0.f, 0.f, 0.f, 0.f};
    float m = 0.f, l = 0.f;
    ATT_WAIT_BAR();
    if (wid >= 4) __builtin_amdgcn_s_setprio(1);
    f32x16 n0, n1;
    qk_tile(n0, n1, lds, cs * 8, qf, r32, hi);
    int kb_cur = 0, kb_nxt = 16384, kb_fre = 32768;
    for (int t = 0; t < NT; ++t) {
        if (t + 2 < NT) stage_img<16>(lds + kb_fre, Kh + (size_t)(t + 2) * 16384, wid, lane);
        if (t + 1 < NT) stage_img<16>(lds + 49152 + ((t + 1) & 1) * 16384, Vh + (size_t)(t + 1) * 16384, wid, lane);
        const int kt0 = t * 64;
        if (kt0 <= qw0 + 31) {
            f32x16 p0 = n0, p1 = n1;
            if (t + 1 < NT && kt0 + 64 <= qw0 + 31) qk_tile(n0, n1, lds + kb_nxt, cs * 8, qf, r32, hi);
            const bool causal = (kt0 + 63 > qw0), near_ = (qw0 - (kt0 + 63) < 113);
            if (causal || near_) bias_vec(p0, p1, rt, qabs - kt0, hi);
            softmax_step<4>(p0, p1, m, l, o, wsf, r32, hi);
            pv_tile<4>(o, lds + 49152 + (t & 1) * 16384, p0, p1, lane);
        }
        ATT_WAIT_BAR();
        { const int tmp = kb_cur; kb_cur = kb_nxt; kb_nxt = kb_fre; kb_fre = tmp; }
    }
    __builtin_amdgcn_s_setprio(0);
    l += __shfl_xor(l, 32);
    scale_rows<4>(o, (cs ? A.lam : 1.f) / l, wsf, r32, hi);
    LAS float* xch = (LAS float*)lds + (size_t)wq * 4096;
    if (cs == 1) {
#pragma unroll
        for (int eb = 0; eb < 4; ++eb)
#pragma unroll
            for (int r = 0; r < 16; ++r) xch[crow(r, hi) * 128 + eb * 32 + r32] = o[eb][r];
    }
    ATT_WAIT_BAR();
    if (cs == 0) {
        float ss[16];
#pragma unroll
        for (int r = 0; r < 16; ++r) ss[r] = 0.f;
#pragma unroll
        for (int eb = 0; eb < 4; ++eb)
#pragma unroll
            for (int r = 0; r < 16; ++r) { o[eb][r] -= xch[crow(r, hi) * 128 + eb * 32 + r32]; ss[r] += o[eb][r] * o[eb][r]; }
#pragma unroll
        for (int r = 0; r < 16; ++r) {
#pragma unroll
            for (int sft = 1; sft < 32; sft <<= 1) ss[r] += __shfl_xor(ss[r], sft);
            ss[r] = rsqrtf(ss[r] * (1.f / 128.f) + RMS_EPS) * (1.f - LAMBDA_INIT);
        }
        int hi_ = hi, r32_ = r32; asm volatile("" : "+v"(hi_), "+v"(r32_));
        bf16* op = A.O + (rowb + qw0 + 4 * hi_) * 512 + h * 128 + r32_;
#pragma unroll
        for (int eb = 0; eb < 4; ++eb) { const float gn = A.out_gain[eb * 32 + r32_];
#pragma unroll
            for (int r = 0; r < 16; ++r) op[(size_t)((r & 3) + 8 * (r >> 2)) * 512 + eb * 32] = f2bf(o[eb][r] * ss[r] * gn); }
    }
    ATT_WAIT_BAR();
}

struct NsaArgs { const bf16 *Q, *KS, *VS, *KW, *VW, *KC, *VC; const float* GN; bf16* O; const float* rel_bias; const float* biasv; };
__device__ __forceinline__ void imp_tile(const f32x16& p, int gbase, LAS float* ip, float inv, int hi, float& prevR) {
    float Av[4], Rv[4];
#pragma unroll
    for (int gq = 0; gq < 4; ++gq) { const float c3 = 0.5f * p[4 * gq + 3]; Av[gq] = p[4 * gq] + p[4 * gq + 1] + p[4 * gq + 2] + c3; Rv[gq] = __shfl_xor(c3, 32); }
#pragma unroll
    for (int gq = 0; gq < 4; ++gq) { const float add = hi ? Rv[gq] : (gq > 0 ? Rv[gq > 0 ? gq - 1 : 0] : prevR); ip[2 * (gbase + gq)] = (Av[gq] + add) * inv; }
    prevR = Rv[3];
}

__device__ __forceinline__ int cmp_class(int qw0, int n0) { return (16 * n0 > qw0) ? 2 : ((qw0 - 16 * (n0 + 31) - 31 >= 113) ? 0 : 1); }
__device__ __forceinline__ void cmp_bm1(f32x16& p, const LAS float* bl, int qabs, int n0, int hi) {
#pragma unroll
    for (int r = 0; r < 16; ++r) { const int d = qabs - 16 * (n0 + crow(r, hi)) - 31; p[r] += bl[d < 0 ? 0 : (d > 255 ? 255 : d)]; if (d < 0) p[r] = NEGB; }
}
__device__ __forceinline__ void cmp_pass(LAS unsigned char* lds, const bf16x8 (&qf)[4], const LAS float* bl, LAS float* ip, bool need_sel, float mref, int qw0, int qabs,
                                         int lane, int r32, int hi, f32x16 (&o)[2], float& l, float& rmax) {
    l = 0.f; rmax = NEGB; float prevR = 0.f;
    o[0] = (f32x16){0.f, 0.f, 0.f, 0.f, 0.f, 0.f, 0.f, 0.f, 0.f, 0.f, 0.f, 0.f, 0.f, 0.f, 0.f, 0.f}; o[1] = o[0];
#pragma unroll
    for (int tl = 0; tl < 2; ++tl) {
        const int c0 = cmp_class(qw0, 64 * tl), c1 = cmp_class(qw0, 64 * tl + 32);
        if (c0 == 2) {
            if (need_sel) {
#pragma unroll
                for (int gq = 0; gq < 8; ++gq) ip[2 * (8 * tl + gq)] = (gq == 0 && hi == 0) ? prevR : 0.f; }
            prevR = 0.f;
        } else {
            f32x16 p0, p1;
            qk_tile(p0, p1, lds + tl * 16384, 0, qf, r32, hi);
            if (c0 == 1) cmp_bm1(p0, bl, qabs, 64 * tl, hi);
            if (c1 == 1) cmp_bm1(p1, bl, qabs, 64 * tl + 32, hi);
            else if (c1 == 2) { p1 = (f32x16){NEGB, NEGB, NEGB, NEGB, NEGB, NEGB, NEGB, NEGB, NEGB, NEGB, NEGB, NEGB, NEGB, NEGB, NEGB, NEGB}; }
            float ra = max3f(p0[0], p0[1], p1[0]), rb2 = max3f(p0[2], p0[3], p1[1]); ra = max3f(ra, p1[2], p1[3]);
#pragma unroll
            for (int r = 4; r < 16; r += 4) { ra = max3f(ra, p0[r], p0[r + 1]); rb2 = max3f(rb2, p0[r + 2], p0[r + 3]); ra = max3f(ra, p1[r], p1[r + 1]); rb2 = max3f(rb2, p1[r + 2], p1[r + 3]); }
            rmax = max3f(rmax, ra, rb2);
            float s0 = 0.f, s1 = 0.f;
#pragma unroll
            for (int r = 0; r < 16; ++r) { p0[r] = __builtin_amdgcn_exp2f(p0[r] - mref); p1[r] = __builtin_amdgcn_exp2f(p1[r] - mref); s0 += p0[r]; s1 += p1[r]; }
            l += s0 + s1;
            if (need_sel) { imp_tile(p0, 8 * tl, ip, 1.f, hi, prevR); imp_tile(p1, 8 * tl + 4, ip, 1.f, hi, prevR); }
            pv_tile<2>(o, lds + tl * 16384 + 8192, p0, p1, lane);
        }
    }
}
__device__ __forceinline__ void nsa_unit(LAS unsigned char* lds, const NsaArgs& A, int b, int g, int qt) {
    int tid_ = threadIdx.x; asm volatile("" : "+v"(tid_));
    const int tid = tid_, wid = __builtin_amdgcn_readfirstlane(tid >> 6);
    int lane = tid & 63, r32 = lane & 31, hi = lane >> 5;
#define NSA_RELANE() do { asm volatile("" : "+v"(lane)); r32 = lane & 31; hi = lane >> 5; qabs = qw0 + r32; } while (0)
    const int hh = wid >> 1, head = g * 4 + hh, q0 = qt * 64, qw0 = q0 + (wid & 1) * 32; int qabs = qw0 + r32;
    LAS float* bl = (LAS float*)(lds + 32768) + hh * 256;
    LAS float* wsf = (LAS float*)(lds + 36864) + wid * 64;
    LAS float* ipart = (LAS float*)(lds + 40960);
    LAS float* itot = (LAS float*)(lds + 73728);
    LAS unsigned* sell = (LAS unsigned*)(lds + 81920);
    LAS float* invs = (LAS float*)(lds + 82176);
    LAS f32x16* otl = (LAS f32x16*)(lds + 86016) + (size_t)wid * 128 + lane;
    const size_t rowb = (size_t)b * S;
    for (int i = tid; i < 1024; i += 512) ((LAS float*)(lds + 32768))[i] = A.rel_bias[g * 1024 + i];
    { const unsigned char* Kc = (const unsigned char*)A.KC + (size_t)(b * 2 + g) * 16384; const unsigned char* Vc = (const unsigned char*)A.VC + (size_t)(b * 2 + g) * 16384;
      stage_img<8>(lds, Kc, wid, lane); stage_img<8>(lds + 8192, Vc, wid, lane);
      stage_img<8>(lds + 16384, Kc + 8192, wid, lane); stage_img<8>(lds + 24576, Vc + 8192, wid, lane); }
    bf16x8 qf[4];
    { const bf16* qp = A.Q + (rowb + qabs) * 512 + head * 64 + hi * 8;
#pragma unroll
      for (int d0 = 0; d0 < 4; ++d0) qf[d0] = *(const bf16x8*)(qp + d0 * 16); }
    ATT_WAIT_BAR();
    const bool need_sel = (qt >= 16);
    {
        NSA_RELANE();
        LAS float* ip = ipart + ((size_t)hh * 64 + (wid & 1) * 32 + r32) * 32 + hi;
        f32x16 o[2]; float l, rmax;
        cmp_pass(lds, qf, bl, ip, need_sel, 0.f, qw0, qabs, lane, r32, hi, o, l, rmax);
        if (__any(rmax > 64.f)) {
            rmax = fmaxf(rmax, __shfl_xor(rmax, 32));
            float dummy;
            cmp_pass(lds, qf, bl, ip, need_sel, fmaxf(rmax, 0.f), qw0, qabs, lane, r32, hi, o, l, dummy);
        }
        l += __shfl_xor(l, 32);
        const float inv = l > 0.f ? 1.f / l : 0.f;
        if (hi == 0) invs[hh * 64 + (wid & 1) * 32 + r32] = inv;
        { int qa = qabs; asm volatile("" : "+v"(qa)); scale_rows<2>(o, A.GN[(rowb + qa) * 24 + head] * inv, wsf, r32, hi); }
        otl[0] = o[0]; otl[64] = o[1];
    }
    ATT_WAIT_BAR();
    unsigned selq, un;
    if (need_sel) {
        {
            const int q = tid >> 3, j4 = (tid & 7) * 4;
#pragma unroll
            for (int jj = 0; jj < 4; ++jj) { const int j = j4 + jj; itot[q * 32 + j] = ((ipart[(0 * 64 + q) * 32 + j] * invs[q] + ipart[(1 * 64 + q) * 32 + j] * invs[64 + q]) + ipart[(2 * 64 + q) * 32 + j] * invs[128 + q]) + ipart[(3 * 64 + q) * 32 + j] * invs[192 + q]; }
        }
        ATT_WAIT_BAR();
        {
            const int j = lane & 31;
#pragma unroll 1
            for (int rd = 0; rd < 4; ++rd) {
                const int q = wid * 8 + rd * 2 + hi;
                const bool vj = j <= qt, fj = (j == 0) || (j == qt) || (j == qt - 1);
                const float sj = vj ? itot[q * 32 + j] + (fj ? 1e4f : 0.f) : -1e30f;
                int cnt = 0;
#pragma unroll 4
                for (int k = 0; k < 32; ++k) {
                    const bool vk = k <= qt, fk = (k == 0) || (k == qt) || (k == qt - 1);
                    const float sk = vk ? itot[q * 32 + k] + (fk ? 1e4f : 0.f) : -1e30f;
                    cnt += (sk > sj || (sk == sj && k < j)) ? 1 : 0;
                }
                const unsigned long long bal = __ballot(cnt < 16);
                if (lane == 0) sell[q] = (unsigned)bal;
                if (lane == 32) sell[q] = (unsigned)(bal >> 32);
            }
        }
        ATT_WAIT_BAR();
        NSA_RELANE();
        selq = sell[(wid & 1) * 32 + r32];
        un = sell[lane];
#pragma unroll
        for (int sft = 1; sft < 64; sft <<= 1) un |= __shfl_xor(un, sft);
        un = __builtin_amdgcn_readfirstlane(un) & (qt >= 31 ? 0xffffffffu : ((2u << qt) - 1u));
    } else {
        selq = (2u << qt) - 1u; un = selq;
    }
    for (int i = tid; i < 5120; i += 512) ipart[i] = A.biasv[(size_t)g * 5120 + i];
    const LAS float* rt = ipart + hh * 1280;
    {
        NSA_RELANE();
        const unsigned char* Kg = (const unsigned char*)A.KS + (size_t)(b * 2 + g) * 32 * 8192; const unsigned char* Vg = (const unsigned char*)A.VS + (size_t)(b * 2 + g) * 32 * 8192;
        f32x16 o[2]; o[0] = (f32x16){0.f, 0.f, 0.f, 0.f, 0.f, 0.f, 0.f, 0.f, 0.f, 0.f, 0.f, 0.f, 0.f, 0.f, 0.f, 0.f}; o[1] = o[0];
        float m = 0.f, l = 0.f;
        unsigned rem = un; int j = __builtin_ctz(rem); rem &= rem - 1u; int it = 0;
        stage_img<8>(lds, Kg + (size_t)j * 8192, wid, lane); stage_img<8>(lds + 8192, Vg + (size_t)j * 8192, wid, lane);
        ATT_WAIT_BAR();
        for (;;) {
            LAS unsigned char* cur = lds + (it & 1) * 16384; LAS unsigned char* nxt = lds + ((it + 1) & 1) * 16384;
            const int jn = rem ? __builtin_ctz(rem) : -1;
            if (jn >= 0) { rem &= rem - 1u; stage_img<8>(nxt, Kg + (size_t)jn * 8192, wid, lane); stage_img<8>(nxt + 8192, Vg + (size_t)jn * 8192, wid, lane); }
            const int kt0 = j * 64;
            if (kt0 <= qw0 + 31 && __any((selq >> j) & 1u)) {
                f32x16 p0, p1;
                qk_tile(p0, p1, cur, 0, qf, r32, hi);
                const bool causal = (kt0 + 63 > qw0), near_ = (qw0 - (kt0 + 63) < 113);
                if (causal || near_) bias_vec(p0, p1, rt, qabs - kt0, hi);
                if (!__all((selq >> j) & 1u)) {
                    const float off = ((selq >> j) & 1u) ? 0.f : NEGB;
#pragma unroll
                    for (int r = 0; r < 16; ++r) { p0[r] += off; p1[r] += off; } }
                softmax_step<2>(p0, p1, m, l, o, wsf, r32, hi);
                pv_tile<2>(o, cur + 8192, p0, p1, lane);
            }
            ATT_WAIT_BAR();
            if (jn < 0) break;
            j = jn; ++it;
        }
        l += __shfl_xor(l, 32);
        { int qa = qabs; asm volatile("" : "+v"(qa)); scale_rows<2>(o, A.GN[(rowb + qa) * 24 + 8 + head] / l, wsf, r32, hi); }
        otl[0] = otl[0] + o[0]; otl[64] = otl[64] + o[1];
    }
    f32x16 ot[2];
    {
        NSA_RELANE();
        const unsigned char* Kg = (const unsigned char*)A.KW + (size_t)(b * 2 + g) * 32 * 8192; const unsigned char* Vg = (const unsigned char*)A.VW + (size_t)(b * 2 + g) * 32 * 8192;
        f32x16 o[2]; o[0] = (f32x16){0.f, 0.f, 0.f, 0.f, 0.f, 0.f, 0.f, 0.f, 0.f, 0.f, 0.f, 0.f, 0.f, 0.f, 0.f, 0.f}; o[1] = o[0];
        float m = 0.f, l = 0.f;
        const int j0 = qt >= 8 ? qt - 8 : 0;
        stage_img<8>(lds, Kg + (size_t)j0 * 8192, wid, lane); stage_img<8>(lds + 8192, Vg + (size_t)j0 * 8192, wid, lane);
        ATT_WAIT_BAR();
        for (int j = j0; j <= qt; ++j) {
            const int it = j - j0;
            LAS unsigned char* cur = lds + (it & 1) * 16384; LAS unsigned char* nxt = lds + ((it + 1) & 1) * 16384;
            if (j < qt) { stage_img<8>(nxt, Kg + (size_t)(j + 1) * 8192, wid, lane); stage_img<8>(nxt + 8192, Vg + (size_t)(j + 1) * 8192, wid, lane); }
            const int kt0 = j * 64;
            if (kt0 <= qw0 + 31) {
                f32x16 p0, p1;
                qk_tile(p0, p1, cur, 0, qf, r32, hi);
                const bool causal = (kt0 + 63 > qw0), near_ = (qw0 - (kt0 + 63) < 113), band = (qw0 + 31 - kt0 >= 512);
                if (causal || near_) bias_vec(p0, p1, rt, qabs - kt0, hi);
                else if (band) bias_mask<false, false, true>(p0, p1, bl, qabs, kt0, hi);
                softmax_step<2>(p0, p1, m, l, o, wsf, r32, hi);
                pv_tile<2>(o, cur + 8192, p0, p1, lane);
            }
            ATT_WAIT_BAR();
        }
        l += __shfl_xor(l, 32);
        { int qa = qabs; asm volatile("" : "+v"(qa)); scale_rows<2>(o, A.GN[(rowb + qa) * 24 + 16 + head] / l, wsf, r32, hi); }
        ot[0] = otl[0] + o[0]; ot[1] = otl[64] + o[1];
    }
    {   int hi_ = hi, r32_ = r32; asm volatile("" : "+v"(hi_), "+v"(r32_));
        bf16* op = A.O + (rowb + qw0 + 4 * hi_) * 512 + head * 64 + r32_;
#pragma unroll
        for (int eb = 0; eb < 2; ++eb)
#pragma unroll
            for (int r = 0; r < 16; ++r) op[(size_t)((r & 3) + 8 * (r >> 2)) * 512 + eb * 32] = f2bf(ot[eb][r]); }
#undef NSA_RELANE
}
}

constexpr int NCLS = 24;
constexpr int CW_CMPD = 10752, CW_FIN = 11008;
constexpr int CW_WQ = 10240;
constexpr int CW_CNT = 8192;
constexpr size_t WS_LIST = 254 * MiB;
constexpr int MISC_OFF = 161792;
constexpr int TAB_OFF = MISC_OFF + 256;
__device__ __forceinline__ void class_experts(int c, int& ea, int& eb) {
    const int g = c / 6, p = c % 6; const int a = p < 3 ? 0 : (p < 5 ? 1 : 2); const int b = p < 3 ? p + 1 : (p < 5 ? p - 1 : 3); ea = g * 4 + a; eb = g * 4 + b; }
__device__ __forceinline__ void moe_build_tab(const unsigned* ctl, LAS int* tab) {
    if (threadIdx.x < 64) {
        const int lane = threadIdx.x;
        const int n = (lane < NCLS) ? (int)__hip_atomic_load(ctl + CW_CNT + 64 * lane, __ATOMIC_RELAXED, __HIP_MEMORY_SCOPE_AGENT) : 0;
        const int nt_ = (n + 255) >> 8;
        int pre = nt_;
#pragma unroll
        for (int o = 1; o < 32; o <<= 1) { const int v = __shfl_up(pre, o); if (lane >= o) pre += v; }
        const int first = pre - nt_;
        if (lane < NCLS) { tab[lane] = first; tab[32 + lane] = n; for (int j = 0; j < nt_; ++j) tab[64 + first + j] = lane; }
        if (lane == NCLS - 1) tab[NCLS] = pre;
    }
    __syncthreads();
}
struct OpsGU { const bf16* H2; const bf16* WGU; const unsigned* LIST; const LAS int* tab; static constexpr int NT = 16, LDB = 1024;
    __device__ __forceinline__ const char* a_base(const pg8::Unit&) const { return (const char*)H2; }
    __device__ __forceinline__ void a_voff(const pg8::Unit& u, const int (&R)[2], const int (&C)[2], unsigned (&out)[2][2]) const {
        const int c = tab[64 + u.pm], n = tab[32 + c], r0 = (u.pm - tab[c]) * 256;
#pragma unroll
        for (int h = 0; h < 2; ++h)
#pragma unroll
            for (int i = 0; i < 2; ++i) { const int r = r0 + h * 128 + R[i]; const unsigned tok = (r < n) ? LIST[(size_t)c * T + r] : 0u; out[h][i] = (tok * 1024u + (unsigned)C[i]) * 2u; } }
    __device__ __forceinline__ void bprep(const pg8::Unit& u, const char*& p0, const char*& p1) const {
        int ea, eb; class_experts(tab[64 + u.pm], ea, eb); const int e = u.z ? eb : ea; p0 = (const char*)(WGU + ((size_t)e * 1024 + u.pn * 256) * 1024); p1 = p0; }
    __device__ static __forceinline__ const char* bat(const char* p0, const char*, int kt) { return p0 + (size_t)kt * 128; } };
constexpr int CW_MQ = 10496;
constexpr int CW_DONE = 12288;
struct SchedGU { const LAS int* tab; int G, vcu;
    __device__ __forceinline__ bool next(int i, pg8::Unit& u) const { const int L = i * G + vcu; if (L >= tab[NCLS] * 8) return false; u.pm = L >> 3; u.z = (L >> 2) & 1; u.pn = L & 3; return true; } };
struct EpiGU { bf16* HID; const unsigned* LIST; const float* ROUTE; const LAS int* tab; unsigned* ctl;
    __device__ __forceinline__ void operator()(const pg8::f32x4 (&acc)[2][2][4][2], const pg8::Unit& u, int wr, int wc, int fr_, int fq_) const {
        int fr = fr_, fq = fq_; asm volatile("" : "+v"(fr), "+v"(fq));
        const int c = tab[64 + u.pm], n = tab[32 + c], r0 = (u.pm - tab[c]) * 256;
        const __amdgpu_buffer_rsrc_t rsrc = __builtin_amdgcn_make_buffer_rsrc((void*)HID, 0, 0x7fffffff, 0x00020000);
#pragma unroll
        for (int ai = 0; ai < 2; ++ai)
#pragma unroll
            for (int m = 0; m < 4; ++m) {
                const int rl = ai * 128 + wr * 64 + m * 16 + fr, r = r0 + rl;
                if (r < n) {
                    const unsigned tok = LIST[(size_t)c * T + r]; const float w = ROUTE[(size_t)tok * 4 + u.z], rs = ROUTE[(size_t)tok * 4 + 3];
                    float v[8];
#pragma unroll
                    for (int nn = 0; nn < 2; ++nn)
#pragma unroll
                        for (int i = 0; i < 4; ++i) { const float gt = acc[ai][0][m][nn][i] * rs, up = acc[ai][1][m][nn][i] * rs; v[4 * nn + i] = gt * __builtin_amdgcn_rcpf(1.f + __builtin_amdgcn_exp2f(-1.4426950408889634f * gt)) * up * w; }
                    uint4 o; o.x = pg8::cvt_pk_bf16(v[0], v[1]); o.y = pg8::cvt_pk_bf16(v[2], v[3]); o.z = pg8::cvt_pk_bf16(v[4], v[5]); o.w = pg8::cvt_pk_bf16(v[6], v[7]);
                    __builtin_amdgcn_raw_buffer_store_b128(__builtin_bit_cast(pg8::u32x4, o), rsrc, (int)(((unsigned)(u.pm * 256 + rl) * 1024u + (unsigned)(u.z * 512 + u.pn * 128 + wc * 32 + 8 * fq)) * 2u), 0, 16);
                }
                asm volatile("" ::: "memory");
            }
        asm volatile("s_waitcnt vmcnt(0)" ::: "memory");
        if (fr == 0 && fq == 0) __hip_atomic_fetch_add(ctl + CW_DONE + 64 * u.pm, 1u, __ATOMIC_RELAXED, __HIP_MEMORY_SCOPE_AGENT);
    }
};
struct OpsDN { const bf16* HID; const bf16* WDN; const LAS int* tab; static constexpr int NT = 16, LDB = 512;
    __device__ __forceinline__ const char* a_base(const pg8::Unit& u) const { return (const char*)(HID + (size_t)u.pm * 256 * 1024); }
    __device__ __forceinline__ void a_voff(const pg8::Unit&, const int (&R)[2], const int (&C)[2], unsigned (&out)[2][2]) const {
#pragma unroll
        for (int h = 0; h < 2; ++h)
#pragma unroll
            for (int i = 0; i < 2; ++i) out[h][i] = (unsigned)((h * 128 + R[i]) * 1024 + C[i]) * 2u; }
    __device__ __forceinline__ void bprep(const pg8::Unit& u, const char*& p0, const char*& p1) const {
        int ea, eb; class_experts(tab[64 + u.pm], ea, eb);
        p0 = (const char*)(WDN + ((size_t)ea * 1024 + u.pn * 256) * 512); p1 = (const char*)(WDN + ((size_t)eb * 1024 + u.pn * 256) * 512); }
    __device__ static __forceinline__ const char* bat(const char* p0, const char* p1, int kt) { return (kt < 8 ? p0 : p1) + (size_t)(kt & 7) * 128; } };
struct SchedDN { const LAS int* tab; unsigned* ctl; int G, vcu, which;
    __device__ __forceinline__ bool next(int i, pg8::Unit& u) const {
        if (i > 0) return false;
        const int total = tab[NCLS] * 4;
        int L = -1;
        if (which == 0) L = vcu; else { const int e = G - 1 - vcu; if (G + e < total) L = G + e; }
        if (L < 0 || L >= total) L = -1;
        __builtin_amdgcn_s_barrier();
        if (threadIdx.x == 0 && L >= 0) {
            unsigned* dn = ctl + CW_DONE + 64 * (L >> 2); unsigned sp = 0;
            while (__hip_atomic_load(dn, __ATOMIC_RELAXED, __HIP_MEMORY_SCOPE_AGENT) < 64u) { __builtin_amdgcn_s_sleep(2); if (++sp > (1u << 22)) { atomicAdd(ctl + XB_TMO + CW_BAR, 1u); break; } }
            __builtin_amdgcn_fence(__ATOMIC_ACQUIRE, "agent");
            asm volatile("s_waitcnt vmcnt(0)" ::: "memory");
        }
        __builtin_amdgcn_s_barrier();
        if (L < 0) return false; u.pm = L >> 2; u.pn = L & 3; u.z = 0; return true; } };
struct EpiDN { float* O; const bf16* X2; const unsigned* LIST; const LAS int* tab;
    __device__ __forceinline__ void operator()(const pg8::f32x4 (&acc)[2][2][4][2], const pg8::Unit& u, int wr, int wc, int fr_, int fq_) const {
        int fr = fr_, fq = fq_; asm volatile("" : "+v"(fr), "+v"(fq));
        const int c = tab[64 + u.pm], n = tab[32 + c], r0 = (u.pm - tab[c]) * 256;
#pragma unroll
        for (int ai = 0; ai < 2; ++ai)
#pragma unroll
            for (int m = 0; m < 4; ++m) {
                const int r = r0 + ai * 128 + wr * 64 + m * 16 + fr;
                if (r < n) {
                    const unsigned tok = LIST[(size_t)c * T + r];
#pragma unroll
                    for (int bj = 0; bj < 2; ++bj) { const size_t off = (size_t)tok * 1024 + u.pn * 256 + bj * 128 + wc * 32 + 8 * fq;
                        const uint4 xw = *(const uint4*)(X2 + off); const pg8::f32x4 a0 = acc[ai][bj][m][0], a1 = acc[ai][bj][m][1];
                        const nt_f32x4 y0 = {LO16(xw.x) + a0[0], HI16(xw.x) + a0[1], LO16(xw.y) + a0[2], HI16(xw.y) + a0[3]}, y1 = {LO16(xw.z) + a1[0], HI16(xw.z) + a1[1], LO16(xw.w) + a1[2], HI16(xw.w) + a1[3]};
                        __builtin_nontemporal_store(y0, (nt_f32x4*)(O + off)); __builtin_nontemporal_store(y1, (nt_f32x4*)(O + off + 4)); }
                }
            }
    }
};

constexpr int NTHR = 512;
constexpr int LDS_BYTES = 163840;

__global__ void __launch_bounds__(NTHR, 2) fwd_kernel(Args args) {
    extern __shared__ __attribute__((aligned(16))) unsigned char lds[];
    const int tid = threadIdx.x, lane = tid & 63;
    const int gtid = blockIdx.x * NTHR + tid, nthreads = gridDim.x * NTHR;
    const int gwave = gtid >> 6, nwaves = nthreads >> 6;
    Ctx c; c.a = args; unsigned char* ws = args.ws;

    volatile LAS unsigned* MISC = (volatile LAS unsigned*)((LAS unsigned char*)lds + MISC_OFF);
    if (tid < 32) MISC[tid] = 0u;
    __syncthreads();
    XcdBarrier bar = xcd_barrier_post((unsigned*)(ws + WS_CTL) + CW_BAR, MISC + 8);
    const int lo = args.ph_lo, hi = args.ph_hi;
#ifdef ONLY_PHASE
#define IN(k) ((k) == ONLY_PHASE)
#else
#define IN(k) (lo <= (k) && (k) < hi)
#endif
#define SEAM(k) do { if (IN(k) && IN((k) + 1)) xcd_barrier(bar); } while (0)


    if (IN(0)) {
        for (int t = gwave * 2; t < T; t += nwaves * 2) {
            const float4* xr = (const float4*)(c.x() + (size_t)t * D) + lane;
            float4 v[8]; float s0 = 0.f, s1 = 0.f;
#pragma unroll
            for (int j = 0; j < 8; ++j) v[j] = xr[64 * j];
#pragma unroll
            for (int j = 0; j < 4; ++j) { s0 += v[j].x * v[j].x + v[j].y * v[j].y + v[j].z * v[j].z + v[j].w * v[j].w; s1 += v[4 + j].x * v[4 + j].x + v[4 + j].y * v[4 + j].y + v[4 + j].z * v[4 + j].z + v[4 + j].w * v[4 + j].w; }
            const float r0 = rsqrtf(wave_sum(s0) * (1.f / D) + RMS_EPS), r1 = rsqrtf(wave_sum(s1) * (1.f / D) + RMS_EPS);
#pragma unroll
            for (int j = 0; j < 8; ++j) { const float4 g = ((const float4*)c.norm1_g())[lane + 64 * (j & 3)]; const float r = j < 4 ? r0 : r1;
                uint2 o; o.x = pk2bf(v[j].x * r * g.x, v[j].y * r * g.y); o.y = pk2bf(v[j].z * r * g.z, v[j].w * r * g.w);
                ((uint2*)(c.H1() + (size_t)t * D))[lane + 64 * j] = o; }
        }
        {
            LAS float* scr = (LAS float*)((LAS unsigned char*)lds + (tid >> 6) * 16384);
            constexpr int I_IN = 16 * 160, I_OUT = 16 * 32, I_BR = 8 * 32, I_GU = 16 * 4 * 2 * 4 * 16, I_DN = 16 * 8 * 32, I_C1 = 512;
            for (int it = gwave; it < I_IN + I_OUT + 2 * I_BR + I_GU + I_DN + I_C1; it += nwaves) {
                int r = it;
                if (r < I_IN) { const int kb = r / 160, vb = r % 160, pn = vb >> 3, bj = (vb >> 2) & 1, wc = vb & 3;
                    const ChunkDesc d = chunk_desc(c, pn * 4 + wc); int nv = d.ncols - 32 * bj; nv = nv < 0 ? 0 : (nv > 32 ? 32 : nv);
                    tr_item(c.w_in(), INC, 64 * kb, d.src + 32 * bj, nv, c.WIN(), 1024, 256 * pn + 128 * bj + 32 * wc, scr, lane); continue; }
                r -= I_IN;
                if (r < I_OUT) { tr_item(c.w_out(), 1024, 64 * (r / 32), 32 * (r % 32), 32, c.WOUT(), 1024, 32 * (r % 32), scr, lane); continue; }
                r -= I_OUT;
                if (r < I_BR) { tr_item(c.w_bn(), 1024, 64 * (r / 32), 32 * (r % 32), 32, c.WBN(), 512, 32 * (r % 32), scr, lane); continue; }
                r -= I_BR;
                if (r < I_BR) { tr_item(c.w_bd(), 1024, 64 * (r / 32), 32 * (r % 32), 32, c.WBD(), 512, 32 * (r % 32), scr, lane); continue; }
                r -= I_BR;
                if (r < I_GU) { const int kb = r & 15, blk = (r >> 4) & 3, bj = (r >> 6) & 1, ntile = (r >> 7) & 3, e = r >> 9;
                    tr_item((bj ? c.w_up() : c.w_gate()) + (size_t)e * 1024 * 512, 512, 64 * kb, ntile * 128 + 32 * blk, 32, c.WGU() + (size_t)e * 1024 * 1024, 1024, 256 * ntile + 128 * bj + 32 * blk, scr, lane, c.norm2_g()); continue; }
                r -= I_GU;
                if (r < I_DN) { const int nb = r & 31, kb = (r >> 5) & 7, e = r >> 8;
                    tr_item(c.w_down() + (size_t)e * 512 * 1024, 1024, 64 * kb, 32 * nb, 32, c.WDN() + (size_t)e * 1024 * 512, 512, 32 * nb, scr, lane); continue; }
                r -= I_DN;
                { const int nb = r & 7, kb = (r >> 3) & 15, bot = (r >> 7) & 1, kv = r >> 8;
                    tr_item(c.cmp_w1() + (size_t)kv * 2048 * 256 + (size_t)bot * 1024 * 256, 256, 64 * kb, 32 * nb, 32, c.WC1() + (size_t)kv * 512 * 1024, 1024, bot * 256 + 32 * nb, scr, lane); }
            }
            if (gwave >= nwaves - 64) { const int w = gwave - (nwaves - 64), sl = w & 7, jb = (w >> 3) & 3, kv = w >> 5, j = jb * 64 + lane;
                const float* w1 = c.cmp_w1() + (size_t)kv * 2048 * 256 + (size_t)sl * 256 * 256 + j; const float* pos = c.cmp_pos() + kv * 2048 + sl * 256;
                float a0 = 0.f, a1 = 0.f, a2 = 0.f, a3 = 0.f;
                for (int k = 0; k < 256; k += 4) { a0 += pos[k] * w1[(size_t)k * 256]; a1 += pos[k + 1] * w1[(size_t)(k + 1) * 256]; a2 += pos[k + 2] * w1[(size_t)(k + 2) * 256]; a3 += pos[k + 3] * w1[(size_t)(k + 3) * 256]; }
                c.POSB()[(sl * 2 + kv) * 256 + j] = (a0 + a1) + (a2 + a3); }
            if (gtid >= 8192 && gtid < 8192 + 12 * 1280) { const int i = gtid - 8192, hd = i / 1280, a = (i % 1280) / 320, j = (i % 320) + a, d = 208 - j;
                c.BIASV()[i] = (d < 0) ? -1e30f : (d >= 113 ? 0.f : (c.rel_bias()[t5_bucket(d) * 12 + hd] - c.rel_bias()[31 * 12 + hd]) * 1.4426950408889634f); }
            if (gtid >= 24576 && gtid < 24576 + 1024) { const int k = gtid - 24576; const float g = c.norm2_g()[k];
                const float4 gw = *(const float4*)(c.rg_w() + (size_t)k * 4);
                float w[20] = {gw.x, gw.y, gw.z, gw.w};
#pragma unroll
                for (int i4 = 0; i4 < 4; ++i4) { const float4 ew = *(const float4*)(c.re_w() + (size_t)k * 16 + 4 * i4); w[4 + 4 * i4] = ew.x; w[5 + 4 * i4] = ew.y; w[6 + 4 * i4] = ew.z; w[7 + 4 * i4] = ew.w; }
                bf16* wr = c.WRT() + k;
#pragma unroll
                for (int i = 0; i < 20; ++i) { const float v = w[i] * g; const bf16 h = f2bf(v); wr[(size_t)i * D] = h; wr[(size_t)(20 + i) * D] = f2bf(v - __uint_as_float((unsigned)h << 16)); }
#pragma unroll
                for (int i = 40; i < 48; ++i) wr[(size_t)i * D] = f2bf(0.f); }
            if (gtid >= 4096 && gtid < 4096 + 3072) { const int i = gtid - 4096, hd = i >> 8, d = i & 255; c.BIAS()[i] = (c.rel_bias()[t5_bucket(d) * 12 + hd] - c.rel_bias()[31 * 12 + hd]) * 1.4426950408889634f; }
            if (gtid >= 512 && gtid < 512 + 2048) { const int i = gtid - 512, kv = i >> 10, bg = (i >> 6) & 15, e = i & 63; const size_t tb = ((size_t)bg * 2 + 1) * 4096; if (kv) c.VCMP()[tb + (e >> 5) * 2048 + 3 * 512 + 15 * 32 + (e & 31)] = 0; else c.KCMP()[tb + (e >> 3) * 512 + 63 * 8 + (e & 7)] = 0; }
        }
        if (gwave == 0) {
            const float a = wave_sum(c.diff_lambda()[lane] * c.diff_lambda()[64 + lane]);
            const float b = wave_sum(c.diff_lambda()[128 + lane] * c.diff_lambda()[192 + lane]);
            if (lane == 0) c.LAM()[0] = expf(a) - expf(b) + LAMBDA_INIT;
        }
    }
    xcd_barrier(bar);

    if (IN(1)) {
        pg8::Ops g; g.A0 = c.H1(); g.A1 = c.H1(); g.B0 = c.WIN(); g.B1 = c.WIN(); g.K = 1024;
        pg8::StaticOrder<1> So; So.init(T, 5120, (int)gridDim.x, (int)blockIdx.x);
        EpiInProj E; E.c = c;
        pg8::gemm_phase(( LAS unsigned char*)lds, g, So, E);
    }
    xcd_barrier(bar);

    if (IN(2)) {
        pg8::Ops g; g.A0 = c.CT(); g.A1 = c.CT(); g.B0 = c.WC1(); g.B1 = c.WC1() + 512 * 1024; g.K = 1024;
        SchedCmp So; So.c = (int)blockIdx.x;
        EpiF32 E; E.O = c.U(); E.ldc = 512;
        pg8::gemm_phase((LAS unsigned char*)lds, g, So, E);
        unsigned* ctl = (unsigned*)(ws + WS_CTL);
        volatile LAS int* wq = (volatile LAS int*)((LAS unsigned char*)lds + MISC_OFF + 64);
        if (blockIdx.x < 32 && tid == 0) { __builtin_amdgcn_fence(__ATOMIC_RELEASE, "agent"); asm volatile("s_waitcnt vmcnt(0)" ::: "memory");
            __hip_atomic_fetch_add(ctl + CW_CMPD, 1u, __ATOMIC_RELAXED, __HIP_MEMORY_SCOPE_AGENT); }
        {   att::DiffArgs A; A.Q = c.QD(); A.K = c.KD(); A.V = c.VD(); A.O = c.ODIFF(); A.biasv = c.BIASV(); A.out_gain = c.diff_out_norm(); A.lam = c.LAM()[0];
            LAS float* hid = (LAS float*)((LAS unsigned char*)lds) + (tid >> 6) * 1024;
            bool cmpd_seen = false;
            for (;;) {
                __syncthreads();
                if (tid == 0) {
                    const int u = (int)atomicAdd(ctl + CW_WQ, 1u);
                    if (u >= 256 && u < 384 && !cmpd_seen) { unsigned sp = 0;
                        while (__hip_atomic_load(ctl + CW_CMPD, __ATOMIC_RELAXED, __HIP_MEMORY_SCOPE_AGENT) < 32u) { __builtin_amdgcn_s_sleep(2); if (++sp > (1u << 22)) { atomicAdd(ctl + XB_TMO + CW_BAR, 1u); break; } }
                        __builtin_amdgcn_fence(__ATOMIC_ACQUIRE, "agent"); asm volatile("s_waitcnt vmcnt(0)" ::: "memory"); cmpd_seen = true; }
                    *wq = u;
                }
                __syncthreads();
                const int u = *wq;
                if (u >= 640) break;
                if (u < 256 || u >= 384) { const int du = u < 256 ? u : u - 128; att::diff_unit((LAS unsigned char*)lds, A, (du & 31) >> 2, du & 3, 15 - (du >> 5)); continue; }
                const int q = u - 256;
                const int quarter = q & 3, b = (q >> 2) & 7, g = (q >> 5) & 1, kv = q >> 6;
                const int n0 = quarter * 32 + (tid >> 6) * 4;
#pragma unroll
                for (int jj = 0; jj < 4; ++jj) {
                    const int n = (n0 + jj < NCMP) ? n0 + jj : NCMP - 1;
                    const float* u1 = c.U() + ((size_t)(kv * 2 + g) * 1024 + b * 128 + n) * 512;
                    const float4 t4 = *(const float4*)(u1 + 4 * lane), b4 = *(const float4*)(u1 + 512 + 256 + 4 * lane), p4 = posb_sum(c.POSB() + kv * 256 + 4 * lane);
                    const float hv[4] = {t4.x + b4.x + p4.x, t4.y + b4.y + p4.y, t4.z + b4.z + p4.z, t4.w + b4.w + p4.w};
#pragma unroll
                    for (int i = 0; i < 4; ++i) { const float a = hv[i]; const float uu = 0.7978845608028654f * (a + 0.044715f * a * a * a); hid[jj * 256 + 4 * lane + i] = 0.5f * a * (1.f + tanhf(uu)); }
                }
                const float* w2 = c.cmp_w2() + (size_t)kv * 256 * 64 + lane;
                float o[4] = {0.f, 0.f, 0.f, 0.f};
#pragma unroll 16
                for (int j = 0; j < 256; ++j) { const float w = w2[j * 64]; o[0] += hid[j] * w; o[1] += hid[256 + j] * w; o[2] += hid[512 + j] * w; o[3] += hid[768 + j] * w; }
#pragma unroll
                for (int jj = 0; jj < 4; ++jj) {
                    const int n = n0 + jj; float ov = o[jj];
                    if (kv == 0) { const float ss = wave_sum(ov * ov); ov = ov * rsqrtf(ss * (1.f / 64.f) + RMS_EPS) * c.nsa_k_norm()[lane]; }
                    if (n < NCMP) { const int key = n & 63, e = lane; const size_t tb = ((size_t)(b * 2 + g) * 2 + (n >> 6)) * 4096;
                      if (kv) c.VCMP()[tb + (e >> 5) * 2048 + (key >> 4) * 512 + (key & 15) * 32 + (e & 31)] = f2bf(ov);
                      else c.KCMP()[tb + (e >> 3) * 512 + key * 8 + (e & 7)] = f2bf(ov); }
                }
                asm volatile("s_waitcnt vmcnt(0)" ::: "memory");
                __syncthreads();
                if (tid == 0) { __builtin_amdgcn_fence(__ATOMIC_RELEASE, "agent"); asm volatile("s_waitcnt vmcnt(0)" ::: "memory");
                    __hip_atomic_fetch_add(ctl + CW_FIN + 64 * (b * 2 + g), 1u, __ATOMIC_RELAXED, __HIP_MEMORY_SCOPE_AGENT); }
            } }
        {   att::NsaArgs A; A.Q = c.QN(); A.KS = c.KS(); A.VS = c.VS(); A.KW = c.KW(); A.VW = c.VW(); A.KC = c.KCMP(); A.VC = c.VCMP(); A.GN = c.GN(); A.O = c.ONSAB(); A.rel_bias = c.BIAS(); A.biasv = c.BIASV();
            bool all_seen = false;
            for (;;) {
                __syncthreads();
                if (tid == 0) {
                    const int u = (int)atomicAdd(ctl + CW_WQ + 64, 1u);
                    if (u < 512 && !all_seen) {
                        unsigned* fc = ctl + CW_FIN + 64 * (u & 15); unsigned sp = 0;
                        while (__hip_atomic_load(fc, __ATOMIC_RELAXED, __HIP_MEMORY_SCOPE_AGENT) < 8u) { __builtin_amdgcn_s_sleep(2); if (++sp > (1u << 22)) { atomicAdd(ctl + XB_TMO + CW_BAR, 1u); break; } }
                        bool all = true;
                        for (int k = 0; k < 16; ++k) all = all && (__hip_atomic_load(ctl + CW_FIN + 64 * k, __ATOMIC_RELAXED, __HIP_MEMORY_SCOPE_AGENT) >= 8u);
                        __builtin_amdgcn_fence(__ATOMIC_ACQUIRE, "agent"); asm volatile("s_waitcnt vmcnt(0)" ::: "memory");
                        all_seen = all;
                    }
                    *wq = u;
                }
                __syncthreads();
                const int u = *wq;
                if (u >= 512) break;
                att::nsa_unit((LAS unsigned char*)lds, A, (u & 15) >> 1, u & 1, 31 - (u >> 4));
            } }
    }
    xcd_barrier(bar);
    if (IN(7)) {
        pg8::Ops g; g.A0 = c.ONSAB(); g.A1 = c.ODIFF(); g.B0 = c.WBN(); g.B1 = c.WBD(); g.K = 512;
        pg8::StaticOrder<2> So; So.init(T, 1024, (int)gridDim.x, (int)blockIdx.x);
        EpiMerge E; E.Y = c.Y(); E.GM = c.GM();
        pg8::gemm_phase((LAS unsigned char*)lds, g, So, E);
    }
    xcd_barrier(bar);
    if (IN(8)) {
        pg8::Ops g; g.A0 = c.Y(); g.A1 = c.Y(); g.B0 = c.WOUT(); g.B1 = c.WOUT(); g.K = 1024;
        pg8::StaticOrder<1> So; So.init(T, 1024, (int)gridDim.x, (int)blockIdx.x);
        EpiResid E; E.X = c.x(); E.O = c.X2B();
        pg8::gemm_phase((LAS unsigned char*)lds, g, So, E);
    }
    xcd_barrier(bar);
    if (IN(9)) {
        unsigned* ctl = (unsigned*)(ws + WS_CTL); unsigned* LIST = (unsigned*)(ws + WS_LIST);
        LAS float* Pl = (LAS float*)lds;
        LAS float* Sl = (LAS float*)((LAS unsigned char*)lds + 24576);
        LAS unsigned char* Wl = (LAS unsigned char*)lds + 32768;
        const int wid = tid >> 6, rt = wid & 3, kh = wid >> 2, fr = lane & 15, fq = lane >> 4;
        for (int tb = blockIdx.x; tb < T / 64; tb += gridDim.x) {
            const bf16* xp = c.X2B() + (size_t)(tb * 64 + rt * 16 + fr) * D + kh * 512 + fq * 8;
            pg8::bf16x8 xv[16];
#pragma unroll
            for (int ks = 0; ks < 16; ++ks) xv[ks] = *(const pg8::bf16x8*)(xp + 32 * ks);
            if (tb == (int)blockIdx.x) {
                const pg8::u32x4* wsrc = (const pg8::u32x4*)c.WRT();
                pg8::u32x4 wq[12];
#pragma unroll
                for (int j = 0; j < 12; ++j) wq[j] = wsrc[tid + 512 * j];
#pragma unroll
                for (int j = 0; j < 12; ++j) { const int q = tid + 512 * j; *(LAS pg8::u32x4*)(Wl + (q >> 7) * 2080 + (q & 127) * 16) = wq[j]; } }
            __syncthreads();
            const LAS unsigned char* wl = Wl + fr * 2080 + (kh * 512 + fq * 8) * 2;
            pg8::f32x4 acc[3];
#pragma unroll
            for (int ct = 0; ct < 3; ++ct) acc[ct] = (pg8::f32x4){0.f, 0.f, 0.f, 0.f};
            float ss = 0.f;
#pragma unroll
            for (int ks = 0; ks < 16; ++ks) {
                pg8::bf16x8 wv[3];
#pragma unroll
                for (int ct = 0; ct < 3; ++ct) wv[ct] = *(const LAS pg8::bf16x8*)(wl + ct * 16 * 2080 + 64 * ks);
#pragma unroll
                for (int ct = 0; ct < 3; ++ct) acc[ct] = __builtin_amdgcn_mfma_f32_16x16x32_bf16(wv[ct], xv[ks], acc[ct], 0, 0, 0);
                const pg8::u32x4 xu = __builtin_bit_cast(pg8::u32x4, xv[ks]);
#pragma unroll
                for (int q = 0; q < 4; ++q) { const float a = LO16(xu[q]), b = HI16(xu[q]); ss += a * a + b * b; }
            }
#pragma unroll
            for (int ct = 0; ct < 3; ++ct) *(LAS pg8::f32x4*)(Pl + (size_t)((kh * 64 + rt * 16 + fr) * 48 + 16 * ct + 4 * fq)) = acc[ct];
            Sl[(kh * 4 + fq) * 64 + rt * 16 + fr] = ss;
            __syncthreads();
            if (tid < 64) {
                const LAS float* p0 = Pl + (size_t)lane * 48; const LAS float* p1 = Pl + (size_t)(64 + lane) * 48;
                float ssum = 0.f;
#pragma unroll
                for (int q = 0; q < 8; ++q) ssum += Sl[q * 64 + lane];
                const float rr = rsqrtf(ssum * (1.f / D) + RMS_EPS);
                float gl[4];
#pragma unroll
                for (int i = 0; i < 4; ++i) gl[i] = ((p0[i] + p1[i]) + (p0[20 + i] + p1[20 + i])) * rr + c.rg_b()[i];
                int gt = 0; float gbest = gl[0];
#pragma unroll
                for (int i = 1; i < 4; ++i) if (gl[i] > gbest) { gbest = gl[i]; gt = i; }
                float gs = 0.f;
#pragma unroll
                for (int i = 0; i < 4; ++i) gs += expf(gl[i] - gbest);
                const float gp = 1.f / gs;
                float el[4];
#pragma unroll
                for (int i = 0; i < 4; ++i) { const int jx = 4 + gt * 4 + i; el[i] = ((p0[jx] + p1[jx]) + (p0[20 + jx] + p1[20 + jx])) * rr + c.re_b()[gt * 4 + i]; }
                int e0 = 0; float b0 = el[0];
#pragma unroll
                for (int i = 1; i < 4; ++i) if (el[i] > b0) { b0 = el[i]; e0 = i; }
                int e1 = -1; float b1 = -3.0e38f;
#pragma unroll
                for (int i = 0; i < 4; ++i) if (i != e0 && el[i] > b1) { b1 = el[i]; e1 = i; }
                const float p1e = expf(b1 - b0); const float w0 = gp / (1.f + p1e), w1 = gp * p1e / (1.f + p1e);
                const int ea = e0 < e1 ? e0 : e1, eb = e0 < e1 ? e1 : e0;
                const int pr = (ea == 0) ? eb - 1 : (ea == 1 ? eb + 1 : 5);
                const int mycls = gt * 6 + pr;
                *(float4*)(c.ROUTE() + (size_t)(tb * 64 + lane) * 4) = make_float4(e0 < e1 ? w0 : w1, e0 < e1 ? w1 : w0, __int_as_float(mycls), rr);
                int cnt_l = 0, rank = 0;
                for (int cc = 0; cc < NCLS; ++cc) {
                    const unsigned long long mask = __ballot(mycls == cc);
                    if (lane == cc) cnt_l = __popcll(mask);
                    if (mycls == cc) rank = __popcll(mask & ((1ull << lane) - 1ull));
                }
                unsigned base_l = 0u;
                if (lane < NCLS && cnt_l > 0) base_l = atomicAdd(ctl + CW_CNT + 64 * lane, (unsigned)cnt_l);
                const unsigned base = __shfl(base_l, mycls);
                LIST[(size_t)mycls * T + base + rank] = (unsigned)(tb * 64 + lane);
            }
            __syncthreads();
        }
    }
    xcd_barrier(bar);
    if (IN(10)) {
        LAS int* tab = (LAS int*)((LAS unsigned char*)lds + TAB_OFF);
        moe_build_tab((const unsigned*)(ws + WS_CTL), tab);
        unsigned* ctl = (unsigned*)(ws + WS_CTL);
        const int G = (int)gridDim.x, bx = (int)blockIdx.x, vcu = (G % 8 == 0) ? (bx % 8) * (G / 8) + bx / 8 : bx;
        {   OpsGU g; g.H2 = c.X2B(); g.WGU = c.WGU(); g.LIST = (const unsigned*)(ws + WS_LIST); g.tab = tab;
            SchedGU So; So.tab = tab; So.G = G; So.vcu = vcu;
            EpiGU E; E.HID = c.HID(); E.LIST = (const unsigned*)(ws + WS_LIST); E.ROUTE = c.ROUTE(); E.tab = tab; E.ctl = ctl;
            pg8::gemm_phase_g((LAS unsigned char*)lds, g, So, E); }
        {   OpsDN g; g.HID = c.HID(); g.WDN = c.WDN(); g.tab = tab;
            SchedDN So; So.tab = tab; So.ctl = ctl; So.G = G; So.vcu = vcu;
            EpiDN E; E.O = c.out(); E.X2 = c.X2B(); E.LIST = (const unsigned*)(ws + WS_LIST); E.tab = tab;
#pragma unroll 1
            for (int w = 0; w < 2; ++w) { So.which = w; pg8::gemm_phase_g((LAS unsigned char*)lds, g, So, E); } }
    }
#undef IN
#undef SEAM
}

extern "C" void kernel_launch(void* const* d_in, const int* in_sizes, int n_in, void* d_out, int out_size, void* d_ws, size_t ws_size, hipStream_t stream) {
    static int grid = 0;
    if (grid == 0) {
        if (n_in != 24 || out_size != T * D || ws_size < WS_END) { fprintf(stderr, "kernel_launch: unexpected shapes (n_in %d out %d ws %zu)\n", n_in, out_size, ws_size); grid = -1; return; }
        int dev = 0, cus = 0, per_cu = 0;
        if (hipGetDevice(&dev) != hipSuccess || hipDeviceGetAttribute(&cus, hipDeviceAttributeMultiprocessorCount, dev) != hipSuccess) { grid = -1; return; }
        if (hipFuncSetAttribute((const void*)fwd_kernel, hipFuncAttributeMaxDynamicSharedMemorySize, LDS_BYTES) != hipSuccess) { fprintf(stderr, "kernel_launch: hipFuncSetAttribute failed\n"); grid = -1; return; }
        if (hipOccupancyMaxActiveBlocksPerMultiprocessor(&per_cu, (const void*)fwd_kernel, NTHR, LDS_BYTES) != hipSuccess || per_cu < 1) { fprintf(stderr, "kernel_launch: occupancy query says %d\n", per_cu); }
        (void)hipGetLastError();
        grid = cus;
    }
    if (grid < 0) return;
    (void)hipMemsetAsync((char*)d_ws + WS_CTL, 0, CTL_ZERO_BYTES, stream);
    Args a{};
    for (int i = 0; i < 24; ++i) a.in[i] = (const float*)d_in[i];
    a.out = (float*)d_out; a.ws = (unsigned char*)d_ws; a.ph_lo = 0; a.ph_hi = 11;
    hipLaunchKernelGGL(fwd_kernel, dim3(grid), dim3(NTHR), LDS_BYTES, stream, a);
}
```

```cpp
#include <hip/hip_runtime.h>
#include <cstdint>
#include <cstdio>

constexpr int NB = 8, S = 2048, D = 1024, T = NB * S;
constexpr int INC = 4888;
constexpr int C_QN = 0, C_KV = 512, C_GN = 1280, C_QD = 1304, C_KD = 1816, C_VD = 2328, C_GM = 2840;
constexpr int NCMP = 127;
constexpr float LAMBDA_INIT = 0.2f;
constexpr float RMS_EPS = 1e-6f;

typedef unsigned short bf16;
#define LAS __attribute__((address_space(3)))

constexpr size_t MiB = 1u << 20;
constexpr size_t WS_CTL = 0, CTL_ZERO_BYTES = 1 * MiB;
constexpr size_t WS_WIN = 1 * MiB;
constexpr size_t WS_WOUT = 11 * MiB;
constexpr size_t WS_WBN = 13 * MiB, WS_WBD = 14 * MiB;
constexpr size_t WS_WC1 = 15 * MiB;
constexpr size_t WS_WGU = 17 * MiB;
constexpr size_t WS_WDN = 49 * MiB;
constexpr size_t WS_H1 = 65 * MiB;
constexpr size_t WS_QN = 97 * MiB;
constexpr size_t WS_CT = 113 * MiB;
constexpr size_t WS_KS = 121 * MiB, WS_VS = 125 * MiB, WS_KW = 129 * MiB, WS_VW = 133 * MiB;
constexpr size_t WS_QD = 137 * MiB, WS_KD = 153 * MiB, WS_VD = 169 * MiB;
constexpr size_t WS_GM = 185 * MiB;
constexpr size_t WS_GN = 249 * MiB;
constexpr size_t WS_KCMP = 251 * MiB;
constexpr size_t WS_VCMP = 251 * MiB + 256 * 1024;
constexpr size_t WS_ROUTE = 252 * MiB + 512 * 1024;
constexpr size_t WS_LAM = 252 * MiB + 768 * 1024;
constexpr size_t WS_POSB = 252 * MiB + 800 * 1024;
constexpr size_t WS_BIAS = 252 * MiB + 832 * 1024;
constexpr size_t WS_BIASV = 252 * MiB + 848 * 1024;
constexpr size_t WS_WRT = 253 * MiB;
constexpr size_t WS_END = 256 * MiB;
constexpr size_t WS_U = WS_H1;
constexpr size_t WS_ONSAB = WS_H1 + 16 * MiB;
constexpr size_t WS_X2B = WS_H1;
constexpr size_t WS_Y = WS_QN;
constexpr size_t WS_HID = WS_GM;

constexpr int CW_BAR = 4096;

#define XB_TMO      128
#define XB_XCNT(j)  (256  + 64 * (j))
#define XB_XSUB(j)  (1280 + 64 * (j))
#define XB_XGEN(j)  (2304 + 64 * (j))
#define XB_TOP      3328
#define XB_TOPGEN   3392
#define XCD_BAR_WORDS 3456
#define XB_SPIN_CAP (1u << 22)

__device__ __forceinline__ unsigned xb_ld(unsigned* p)              { return __hip_atomic_load(p, __ATOMIC_RELAXED, __HIP_MEMORY_SCOPE_AGENT); }
__device__ __forceinline__ unsigned xb_add(unsigned* p, unsigned v) { return __hip_atomic_fetch_add(p, v, __ATOMIC_RELAXED, __HIP_MEMORY_SCOPE_AGENT); }
__device__ __forceinline__ unsigned xb_xcc_id() { return (unsigned)__builtin_amdgcn_s_getreg((3 << 11) | 20) & 0xFu; }
#define XB_SPIN(cond, bar) do { unsigned _sp = 0; while (cond) { __builtin_amdgcn_s_sleep(1); \
    if ((++_sp & 255u) == 0u) { if (xb_ld(&(bar)[XB_TMO])) break; if (_sp > XB_SPIN_CAP) { atomicAdd(&(bar)[XB_TMO], 1u); break; } } } } while (0)

struct XcdBarrier { unsigned* bar; unsigned x; volatile LAS unsigned* st; };

__device__ __forceinline__ XcdBarrier xcd_barrier_post(unsigned* bar, volatile LAS unsigned* st) {
    XcdBarrier b; b.bar = bar; b.x = xb_xcc_id(); b.st = st;
    if (threadIdx.x == 0) (void)xb_add(&bar[XB_XCNT(b.x)], 1u);
    return b;
}
__device__ __forceinline__ void xcd_barrier_complete(unsigned* bar, unsigned x, unsigned& nloc, unsigned& nx) {
    const unsigned G = gridDim.x * gridDim.y * gridDim.z;
    unsigned sum, cnt, mine, sp = 0u;
    for (;;) {
        sum = 0u; cnt = 0u; mine = 0u;
#pragma unroll
        for (unsigned j = 0; j < 16; ++j) { const unsigned c = xb_ld(&bar[XB_XCNT(j)]); sum += c; cnt += (c > 0u) ? 1u : 0u; mine = (j == x) ? c : mine; }
        if (sum == G) break;
        __builtin_amdgcn_s_sleep(1);
        if ((++sp & 255u) == 0u) { if (xb_ld(&bar[XB_TMO])) break; if (sp > XB_SPIN_CAP) { atomicAdd(&bar[XB_TMO], 1u); break; } }
    }
    nloc = mine > 0u ? mine : 1u; nx = cnt > 0u ? cnt : 1u;
}
__device__ __forceinline__ void xcd_barrier(const XcdBarrier& b) {
    asm volatile("s_waitcnt vmcnt(0)" ::: "memory");
    __syncthreads();
    if (threadIdx.x == 0) {
        unsigned* bar = b.bar;
        __builtin_amdgcn_s_waitcnt(0);
        unsigned nloc = b.st[0], nx = b.st[1];
        if (nloc == 0u) { xcd_barrier_complete(bar, b.x, nloc, nx); b.st[0] = nloc; b.st[1] = nx; }
        const unsigned old = xb_add(&bar[XB_XSUB(b.x)], 1u);
        const unsigned gen = old / nloc;
        if (old + 1u == (gen + 1u) * nloc) {
            __builtin_amdgcn_fence(__ATOMIC_RELEASE, "agent");
            asm volatile("s_waitcnt vmcnt(0)" ::: "memory");
            const unsigned og = xb_add(&bar[XB_TOP], 1u);
            const unsigned tg = og / nx;
            if (og + 1u == (tg + 1u) * nx) xb_add(&bar[XB_TOPGEN], 1u);
            else XB_SPIN(xb_ld(&bar[XB_TOPGEN]) == tg, bar);
            __builtin_amdgcn_fence(__ATOMIC_ACQUIRE, "agent");
            xb_add(&bar[XB_XGEN(b.x)], 1u);
            asm volatile("s_waitcnt vmcnt(0)" ::: "memory");
        } else {
            XB_SPIN(xb_ld(&bar[XB_XGEN(b.x)]) == gen, bar);
            __builtin_amdgcn_fence(__ATOMIC_ACQUIRE, "agent");
            asm volatile("s_waitcnt vmcnt(0)" ::: "memory");
        }
    }
    __syncthreads();
}

__device__ __forceinline__ bf16 f2bf(float f) { unsigned u = __float_as_uint(f); return (bf16)((u + 0x7fffu + ((u >> 16) & 1u)) >> 16); }
typedef float g_f32x2 __attribute__((ext_vector_type(2))); typedef __bf16 g_bf16x2 __attribute__((ext_vector_type(2)));
__device__ __forceinline__ unsigned pk2bf(float lo, float hi) { const g_f32x2 v = {lo, hi}; const g_bf16x2 b = __builtin_convertvector(v, g_bf16x2); return __builtin_bit_cast(unsigned, b); }
__device__ __forceinline__ float wave_sum(float v) {
#pragma unroll
    for (int o = 1; o < 64; o <<= 1) v += __shfl_xor(v, o);
    return v;
}
typedef float nt_f32x4 __attribute__((ext_vector_type(4)));
__device__ __forceinline__ float sigmoidf_(float x) { return __builtin_amdgcn_rcpf(1.f + __builtin_amdgcn_exp2f(-1.4426950408889634f * x)); }

__device__ const unsigned char T5B[128] = {0, 1, 2, 3, 4, 5, 6, 7, 8, 9, 10, 11, 12, 13, 14, 15, 16, 16, 16, 17, 17, 18, 18, 18, 19, 19, 19, 20, 20, 20, 20, 21, 21, 21, 21, 22, 22, 22, 22, 22, 23, 23, 23, 23, 23, 23, 24, 24, 24, 24, 24, 24, 25, 25, 25, 25, 25, 25, 25, 26, 26, 26, 26, 26, 26, 26, 26, 27, 27, 27, 27, 27, 27, 27, 27, 27, 27, 28, 28, 28, 28, 28, 28, 28, 28, 28, 28, 29, 29, 29, 29, 29, 29, 29, 29, 29, 29, 29, 29, 30, 30, 30, 30, 30, 30, 30, 30, 30, 30, 30, 30, 30, 30, 31, 31, 31, 31, 31, 31, 31, 31, 31, 31, 31, 31, 31, 31, 31};
__device__ __forceinline__ int t5_bucket(int dist) { return (int)T5B[dist > 127 ? 127 : (dist < 0 ? 0 : dist)]; }

#define LO16(u) __uint_as_float((u) << 16)
#define HI16(u) __uint_as_float((u) & 0xffff0000u)

struct Args { const float* in[24]; float* out; unsigned char* ws; int ph_lo, ph_hi; };

struct Ctx {
    Args a;
#define CF(name, idx) __device__ __forceinline__ const float* name() const { return a.in[idx]; }
    CF(x, 0) CF(norm1_g, 1) CF(w_in, 2) CF(nsa_q_norm, 3) CF(nsa_k_norm, 4) CF(cmp_pos, 5) CF(cmp_w1, 6) CF(cmp_w2, 7) CF(diff_q_norm, 8) CF(diff_k_norm, 9)
    CF(diff_lambda, 10) CF(diff_out_norm, 11) CF(rel_bias, 12) CF(w_bn, 13) CF(w_bd, 14) CF(w_out, 15) CF(norm2_g, 16) CF(rg_w, 17) CF(rg_b, 18) CF(re_w, 19) CF(re_b, 20)
    CF(w_gate, 21) CF(w_up, 22) CF(w_down, 23)
#undef CF
#define CW(type, name, off) __device__ __forceinline__ type* name() const { return (type*)(a.ws + (off)); }
    CW(bf16, H1, WS_H1) CW(bf16, QN, WS_QN) CW(bf16, CT, WS_CT) CW(bf16, KS, WS_KS) CW(bf16, VS, WS_VS) CW(bf16, KW, WS_KW) CW(bf16, VW, WS_VW)
    CW(bf16, QD, WS_QD) CW(bf16, KD, WS_KD) CW(bf16, VD, WS_VD) CW(bf16, GM, WS_GM) CW(float, GN, WS_GN) CW(bf16, KCMP, WS_KCMP) CW(bf16, VCMP, WS_VCMP)
    CW(bf16, ONSAB, WS_ONSAB) CW(float, ROUTE, WS_ROUTE)
    CW(float, LAM, WS_LAM) CW(bf16, Y, WS_Y) CW(bf16, HID, WS_HID)
    CW(float, U, WS_U) CW(bf16, X2B, WS_X2B) CW(float, POSB, WS_POSB) CW(float, BIAS, WS_BIAS) CW(float, BIASV, WS_BIASV) CW(bf16, WIN, WS_WIN) CW(bf16, WOUT, WS_WOUT) CW(bf16, WBN, WS_WBN) CW(bf16, WBD, WS_WBD) CW(bf16, WC1, WS_WC1) CW(bf16, WGU, WS_WGU) CW(bf16, WDN, WS_WDN) CW(bf16, WRT, WS_WRT)
    __device__ __forceinline__ bf16* ODIFF() const { return (bf16*)a.out; }
#undef CW
    __device__ __forceinline__ float* out() const { return a.out; }
};

struct ChunkDesc { int src; int ncols; int mode; const float* gain; bf16* dst; float* dstf; int pitch; int dcol; float qscale;
    int img; int c0; int tile_bytes; int bstride; };
__device__ __forceinline__ ChunkDesc chunk_desc(const Ctx& c, int ch) {
    ChunkDesc d; d.src = 0; d.ncols = 64; d.mode = 0; d.gain = nullptr; d.dst = nullptr; d.dstf = nullptr; d.pitch = 0; d.dcol = 0; d.qscale = 1.f; d.img = 0; d.c0 = 0; d.tile_bytes = 0; d.bstride = 0;
    if (ch < 8) { d.src = C_QN + 64 * ch; d.mode = 1; d.gain = c.nsa_q_norm(); d.dst = c.QN(); d.pitch = 512; d.dcol = 64 * ch; d.qscale = 0.125f * 1.4426950408889634f; }
    else if (ch < 20) { const int j = ch - 8; d.src = C_KV + 64 * j; const int t = j >> 2, kv = (j >> 1) & 1, g = j & 1;
        if (t == 0) { d.dst = c.CT() + (size_t)(kv * 2 + g) * T * 64; d.pitch = 64; d.dcol = 0; }
        else { d.dst = ((t == 1) ? (kv ? c.VS() : c.KS()) : (kv ? c.VW() : c.KW())) + (size_t)g * 32 * 4096; d.img = kv ? 2 : 1; d.c0 = 0; d.tile_bytes = 8192; d.bstride = 2 * 32 * 8192;
               if (kv == 0) { d.mode = 1; d.gain = c.nsa_k_norm() + 64 * t; } } }
    else if (ch < 24) { if (ch == 20) { d.src = C_GN; d.ncols = 24; d.mode = 2; d.dstf = c.GN(); d.pitch = 24; d.dcol = 0; } else d.ncols = 0; }
    else if (ch < 32) { const int j = ch - 24; d.src = C_QD + 64 * j; d.mode = 1; d.gain = c.diff_q_norm() + 64 * (j & 1); d.dst = c.QD(); d.pitch = 512; d.dcol = 64 * j; d.qscale = 0.125f * 1.4426950408889634f; }
    else if (ch < 40) { const int j = ch - 32; d.src = C_KD + 64 * j; d.mode = 1; d.gain = c.diff_k_norm() + 64 * (j & 1); d.dst = c.KD() + (size_t)(j >> 1) * 32 * 8192; d.img = 1; d.c0 = (j & 1) * 8; d.tile_bytes = 16384; d.bstride = 4 * 32 * 16384; }
    else if (ch < 48) { const int j = ch - 40; d.src = C_VD + 64 * j; d.dst = c.VD() + (size_t)(j >> 1) * 32 * 8192; d.img = 2; d.c0 = (j & 1) * 2; d.tile_bytes = 16384; d.bstride = 4 * 32 * 16384; }
    else { const int j = ch - 48; d.src = C_GM + 64 * j; d.mode = 2; d.dst = c.GM(); d.pitch = 2048; d.dcol = 64 * j; }
    return d;
}


namespace pg8 {
typedef short bf16x8 __attribute__((ext_vector_type(8)));
typedef float f32x4 __attribute__((ext_vector_type(4)));
typedef unsigned u32x4 __attribute__((ext_vector_type(4)));
constexpr int BM = 256, BK = 64, HALF = 128, HTB = HALF * BK * 2, NXCD = 8, WGM = 8;
__device__ __forceinline__ int lds_byte(int r, int c) { const int st = (r >> 4) * 2 + (c >> 5), rr = r & 15, cc = c & 31, ob = rr * 64 + cc * 2; return st * 1024 + (ob ^ (((ob >> 9) & 1) << 5)); }
__device__ __forceinline__ void stage_rc(int b, int& R, int& C) { const int st = b / 1024, sb = b % 1024, swz = sb ^ (((sb >> 9) & 1) << 5); R = (st >> 1) * 16 + swz / 64; C = (st & 1) * 32 + (swz % 64) / 2; }
__device__ __forceinline__ int perm32(int rho) { const int n = rho >> 4, i = rho & 15; return 8 * (i >> 2) + 4 * n + (i & 3); }
__device__ __forceinline__ unsigned cvt_pk_bf16(float lo, float hi) { return pk2bf(lo, hi); }

struct Unit { int pm, pn, z; };
struct Ops { const bf16 *A0, *A1, *B0, *B1; int K;
    __device__ __forceinline__ const char* a(const Unit& u) const { return (const char*)((u.z ? A1 : A0) + (size_t)u.pm * BM * K); }
    __device__ __forceinline__ const char* b(const Unit& u) const { return (const char*)((u.z ? B1 : B0) + (size_t)u.pn * BM * K); } };

template <int NZ> struct StaticOrder {
    int nM, nN, nwg, G, c;
    __device__ __forceinline__ void init(int M, int N, int G_, int c_) { nM = M / BM; nN = N / BM; nwg = nM * nN; G = G_; c = c_; }
    __device__ __forceinline__ bool next(int i, Unit& u) const {
        const int it = i / NZ; u.z = i % NZ;
        const long L = (long)it * G + c; if (L >= nwg) return false;
        int wgid = (int)L; { const int q = nwg / NXCD, r = nwg % NXCD, xcd = wgid % NXCD, off = wgid / NXCD; wgid = (xcd < r ? xcd * (q + 1) : r * (q + 1) + (xcd - r) * q) + off; }
        const int nig = WGM * nN, gid = wgid / nig, fm = gid * WGM, gsz = (nM - fm) < WGM ? (nM - fm) : WGM;
        u.pm = fm + ((wgid % nig) % gsz); u.pn = (wgid % nig) / gsz; return true;
    }
};

template <class Epi, class Sched>
__device__ __forceinline__ void gemm_phase(LAS unsigned char* lds, const Ops g, const Sched& S, const Epi& E) {
    const int tid = threadIdx.x, wid = __builtin_amdgcn_readfirstlane(tid >> 6), lane = tid & 63, wr = wid >> 2, wc = wid & 3, fr = lane & 15, fq = lane >> 4;
    const int K = g.K, nt = K / BK;
    unsigned voffA[2], voffB[2];
#pragma unroll
    for (int i = 0; i < 2; ++i) { int R, C; stage_rc(tid * 16 + i * 8192, R, C); const int Rb = (R & ~31) + perm32(R & 31);
        voffA[i] = (unsigned)(R * K + C) * 2u; voffB[i] = (unsigned)(Rb * K + C) * 2u; }
    const size_t kstep = (size_t)(BK * 2);
    const size_t hstep = (size_t)HALF * K * 2;
    const unsigned ldsw = (unsigned)wid * 1024u;
    const int aoff = lds_byte(wr * 64 + fr, fq * 8), boff = lds_byte(wc * 32 + fr, fq * 8);
#define PG8_SA(b, h) (((b) * 2 + (h)) * HTB)
#define PG8_SB(b, h) ((4 + (b) * 2 + (h)) * HTB)
#define PG8_STAGE(bufoff, gbase, voff) do { _Pragma("unroll") for (int _i = 0; _i < 2; ++_i) \
        __builtin_amdgcn_global_load_lds((const unsigned*)((const char*)(gbase) + (voff)[_i]), (LAS unsigned*)(lds + (bufoff) + ldsw + _i * 8192), 16, 0, 0); } while (0)
#define PG8_LDA(dst, b, h) do { _Pragma("unroll") for (int m = 0; m < 4; ++m) _Pragma("unroll") for (int k = 0; k < 2; ++k) dst[m][k] = *(const LAS bf16x8*)(lds + PG8_SA(b, h) + aoff + m * 2048 + k * 1024); } while (0)
#define PG8_LDB(dst, b, h) do { _Pragma("unroll") for (int n = 0; n < 2; ++n) _Pragma("unroll") for (int k = 0; k < 2; ++k) dst[n][k] = *(const LAS bf16x8*)(lds + PG8_SB(b, h) + boff + n * 2048 + k * 1024); } while (0)
#define PG8_MMA(ai, bj, At, Bt) do { __builtin_amdgcn_s_setprio(1); _Pragma("unroll") for (int m = 0; m < 4; ++m) _Pragma("unroll") for (int n = 0; n < 2; ++n) _Pragma("unroll") for (int k = 0; k < 2; ++k) \
        acc[ai][bj][m][n] = __builtin_amdgcn_mfma_f32_16x16x32_bf16(Bt[n][k], At[m][k], acc[ai][bj][m][n], 0, 0, 0); __builtin_amdgcn_s_setprio(0); } while (0)
#define PG8_WAIT_V(n) asm volatile("s_waitcnt vmcnt(" #n ")" ::: "memory")
#define PG8_WAIT_L(n) asm volatile("s_waitcnt lgkmcnt(" #n ")" ::: "memory")
#define PG8_BAR __builtin_amdgcn_s_barrier()
#define PG8_SCHED __builtin_amdgcn_sched_barrier(0)
    Unit cur, nxt; int ui = 0;
    if (!S.next(0, cur)) return;
    f32x4 acc[2][2][4][2];
#pragma unroll
    for (int a = 0; a < 2; ++a)
#pragma unroll
        for (int b = 0; b < 2; ++b)
#pragma unroll
            for (int m = 0; m < 4; ++m)
#pragma unroll
                for (int n = 0; n < 2; ++n) acc[a][b][m][n] = (f32x4){0.f, 0.f, 0.f, 0.f};
    bf16x8 At[4][2], B0[2][2], B1[2][2];
    const char* cA = g.a(cur); const char* cB = g.b(cur);
    PG8_STAGE(PG8_SB(0, 0), cB, voffB); PG8_STAGE(PG8_SB(0, 1), cB + hstep, voffB); PG8_STAGE(PG8_SA(0, 0), cA, voffA); PG8_STAGE(PG8_SA(0, 1), cA + hstep, voffA);
    if (wr == 1) PG8_BAR;
    PG8_WAIT_V(2); PG8_BAR;
    PG8_STAGE(PG8_SB(1, 0), cB + kstep, voffB); PG8_STAGE(PG8_SA(1, 0), cA + kstep, voffA); PG8_STAGE(PG8_SB(1, 1), cB + hstep + kstep, voffB);
    PG8_WAIT_V(6); PG8_BAR;
    for (;;) {
        const bool has_next = S.next(ui + 1, nxt);
        const char* nA = has_next ? g.a(nxt) : cA; const char* nB = has_next ? g.b(nxt) : cB;
        for (int t = 0; t < nt; t += 2) {
            const bool last = (t == nt - 2);
            const char* a1 = cA + (size_t)(t + 1) * kstep;
            const char* a2 = last ? nA : cA + (size_t)(t + 2) * kstep; const char* b2 = last ? nB : cB + (size_t)(t + 2) * kstep;
            const char* a3 = a2 + kstep; const char* b3 = b2 + kstep;
            PG8_LDB(B0, 0, 0); PG8_LDB(B1, 0, 1); PG8_SCHED; PG8_LDA(At, 0, 0); PG8_STAGE(PG8_SA(1, 1), a1 + hstep, voffA);
            PG8_WAIT_V(8); PG8_WAIT_L(0); PG8_BAR; PG8_MMA(0, 0, At, B0); PG8_MMA(0, 1, At, B1); PG8_BAR; PG8_SCHED;
            PG8_LDA(At, 0, 1); PG8_STAGE(PG8_SB(0, 0), b2, voffB); PG8_STAGE(PG8_SB(0, 1), b2 + hstep, voffB); PG8_STAGE(PG8_SA(0, 0), a2, voffA);
            PG8_WAIT_V(8); PG8_WAIT_L(0); PG8_BAR; PG8_MMA(1, 0, At, B0); PG8_MMA(1, 1, At, B1); PG8_BAR; PG8_SCHED;
            PG8_LDB(B0, 1, 0); PG8_LDB(B1, 1, 1); PG8_SCHED; PG8_LDA(At, 1, 0); PG8_STAGE(PG8_SA(0, 1), a2 + hstep, voffA);
            PG8_WAIT_V(8); PG8_WAIT_L(0); PG8_BAR; PG8_MMA(0, 0, At, B0); PG8_MMA(0, 1, At, B1); PG8_BAR; PG8_SCHED;
            PG8_LDA(At, 1, 1); PG8_STAGE(PG8_SB(1, 0), b3, voffB); PG8_STAGE(PG8_SB(1, 1), b3 + hstep, voffB); PG8_STAGE(PG8_SA(1, 0), a3, voffA);
            PG8_WAIT_V(8); PG8_WAIT_L(0); PG8_BAR; PG8_MMA(1, 0, At, B0); PG8_MMA(1, 1, At, B1); PG8_BAR; PG8_SCHED;
        }
        if (wr == 0) PG8_BAR;
        const bool keep = E(acc, cur, wr, wc, fr, fq);
        if (!has_next) break;
        if (!keep) {
#pragma unroll
        for (int a = 0; a < 2; ++a)
#pragma unroll
            for (int b = 0; b < 2; ++b)
#pragma unroll
                for (int m = 0; m < 4; ++m)
#pragma unroll
                    for (int n = 0; n < 2; ++n) acc[a][b][m][n] = (f32x4){0.f, 0.f, 0.f, 0.f};
        }
        cur = nxt; cA = nA; cB = nB; ++ui;
        if (wr == 1) PG8_BAR;
    }
    PG8_WAIT_V(0);
    PG8_BAR;
#undef PG8_SA
#undef PG8_SB
#undef PG8_STAGE
#undef PG8_LDA
#undef PG8_LDB
#undef PG8_MMA
#undef PG8_WAIT_V
#undef PG8_WAIT_L
#undef PG8_BAR
#undef PG8_SCHED
}

template <class G, class Epi, class Sched>
__device__ __forceinline__ void gemm_phase_g(LAS unsigned char* lds, const G& g, const Sched& S, const Epi& E) {
    const int tid = threadIdx.x, wid = __builtin_amdgcn_readfirstlane(tid >> 6), lane = tid & 63, wr = wid >> 2, wc = wid & 3, fr = lane & 15, fq = lane >> 4;
    constexpr int nt = G::NT;
    unsigned voffB[2];
#pragma unroll
    for (int i = 0; i < 2; ++i) { int R, C; stage_rc(tid * 16 + i * 8192, R, C); const int Rb = (R & ~31) + perm32(R & 31); voffB[i] = (unsigned)(Rb * G::LDB + C) * 2u; }
#define PG8_RC int sR[2], sC[2]; stage_rc(tid * 16, sR[0], sC[0]); stage_rc(tid * 16 + 8192, sR[1], sC[1])
    const size_t kstep = (size_t)(BK * 2);
    const size_t hstepB = (size_t)HALF * G::LDB * 2;
    const unsigned ldsw = (unsigned)wid * 1024u;
    const int aoff = lds_byte(wr * 64 + fr, fq * 8), boff = lds_byte(wc * 32 + fr, fq * 8);
#define PG8_SA(b, h) (((b) * 2 + (h)) * HTB)
#define PG8_SB(b, h) ((4 + (b) * 2 + (h)) * HTB)
#define PG8_STAGE(bufoff, gbase, voff) do { _Pragma("unroll") for (int _i = 0; _i < 2; ++_i) \
        __builtin_amdgcn_global_load_lds((const unsigned*)((const char*)(gbase) + (voff)[_i]), (LAS unsigned*)(lds + (bufoff) + ldsw + _i * 8192), 16, 0, 0); } while (0)
#define PG8_LDA(dst, b, h) do { _Pragma("unroll") for (int m = 0; m < 4; ++m) _Pragma("unroll") for (int k = 0; k < 2; ++k) dst[m][k] = *(const LAS bf16x8*)(lds + PG8_SA(b, h) + aoff + m * 2048 + k * 1024); } while (0)
#define PG8_LDB(dst, b, h) do { _Pragma("unroll") for (int n = 0; n < 2; ++n) _Pragma("unroll") for (int k = 0; k < 2; ++k) dst[n][k] = *(const LAS bf16x8*)(lds + PG8_SB(b, h) + boff + n * 2048 + k * 1024); } while (0)
#define PG8_MMA(ai, bj, At, Bt) do { __builtin_amdgcn_s_setprio(1); _Pragma("unroll") for (int m = 0; m < 4; ++m) _Pragma("unroll") for (int n = 0; n < 2; ++n) _Pragma("unroll") for (int k = 0; k < 2; ++k) \
        acc[ai][bj][m][n] = __builtin_amdgcn_mfma_f32_16x16x32_bf16(Bt[n][k], At[m][k], acc[ai][bj][m][n], 0, 0, 0); __builtin_amdgcn_s_setprio(0); } while (0)
#define PG8_WAIT_V(n) asm volatile("s_waitcnt vmcnt(" #n ")" ::: "memory")
#define PG8_WAIT_L(n) asm volatile("s_waitcnt lgkmcnt(" #n ")" ::: "memory")
#define PG8_BAR __builtin_amdgcn_s_barrier()
#define PG8_SCHED __builtin_amdgcn_sched_barrier(0)
    Unit cur, nxt; int ui = 0;
    if (!S.next(0, cur)) return;
    unsigned vc[2][2], vn[2][2];
    bool has_next = S.next(1, nxt);
    {   PG8_RC; g.a_voff(cur, sR, sC, vc);
        if (has_next) g.a_voff(nxt, sR, sC, vn); }
    if (has_next) {} else { vn[0][0] = vc[0][0]; vn[0][1] = vc[0][1]; vn[1][0] = vc[1][0]; vn[1][1] = vc[1][1]; }
    f32x4 acc[2][2][4][2];
#pragma unroll
    for (int a = 0; a < 2; ++a)
#pragma unroll
        for (int b = 0; b < 2; ++b)
#pragma unroll
            for (int m = 0; m < 4; ++m)
#pragma unroll
                for (int n = 0; n < 2; ++n) acc[a][b][m][n] = (f32x4){0.f, 0.f, 0.f, 0.f};
    bf16x8 At[4][2], B0[2][2], B1[2][2];
    const char* cA = g.a_base(cur);
    const char *cb0, *cb1, *nb0, *nb1;
    g.bprep(cur, cb0, cb1);
    if (has_next) g.bprep(nxt, nb0, nb1); else { nb0 = cb0; nb1 = cb1; }
    {   const char* cB0 = G::bat(cb0, cb1, 0); const char* cB1 = G::bat(cb0, cb1, 1);
        PG8_STAGE(PG8_SB(0, 0), cB0, voffB); PG8_STAGE(PG8_SB(0, 1), cB0 + hstepB, voffB); PG8_STAGE(PG8_SA(0, 0), cA, vc[0]); PG8_STAGE(PG8_SA(0, 1), cA, vc[1]);
        if (wr == 1) PG8_BAR;
        PG8_WAIT_V(2); PG8_BAR;
        PG8_STAGE(PG8_SB(1, 0), cB1, voffB); PG8_STAGE(PG8_SA(1, 0), cA + kstep, vc[0]); PG8_STAGE(PG8_SB(1, 1), cB1 + hstepB, voffB);
        PG8_WAIT_V(6); PG8_BAR; }
    for (;;) {
        const char* nA = has_next ? g.a_base(nxt) : cA;
        for (int t = 0; t < nt; t += 2) {
            const bool last = (t == nt - 2);
            const char* a1 = cA + (size_t)(t + 1) * kstep;
            const char* a2 = last ? nA : cA + (size_t)(t + 2) * kstep; const char* a3 = a2 + kstep;
            const char* b2 = last ? G::bat(nb0, nb1, 0) : G::bat(cb0, cb1, t + 2); const char* b3 = last ? G::bat(nb0, nb1, 1) : G::bat(cb0, cb1, t + 3);
            PG8_LDB(B0, 0, 0); PG8_LDB(B1, 0, 1); PG8_SCHED; PG8_LDA(At, 0, 0); PG8_STAGE(PG8_SA(1, 1), a1, vc[1]);
            if (last) { vc[0][0] = vn[0][0]; vc[0][1] = vn[0][1]; vc[1][0] = vn[1][0]; vc[1][1] = vn[1][1]; }
            PG8_WAIT_V(8); PG8_WAIT_L(0); PG8_BAR; PG8_MMA(0, 0, At, B0); PG8_MMA(0, 1, At, B1); PG8_BAR; PG8_SCHED;
            PG8_LDA(At, 0, 1); PG8_STAGE(PG8_SB(0, 0), b2, voffB); PG8_STAGE(PG8_SB(0, 1), b2 + hstepB, voffB); PG8_STAGE(PG8_SA(0, 0), a2, vc[0]);
            PG8_WAIT_V(8); PG8_WAIT_L(0); PG8_BAR; PG8_MMA(1, 0, At, B0); PG8_MMA(1, 1, At, B1); PG8_BAR; PG8_SCHED;
            PG8_LDB(B0, 1, 0); PG8_LDB(B1, 1, 1); PG8_SCHED; PG8_LDA(At, 1, 0); PG8_STAGE(PG8_SA(0, 1), a2, vc[1]);
            PG8_WAIT_V(8); PG8_WAIT_L(0); PG8_BAR; PG8_MMA(0, 0, At, B0); PG8_MMA(0, 1, At, B1); PG8_BAR; PG8_SCHED;
            PG8_LDA(At, 1, 1); PG8_STAGE(PG8_SB(1, 0), b3, voffB); PG8_STAGE(PG8_SB(1, 1), b3 + hstepB, voffB); PG8_STAGE(PG8_SA(1, 0), a3, vc[0]);
            PG8_WAIT_V(8); PG8_WAIT_L(0); PG8_BAR; PG8_MMA(1, 0, At, B0); PG8_MMA(1, 1, At, B1); PG8_BAR; PG8_SCHED;
        }
        if (wr == 0) PG8_BAR;
        E(acc, cur, wr, wc, fr, fq);
        if (!has_next) break;
#pragma unroll
        for (int a = 0; a < 2; ++a)
#pragma unroll
            for (int b = 0; b < 2; ++b)
#pragma unroll
                for (int m = 0; m < 4; ++m)
#pragma unroll
                    for (int n = 0; n < 2; ++n) acc[a][b][m][n] = (f32x4){0.f, 0.f, 0.f, 0.f};
        cur = nxt; cA = nA; cb0 = nb0; cb1 = nb1; ++ui;
        has_next = S.next(ui + 1, nxt);
        if (has_next) { PG8_RC; g.a_voff(nxt, sR, sC, vn); g.bprep(nxt, nb0, nb1); }
        if (wr == 1) PG8_BAR;
    }
    PG8_WAIT_V(0);
    PG8_BAR;
#undef PG8_RC
#undef PG8_SA
#undef PG8_SB
#undef PG8_STAGE
#undef PG8_LDA
#undef PG8_LDB
#undef PG8_MMA
#undef PG8_WAIT_V
#undef PG8_WAIT_L
#undef PG8_BAR
#undef PG8_SCHED
}
}

struct EpiInProj {
    Ctx c;
    __device__ __forceinline__ bool operator()(pg8::f32x4 (&acc)[2][2][4][2], const pg8::Unit& u, int wr, int wc, int fr_, int fq_) const {
        int fr = fr_, fq = fq_; asm volatile("" : "+v"(fr), "+v"(fq));
        const ChunkDesc d = chunk_desc(c, u.pn * 4 + wc);
        if (d.ncols == 0) return false;
        const int row0 = u.pm * 256 + wr * 64 + fr;
        float gn[2][8];
        const float* gp = (d.mode == 1) ? d.gain : c.nsa_q_norm();
        pg8::f32x4 g4[4];
#pragma unroll
        for (int q = 0; q < 4; ++q) g4[q] = *(const pg8::f32x4*)(gp + 32 * (q >> 1) + 8 * fq + 4 * (q & 1));
#pragma unroll
        for (int q = 0; q < 4; ++q) asm volatile("" : "+v"(g4[q]));
#pragma unroll
        for (int bj = 0; bj < 2; ++bj)
#pragma unroll
            for (int i = 0; i < 8; ++i) gn[bj][i] = g4[2 * bj + (i >> 2)][i & 3] * d.qscale;
#pragma unroll
        for (int ai = 0; ai < 2; ++ai)
#pragma unroll
            for (int m = 0; m < 4; ++m) {
                const size_t row = (size_t)(row0 + ai * 128 + m * 16);
                float v[2][8];
#pragma unroll
                for (int bj = 0; bj < 2; ++bj)
#pragma unroll
                    for (int n = 0; n < 2; ++n)
#pragma unroll
                        for (int i = 0; i < 4; ++i) v[bj][4 * n + i] = acc[ai][bj][m][n][i];
                if (d.mode == 1) {
                    float ss = 0.f;
#pragma unroll
                    for (int bj = 0; bj < 2; ++bj)
#pragma unroll
                        for (int i = 0; i < 8; ++i) ss += v[bj][i] * v[bj][i];
                    ss += __shfl_xor(ss, 16); ss += __shfl_xor(ss, 32);
                    const float r = rsqrtf(ss * (1.f / 64.f) + RMS_EPS);
#pragma unroll
                    for (int bj = 0; bj < 2; ++bj)
#pragma unroll
                        for (int i = 0; i < 8; ++i) v[bj][i] = v[bj][i] * r * gn[bj][i];
                } else if (d.mode == 2) {
#pragma unroll
                    for (int bj = 0; bj < 2; ++bj)
#pragma unroll
                        for (int i = 0; i < 8; ++i) v[bj][i] = sigmoidf_(v[bj][i]);
                }
                if (d.dstf) {
                    if (fq < 3) { float4* p = (float4*)(d.dstf + row * 24 + 8 * fq); p[0] = make_float4(v[0][0], v[0][1], v[0][2], v[0][3]); p[1] = make_float4(v[0][4], v[0][5], v[0][6], v[0][7]); }
                } else {
#pragma unroll
                    for (int bj = 0; bj < 2; ++bj) { pg8::u32x4 w; w.x = pg8::cvt_pk_bf16(v[bj][0], v[bj][1]); w.y = pg8::cvt_pk_bf16(v[bj][2], v[bj][3]); w.z = pg8::cvt_pk_bf16(v[bj][4], v[bj][5]); w.w = pg8::cvt_pk_bf16(v[bj][6], v[bj][7]);
                        if (d.img == 0) *(pg8::u32x4*)(d.dst + row * d.pitch + d.dcol + 32 * bj + 8 * fq) = w;
                        else { const int bb = (int)(row >> 11), sq = (int)(row & 2047), key = sq & 63;
                            const size_t tb = (size_t)bb * d.bstride + (size_t)(sq >> 6) * d.tile_bytes;
                            const size_t off = (d.img == 1) ? tb + (size_t)(d.c0 + 4 * bj + fq) * 1024 + key * 16 : tb + (size_t)(d.c0 + bj) * 4096 + (key >> 4) * 1024 + (key & 15) * 64 + fq * 16;
                            *(pg8::u32x4*)((unsigned char*)d.dst + off) = w; } }
                }
            }
        return false;
    }
};
struct EpiMerge {
    bf16* Y; const bf16* GM;
    __device__ __forceinline__ bool operator()(pg8::f32x4 (&acc)[2][2][4][2], const pg8::Unit& u, int wr, int wc, int fr_, int fq_) const {
        int fr = fr_, fq = fq_; asm volatile("" : "+v"(fr), "+v"(fq));
        const int row0 = u.pm * 256 + wr * 64 + fr, col0 = u.pn * 256 + wc * 32 + 8 * fq;
#pragma unroll
        for (int ai = 0; ai < 2; ++ai)
#pragma unroll
            for (int m = 0; m < 4; ++m) {
                const size_t row = (size_t)(row0 + ai * 128 + m * 16);
#pragma unroll
                for (int bj = 0; bj < 2; ++bj) {
                    const int col = col0 + bj * 128;
                    const uint4 g1 = *(const uint4*)(GM + row * 2048 + 1024 + col);
                    float q1[8] = {LO16(g1.x), HI16(g1.x), LO16(g1.y), HI16(g1.y), LO16(g1.z), HI16(g1.z), LO16(g1.w), HI16(g1.w)};
                    if (u.z == 0) {
                        const uint4 g0 = *(const uint4*)(GM + row * 2048 + col);
                        const float q0[8] = {LO16(g0.x), HI16(g0.x), LO16(g0.y), HI16(g0.y), LO16(g0.z), HI16(g0.z), LO16(g0.w), HI16(g0.w)};
#pragma unroll
                        for (int n = 0; n < 2; ++n)
#pragma unroll
                            for (int i = 0; i < 4; ++i) acc[ai][bj][m][n][i] *= q0[4 * n + i] * __builtin_amdgcn_rcpf(fmaxf(q1[4 * n + i], 1e-30f));
                    } else {
                        float v[8];
#pragma unroll
                        for (int n = 0; n < 2; ++n)
#pragma unroll
                            for (int i = 0; i < 4; ++i) v[4 * n + i] = acc[ai][bj][m][n][i] * fmaxf(q1[4 * n + i], 1e-30f);
                        uint4 w; w.x = pg8::cvt_pk_bf16(v[0], v[1]); w.y = pg8::cvt_pk_bf16(v[2], v[3]); w.z = pg8::cvt_pk_bf16(v[4], v[5]); w.w = pg8::cvt_pk_bf16(v[6], v[7]);
                        *(uint4*)(Y + row * 1024 + col) = w;
                    }
                }
            }
        return u.z == 0;
    }
};
struct EpiResid {
    const float* X; bf16* O;
    __device__ __forceinline__ bool operator()(pg8::f32x4 (&acc)[2][2][4][2], const pg8::Unit& u, int wr, int wc, int fr_, int fq_) const {
        int fr = fr_, fq = fq_; asm volatile("" : "+v"(fr), "+v"(fq));
        const int row0 = u.pm * 256 + wr * 64 + fr, col0 = u.pn * 256 + wc * 32 + 8 * fq;
#pragma unroll
        for (int ai = 0; ai < 2; ++ai)
#pragma unroll
            for (int m = 0; m < 4; ++m) {
                const size_t row = (size_t)(row0 + ai * 128 + m * 16);
#pragma unroll
                for (int bj = 0; bj < 2; ++bj) { const size_t off = row * 1024 + col0 + bj * 128;
                    const float4 x0 = *(const float4*)(X + off), x1 = *(const float4*)(X + off + 4); const pg8::f32x4 a0 = acc[ai][bj][m][0], a1 = acc[ai][bj][m][1];
                    uint4 w; w.x = pk2bf(x0.x + a0[0], x0.y + a0[1]); w.y = pk2bf(x0.z + a0[2], x0.w + a0[3]); w.z = pk2bf(x1.x + a1[0], x1.y + a1[1]); w.w = pk2bf(x1.z + a1[2], x1.w + a1[3]);
                    *(uint4*)(O + off) = w; }
            }
        return false;
    }
};

struct EpiF32 {
    float* O; int ldc;
    __device__ __forceinline__ bool operator()(pg8::f32x4 (&acc)[2][2][4][2], const pg8::Unit& u, int wr, int wc, int fr_, int fq_) const {
        int fr = fr_, fq = fq_; asm volatile("" : "+v"(fr), "+v"(fq));
        const int row0 = u.pm * 256 + wr * 64 + fr, col0 = u.pn * 256 + wc * 32 + 8 * fq;
#pragma unroll
        for (int ai = 0; ai < 2; ++ai)
#pragma unroll
            for (int m = 0; m < 4; ++m)
#pragma unroll
                for (int bj = 0; bj < 2; ++bj)
#pragma unroll
                    for (int n = 0; n < 2; ++n) { const pg8::f32x4 a = acc[ai][bj][m][n];
                        *(float4*)(O + (size_t)(row0 + ai * 128 + m * 16) * ldc + col0 + bj * 128 + 4 * n) = make_float4(a[0], a[1], a[2], a[3]); }
        return false;
    }
};
struct SchedCmp { int c;
    __device__ __forceinline__ bool next(int i, pg8::Unit& u) const { if (i > 0 || c >= 32) return false; u.pm = c >> 1; u.pn = c & 1; u.z = c >> 4; return true; } };

__device__ __forceinline__ float4 posb_sum(const float* p) { float4 a = *(const float4*)p;
#pragma unroll
    for (int sl = 1; sl < 8; ++sl) { const float4 b = *(const float4*)(p + sl * 512); a.x += b.x; a.y += b.y; a.z += b.z; a.w += b.w; }
    return a; }

__device__ __forceinline__ void tr_item(const float* src, int ldn, int k0, int n0, int nvalid, bf16* dst, int ldk, int r0, LAS float* scr, int lane, const float* kgain = nullptr) {
    const int nn = lane & 31;
    float tv[32];
#pragma unroll
    for (int i = 0; i < 32; ++i) { const int kk = 2 * i + (lane >> 5); tv[i] = (nn < nvalid) ? __builtin_nontemporal_load(src + (size_t)(k0 + kk) * ldn + n0 + nn) : 0.f; }
#pragma unroll
    for (int i = 0; i < 32; ++i) { const int kk = 2 * i + (lane >> 5); scr[kk * 33 + nn] = kgain ? tv[i] * kgain[k0 + kk] : tv[i]; }
    asm volatile("s_waitcnt lgkmcnt(0)" ::: "memory");
    const int cch = lane & 7;
#pragma unroll
    for (int j = 0; j < 4; ++j) { const int n = (lane >> 3) + 8 * j; const LAS float* sp = scr + (8 * cch) * 33 + n;
        uint4 o; o.x = pg8::cvt_pk_bf16(sp[0 * 33], sp[1 * 33]); o.y = pg8::cvt_pk_bf16(sp[2 * 33], sp[3 * 33]); o.z = pg8::cvt_pk_bf16(sp[4 * 33], sp[5 * 33]); o.w = pg8::cvt_pk_bf16(sp[6 * 33], sp[7 * 33]);
        *(uint4*)(dst + (size_t)(r0 + n) * ldk + k0 + 8 * cch) = o; }
    asm volatile("s_waitcnt lgkmcnt(0)" ::: "memory");
}


namespace att {
typedef short bf16x8 __attribute__((ext_vector_type(8)));
typedef short s16x4 __attribute__((ext_vector_type(4)));
typedef short v4i16_t __attribute__((ext_vector_type(4)));
typedef float f32x16 __attribute__((ext_vector_type(16)));
typedef unsigned u32x4 __attribute__((ext_vector_type(4)));
typedef float f32x4v __attribute__((ext_vector_type(4)));
constexpr float C2 = 0.125f * 1.4426950408889634f;
constexpr float LOG2E = 1.4426950408889634f;
constexpr float NEGB = -1e30f, MFLOOR = -1e4f;
__device__ __forceinline__ int crow(int r, int hi) { return (r & 3) + 8 * (r >> 2) + 4 * hi; }
__device__ __forceinline__ s16x4 vtr(const LAS char* p) { return __builtin_bit_cast(s16x4, __builtin_amdgcn_ds_read_tr16_b64_v4i16((LAS v4i16_t*)p)); }
typedef float f32x2_t __attribute__((ext_vector_type(2))); typedef __bf16 bf16x2_t __attribute__((ext_vector_type(2)));
__device__ __forceinline__ unsigned cvtpk(float lo, float hi) { const f32x2_t v = {lo, hi}; const bf16x2_t b = __builtin_convertvector(v, bf16x2_t); return __builtin_bit_cast(unsigned, b); }
#define ATT_WAIT_BAR() asm volatile("s_waitcnt vmcnt(0) lgkmcnt(0)\n\ts_barrier" ::: "memory")

template <int NKB> __device__ __forceinline__ void stage_img(LAS unsigned char* dst, const unsigned char* src, int wid, int lane) {
#pragma unroll
    for (int c = 0; c < (NKB + 7) / 8; ++c) { const int pc = wid + 8 * c;
        if (NKB % 8 == 0 || pc < NKB) __builtin_amdgcn_global_load_lds((const unsigned*)(src + pc * 1024 + lane * 16), (LAS unsigned*)(dst + pc * 1024), 16, 0, 0); }
}
__device__ __forceinline__ void qk_tile(f32x16& p0, f32x16& p1, const LAS unsigned char* kt, int ch0, const bf16x8 (&qf)[4], int r32, int hi) {
    const LAS unsigned char* kb = kt + (ch0 + hi) * 1024 + r32 * 16;
    p0 = (f32x16){0.f, 0.f, 0.f, 0.f, 0.f, 0.f, 0.f, 0.f, 0.f, 0.f, 0.f, 0.f, 0.f, 0.f, 0.f, 0.f}; p1 = p0;
#pragma unroll
    for (int d0 = 0; d0 < 4; ++d0) {
        const bf16x8 a0 = *(const LAS bf16x8*)(kb + d0 * 2048), a1 = *(const LAS bf16x8*)(kb + d0 * 2048 + 512);
        p0 = __builtin_amdgcn_mfma_f32_32x32x16_bf16(a0, qf[d0], p0, 0, 0, 0);
        p1 = __builtin_amdgcn_mfma_f32_32x32x16_bf16(a1, qf[d0], p1, 0, 0, 0);
    }
}
template <int EB> __device__ __forceinline__ void pv_tile(f32x16 (&o)[EB], const LAS unsigned char* vt, const f32x16& p0, const f32x16& p1, int lane) {
    const int hi = lane >> 5;
    const LAS char* vb = (const LAS char*)vt + ((lane >> 4) & 1) * 32 + (lane & 3) * 8 + (4 * hi + ((lane & 15) >> 2)) * 64;
#pragma unroll
    for (int ks = 0; ks < 4; ++ks) {
        s16x4 lo[EB], hh[EB];
#pragma unroll
        for (int eb = 0; eb < EB; ++eb) { lo[eb] = vtr(vb + eb * 4096 + ks * 1024); hh[eb] = vtr(vb + eb * 4096 + ks * 1024 + 512); }
        const f32x16& p = (ks < 2) ? p0 : p1; const int rb = (ks & 1) * 8;
        const u32x4 w = (u32x4){cvtpk(p[rb + 0], p[rb + 1]), cvtpk(p[rb + 2], p[rb + 3]), cvtpk(p[rb + 4], p[rb + 5]), cvtpk(p[rb + 6], p[rb + 7])};
        const bf16x8 pa = __builtin_bit_cast(bf16x8, w);
#pragma unroll
        for (int eb = 0; eb < EB; ++eb) {
            const bf16x8 vf = (bf16x8){lo[eb][0], lo[eb][1], lo[eb][2], lo[eb][3], hh[eb][0], hh[eb][1], hh[eb][2], hh[eb][3]};
            o[eb] = __builtin_amdgcn_mfma_f32_32x32x16_bf16(pa, vf, o[eb], 0, 0, 0);
        }
    }
}
template <bool BIAS, bool CAUSAL, bool BAND> __device__ __forceinline__ void bias_mask(f32x16& p0, f32x16& p1, const LAS float* bl, int qabs, int kt0, int hi) {
#pragma unroll
    for (int r = 0; r < 16; ++r) {
        const int d0 = qabs - (kt0 + crow(r, hi)), d1 = d0 - 32;
        if (BIAS) { p0[r] += bl[d0 < 0 ? 0 : (d0 > 255 ? 255 : d0)]; p1[r] += bl[d1 < 0 ? 0 : (d1 > 255 ? 255 : d1)]; }
        if (CAUSAL) { if (d0 < 0) p0[r] = NEGB; if (d1 < 0) p1[r] = NEGB; }
        if (BAND) { if (d0 >= 512) p0[r] = NEGB; if (d1 >= 512) p1[r] = NEGB; }
    }
}
__device__ __forceinline__ void bias_vec(f32x16& p0, f32x16& p1, const LAS float* rt, int e0, int hi) {
    const int a = (-e0) & 3;
    const LAS float* bp = rt + a * 320 + (208 - e0 - a) + 4 * hi;
#pragma unroll
    for (int g4 = 0; g4 < 4; ++g4) { const f32x4v v0 = *(const LAS f32x4v*)(bp + 8 * g4), v1 = *(const LAS f32x4v*)(bp + 8 * g4 + 32);
        p0[4 * g4] += v0[0]; p0[4 * g4 + 1] += v0[1]; p0[4 * g4 + 2] += v0[2]; p0[4 * g4 + 3] += v0[3];
        p1[4 * g4] += v1[0]; p1[4 * g4 + 1] += v1[1]; p1[4 * g4 + 2] += v1[2]; p1[4 * g4 + 3] += v1[3]; }
}
constexpr float THR = 8.f;
__device__ __forceinline__ float max3f(float a, float b, float c) { return fmaxf(fmaxf(a, b), c); }
template <int EB> __device__ __forceinline__ void softmax_step(f32x16& p0, f32x16& p1, float& m, float& l, f32x16 (&o)[EB], LAS float* wsf, int r32, int hi) {
    if (__any(m != 0.f)) {
#pragma unroll
        for (int r = 0; r < 16; ++r) { p0[r] -= m; p1[r] -= m; }
    }
    float ra = max3f(p0[0], p0[1], p1[0]), rb2 = max3f(p0[2], p0[3], p1[1]); ra = max3f(ra, p1[2], p1[3]);
#pragma unroll
    for (int r = 4; r < 16; r += 4) { ra = max3f(ra, p0[r], p0[r + 1]); rb2 = max3f(rb2, p0[r + 2], p0[r + 3]); ra = max3f(ra, p1[r], p1[r + 1]); rb2 = max3f(rb2, p1[r + 2], p1[r + 3]); }
    float rm = fmaxf(ra, rb2);
    if (__any(rm > THR)) {
        rm = fmaxf(rm, __shfl_xor(rm, 32));
        const float dl = rm > THR ? rm : 0.f;
        const float al = __builtin_amdgcn_exp2f(-dl);
        m += dl; l *= al;
#pragma unroll
        for (int r = 0; r < 16; ++r) { p0[r] -= dl; p1[r] -= dl; }
        if (hi == 0) wsf[r32] = al;
#pragma unroll
        for (int g = 0; g < 4; ++g) { const f32x4v a4 = *(const LAS f32x4v*)(wsf + 8 * g + 4 * hi);
#pragma unroll
            for (int eb = 0; eb < EB; ++eb) { o[eb][4 * g + 0] *= a4.x; o[eb][4 * g + 1] *= a4.y; o[eb][4 * g + 2] *= a4.z; o[eb][4 * g + 3] *= a4.w; } }
    }
    float s0 = 0.f, s1 = 0.f;
#pragma unroll
    for (int r = 0; r < 16; ++r) { p0[r] = __builtin_amdgcn_exp2f(p0[r]); p1[r] = __builtin_amdgcn_exp2f(p1[r]); s0 += p0[r]; s1 += p1[r]; }
    l += s0 + s1;
}
template <int EB> __device__ __forceinline__ void scale_rows(f32x16 (&o)[EB], float f, LAS float* wsf, int r32, int hi) {
    if (hi == 0) wsf[r32] = f;
#pragma unroll
    for (int g = 0; g < 4; ++g) { const f32x4v a4 = *(const LAS f32x4v*)(wsf + 8 * g + 4 * hi);
#pragma unroll
        for (int eb = 0; eb < EB; ++eb) { o[eb][4 * g + 0] *= a4.x; o[eb][4 * g + 1] *= a4.y; o[eb][4 * g + 2] *= a4.z; o[eb][4 * g + 3] *= a4.w; } }
}

struct DiffArgs { const bf16 *Q, *K, *V; bf16* O; const float* biasv; const float* out_gain; float lam; };
__device__ __forceinline__ void diff_unit(LAS unsigned char* lds, const DiffArgs& A, int b, int h, int qt) {
    int tid_ = threadIdx.x; asm volatile("" : "+v"(tid_));
    const int tid = tid_, lane = tid & 63, r32 = lane & 31, hi = lane >> 5, wid = __builtin_amdgcn_readfirstlane(tid >> 6);
    const int cs = wid >> 2, wq = wid & 3, q0 = qt * 128, qw0 = q0 + wq * 32, qabs = qw0 + r32;
    LAS float* bl = (LAS float*)(lds + 81920);
    LAS float* wsf = (LAS float*)(lds + 83968) + wid * 64;
    const size_t rowb = (size_t)b * S;
    LAS float* rt = (LAS float*)(lds + 86016);
    for (int i = tid; i < 1280; i += 512) rt[i] = A.biasv[(8 + h) * 1280 + i];
    const unsigned char* Kh = (const unsigned char*)A.K + (size_t)(b * 4 + h) * 32 * 16384; const unsigned char* Vh = (const unsigned char*)A.V + (size_t)(b * 4 + h) * 32 * 16384;
    const int NT = (q0 + 128) / 64;
    stage_img<16>(lds, Kh, wid, lane); stage_img<16>(lds + 49152, Vh, wid, lane);
    stage_img<16>(lds + 16384, Kh + 16384, wid, lane);
    bf16x8 qf[4];
    { const bf16* qp = A.Q + (rowb + qabs) * 512 + h * 128 + cs * 64 + hi * 8;
#pragma unroll
      for (int d0 = 0; d0 < 4; ++d0) qf[d0] = *(const bf16x8*)(qp + d0 * 16); }
    f32x16 o[4];
#pragma unroll
    for (int eb = 0; eb < 4; ++eb) o[eb] = (f32x16){0.f, 0.f, 0.f, 0.f, 0.f, 0.f, 0.f, 0.f, 0.f, 0.f, 0.f, 0.f, 0.f, 0.f, 0.f, 0.f};
    float m = 0.f, l = 0.f;
    ATT_WAIT_BAR();
    if (wid >= 4) __builtin_amdgcn_s_setprio(1);
    f32x16 n0, n1;
    qk_tile(n0, n1, lds, cs * 8, qf, r32, hi);
    int kb_cur = 0, kb_nxt = 16384, kb_fre = 32768;
    for (int t = 0; t < NT; ++t) {
        if (t + 2 < NT) stage_img<16>(lds + kb_fre, Kh + (size_t)(t + 2) * 16384, wid, lane);
        if (t + 1 < NT) stage_img<16>(lds + 49152 + ((t + 1) & 1) * 16384, Vh + (size_t)(t + 1) * 16384, wid, lane);
        const int kt0 = t * 64;
        if (kt0 <= qw0 + 31) {
            f32x16 p0 = n0, p1 = n1;
            if (t + 1 < NT && kt0 + 64 <= qw0 + 31) qk_tile(n0, n1, lds + kb_nxt, cs * 8, qf, r32, hi);
            const bool causal = (kt0 + 63 > qw0), near_ = (qw0 - (kt0 + 63) < 113);
            if (causal || near_) bias_vec(p0, p1, rt, qabs - kt0, hi);
            softmax_step<4>(p0, p1, m, l, o, wsf, r32, hi);
            pv_tile<4>(o, lds + 49152 + (t & 1) * 16384, p0, p1, lane);
        }
        ATT_WAIT_BAR();
        { const int tmp = kb_cur; kb_cur = kb_nxt; kb_nxt = kb_fre; kb_fre = tmp; }
    }
    __builtin_amdgcn_s_setprio(0);
    l += __shfl_xor(l, 32);
    scale_rows<4>(o, (cs ? A.lam : 1.f) / l, wsf, r32, hi);
    LAS float* xch = (LAS float*)lds + (size_t)wq * 4096;
    if (cs == 1) {
#pragma unroll
        for (int eb = 0; eb < 4; ++eb)
#pragma unroll
            for (int r = 0; r < 16; ++r) xch[crow(r, hi) * 128 + eb * 32 + r32] = o[eb][r];
    }
    ATT_WAIT_BAR();
    if (cs == 0) {
        float ss[16];
#pragma unroll
        for (int r = 0; r < 16; ++r) ss[r] = 0.f;
#pragma unroll
        for (int eb = 0; eb < 4; ++eb)
#pragma unroll
            for (int r = 0; r < 16; ++r) { o[eb][r] -= xch[crow(r, hi) * 128 + eb * 32 + r32]; ss[r] += o[eb][r] * o[eb][r]; }
#pragma unroll
        for (int r = 0; r < 16; ++r) {
#pragma unroll
            for (int sft = 1; sft < 32; sft <<= 1) ss[r] += __shfl_xor(ss[r], sft);
            ss[r] = rsqrtf(ss[r] * (1.f / 128.f) + RMS_EPS) * (1.f - LAMBDA_INIT);
        }
        int hi_ = hi, r32_ = r32; asm volatile("" : "+v"(hi_), "+v"(r32_));
        bf16* op = A.O + (rowb + qw0 + 4 * hi_) * 512 + h * 128 + r32_;
#pragma unroll
        for (int eb = 0; eb < 4; ++eb) { const float gn = A.out_gain[eb * 32 + r32_];
#pragma unroll
            for (int r = 0; r < 16; ++r) op[(size_t)((r & 3) + 8 * (r >> 2)) * 512 + eb * 32] = f2bf(o[eb][r] * ss[r] * gn); }
    }
    ATT_WAIT_BAR();
}

struct NsaArgs { const bf16 *Q, *KS, *VS, *KW, *VW, *KC, *VC; const float* GN; bf16* O; const float* rel_bias; const float* biasv; };
__device__ __forceinline__ void imp_tile(const f32x16& p, int gbase, LAS float* ip, float inv, int hi, float& prevR) {
    float Av[4], Rv[4];
#pragma unroll
    for (int gq = 0; gq < 4; ++gq) { const float c3 = 0.5f * p[4 * gq + 3]; Av[gq] = p[4 * gq] + p[4 * gq + 1] + p[4 * gq + 2] + c3; Rv[gq] = __shfl_xor(c3, 32); }
#pragma unroll
    for (int gq = 0; gq < 4; ++gq) { const float add = hi ? Rv[gq] : (gq > 0 ? Rv[gq > 0 ? gq - 1 : 0] : prevR); ip[2 * (gbase + gq)] = (Av[gq] + add) * inv; }
    prevR = Rv[3];
}

__device__ __forceinline__ int cmp_class(int qw0, int n0) { return (16 * n0 > qw0) ? 2 : ((qw0 - 16 * (n0 + 31) - 31 >= 113) ? 0 : 1); }
__device__ __forceinline__ void cmp_bm1(f32x16& p, const LAS float* bl, int qabs, int n0, int hi) {
#pragma unroll
    for (int r = 0; r < 16; ++r) { const int d = qabs - 16 * (n0 + crow(r, hi)) - 31; p[r] += bl[d < 0 ? 0 : (d > 255 ? 255 : d)]; if (d < 0) p[r] = NEGB; }
}
__device__ __forceinline__ void cmp_pass(LAS unsigned char* lds, const bf16x8 (&qf)[4], const LAS float* bl, LAS float* ip, bool need_sel, float mref, int qw0, int qabs,
                                         int lane, int r32, int hi, f32x16 (&o)[2], float& l, float& rmax) {
    l = 0.f; rmax = NEGB; float prevR = 0.f;
    o[0] = (f32x16){0.f, 0.f, 0.f, 0.f, 0.f, 0.f, 0.f, 0.f, 0.f, 0.f, 0.f, 0.f, 0.f, 0.f, 0.f, 0.f}; o[1] = o[0];
#pragma unroll
    for (int tl = 0; tl < 2; ++tl) {
        const int c0 = cmp_class(qw0, 64 * tl), c1 = cmp_class(qw0, 64 * tl + 32);
        if (c0 == 2) {
            if (need_sel) {
#pragma unroll
                for (int gq = 0; gq < 8; ++gq) ip[2 * (8 * tl + gq)] = (gq == 0 && hi == 0) ? prevR : 0.f; }
            prevR = 0.f;
        } else {
            f32x16 p0, p1;
            qk_tile(p0, p1, lds + tl * 16384, 0, qf, r32, hi);
            if (c0 == 1) cmp_bm1(p0, bl, qabs, 64 * tl, hi);
            if (c1 == 1) cmp_bm1(p1, bl, qabs, 64 * tl + 32, hi);
            else if (c1 == 2) { p1 = (f32x16){NEGB, NEGB, NEGB, NEGB, NEGB, NEGB, NEGB, NEGB, NEGB, NEGB, NEGB, NEGB, NEGB, NEGB, NEGB, NEGB}; }
            float ra = max3f(p0[0], p0[1], p1[0]), rb2 = max3f(p0[2], p0[3], p1[1]); ra = max3f(ra, p1[2], p1[3]);
#pragma unroll
            for (int r = 4; r < 16; r += 4) { ra = max3f(ra, p0[r], p0[r + 1]); rb2 = max3f(rb2, p0[r + 2], p0[r + 3]); ra = max3f(ra, p1[r], p1[r + 1]); rb2 = max3f(rb2, p1[r + 2], p1[r + 3]); }
            rmax = max3f(rmax, ra, rb2);
            float s0 = 0.f, s1 = 0.f;
#pragma unroll
            for (int r = 0; r < 16; ++r) { p0[r] = __builtin_amdgcn_exp2f(p0[r] - mref); p1[r] = __builtin_amdgcn_exp2f(p1[r] - mref); s0 += p0[r]; s1 += p1[r]; }
            l += s0 + s1;
            if (need_sel) { imp_tile(p0, 8 * tl, ip, 1.f, hi, prevR); imp_tile(p1, 8 * tl + 4, ip, 1.f, hi, prevR); }
            pv_tile<2>(o, lds + tl * 16384 + 8192, p0, p1, lane);
        }
    }
}
__device__ __forceinline__ void nsa_unit(LAS unsigned char* lds, const NsaArgs& A, int b, int g, int qt) {
    int tid_ = threadIdx.x; asm volatile("" : "+v"(tid_));
    const int tid = tid_, wid = __builtin_amdgcn_readfirstlane(tid >> 6);
    int lane = tid & 63, r32 = lane & 31, hi = lane >> 5;
#define NSA_RELANE() do { asm volatile("" : "+v"(lane)); r32 = lane & 31; hi = lane >> 5; qabs = qw0 + r32; } while (0)
    const int hh = wid >> 1, head = g * 4 + hh, q0 = qt * 64, qw0 = q0 + (wid & 1) * 32; int qabs = qw0 + r32;
    LAS float* bl = (LAS float*)(lds + 32768) + hh * 256;
    LAS float* wsf = (LAS float*)(lds + 36864) + wid * 64;
    LAS float* ipart = (LAS float*)(lds + 40960);
    LAS float* itot = (LAS float*)(lds + 73728);
    LAS unsigned* sell = (LAS unsigned*)(lds + 81920);
    LAS float* invs = (LAS float*)(lds + 82176);
    LAS f32x16* otl = (LAS f32x16*)(lds + 86016) + (size_t)wid * 128 + lane;
    const size_t rowb = (size_t)b * S;
    for (int i = tid; i < 1024; i += 512) ((LAS float*)(lds + 32768))[i] = A.rel_bias[g * 1024 + i];
    { const unsigned char* Kc = (const unsigned char*)A.KC + (size_t)(b * 2 + g) * 16384; const unsigned char* Vc = (const unsigned char*)A.VC + (size_t)(b * 2 + g) * 16384;
      stage_img<8>(lds, Kc, wid, lane); stage_img<8>(lds + 8192, Vc, wid, lane);
      stage_img<8>(lds + 16384, Kc + 8192, wid, lane); stage_img<8>(lds + 24576, Vc + 8192, wid, lane); }
    bf16x8 qf[4];
    { const bf16* qp = A.Q + (rowb + qabs) * 512 + head * 64 + hi * 8;
#pragma unroll
      for (int d0 = 0; d0 < 4; ++d0) qf[d0] = *(const bf16x8*)(qp + d0 * 16); }
    ATT_WAIT_BAR();
    const bool need_sel = (qt >= 16);
    {
        NSA_RELANE();
        LAS float* ip = ipart + ((size_t)hh * 64 + (wid & 1) * 32 + r32) * 32 + hi;
        f32x16 o[2]; float l, rmax;
        cmp_pass(lds, qf, bl, ip, need_sel, 0.f, qw0, qabs, lane, r32, hi, o, l, rmax);
        if (__any(rmax > 64.f)) {
            rmax = fmaxf(rmax, __shfl_xor(rmax, 32));
            float dummy;
            cmp_pass(lds, qf, bl, ip, need_sel, fmaxf(rmax, 0.f), qw0, qabs, lane, r32, hi, o, l, dummy);
        }
        l += __shfl_xor(l, 32);
        const float inv = l > 0.f ? 1.f / l : 0.f;
        if (hi == 0) invs[hh * 64 + (wid & 1) * 32 + r32] = inv;
        { int qa = qabs; asm volatile("" : "+v"(qa)); scale_rows<2>(o, A.GN[(rowb + qa) * 24 + head] * inv, wsf, r32, hi); }
        otl[0] = o[0]; otl[64] = o[1];
    }
    ATT_WAIT_BAR();
    unsigned selq, un;
    if (need_sel) {
        {
            const int q = tid >> 3, j4 = (tid & 7) * 4;
#pragma unroll
            for (int jj = 0; jj < 4; ++jj) { const int j = j4 + jj; itot[q * 32 + j] = ((ipart[(0 * 64 + q) * 32 + j] * invs[q] + ipart[(1 * 64 + q) * 32 + j] * invs[64 + q]) + ipart[(2 * 64 + q) * 32 + j] * invs[128 + q]) + ipart[(3 * 64 + q) * 32 + j] * invs[192 + q]; }
        }
        ATT_WAIT_BAR();
        {
            const int j = lane & 31;
#pragma unroll 1
            for (int rd = 0; rd < 4; ++rd) {
                const int q = wid * 8 + rd * 2 + hi;
                const bool vj = j <= qt, fj = (j == 0) || (j == qt) || (j == qt - 1);
                const float sj = vj ? itot[q * 32 + j] + (fj ? 1e4f : 0.f) : -1e30f;
                int cnt = 0;
#pragma unroll 4
                for (int k = 0; k < 32; ++k) {
                    const bool vk = k <= qt, fk = (k == 0) || (k == qt) || (k == qt - 1);
                    const float sk = vk ? itot[q * 32 + k] + (fk ? 1e4f : 0.f) : -1e30f;
                    cnt += (sk > sj || (sk == sj && k < j)) ? 1 : 0;
                }
                const unsigned long long bal = __ballot(cnt < 16);
                if (lane == 0) sell[q] = (unsigned)bal;
                if (lane == 32) sell[q] = (unsigned)(bal >> 32);
            }
        }
        ATT_WAIT_BAR();
        NSA_RELANE();
        selq = sell[(wid & 1) * 32 + r32];
        un = sell[lane];
#pragma unroll
        for (int sft = 1; sft < 64; sft <<= 1) un |= __shfl_xor(un, sft);
        un = __builtin_amdgcn_readfirstlane(un) & (qt >= 31 ? 0xffffffffu : ((2u << qt) - 1u));
    } else {
        selq = (2u << qt) - 1u; un = selq;
    }
    for (int i = tid; i < 5120; i += 512) ipart[i] = A.biasv[(size_t)g * 5120 + i];
    const LAS float* rt = ipart + hh * 1280;
    {
        NSA_RELANE();
        const unsigned char* Kg = (const unsigned char*)A.KS + (size_t)(b * 2 + g) * 32 * 8192; const unsigned char* Vg = (const unsigned char*)A.VS + (size_t)(b * 2 + g) * 32 * 8192;
        f32x16 o[2]; o[0] = (f32x16){0.f, 0.f, 0.f, 0.f, 0.f, 0.f, 0.f, 0.f, 0.f, 0.f, 0.f, 0.f, 0.f, 0.f, 0.f, 0.f}; o[1] = o[0];
        float m = 0.f, l = 0.f;
        unsigned rem = un; int j = __builtin_ctz(rem); rem &= rem - 1u; int it = 0;
        stage_img<8>(lds, Kg + (size_t)j * 8192, wid, lane); stage_img<8>(lds + 8192, Vg + (size_t)j * 8192, wid, lane);
        ATT_WAIT_BAR();
        for (;;) {
            LAS unsigned char* cur = lds + (it & 1) * 16384; LAS unsigned char* nxt = lds + ((it + 1) & 1) * 16384;
            const int jn = rem ? __builtin_ctz(rem) : -1;
            if (jn >= 0) { rem &= rem - 1u; stage_img<8>(nxt, Kg + (size_t)jn * 8192, wid, lane); stage_img<8>(nxt + 8192, Vg + (size_t)jn * 8192, wid, lane); }
            const int kt0 = j * 64;
            if (kt0 <= qw0 + 31 && __any((selq >> j) & 1u)) {
                f32x16 p0, p1;
                qk_tile(p0, p1, cur, 0, qf, r32, hi);
                const bool causal = (kt0 + 63 > qw0), near_ = (qw0 - (kt0 + 63) < 113);
                if (causal || near_) bias_vec(p0, p1, rt, qabs - kt0, hi);
                if (!__all((selq >> j) & 1u)) {
                    const float off = ((selq >> j) & 1u) ? 0.f : NEGB;
#pragma unroll
                    for (int r = 0; r < 16; ++r) { p0[r] += off; p1[r] += off; } }
                softmax_step<2>(p0, p1, m, l, o, wsf, r32, hi);
                pv_tile<2>(o, cur + 8192, p0, p1, lane);
            }
            ATT_WAIT_BAR();
            if (jn < 0) break;
            j = jn; ++it;
        }
        l += __shfl_xor(l, 32);
        { int qa = qabs; asm volatile("" : "+v"(qa)); scale_rows<2>(o, A.GN[(rowb + qa) * 24 + 8 + head] / l, wsf, r32, hi); }
        otl[0] = otl[0] + o[0]; otl[64] = otl[64] + o[1];
    }
    f32x16 ot[2];
    {
        NSA_RELANE();
        const unsigned char* Kg = (const unsigned char*)A.KW + (size_t)(b * 2 + g) * 32 * 8192; const unsigned char* Vg = (const unsigned char*)A.VW + (size_t)(b * 2 + g) * 32 * 8192;
        f32x16 o[2]; o[0] = (f32x16){0.f, 0.f, 0.f, 0.f, 0.f, 0.f, 0.f, 0.f, 0.f, 0.f, 0.f, 0.f, 0.f, 0.f, 0.f, 0.f}; o[1] = o[0];
        float m = 0.f, l = 0.f;
        const int j0 = qt >= 8 ? qt - 8 : 0;
        stage_img<8>(lds, Kg + (size_t)j0 * 8192, wid, lane); stage_img<8>(lds + 8192, Vg + (size_t)j0 * 8192, wid, lane);
        ATT_WAIT_BAR();
        for (int j = j0; j <= qt; ++j) {
            const int it = j - j0;
            LAS unsigned char* cur = lds + (it & 1) * 16384; LAS unsigned char* nxt = lds + ((it + 1) & 1) * 16384;
            if (j < qt) { stage_img<8>(nxt, Kg + (size_t)(j + 1) * 8192, wid, lane); stage_img<8>(nxt + 8192, Vg + (size_t)(j + 1) * 8192, wid, lane); }
            const int kt0 = j * 64;
            if (kt0 <= qw0 + 31) {
                f32x16 p0, p1;
                qk_tile(p0, p1, cur, 0, qf, r32, hi);
                const bool causal = (kt0 + 63 > qw0), near_ = (qw0 - (kt0 + 63) < 113), band = (qw0 + 31 - kt0 >= 512);
                if (causal || near_) bias_vec(p0, p1, rt, qabs - kt0, hi);
                else if (band) bias_mask<false, false, true>(p0, p1, bl, qabs, kt0, hi);
                softmax_step<2>(p0, p1, m, l, o, wsf, r32, hi);
                pv_tile<2>(o, cur + 8192, p0, p1, lane);
            }
            ATT_WAIT_BAR();
        }
        l += __shfl_xor(l, 32);
        { int qa = qabs; asm volatile("" : "+v"(qa)); scale_rows<2>(o, A.GN[(rowb + qa) * 24 + 16 + head] / l, wsf, r32, hi); }
        ot[0] = otl[0] + o[0]; ot[1] = otl[64] + o[1];
    }
    {   int hi_ = hi, r32_ = r32; asm volatile("" : "+v"(hi_), "+v"(r32_));
        bf16* op = A.O + (rowb + qw0 + 4 * hi_) * 512 + head * 64 + r32_;
#pragma unroll
        for (int eb = 0; eb < 2; ++eb)
#pragma unroll
            for (int r = 0; r < 16; ++r) op[(size_t)((r & 3) + 8 * (r >> 2)) * 512 + eb * 32] = f2bf(ot[eb][r]); }
#undef NSA_RELANE
}
}

constexpr int NCLS = 24;
constexpr int CW_CMPD = 10752, CW_FIN = 11008;
constexpr int CW_WQ = 10240;
constexpr int CW_CNT = 8192;
constexpr size_t WS_LIST = 254 * MiB;
constexpr int MISC_OFF = 161792;
constexpr int TAB_OFF = MISC_OFF + 256;
__device__ __forceinline__ void class_experts(int c, int& ea, int& eb) {
    const int g = c / 6, p = c % 6; const int a = p < 3 ? 0 : (p < 5 ? 1 : 2); const int b = p < 3 ? p + 1 : (p < 5 ? p - 1 : 3); ea = g * 4 + a; eb = g * 4 + b; }
__device__ __forceinline__ void moe_build_tab(const unsigned* ctl, LAS int* tab) {
    if (threadIdx.x < 64) {
        const int lane = threadIdx.x;
        const int n = (lane < NCLS) ? (int)__hip_atomic_load(ctl + CW_CNT + 64 * lane, __ATOMIC_RELAXED, __HIP_MEMORY_SCOPE_AGENT) : 0;
        const int nt_ = (n + 255) >> 8;
        int pre = nt_;
#pragma unroll
        for (int o = 1; o < 32; o <<= 1) { const int v = __shfl_up(pre, o); if (lane >= o) pre += v; }
        const int first = pre - nt_;
        if (lane < NCLS) { tab[lane] = first; tab[32 + lane] = n; for (int j = 0; j < nt_; ++j) tab[64 + first + j] = lane; }
        if (lane == NCLS - 1) tab[NCLS] = pre;
    }
    __syncthreads();
}
struct OpsGU { const bf16* H2; const bf16* WGU; const unsigned* LIST; const LAS int* tab; static constexpr int NT = 16, LDB = 1024;
    __device__ __forceinline__ const char* a_base(const pg8::Unit&) const { return (const char*)H2; }
    __device__ __forceinline__ void a_voff(const pg8::Unit& u, const int (&R)[2], const int (&C)[2], unsigned (&out)[2][2]) const {
        const int c = tab[64 + u.pm], n = tab[32 + c], r0 = (u.pm - tab[c]) * 256;
#pragma unroll
        for (int h = 0; h < 2; ++h)
#pragma unroll
            for (int i = 0; i < 2; ++i) { const int r = r0 + h * 128 + R[i]; const unsigned tok = (r < n) ? LIST[(size_t)c * T + r] : 0u; out[h][i] = (tok * 1024u + (unsigned)C[i]) * 2u; } }
    __device__ __forceinline__ void bprep(const pg8::Unit& u, const char*& p0, const char*& p1) const {
        int ea, eb; class_experts(tab[64 + u.pm], ea, eb); const int e = u.z ? eb : ea; p0 = (const char*)(WGU + ((size_t)e * 1024 + u.pn * 256) * 1024); p1 = p0; }
    __device__ static __forceinline__ const char* bat(const char* p0, const char*, int kt) { return p0 + (size_t)kt * 128; } };
constexpr int CW_MQ = 10496;
constexpr int CW_DONE = 12288;
struct SchedGU { const LAS int* tab; int G, vcu;
    __device__ __forceinline__ bool next(int i, pg8::Unit& u) const { const int L = i * G + vcu; if (L >= tab[NCLS] * 8) return false; u.pm = L >> 3; u.z = (L >> 2) & 1; u.pn = L & 3; return true; } };
struct EpiGU { bf16* HID; const unsigned* LIST; const float* ROUTE; const LAS int* tab; unsigned* ctl;
    __device__ __forceinline__ void operator()(const pg8::f32x4 (&acc)[2][2][4][2], const pg8::Unit& u, int wr, int wc, int fr_, int fq_) const {
        int fr = fr_, fq = fq_; asm volatile("" : "+v"(fr), "+v"(fq));
        const int c = tab[64 + u.pm], n = tab[32 + c], r0 = (u.pm - tab[c]) * 256;
        const __amdgpu_buffer_rsrc_t rsrc = __builtin_amdgcn_make_buffer_rsrc((void*)HID, 0, 0x7fffffff, 0x00020000);
#pragma unroll
        for (int ai = 0; ai < 2; ++ai)
#pragma unroll
            for (int m = 0; m < 4; ++m) {
                const int rl = ai * 128 + wr * 64 + m * 16 + fr, r = r0 + rl;
                if (r < n) {
                    const unsigned tok = LIST[(size_t)c * T + r]; const float w = ROUTE[(size_t)tok * 4 + u.z], rs = ROUTE[(size_t)tok * 4 + 3];
                    float v[8];
#pragma unroll
                    for (int nn = 0; nn < 2; ++nn)
#pragma unroll
                        for (int i = 0; i < 4; ++i) { const float gt = acc[ai][0][m][nn][i] * rs, up = acc[ai][1][m][nn][i] * rs; v[4 * nn + i] = gt * __builtin_amdgcn_rcpf(1.f + __builtin_amdgcn_exp2f(-1.4426950408889634f * gt)) * up * w; }
                    uint4 o; o.x = pg8::cvt_pk_bf16(v[0], v[1]); o.y = pg8::cvt_pk_bf16(v[2], v[3]); o.z = pg8::cvt_pk_bf16(v[4], v[5]); o.w = pg8::cvt_pk_bf16(v[6], v[7]);
                    __builtin_amdgcn_raw_buffer_store_b128(__builtin_bit_cast(pg8::u32x4, o), rsrc, (int)(((unsigned)(u.pm * 256 + rl) * 1024u + (unsigned)(u.z * 512 + u.pn * 128 + wc * 32 + 8 * fq)) * 2u), 0, 16);
                }
                asm volatile("" ::: "memory");
            }
        asm volatile("s_waitcnt vmcnt(0)" ::: "memory");
        if (fr == 0 && fq == 0) __hip_atomic_fetch_add(ctl + CW_DONE + 64 * u.pm, 1u, __ATOMIC_RELAXED, __HIP_MEMORY_SCOPE_AGENT);
    }
};
struct OpsDN { const bf16* HID; const bf16* WDN; const LAS int* tab; static constexpr int NT = 16, LDB = 512;
    __device__ __forceinline__ const char* a_base(const pg8::Unit& u) const { return (const char*)(HID + (size_t)u.pm * 256 * 1024); }
    __device__ __forceinline__ void a_voff(const pg8::Unit&, const int (&R)[2], const int (&C)[2], unsigned (&out)[2][2]) const {
#pragma unroll
        for (int h = 0; h < 2; ++h)
#pragma unroll
            for (int i = 0; i < 2; ++i) out[h][i] = (unsigned)((h * 128 + R[i]) * 1024 + C[i]) * 2u; }
    __device__ __forceinline__ void bprep(const pg8::Unit& u, const char*& p0, const char*& p1) const {
        int ea, eb; class_experts(tab[64 + u.pm], ea, eb);
        p0 = (const char*)(WDN + ((size_t)ea * 1024 + u.pn * 256) * 512); p1 = (const char*)(WDN + ((size_t)eb * 1024 + u.pn * 256) * 512); }
    __device__ static __forceinline__ const char* bat(const char* p0, const char* p1, int kt) { return (kt < 8 ? p0 : p1) + (size_t)(kt & 7) * 128; } };
struct SchedDN { const LAS int* tab; unsigned* ctl; int G, vcu, which;
    __device__ __forceinline__ bool next(int i, pg8::Unit& u) const {
        if (i > 0) return false;
        const int total = tab[NCLS] * 4;
        int L = -1;
        if (which == 0) L = vcu; else { const int e = G - 1 - vcu; if (G + e < total) L = G + e; }
        if (L < 0 || L >= total) L = -1;
        __builtin_amdgcn_s_barrier();
        if (threadIdx.x == 0 && L >= 0) {
            unsigned* dn = ctl + CW_DONE + 64 * (L >> 2); unsigned sp = 0;
            while (__hip_atomic_load(dn, __ATOMIC_RELAXED, __HIP_MEMORY_SCOPE_AGENT) < 64u) { __builtin_amdgcn_s_sleep(2); if (++sp > (1u << 22)) { atomicAdd(ctl + XB_TMO + CW_BAR, 1u); break; } }
            __builtin_amdgcn_fence(__ATOMIC_ACQUIRE, "agent");
            asm volatile("s_waitcnt vmcnt(0)" ::: "memory");
        }
        __builtin_amdgcn_s_barrier();
        if (L < 0) return false; u.pm = L >> 2; u.pn = L & 3; u.z = 0; return true; } };
struct EpiDN { float* O; const bf16* X2; const unsigned* LIST; const LAS int* tab;
    __device__ __forceinline__ void operator()(const pg8::f32x4 (&acc)[2][2][4][2], const pg8::Unit& u, int wr, int wc, int fr_, int fq_) const {
        int fr = fr_, fq = fq_; asm volatile("" : "+v"(fr), "+v"(fq));
        const int c = tab[64 + u.pm], n = tab[32 + c], r0 = (u.pm - tab[c]) * 256;
#pragma unroll
        for (int ai = 0; ai < 2; ++ai)
#pragma unroll
            for (int m = 0; m < 4; ++m) {
                const int r = r0 + ai * 128 + wr * 64 + m * 16 + fr;
                if (r < n) {
                    const unsigned tok = LIST[(size_t)c * T + r];
#pragma unroll
                    for (int bj = 0; bj < 2; ++bj) { const size_t off = (size_t)tok * 1024 + u.pn * 256 + bj * 128 + wc * 32 + 8 * fq;
                        const uint4 xw = *(const uint4*)(X2 + off); const pg8::f32x4 a0 = acc[ai][bj][m][0], a1 = acc[ai][bj][m][1];
                        const nt_f32x4 y0 = {LO16(xw.x) + a0[0], HI16(xw.x) + a0[1], LO16(xw.y) + a0[2], HI16(xw.y) + a0[3]}, y1 = {LO16(xw.z) + a1[0], HI16(xw.z) + a1[1], LO16(xw.w) + a1[2], HI16(xw.w) + a1[3]};
                        __builtin_nontemporal_store(y0, (nt_f32x4*)(O + off)); __builtin_nontemporal_store(y1, (nt_f32x4*)(O + off + 4)); }
                }
            }
    }
};

constexpr int NTHR = 512;
constexpr int LDS_BYTES = 163840;

__global__ void __launch_bounds__(NTHR, 2) fwd_kernel(Args args) {
    extern __shared__ __attribute__((aligned(16))) unsigned char lds[];
    const int tid = threadIdx.x, lane = tid & 63;
    const int gtid = blockIdx.x * NTHR + tid, nthreads = gridDim.x * NTHR;
    const int gwave = gtid >> 6, nwaves = nthreads >> 6;
    Ctx c; c.a = args; unsigned char* ws = args.ws;

    volatile LAS unsigned* MISC = (volatile LAS unsigned*)((LAS unsigned char*)lds + MISC_OFF);
    if (tid < 32) MISC[tid] = 0u;
    __syncthreads();
    XcdBarrier bar = xcd_barrier_post((unsigned*)(ws + WS_CTL) + CW_BAR, MISC + 8);
    const int lo = args.ph_lo, hi = args.ph_hi;
#ifdef ONLY_PHASE
#define IN(k) ((k) == ONLY_PHASE)
#else
#define IN(k) (lo <= (k) && (k) < hi)
#endif
#define SEAM(k) do { if (IN(k) && IN((k) + 1)) xcd_barrier(bar); } while (0)


    if (IN(0)) {
        for (int t = gwave * 2; t < T; t += nwaves * 2) {
            const float4* xr = (const float4*)(c.x() + (size_t)t * D) + lane;
            float4 v[8]; float s0 = 0.f, s1 = 0.f;
#pragma unroll
            for (int j = 0; j < 8; ++j) v[j] = xr[64 * j];
#pragma unroll
            for (int j = 0; j < 4; ++j) { s0 += v[j].x * v[j].x + v[j].y * v[j].y + v[j].z * v[j].z + v[j].w * v[j].w; s1 += v[4 + j].x * v[4 + j].x + v[4 + j].y * v[4 + j].y + v[4 + j].z * v[4 + j].z + v[4 + j].w * v[4 + j].w; }
            const float r0 = rsqrtf(wave_sum(s0) * (1.f / D) + RMS_EPS), r1 = rsqrtf(wave_sum(s1) * (1.f / D) + RMS_EPS);
#pragma unroll
            for (int j = 0; j < 8; ++j) { const float4 g = ((const float4*)c.norm1_g())[lane + 64 * (j & 3)]; const float r = j < 4 ? r0 : r1;
                uint2 o; o.x = pk2bf(v[j].x * r * g.x, v[j].y * r * g.y); o.y = pk2bf(v[j].z * r * g.z, v[j].w * r * g.w);
                ((uint2*)(c.H1() + (size_t)t * D))[lane + 64 * j] = o; }
        }
        {
            LAS float* scr = (LAS float*)((LAS unsigned char*)lds + (tid >> 6) * 16384);
            constexpr int I_IN = 16 * 160, I_OUT = 16 * 32, I_BR = 8 * 32, I_GU = 16 * 4 * 2 * 4 * 16, I_DN = 16 * 8 * 32, I_C1 = 512;
            for (int it = gwave; it < I_IN + I_OUT + 2 * I_BR + I_GU + I_DN + I_C1; it += nwaves) {
                int r = it;
                if (r < I_IN) { const int kb = r / 160, vb = r % 160, pn = vb >> 3, bj = (vb >> 2) & 1, wc = vb & 3;
                    const ChunkDesc d = chunk_desc(c, pn * 4 + wc); int nv = d.ncols - 32 * bj; nv = nv < 0 ? 0 : (nv > 32 ? 32 : nv);
                    tr_item(c.w_in(), INC, 64 * kb, d.src + 32 * bj, nv, c.WIN(), 1024, 256 * pn + 128 * bj + 32 * wc, scr, lane); continue; }
                r -= I_IN;
                if (r < I_OUT) { tr_item(c.w_out(), 1024, 64 * (r / 32), 32 * (r % 32), 32, c.WOUT(), 1024, 32 * (r % 32), scr, lane); continue; }
                r -= I_OUT;
                if (r < I_BR) { tr_item(c.w_bn(), 1024, 64 * (r / 32), 32 * (r % 32), 32, c.WBN(), 512, 32 * (r % 32), scr, lane); continue; }
                r -= I_BR;
                if (r < I_BR) { tr_item(c.w_bd(), 1024, 64 * (r / 32), 32 * (r % 32), 32, c.WBD(), 512, 32 * (r % 32), scr, lane); continue; }
                r -= I_BR;
                if (r < I_GU) { const int kb = r & 15, blk = (r >> 4) & 3, bj = (r >> 6) & 1, ntile = (r >> 7) & 3, e = r >> 9;
                    tr_item((bj ? c.w_up() : c.w_gate()) + (size_t)e * 1024 * 512, 512, 64 * kb, ntile * 128 + 32 * blk, 32, c.WGU() + (size_t)e * 1024 * 1024, 1024, 256 * ntile + 128 * bj + 32 * blk, scr, lane, c.norm2_g()); continue; }
                r -= I_GU;
                if (r < I_DN) { const int nb = r & 31, kb = (r >> 5) & 7, e = r >> 8;
                    tr_item(c.w_down() + (size_t)e * 512 * 1024, 1024, 64 * kb, 32 * nb, 32, c.WDN() + (size_t)e * 1024 * 512, 512, 32 * nb, scr, lane); continue; }
                r -= I_DN;
                { const int nb = r & 7, kb = (r >> 3) & 15, bot = (r >> 7) & 1, kv = r >> 8;
                    tr_item(c.cmp_w1() + (size_t)kv * 2048 * 256 + (size_t)bot * 1024 * 256, 256, 64 * kb, 32 * nb, 32, c.WC1() + (size_t)kv * 512 * 1024, 1024, bot * 256 + 32 * nb, scr, lane); }
            }
            if (gwave >= nwaves - 64) { const int w = gwave - (nwaves - 64), sl = w & 7, jb = (w >> 3) & 3, kv = w >> 5, j = jb * 64 + lane;
                const float* w1 = c.cmp_w1() + (size_t)kv * 2048 * 256 + (size_t)sl * 256 * 256 + j; const float* pos = c.cmp_pos() + kv * 2048 + sl * 256;
                float a0 = 0.f, a1 = 0.f, a2 = 0.f, a3 = 0.f;
                for (int k = 0; k < 256; k += 4) { a0 += pos[k] * w1[(size_t)k * 256]; a1 += pos[k + 1] * w1[(size_t)(k + 1) * 256]; a2 += pos[k + 2] * w1[(size_t)(k + 2) * 256]; a3 += pos[k + 3] * w1[(size_t)(k + 3) * 256]; }
                c.POSB()[(sl * 2 + kv) * 256 + j] = (a0 + a1) + (a2 + a3); }
            if (gtid >= 8192 && gtid < 8192 + 12 * 1280) { const int i = gtid - 8192, hd = i / 1280, a = (i % 1280) / 320, j = (i % 320) + a, d = 208 - j;
                c.BIASV()[i] = (d < 0) ? -1e30f : (d >= 113 ? 0.f : (c.rel_bias()[t5_bucket(d) * 12 + hd] - c.rel_bias()[31 * 12 + hd]) * 1.4426950408889634f); }
            if (gtid >= 24576 && gtid < 24576 + 1024) { const int k = gtid - 24576; const float g = c.norm2_g()[k];
                const float4 gw = *(const float4*)(c.rg_w() + (size_t)k * 4);
                float w[20] = {gw.x, gw.y, gw.z, gw.w};
#pragma unroll
                for (int i4 = 0; i4 < 4; ++i4) { const float4 ew = *(const float4*)(c.re_w() + (size_t)k * 16 + 4 * i4); w[4 + 4 * i4] = ew.x; w[5 + 4 * i4] = ew.y; w[6 + 4 * i4] = ew.z; w[7 + 4 * i4] = ew.w; }
                bf16* wr = c.WRT() + k;
#pragma unroll
                for (int i = 0; i < 20; ++i) { const float v = w[i] * g; const bf16 h = f2bf(v); wr[(size_t)i * D] = h; wr[(size_t)(20 + i) * D] = f2bf(v - __uint_as_float((unsigned)h << 16)); }
#pragma unroll
                for (int i = 40; i < 48; ++i) wr[(size_t)i * D] = f2bf(0.f); }
            if (gtid >= 4096 && gtid < 4096 + 3072) { const int i = gtid - 4096, hd = i >> 8, d = i & 255; c.BIAS()[i] = (c.rel_bias()[t5_bucket(d) * 12 + hd] - c.rel_bias()[31 * 12 + hd]) * 1.4426950408889634f; }
            if (gtid >= 512 && gtid < 512 + 2048) { const int i = gtid - 512, kv = i >> 10, bg = (i >> 6) & 15, e = i & 63; const size_t tb = ((size_t)bg * 2 + 1) * 4096; if (kv) c.VCMP()[tb + (e >> 5) * 2048 + 3 * 512 + 15 * 32 + (e & 31)] = 0; else c.KCMP()[tb + (e >> 3) * 512 + 63 * 8 + (e & 7)] = 0; }
        }
        if (gwave == 0) {
            const float a = wave_sum(c.diff_lambda()[lane] * c.diff_lambda()[64 + lane]);
            const float b = wave_sum(c.diff_lambda()[128 + lane] * c.diff_lambda()[192 + lane]);
            if (lane == 0) c.LAM()[0] = expf(a) - expf(b) + LAMBDA_INIT;
        }
    }
    xcd_barrier(bar);

    if (IN(1)) {
        pg8::Ops g; g.A0 = c.H1(); g.A1 = c.H1(); g.B0 = c.WIN(); g.B1 = c.WIN(); g.K = 1024;
        pg8::StaticOrder<1> So; So.init(T, 5120, (int)gridDim.x, (int)blockIdx.x);
        EpiInProj E; E.c = c;
        pg8::gemm_phase(( LAS unsigned char*)lds, g, So, E);
    }
    xcd_barrier(bar);

    if (IN(2)) {
        pg8::Ops g; g.A0 = c.CT(); g.A1 = c.CT(); g.B0 = c.WC1(); g.B1 = c.WC1() + 512 * 1024; g.K = 1024;
        SchedCmp So; So.c = (int)blockIdx.x;
        EpiF32 E; E.O = c.U(); E.ldc = 512;
        pg8::gemm_phase((LAS unsigned char*)lds, g, So, E);
        unsigned* ctl = (unsigned*)(ws + WS_CTL);
        volatile LAS int* wq = (volatile LAS int*)((LAS unsigned char*)lds + MISC_OFF + 64);
        if (blockIdx.x < 32 && tid == 0) { __builtin_amdgcn_fence(__ATOMIC_RELEASE, "agent"); asm volatile("s_waitcnt vmcnt(0)" ::: "memory");
            __hip_atomic_fetch_add(ctl + CW_CMPD, 1u, __ATOMIC_RELAXED, __HIP_MEMORY_SCOPE_AGENT); }
        {   att::DiffArgs A; A.Q = c.QD(); A.K = c.KD(); A.V = c.VD(); A.O = c.ODIFF(); A.biasv = c.BIASV(); A.out_gain = c.diff_out_norm(); A.lam = c.LAM()[0];
            LAS float* hid = (LAS float*)((LAS unsigned char*)lds) + (tid >> 6) * 1024;
            bool cmpd_seen = false;
            for (;;) {
                __syncthreads();
                if (tid == 0) {
                    const int u = (int)atomicAdd(ctl + CW_WQ, 1u);
                    if (u >= 256 && u < 384 && !cmpd_seen) { unsigned sp = 0;
                        while (__hip_atomic_load(ctl + CW_CMPD, __ATOMIC_RELAXED, __HIP_MEMORY_SCOPE_AGENT) < 32u) { __builtin_amdgcn_s_sleep(2); if (++sp > (1u << 22)) { atomicAdd(ctl + XB_TMO + CW_BAR, 1u); break; } }
                        __builtin_amdgcn_fence(__ATOMIC_ACQUIRE, "agent"); asm volatile("s_waitcnt vmcnt(0)" ::: "memory"); cmpd_seen = true; }
                    *wq = u;
                }
                __syncthreads();
                const int u = *wq;
                if (u >= 640) break;
                if (u < 256 || u >= 384) { const int du = u < 256 ? u : u - 128; att::diff_unit((LAS unsigned char*)lds, A, (du & 31) >> 2, du & 3, 15 - (du >> 5)); continue; }
                const int q = u - 256;
                const int quarter = q & 3, b = (q >> 2) & 7, g = (q >> 5) & 1, kv = q >> 6;
                const int n0 = quarter * 32 + (tid >> 6) * 4;
#pragma unroll
                for (int jj = 0; jj < 4; ++jj) {
                    const int n = (n0 + jj < NCMP) ? n0 + jj : NCMP - 1;
                    const float* u1 = c.U() + ((size_t)(kv * 2 + g) * 1024 + b * 128 + n) * 512;
                    const float4 t4 = *(const float4*)(u1 + 4 * lane), b4 = *(const float4*)(u1 + 512 + 256 + 4 * lane), p4 = posb_sum(c.POSB() + kv * 256 + 4 * lane);
                    const float hv[4] = {t4.x + b4.x + p4.x, t4.y + b4.y + p4.y, t4.z + b4.z + p4.z, t4.w + b4.w + p4.w};
#pragma unroll
                    for (int i = 0; i < 4; ++i) { const float a = hv[i]; const float uu = 0.7978845608028654f * (a + 0.044715f * a * a * a); hid[jj * 256 + 4 * lane + i] = 0.5f * a * (1.f + tanhf(uu)); }
                }
                const float* w2 = c.cmp_w2() + (size_t)kv * 256 * 64 + lane;
                float o[4] = {0.f, 0.f, 0.f, 0.f};
#pragma unroll 16
                for (int j = 0; j < 256; ++j) { const float w = w2[j * 64]; o[0] += hid[j] * w; o[1] += hid[256 + j] * w; o[2] += hid[512 + j] * w; o[3] += hid[768 + j] * w; }
#pragma unroll
                for (int jj = 0; jj < 4; ++jj) {
                    const int n = n0 + jj; float ov = o[jj];
                    if (kv == 0) { const float ss = wave_sum(ov * ov); ov = ov * rsqrtf(ss * (1.f / 64.f) + RMS_EPS) * c.nsa_k_norm()[lane]; }
                    if (n < NCMP) { const int key = n & 63, e = lane; const size_t tb = ((size_t)(b * 2 + g) * 2 + (n >> 6)) * 4096;
                      if (kv) c.VCMP()[tb + (e >> 5) * 2048 + (key >> 4) * 512 + (key & 15) * 32 + (e & 31)] = f2bf(ov);
                      else c.KCMP()[tb + (e >> 3) * 512 + key * 8 + (e & 7)] = f2bf(ov); }
                }
                asm volatile("s_waitcnt vmcnt(0)" ::: "memory");
                __syncthreads();
                if (tid == 0) { __builtin_amdgcn_fence(__ATOMIC_RELEASE, "agent"); asm volatile("s_waitcnt vmcnt(0)" ::: "memory");
                    __hip_atomic_fetch_add(ctl + CW_FIN + 64 * (b * 2 + g), 1u, __ATOMIC_RELAXED, __HIP_MEMORY_SCOPE_AGENT); }
            } }
        {   att::NsaArgs A; A.Q = c.QN(); A.KS = c.KS(); A.VS = c.VS(); A.KW = c.KW(); A.VW = c.VW(); A.KC = c.KCMP(); A.VC = c.VCMP(); A.GN = c.GN(); A.O = c.ONSAB(); A.rel_bias = c.BIAS(); A.biasv = c.BIASV();
            bool all_seen = false;
            for (;;) {
                __syncthreads();
                if (tid == 0) {
                    const int u = (int)atomicAdd(ctl + CW_WQ + 64, 1u);
                    if (u < 512 && !all_seen) {
                        unsigned* fc = ctl + CW_FIN + 64 * (u & 15); unsigned sp = 0;
                        while (__hip_atomic_load(fc, __ATOMIC_RELAXED, __HIP_MEMORY_SCOPE_AGENT) < 8u) { __builtin_amdgcn_s_sleep(2); if (++sp > (1u << 22)) { atomicAdd(ctl + XB_TMO + CW_BAR, 1u); break; } }
                        unsigned fv[16];
#pragma unroll
                        for (int k = 0; k < 16; ++k) fv[k] = __hip_atomic_load(ctl + CW_FIN + 64 * k, __ATOMIC_RELAXED, __HIP_MEMORY_SCOPE_AGENT);
                        bool all = true;
#pragma unroll
                        for (int k = 0; k < 16; ++k) all = all & (fv[k] >= 8u);
                        __builtin_amdgcn_fence(__ATOMIC_ACQUIRE, "agent"); asm volatile("s_waitcnt vmcnt(0)" ::: "memory");
                        all_seen = all;
                    }
                    *wq = u;
                }
                __syncthreads();
                const int u = *wq;
                if (u >= 512) break;
                att::nsa_unit((LAS unsigned char*)lds, A, (u & 15) >> 1, u & 1, 31 - (u >> 4));
            } }
    }
    xcd_barrier(bar);
    if (IN(7)) {
        pg8::Ops g; g.A0 = c.ONSAB(); g.A1 = c.ODIFF(); g.B0 = c.WBN(); g.B1 = c.WBD(); g.K = 512;
        pg8::StaticOrder<2> So; So.init(T, 1024, (int)gridDim.x, (int)blockIdx.x);
        EpiMerge E; E.Y = c.Y(); E.GM = c.GM();
        pg8::gemm_phase((LAS unsigned char*)lds, g, So, E);
    }
    xcd_barrier(bar);
    if (IN(8)) {
        pg8::Ops g; g.A0 = c.Y(); g.A1 = c.Y(); g.B0 = c.WOUT(); g.B1 = c.WOUT(); g.K = 1024;
        pg8::StaticOrder<1> So; So.init(T, 1024, (int)gridDim.x, (int)blockIdx.x);
        EpiResid E; E.X = c.x(); E.O = c.X2B();
        pg8::gemm_phase((LAS unsigned char*)lds, g, So, E);
    }
    xcd_barrier(bar);
    if (IN(9)) {
        unsigned* ctl = (unsigned*)(ws + WS_CTL); unsigned* LIST = (unsigned*)(ws + WS_LIST);
        LAS float* Pl = (LAS float*)lds;
        LAS float* Sl = (LAS float*)((LAS unsigned char*)lds + 24576);
        LAS unsigned char* Wl = (LAS unsigned char*)lds + 32768;
        const int wid = tid >> 6, rt = wid & 3, kh = wid >> 2, fr = lane & 15, fq = lane >> 4;
        for (int tb = blockIdx.x; tb < T / 64; tb += gridDim.x) {
            const bf16* xp = c.X2B() + (size_t)(tb * 64 + rt * 16 + fr) * D + kh * 512 + fq * 8;
            pg8::bf16x8 xv[16];
#pragma unroll
            for (int ks = 0; ks < 16; ++ks) xv[ks] = *(const pg8::bf16x8*)(xp + 32 * ks);
            if (tb == (int)blockIdx.x) {
                const pg8::u32x4* wsrc = (const pg8::u32x4*)c.WRT();
                pg8::u32x4 wq[12];
#pragma unroll
                for (int j = 0; j < 12; ++j) wq[j] = wsrc[tid + 512 * j];
#pragma unroll
                for (int j = 0; j < 12; ++j) { const int q = tid + 512 * j; *(LAS pg8::u32x4*)(Wl + (q >> 7) * 2080 + (q & 127) * 16) = wq[j]; } }
            __syncthreads();
            const LAS unsigned char* wl = Wl + fr * 2080 + (kh * 512 + fq * 8) * 2;
            pg8::f32x4 acc[3];
#pragma unroll
            for (int ct = 0; ct < 3; ++ct) acc[ct] = (pg8::f32x4){0.f, 0.f, 0.f, 0.f};
            float ss = 0.f;
#pragma unroll
            for (int ks = 0; ks < 16; ++ks) {
                pg8::bf16x8 wv[3];
#pragma unroll
                for (int ct = 0; ct < 3; ++ct) wv[ct] = *(const LAS pg8::bf16x8*)(wl + ct * 16 * 2080 + 64 * ks);
#pragma unroll
                for (int ct = 0; ct < 3; ++ct) acc[ct] = __builtin_amdgcn_mfma_f32_16x16x32_bf16(wv[ct], xv[ks], acc[ct], 0, 0, 0);
                const pg8::u32x4 xu = __builtin_bit_cast(pg8::u32x4, xv[ks]);
#pragma unroll
                for (int q = 0; q < 4; ++q) { const float a = LO16(xu[q]), b = HI16(xu[q]); ss += a * a + b * b; }
            }
#pragma unroll
            for (int ct = 0; ct < 3; ++ct) *(LAS pg8::f32x4*)(Pl + (size_t)((kh * 64 + rt * 16 + fr) * 48 + 16 * ct + 4 * fq)) = acc[ct];
            Sl[(kh * 4 + fq) * 64 + rt * 16 + fr] = ss;
            __syncthreads();
            if (tid < 64) {
                const LAS float* p0 = Pl + (size_t)lane * 48; const LAS float* p1 = Pl + (size_t)(64 + lane) * 48;
                float ssum = 0.f;
#pragma unroll
                for (int q = 0; q < 8; ++q) ssum += Sl[q * 64 + lane];
                const float rr = rsqrtf(ssum * (1.f / D) + RMS_EPS);
                float gl[4];
#pragma unroll
                for (int i = 0; i < 4; ++i) gl[i] = ((p0[i] + p1[i]) + (p0[20 + i] + p1[20 + i])) * rr + c.rg_b()[i];
                int gt = 0; float gbest = gl[0];
#pragma unroll
                for (int i = 1; i < 4; ++i) if (gl[i] > gbest) { gbest = gl[i]; gt = i; }
                float gs = 0.f;
#pragma unroll
                for (int i = 0; i < 4; ++i) gs += expf(gl[i] - gbest);
                const float gp = 1.f / gs;
                float el[4];
#pragma unroll
                for (int i = 0; i < 4; ++i) { const int jx = 4 + gt * 4 + i; el[i] = ((p0[jx] + p1[jx]) + (p0[20 + jx] + p1[20 + jx])) * rr + c.re_b()[gt * 4 + i]; }
                int e0 = 0; float b0 = el[0];
#pragma unroll
                for (int i = 1; i < 4; ++i) if (el[i] > b0) { b0 = el[i]; e0 = i; }
                int e1 = -1; float b1 = -3.0e38f;
#pragma unroll
                for (int i = 0; i < 4; ++i) if (i != e0 && el[i] > b1) { b1 = el[i]; e1 = i; }
                const float p1e = expf(b1 - b0); const float w0 = gp / (1.f + p1e), w1 = gp * p1e / (1.f + p1e);
                const int ea = e0 < e1 ? e0 : e1, eb = e0 < e1 ? e1 : e0;
                const int pr = (ea == 0) ? eb - 1 : (ea == 1 ? eb + 1 : 5);
                const int mycls = gt * 6 + pr;
                *(float4*)(c.ROUTE() + (size_t)(tb * 64 + lane) * 4) = make_float4(e0 < e1 ? w0 : w1, e0 < e1 ? w1 : w0, __int_as_float(mycls), rr);
                int cnt_l = 0, rank = 0;
                for (int cc = 0; cc < NCLS; ++cc) {
                    const unsigned long long mask = __ballot(mycls == cc);
                    if (lane == cc) cnt_l = __popcll(mask);
                    if (mycls == cc) rank = __popcll(mask & ((1ull << lane) - 1ull));
                }
                unsigned base_l = 0u;
                if (lane < NCLS && cnt_l > 0) base_l = atomicAdd(ctl + CW_CNT + 64 * lane, (unsigned)cnt_l);
                const unsigned base = __shfl(base_l, mycls);
                LIST[(size_t)mycls * T + base + rank] = (unsigned)(tb * 64 + lane);
            }
            __syncthreads();
        }
    }
    xcd_barrier(bar);
    if (IN(10)) {
        LAS int* tab = (LAS int*)((LAS unsigned char*)lds + TAB_OFF);
        moe_build_tab((const unsigned*)(ws + WS_CTL), tab);
        unsigned* ctl = (unsigned*)(ws + WS_CTL);
        const int G = (int)gridDim.x, bx = (int)blockIdx.x, vcu = (G % 8 == 0) ? (bx % 8) * (G / 8) + bx / 8 : bx;
        {   OpsGU g; g.H2 = c.X2B(); g.WGU = c.WGU(); g.LIST = (const unsigned*)(ws + WS_LIST); g.tab = tab;
            SchedGU So; So.tab = tab; So.G = G; So.vcu = vcu;
            EpiGU E; E.HID = c.HID(); E.LIST = (const unsigned*)(ws + WS_LIST); E.ROUTE = c.ROUTE(); E.tab = tab; E.ctl = ctl;
            pg8::gemm_phase_g((LAS unsigned char*)lds, g, So, E); }
        {   OpsDN g; g.HID = c.HID(); g.WDN = c.WDN(); g.tab = tab;
            SchedDN So; So.tab = tab; So.ctl = ctl; So.G = G; So.vcu = vcu;
            EpiDN E; E.O = c.out(); E.X2 = c.X2B(); E.LIST = (const unsigned*)(ws + WS_LIST); E.tab = tab;
#pragma unroll 1
            for (int w = 0; w < 2; ++w) { So.which = w; pg8::gemm_phase_g((LAS unsigned char*)lds, g, So, E); } }
    }
#undef IN
#undef SEAM
}

extern "C" void kernel_launch(void* const* d_in, const int* in_sizes, int n_in, void* d_out, int out_size, void* d_ws, size_t ws_size, hipStream_t stream) {
    static int grid = 0;
    if (grid == 0) {
        if (n_in != 24 || out_size != T * D || ws_size < WS_END) { fprintf(stderr, "kernel_launch: unexpected shapes (n_in %d out %d ws %zu)\n", n_in, out_size, ws_size); grid = -1; return; }
        int dev = 0, cus = 0, per_cu = 0;
        if (hipGetDevice(&dev) != hipSuccess || hipDeviceGetAttribute(&cus, hipDeviceAttributeMultiprocessorCount, dev) != hipSuccess) { grid = -1; return; }
        if (hipFuncSetAttribute((const void*)fwd_kernel, hipFuncAttributeMaxDynamicSharedMemorySize, LDS_BYTES) != hipSuccess) { fprintf(stderr, "kernel_launch: hipFuncSetAttribute failed\n"); grid = -1; return; }
        if (hipOccupancyMaxActiveBlocksPerMultiprocessor(&per_cu, (const void*)fwd_kernel, NTHR, LDS_BYTES) != hipSuccess || per_cu < 1) { fprintf(stderr, "kernel_launch: occupancy query says %d\n", per_cu); }
        (void)hipGetLastError();
        grid = cus;
    }
    if (grid < 0) return;
    (void)hipMemsetAsync((char*)d_ws + WS_CTL, 0, CTL_ZERO_BYTES, stream);
    Args a{};
    for (int i = 0; i < 24; ++i) a.in[i] = (const float*)d_in[i];
    a.out = (float*)d_out; a.ws = (unsigned char*)d_ws; a.ph_lo = 0; a.ph_hi = 11;
    hipLaunchKernelGGL(fwd_kernel, dim3(grid), dim3(NTHR), LDS_BYTES, stream, a);
}
```
